# Optimizing an MI355X kernel written in HIP

```python
import jax, jax.numpy as jnp
from jax import lax
import numpy as np

D_MODEL = 1024
BATCH = 8
SEQ = 4096
DEPTH = 1

D_RNN = D_MODEL
RNN_HEADS = 8
RNN_HEAD_DIM = D_RNN // RNN_HEADS
CONV_WIDTH = 4
LRU_C = 8.0
D_GMLP = D_MODEL
GMLP_HEADS = 8
GMLP_HEAD_DIM = D_GMLP // GMLP_HEADS
CHUNK = 128
N_BRANCH = 2
D_IN = 2 * D_RNN + 2 * D_GMLP + N_BRANCH * D_MODEL
PEER_HEADS = 8
N_KEYS = 128
N_EXPERTS = N_KEYS * N_KEYS
D_KEY = 256
D_HALF = D_KEY // 2
TOPK = 16
TOK_BLOCK = 128
ALPHA = (2.0 * DEPTH) ** 0.25
BETA = (8.0 * DEPTH) ** -0.25
LN_EPS = 1e-5

kernel_name = "hybrid_rglru_gmlp_peer_deepnorm"


def layer_norm(x, g, b):
    xf = x.astype(jnp.float32)
    mu = jnp.mean(xf, axis=-1, keepdims=True)
    var = jnp.mean(jnp.square(xf - mu), axis=-1, keepdims=True)
    y = (xf - mu) * lax.rsqrt(var + LN_EPS) * g.astype(jnp.float32) + b.astype(jnp.float32)
    return y.astype(x.dtype)


def causal_depthwise_conv(x, w, b):
    s = x.shape[1]
    xp = jnp.pad(x, ((0, 0), (CONV_WIDTH - 1, 0), (0, 0)))
    return sum(w[k] * xp[:, k:k + s] for k in range(CONV_WIDTH)) + b


def rg_lru(x, w_a, b_a, w_x, b_x, lam):
    bsz, s, _ = x.shape
    xh = x.reshape(bsz, s, RNN_HEADS, RNN_HEAD_DIM)
    r = jax.nn.sigmoid(jnp.einsum('bshi,hij->bshj', xh, w_a).reshape(bsz, s, D_RNN) + b_a)
    i = jax.nn.sigmoid(jnp.einsum('bshi,hij->bshj', xh, w_x).reshape(bsz, s, D_RNN) + b_x)
    log_a = -LRU_C * r.astype(jnp.float32) * jax.nn.softplus(-lam.astype(jnp.float32))
    a = jnp.exp(log_a)
    mult = jnp.sqrt(-jnp.expm1(2.0 * log_a))
    bx = mult * (i * x).astype(jnp.float32)

    def combine(e1, e2):
        a1, b1 = e1
        a2, b2 = e2
        return a1 * a2, a2 * b1 + b2

    _, h = lax.associative_scan(combine, (a, bx), axis=1)
    return h.astype(x.dtype)


def chunked_spatial_gating(u, v, ln_g, ln_b, ws, bs):
    bsz, s, _ = u.shape
    u = jax.nn.gelu(u)
    v = layer_norm(jax.nn.gelu(v), ln_g, ln_b)
    vc = v.reshape(bsz, s // CHUNK, CHUNK, GMLP_HEADS, GMLP_HEAD_DIM)
    mask = jnp.tril(jnp.ones((CHUNK, CHUNK), dtype=bool))
    wsm = jnp.where(mask[None], ws, jnp.zeros_like(ws))
    mixed = jnp.einsum('hts,bcshd->bcthd', wsm, vc) + bs.T[None, None, :, :, None]
    return u * mixed.reshape(bsz, s, D_GMLP)


def peer(x, wq, sub_keys, u_tab, v_tab):
    bsz, s, d = x.shape
    t = bsz * s
    xt = x.reshape(t, d)
    q = (xt @ wq).reshape(t, PEER_HEADS, 2, D_HALF).astype(jnp.float32)
    scores = jnp.einsum('thpd,hpnd->thpn', q, sub_keys.astype(jnp.float32))
    s1, i1 = lax.top_k(scores[:, :, 0], TOPK)
    s2, i2 = lax.top_k(scores[:, :, 1], TOPK)
    cand_s = (s1[..., :, None] + s2[..., None, :]).reshape(t, PEER_HEADS, TOPK * TOPK)
    cand_i = (i1[..., :, None] * N_KEYS + i2[..., None, :]).reshape(t, PEER_HEADS, TOPK * TOPK)
    top_s, pos = lax.top_k(cand_s, TOPK)
    idx = jnp.take_along_axis(cand_i, pos, axis=-1)
    gate = jax.nn.softmax(top_s, axis=-1).astype(x.dtype)
    nb = t // TOK_BLOCK

    def block(args):
        xb, ib, gb = args
        u_sel = u_tab[ib]
        h = jnp.einsum('thkd,td->thk', u_sel, xb)
        act = jax.nn.gelu(h) * gb
        return jnp.einsum('thk,thkd->td', act, v_tab[ib])

    out = lax.map(block, (xt.reshape(nb, TOK_BLOCK, d),
                          idx.reshape(nb, TOK_BLOCK, PEER_HEADS, TOPK),
                          gate.reshape(nb, TOK_BLOCK, PEER_HEADS, TOPK)))
    return out.reshape(bsz, s, d)


def setup_inputs(seed: int = 0) -> dict:
    key = jax.random.key(seed)
    ks = jax.random.split(key, 24)
    nrm = lambda k, shape, scale: jax.random.normal(k, shape, jnp.float32) * scale
    L = DEPTH
    a0 = jax.random.uniform(ks[9], (L, D_RNN), jnp.float32, minval=0.9, maxval=0.999)
    return {
        "x": nrm(ks[0], (BATCH, SEQ, D_MODEL), 1.0),
        "w_in": nrm(ks[1], (L, D_MODEL, D_IN), D_MODEL ** -0.5),
        "b_gate": nrm(ks[2], (L, N_BRANCH, D_MODEL), 0.02),
        "conv_w": nrm(ks[3], (L, CONV_WIDTH, D_RNN), CONV_WIDTH ** -0.5),
        "conv_b": nrm(ks[4], (L, D_RNN), 0.02),
        "rg_w_a": nrm(ks[5], (L, RNN_HEADS, RNN_HEAD_DIM, RNN_HEAD_DIM), RNN_HEAD_DIM ** -0.5),
        "rg_b_a": nrm(ks[6], (L, D_RNN), 0.02),
        "rg_w_x": nrm(ks[7], (L, RNN_HEADS, RNN_HEAD_DIM, RNN_HEAD_DIM), RNN_HEAD_DIM ** -0.5),
        "rg_b_x": nrm(ks[8], (L, D_RNN), 0.02),
        "rg_lambda": jnp.log(a0) - jnp.log1p(-a0),
        "gm_ln_g": 1.0 + nrm(ks[10], (L, D_GMLP), 0.02),
        "gm_ln_b": nrm(ks[11], (L, D_GMLP), 0.02),
        "gm_ws": nrm(ks[12], (L, GMLP_HEADS, CHUNK, CHUNK), CHUNK ** -0.5),
        "gm_bs": 1.0 + nrm(ks[13], (L, GMLP_HEADS, CHUNK), 0.02),
        "w_out": nrm(ks[14], (L, D_MODEL, D_MODEL), BETA * D_MODEL ** -0.5),
        "ln1_g": 1.0 + nrm(ks[15], (L, D_MODEL), 0.02),
        "ln1_b": nrm(ks[16], (L, D_MODEL), 0.02),
        "peer_wq": nrm(ks[17], (L, D_MODEL, PEER_HEADS * D_KEY), D_MODEL ** -0.5),
        "peer_sub_keys": nrm(ks[18], (L, PEER_HEADS, 2, N_KEYS, D_HALF), D_HALF ** -0.5),
        "peer_u": nrm(ks[19], (L, N_EXPERTS, D_MODEL), D_MODEL ** -0.5),
        "peer_v": nrm(ks[20], (L, N_EXPERTS, D_MODEL), BETA),
        "ln2_g": 1.0 + nrm(ks[21], (L, D_MODEL), 0.02),
        "ln2_b": nrm(ks[22], (L, D_MODEL), 0.02),
    }


def reference(x, w_in, b_gate, conv_w, conv_b, rg_w_a, rg_b_a, rg_w_x, rg_b_x, rg_lambda,
              gm_ln_g, gm_ln_b, gm_ws, gm_bs, w_out, ln1_g, ln1_b,
              peer_wq, peer_sub_keys, peer_u, peer_v, ln2_g, ln2_b):
    bsz, s, _ = x.shape
    splits = [D_RNN, 2 * D_RNN, 2 * D_RNN + D_GMLP, 2 * D_RNN + 2 * D_GMLP]
    for l in range(DEPTH):
        proj = x @ w_in[l]
        xa, ga, u, v, g = jnp.split(proj, splits, axis=-1)
        ya = jax.nn.gelu(ga) * rg_lru(causal_depthwise_conv(xa, conv_w[l], conv_b[l]),
                                      rg_w_a[l], rg_b_a[l], rg_w_x[l], rg_b_x[l], rg_lambda[l])
        yb = chunked_spatial_gating(u, v, gm_ln_g[l], gm_ln_b[l], gm_ws[l], gm_bs[l])
        gates = jax.nn.sigmoid(g.reshape(bsz, s, N_BRANCH, D_MODEL) + b_gate[l])
        y = gates[:, :, 0] * ya + gates[:, :, 1] * yb
        x = layer_norm(ALPHA * x + y @ w_out[l], ln1_g[l], ln1_b[l])
        x = layer_norm(ALPHA * x + peer(x, peer_wq[l], peer_sub_keys[l], peer_u[l], peer_v[l]),
                       ln2_g[l], ln2_b[l])
    return x
```

```cpp
#include <hip/hip_runtime.h>
#include <hip/hip_cooperative_groups.h>
#include <cstdio>
#include <cstdint>
namespace cg = cooperative_groups;

#define LAS __attribute__((address_space(3)))
typedef unsigned short bf16;
typedef short bf16x8 __attribute__((ext_vector_type(8)));
typedef float f32x4 __attribute__((ext_vector_type(4)));
typedef float f32x16 __attribute__((ext_vector_type(16)));
typedef float f32x2 __attribute__((ext_vector_type(2)));
typedef unsigned u32x4 __attribute__((ext_vector_type(4)));
typedef unsigned u32x2 __attribute__((ext_vector_type(2)));
typedef int i32x4 __attribute__((ext_vector_type(4)));
typedef __bf16 bf16v2 __attribute__((ext_vector_type(2)));

#ifndef Q_I8
#define Q_I8 0
#endif
constexpr int T = 32768, D = 1024, SEQ = 4096, DIN = 6144, CHUNK = 128, NTILE = T / CHUNK, NCHUNK = SEQ / CHUNK, NH = 8, HD = 128;
constexpr int NEXP = 16384;
constexpr float ALPHA = 1.18920711500272f, LN_EPS = 1e-5f;
constexpr int NTHR = 512;
constexpr int LDS_BYTES = 147456;
constexpr int LDS_BARST = 147440;

constexpr size_t MiB = 1u << 20;
constexpr size_t WS_SPT = 0;
constexpr size_t WS_BAS = 4096;
constexpr size_t WS_BXS = 8192;
constexpr size_t WS_BGS = 12288;
constexpr size_t WS_STATS = 256 * 1024;
constexpr size_t WS_BAR = 64 * 1024;
constexpr size_t WS_WIN = 1 * MiB;
constexpr size_t WS_WOUT = 13 * MiB;
constexpr size_t WS_WQ = 15 * MiB;
constexpr size_t WS_KEYS = 19 * MiB;
constexpr size_t WS_WAX = 20 * MiB;
constexpr size_t WS_WTRIL = 20 * MiB + 512 * 1024;
constexpr size_t WS_UQ = 22 * MiB;
constexpr size_t WS_VQ = 38 * MiB;
constexpr size_t WS_USC = 54 * MiB;
constexpr size_t WS_VSC = 55 * MiB;
constexpr size_t WS_WQ8 = 56 * MiB;
constexpr size_t WS_SXR = 62 * MiB;
constexpr size_t WS_SWC = 63 * MiB;
constexpr size_t WS_WQQ8 = 64 * MiB;
constexpr size_t WS_SWQ = 66 * MiB;
constexpr size_t WS_SX1 = 67 * MiB;
constexpr size_t WS_X1Q8 = 182 * MiB;
constexpr size_t WS_XQ8 = 472 * MiB;
constexpr size_t WS_XB = 86 * MiB;
constexpr size_t OUT_PC = 64 * MiB;
constexpr size_t WS_P4 = 150 * MiB;
constexpr size_t WS_HL = 406 * MiB;
constexpr size_t WS_PEND = 470 * MiB;
constexpr size_t WS_HEND = 471 * MiB;
constexpr size_t WS_X1B = 278 * MiB;
constexpr size_t WS_Q = 342 * MiB;
constexpr size_t WS_IDX = 470 * MiB;
constexpr size_t WS_GATE = 486 * MiB;
constexpr size_t WS_END = 504 * MiB;

__device__ __forceinline__ unsigned pk2(float lo, float hi) { f32x2 v = {lo, hi}; return __builtin_bit_cast(unsigned, __builtin_convertvector(v, bf16v2)); }
__device__ __forceinline__ float bf_lo(unsigned w) { return __uint_as_float(w << 16); }
__device__ __forceinline__ float bf_hi(unsigned w) { return __uint_as_float(w & 0xffff0000u); }
constexpr float NLOG2E = -1.4426950408889634f;
__device__ __forceinline__ float sig_pre(float xs) { return __builtin_amdgcn_rcpf(1.0f + __builtin_amdgcn_exp2f(xs)); }
__device__ __forceinline__ float gelu_tanh(float x) { const float u = x * (1.0f + 0.044715f * x * x); return x * __builtin_amdgcn_rcpf(1.0f + __builtin_amdgcn_exp2f(-2.3022081989f * u)); }
__device__ __forceinline__ float wave_sum(float v) {
#pragma unroll
    for (int o = 32; o >= 1; o >>= 1) v += __shfl_xor(v, o);
    return v;
}
#define XB_TMO      128
#define XB_XCNT(j)  (256  + 64 * (j))
#define XB_XSUB(j)  (1280 + 64 * (j))
#define XB_XGEN(j)  (2304 + 64 * (j))
#define XB_TOP      3328
#define XB_TOPGEN   3392
#define XCD_BAR_WORDS 3456
#define XB_SPIN_CAP (1u << 22)

__device__ __forceinline__ unsigned xb_ld(unsigned* p)              { return __hip_atomic_load(p, __ATOMIC_RELAXED, __HIP_MEMORY_SCOPE_AGENT); }
__device__ __forceinline__ unsigned xb_add(unsigned* p, unsigned v) { return __hip_atomic_fetch_add(p, v, __ATOMIC_RELAXED, __HIP_MEMORY_SCOPE_AGENT); }
__device__ __forceinline__ unsigned xb_xcc_id() { return (unsigned)__builtin_amdgcn_s_getreg((3 << 11) | 20) & 0xFu; }
#define XB_SPIN(cond, bar) do { unsigned _sp = 0; while (cond) { __builtin_amdgcn_s_sleep(1); \
    if ((++_sp & 255u) == 0u) { if (xb_ld(&(bar)[XB_TMO])) break; if (_sp > XB_SPIN_CAP) { atomicAdd(&(bar)[XB_TMO], 1u); break; } } } } while (0)

struct XcdBarrier {
    unsigned* bar; unsigned x;
    volatile LAS unsigned* st;
};

__device__ __forceinline__ XcdBarrier xcd_barrier_post(unsigned* bar, volatile LAS unsigned* st) {
    XcdBarrier b; b.bar = bar; b.x = xb_xcc_id(); b.st = st;
    if (threadIdx.x == 0) (void)xb_add(&bar[XB_XCNT(b.x)], 1u);
    return b;
}
__device__ __forceinline__ void xcd_barrier_complete(unsigned* bar, unsigned x, unsigned& nloc, unsigned& nx) {
    const unsigned G = gridDim.x * gridDim.y * gridDim.z;
    unsigned sum, cnt, mine, sp = 0u;
    for (;;) {
        sum = 0u; cnt = 0u; mine = 0u;
#pragma unroll
        for (unsigned j = 0; j < 16; ++j) { const unsigned c = xb_ld(&bar[XB_XCNT(j)]); sum += c; cnt += (c > 0u) ? 1u : 0u; mine = (j == x) ? c : mine; }
        if (sum == G) break;
        __builtin_amdgcn_s_sleep(1);
        if ((++sp & 255u) == 0u) { if (xb_ld(&bar[XB_TMO])) break; if (sp > XB_SPIN_CAP) { atomicAdd(&bar[XB_TMO], 1u); break; } }
    }
    nloc = mine > 0u ? mine : 1u; nx = cnt > 0u ? cnt : 1u;
}

__device__ __forceinline__ void xcd_barrier(const XcdBarrier& b) {
    asm volatile("s_waitcnt vmcnt(0)" ::: "memory");
    __syncthreads();
    if (threadIdx.x == 0) {
        unsigned* bar = b.bar;
        __builtin_amdgcn_s_waitcnt(0);
        unsigned nloc = b.st[0], nx = b.st[1];
        if (nloc == 0u) { xcd_barrier_complete(bar, b.x, nloc, nx); b.st[0] = nloc; b.st[1] = nx; }
        const unsigned old = xb_add(&bar[XB_XSUB(b.x)], 1u);
        const unsigned gen = old / nloc;
        if (old + 1u == (gen + 1u) * nloc) {
            __builtin_amdgcn_fence(__ATOMIC_RELEASE, "agent");
            asm volatile("s_waitcnt vmcnt(0)" ::: "memory");
            const unsigned og = xb_add(&bar[XB_TOP], 1u);
            const unsigned tg = og / nx;
            if (og + 1u == (tg + 1u) * nx) xb_add(&bar[XB_TOPGEN], 1u);
            else XB_SPIN(xb_ld(&bar[XB_TOPGEN]) == tg, bar);
            __builtin_amdgcn_fence(__ATOMIC_ACQUIRE, "agent");
            xb_add(&bar[XB_XGEN(b.x)], 1u);
            asm volatile("s_waitcnt vmcnt(0)" ::: "memory");
        } else {
            XB_SPIN(xb_ld(&bar[XB_XGEN(b.x)]) == gen, bar);
            __builtin_amdgcn_fence(__ATOMIC_ACQUIRE, "agent");
            asm volatile("s_waitcnt vmcnt(0)" ::: "memory");
        }
    }
    __syncthreads();
}
namespace pg8 {
#define PG8_LAS __attribute__((address_space(3)))
typedef unsigned short bf16_t;
typedef short bf16x8 __attribute__((ext_vector_type(8)));
typedef float f32x4 __attribute__((ext_vector_type(4)));
typedef unsigned u32x4 __attribute__((ext_vector_type(4)));
typedef int i32x4_ __attribute__((ext_vector_type(4)));
constexpr int BM = 256, BK = 64, HALF = 128, HTB = HALF * BK * 2  , STAGE_BYTES = 8 * HTB, NXCD = 8, WGM = 8;

__host__ __device__ __forceinline__ int lds_byte(int r, int c) { const int st = (r >> 4) * 2 + (c >> 5), rr = r & 15, cc = c & 31, ob = rr * 64 + cc * 2; return st * 1024 + (ob ^ (((ob >> 9) & 1) << 5)); }
__host__ __device__ __forceinline__ void stage_rc(int b, int& R, int& C) { const int st = b / 1024, sb = b % 1024, swz = sb ^ (((sb >> 9) & 1) << 5); R = (st >> 1) * 16 + swz / 64; C = (st & 1) * 32 + (swz % 64) / 2; }
__host__ __device__ __forceinline__ int perm32(int rho) { const int n = rho >> 4, i = rho & 15; return 8 * (i >> 2) + 4 * n + (i & 3); }

struct Unit { int pm, pn; };
struct Gemm { const bf16_t* A; const bf16_t* Bt; int M, N, K, lda, ldb, a_pn_bytes; };

struct StaticOrder {
    int nM, nN, nwg, G, c;
    __host__ __device__ void init(int M, int N, int G_, int c_) { nM = M / BM; nN = N / BM; nwg = nM * nN; G = G_; c = c_; }
    __host__ __device__ bool next(int i, Unit& u) const {
        const long L = (long)i * G + c; if (L >= nwg) return false;
        int wgid = (int)L; { const int q = nwg / NXCD, r = nwg % NXCD, xcd = wgid % NXCD, off = wgid / NXCD; wgid = (xcd < r ? xcd * (q + 1) : r * (q + 1) + (xcd - r) * q) + off; }
        const int nig = WGM * nN, gid = wgid / nig, fm = gid * WGM, gsz = (nM - fm) < WGM ? (nM - fm) : WGM;
        u.pm = fm + ((wgid % nig) % gsz); u.pn = (wgid % nig) / gsz; return true;
    }
    __device__ __forceinline__ void a_ready(const Unit&) const {}
    __device__ __forceinline__ void done(const Unit&) const {}
};


struct EpiProj {
    static constexpr bool PERM = true, AFTER_DRAIN = false, AROWS = false, I8 = true;
    bf16_t* P4; const float* bgate;
    const float* sxr; const float* swc;
    __device__ __forceinline__ void operator()(const f32x4 (&acc)[2][2][4][2], const Unit& u, int, int, int, int) const {
        int t_ = threadIdx.x; asm volatile("" : "+v"(t_)); const int fr = t_ & 15, fq = (t_ >> 4) & 3, wc = (t_ >> 6) & 3, wr = t_ >> 8;
        const int k = u.pn / 3, ty = u.pn - 3 * k;
        const int row0 = u.pm * BM + wr * 64 + fr, cl = k * 128 + wc * 32 + 8 * fq;
        const float* swp = swc + u.pn * BM + wc * 32 + 8 * fq;
        const f32x4 w00 = *(const f32x4*)swp, w01 = *(const f32x4*)(swp + 4), w10 = *(const f32x4*)(swp + HALF), w11 = *(const f32x4*)(swp + HALF + 4);
#define EPI_I2F(v, w, s) ((f32x4){(float)__builtin_bit_cast(i32x4_, v)[0], (float)__builtin_bit_cast(i32x4_, v)[1], (float)__builtin_bit_cast(i32x4_, v)[2], (float)__builtin_bit_cast(i32x4_, v)[3]} * (w) * (s))
        if (ty == 0) {
#pragma unroll
            for (int ai = 0; ai < 2; ++ai)
#pragma unroll
                for (int m = 0; m < 4; ++m) {
                    const int row = row0 + ai * HALF + m * 16; const float sx = sxr[row];
                    bf16_t* rowp = P4 + (size_t)row * 4096 + cl;
                    const f32x4 a0 = EPI_I2F(acc[ai][0][m][0], w00, sx), a1 = EPI_I2F(acc[ai][0][m][1], w01, sx); f32x4 v0 = EPI_I2F(acc[ai][1][m][0], w10, sx), v1 = EPI_I2F(acc[ai][1][m][1], w11, sx);
#pragma unroll
                    for (int j = 0; j < 4; ++j) { v0[j] = gelu_tanh(v0[j]); v1[j] = gelu_tanh(v1[j]); }
                    u32x4 w; w.x = pk2(a0[0], a0[1]); w.y = pk2(a0[2], a0[3]); w.z = pk2(a1[0], a1[1]); w.w = pk2(a1[2], a1[3]);
                    *(u32x4*)rowp = w;
                    w.x = pk2(v0[0], v0[1]); w.y = pk2(v0[2], v0[3]); w.z = pk2(v1[0], v1[1]); w.w = pk2(v1[2], v1[3]);
                    *(u32x4*)(rowp + 3072) = w;
                }
        } else {
            const float* bp = bgate + (ty - 1) * 1024 + cl;
            const f32x4 b0 = *(const f32x4*)bp, b1 = *(const f32x4*)(bp + 4);
#pragma unroll
            for (int ai = 0; ai < 2; ++ai)
#pragma unroll
                for (int m = 0; m < 4; ++m) {
                    const int row = row0 + ai * HALF + m * 16; const float sx = sxr[row];
                    bf16_t* rowp = P4 + (size_t)row * 4096 + ty * 1024 + cl;
                    f32x4 a0 = EPI_I2F(acc[ai][0][m][0], w00, sx), a1 = EPI_I2F(acc[ai][0][m][1], w01, sx); const f32x4 g0 = EPI_I2F(acc[ai][1][m][0], w10, sx) + b0, g1 = EPI_I2F(acc[ai][1][m][1], w11, sx) + b1;
#pragma unroll
                    for (int j = 0; j < 4; ++j) { a0[j] = gelu_tanh(a0[j]) * sig_pre(g0[j]); a1[j] = gelu_tanh(a1[j]) * sig_pre(g1[j]); }
                    u32x4 w; w.x = pk2(a0[0], a0[1]); w.y = pk2(a0[2], a0[3]); w.z = pk2(a1[0], a1[1]); w.w = pk2(a1[2], a1[3]);
                    *(u32x4*)rowp = w;
                }
        }
#undef EPI_I2F
    }
};
template <int S> __device__ __forceinline__ float row_shr_f(float ident, float v) {
    return __int_as_float(__builtin_amdgcn_update_dpp(__float_as_int(ident), __float_as_int(v), 0x110 + S, 0xf, 0xf, false));
}
struct EpiGate {
    static constexpr bool PERM = true, AFTER_DRAIN = false, AROWS = true, I8 = false;
    const bf16_t* XC; bf16_t* HL; bf16_t* PC; float* PEND; float* HEND; const float* b_a; const float* b_x; const float* spt;
    __device__ __forceinline__ void operator()(const f32x4 (&acc)[2][2][4][2], const Unit& u, int, int, int, int) const {
        int t_ = threadIdx.x; asm volatile("" : "+v"(t_)); const int fr = t_ & 15, fq = (t_ >> 4) & 3, wc = (t_ >> 6) & 3, wr = t_ >> 8, lane15 = (t_ & 63) | 15;
        const int row0 = u.pm * BM + wr * 128 + fr, ch = u.pn * 128 + wc * 32 + 8 * fq, chunk = u.pm * 2 + wr;
        float Ac[8], Hc[8];
#pragma unroll
        for (int j = 0; j < 8; ++j) { Ac[j] = 1.0f; Hc[j] = 0.0f; }
#pragma unroll
        for (int ai = 0; ai < 2; ++ai)
#pragma unroll
            for (int m = 0; m < 4; ++m) {
                asm volatile("" ::: "memory");
                int zo = 0; asm volatile("" : "+v"(zo));
                const size_t off = (size_t)(row0 + ai * 64 + m * 16) * 1024 + ch;
                const u32x4 xw = *(const u32x4*)(XC + off);
                float ba[8], bx[8], sp[8];
                { const int cz = ch + zo;
                  const f32x4 t0 = *(const f32x4*)(b_a + cz), t1 = *(const f32x4*)(b_a + cz + 4), t2 = *(const f32x4*)(b_x + cz), t3 = *(const f32x4*)(b_x + cz + 4), t4 = *(const f32x4*)(spt + cz), t5 = *(const f32x4*)(spt + cz + 4);
#pragma unroll
                  for (int j = 0; j < 4; ++j) { ba[j] = t0[j]; ba[4 + j] = t1[j]; bx[j] = t2[j]; bx[4 + j] = t3[j]; sp[j] = t4[j]; sp[4 + j] = t5[j]; } }
                float a[8], b[8];
#pragma unroll
                for (int j = 0; j < 8; ++j) {
                    const float rp = acc[ai][0][m][j >> 2][j & 3], ip = acc[ai][1][m][j >> 2][j & 3];
                    const float xv = (j & 1) ? bf_hi(xw[j >> 1]) : bf_lo(xw[j >> 1]);
                    a[j] = __builtin_amdgcn_exp2f(sig_pre(rp + ba[j]) * sp[j]);
                    b[j] = __builtin_amdgcn_sqrtf(__builtin_fmaxf(1.0f - a[j] * a[j], 0.f)) * sig_pre(ip + bx[j]) * xv;
                }
#pragma unroll
                for (int j = 0; j < 8; ++j) { const float ap = row_shr_f<1>(1.0f, a[j]), bp = row_shr_f<1>(0.0f, b[j]); b[j] = a[j] * bp + b[j]; a[j] = a[j] * ap; }
#pragma unroll
                for (int j = 0; j < 8; ++j) { const float ap = row_shr_f<2>(1.0f, a[j]), bp = row_shr_f<2>(0.0f, b[j]); b[j] = a[j] * bp + b[j]; a[j] = a[j] * ap; }
#pragma unroll
                for (int j = 0; j < 8; ++j) { const float ap = row_shr_f<4>(1.0f, a[j]), bp = row_shr_f<4>(0.0f, b[j]); b[j] = a[j] * bp + b[j]; a[j] = a[j] * ap; }
#pragma unroll
                for (int j = 0; j < 8; ++j) { const float ap = row_shr_f<8>(1.0f, a[j]), bp = row_shr_f<8>(0.0f, b[j]); b[j] = a[j] * bp + b[j]; a[j] = a[j] * ap; }
                float hl[8], pc[8];
#pragma unroll
                for (int j = 0; j < 8; ++j) {
                    const float at = __shfl(a[j], lane15), bt = __shfl(b[j], lane15);
                    hl[j] = b[j] + a[j] * Hc[j]; pc[j] = a[j] * Ac[j];
                    Hc[j] = bt + at * Hc[j]; Ac[j] = at * Ac[j];
                }
                u32x4 w; w.x = pk2(hl[0], hl[1]); w.y = pk2(hl[2], hl[3]); w.z = pk2(hl[4], hl[5]); w.w = pk2(hl[6], hl[7]);
                *(u32x4*)(HL + off) = w;
                w.x = pk2(pc[0], pc[1]); w.y = pk2(pc[2], pc[3]); w.z = pk2(pc[4], pc[5]); w.w = pk2(pc[6], pc[7]);
                *(u32x4*)(PC + off) = w;
            }
        if (fr == 0) {
            float* pp = PEND + (size_t)chunk * 1024 + ch; float* hp = HEND + (size_t)chunk * 1024 + ch;
            *(f32x4*)pp = (f32x4){Ac[0], Ac[1], Ac[2], Ac[3]}; *(f32x4*)(pp + 4) = (f32x4){Ac[4], Ac[5], Ac[6], Ac[7]};
            *(f32x4*)hp = (f32x4){Hc[0], Hc[1], Hc[2], Hc[3]}; *(f32x4*)(hp + 4) = (f32x4){Hc[4], Hc[5], Hc[6], Hc[7]};
        }
    }
};
struct EpiBf16 {
    static constexpr bool PERM = true, AFTER_DRAIN = false, AROWS = false, I8 = false;
    bf16_t* O; int ldc;
    __device__ __forceinline__ void operator()(const f32x4 (&acc)[2][2][4][2], const Unit& u, int, int, int, int) const {
        int t_ = threadIdx.x; asm volatile("" : "+v"(t_)); const int fr = t_ & 15, fq = (t_ >> 4) & 3, wc = (t_ >> 6) & 3, wr = t_ >> 8;
        const int row0 = u.pm * BM + wr * 64 + fr, col0 = u.pn * BM + wc * 32 + 8 * fq;
#pragma unroll
        for (int ai = 0; ai < 2; ++ai)
#pragma unroll
            for (int m = 0; m < 4; ++m) {
                bf16_t* rowp = O + (size_t)(row0 + ai * HALF + m * 16) * ldc + col0;
#pragma unroll
                for (int bj = 0; bj < 2; ++bj) {
                    const f32x4 v0 = acc[ai][bj][m][0], v1 = acc[ai][bj][m][1];
                    u32x4 w; w.x = pk2(v0[0], v0[1]); w.y = pk2(v0[2], v0[3]); w.z = pk2(v1[0], v1[1]); w.w = pk2(v1[2], v1[3]);
                    *(u32x4*)(rowp + bj * HALF) = w;
                }
            }
    }
};
struct EpiResid {
    static constexpr bool PERM = true, AFTER_DRAIN = false, AROWS = false, I8 = false;
    const bf16_t* X; bf16_t* Z; int ldc; float alpha;
    __device__ __forceinline__ void operator()(const f32x4 (&acc)[2][2][4][2], const Unit& u, int, int, int, int) const {
        int t_ = threadIdx.x; asm volatile("" : "+v"(t_)); const int fr = t_ & 15, fq = (t_ >> 4) & 3, wc = (t_ >> 6) & 3, wr = t_ >> 8;
        const int row0 = u.pm * BM + wr * 64 + fr, col0 = u.pn * BM + wc * 32 + 8 * fq;
#pragma unroll
        for (int ai = 0; ai < 2; ++ai)
#pragma unroll
            for (int m = 0; m < 4; ++m) {
                const size_t off = (size_t)(row0 + ai * HALF + m * 16) * ldc + col0;
#pragma unroll
                for (int bj = 0; bj < 2; ++bj) {
                    const u32x4 xw = *(const u32x4*)(X + off + bj * HALF);
                    const f32x4 x0 = (f32x4){bf_lo(xw.x), bf_hi(xw.x), bf_lo(xw.y), bf_hi(xw.y)}, x1 = (f32x4){bf_lo(xw.z), bf_hi(xw.z), bf_lo(xw.w), bf_hi(xw.w)};
                    const f32x4 z0 = x0 * alpha + acc[ai][bj][m][0], z1 = x1 * alpha + acc[ai][bj][m][1];
                    u32x4 w; w.x = pk2(z0[0], z0[1]); w.y = pk2(z0[2], z0[3]); w.z = pk2(z1[0], z1[1]); w.w = pk2(z1[2], z1[3]);
                    *(u32x4*)(Z + off + bj * HALF) = w;
                }
            }
    }
};

struct EpiBf16I8 {
    static constexpr bool PERM = true, AFTER_DRAIN = false, AROWS = false, I8 = true;
    bf16_t* O; int ldc; const float* sxr; const float* swc;
    __device__ __forceinline__ void operator()(const f32x4 (&acc)[2][2][4][2], const Unit& u, int, int, int, int) const {
        int t_ = threadIdx.x; asm volatile("" : "+v"(t_)); const int fr = t_ & 15, fq = (t_ >> 4) & 3, wc = (t_ >> 6) & 3, wr = t_ >> 8;
        const int row0 = u.pm * BM + wr * 64 + fr, col0 = u.pn * BM + wc * 32 + 8 * fq;
        const f32x4 w00 = *(const f32x4*)(swc + col0), w01 = *(const f32x4*)(swc + col0 + 4), w10 = *(const f32x4*)(swc + col0 + HALF), w11 = *(const f32x4*)(swc + col0 + HALF + 4);
#define EPI_I2F(v, w, s) ((f32x4){(float)__builtin_bit_cast(i32x4_, v)[0], (float)__builtin_bit_cast(i32x4_, v)[1], (float)__builtin_bit_cast(i32x4_, v)[2], (float)__builtin_bit_cast(i32x4_, v)[3]} * (w) * (s))
#pragma unroll
        for (int ai = 0; ai < 2; ++ai)
#pragma unroll
            for (int m = 0; m < 4; ++m) {
                const int row = row0 + ai * HALF + m * 16; const float sx = sxr[row];
                bf16_t* rowp = O + (size_t)row * ldc + col0;
                { const f32x4 v0 = EPI_I2F(acc[ai][0][m][0], w00, sx), v1 = EPI_I2F(acc[ai][0][m][1], w01, sx);
                  u32x4 w; w.x = pk2(v0[0], v0[1]); w.y = pk2(v0[2], v0[3]); w.z = pk2(v1[0], v1[1]); w.w = pk2(v1[2], v1[3]); *(u32x4*)rowp = w; }
                { const f32x4 v0 = EPI_I2F(acc[ai][1][m][0], w10, sx), v1 = EPI_I2F(acc[ai][1][m][1], w11, sx);
                  u32x4 w; w.x = pk2(v0[0], v0[1]); w.y = pk2(v0[2], v0[3]); w.z = pk2(v1[0], v1[1]); w.w = pk2(v1[2], v1[3]); *(u32x4*)(rowp + HALF) = w; }
            }
#undef EPI_I2F
    }
};
template <class Epi, class Sched, bool ALIGN_EPI = false, bool SP2 = false>
__device__ __forceinline__ void gemm_phase(PG8_LAS unsigned char* lds, const Gemm g, const Sched& S, const Epi& E) {
    int tid_ = threadIdx.x; asm volatile("" : "+v"(tid_)); const int tid = tid_, wid = __builtin_amdgcn_readfirstlane(tid >> 6), lane = tid & 63, wr = wid >> 2, wc = wid & 3, fr = lane & 15, fq = lane >> 4;
    const int K = g.K, nt = K / BK;
    unsigned voffA[2], voffB[2];
#pragma unroll
    for (int i = 0; i < 2; ++i) { int R, C; stage_rc(tid * 16 + i * 8192, R, C); const int Rb = Epi::PERM ? ((R & ~31) + perm32(R & 31)) : R;
        const int Ra = Epi::AROWS ? ((R >> 6) * 128 + (R & 63)) : R;
        voffA[i] = (unsigned)(Ra * g.lda + C) * 2u; voffB[i] = (unsigned)(Rb * g.ldb + C) * 2u; }
    const size_t kstep = (size_t)(BK * 2);
    const size_t hstepA = (size_t)(Epi::AROWS ? 64 : HALF) * g.lda * 2, hstepB = (size_t)HALF * g.ldb * 2;
    const size_t tstepA = (size_t)2 * HALF * g.lda * 2, tstepB = 2 * hstepB;
    const unsigned ldsw = (unsigned)wid * 1024u;
    const int aoff = lds_byte(wr * 64 + fr, fq * 8), boff = lds_byte(wc * 32 + fr, fq * 8);
#define PG8_SA(b, h) (((b) * 2 + (h)) * HTB)
#define PG8_SB(b, h) ((4 + (b) * 2 + (h)) * HTB)
#define PG8_STAGE(bufoff, gbase, voff) do { _Pragma("unroll") for (int _i = 0; _i < 2; ++_i) \
        __builtin_amdgcn_global_load_lds((const unsigned*)((const char*)(gbase) + (voff)[_i]), (PG8_LAS unsigned*)(lds + (bufoff) + ldsw + _i * 8192), 16, 0, 0); } while (0)
#define PG8_LDA(dst, b, h) do { _Pragma("unroll") for (int m = 0; m < 4; ++m) _Pragma("unroll") for (int k = 0; k < 2; ++k) dst[m][k] = *(const PG8_LAS bf16x8*)(lds + PG8_SA(b, h) + aoff + m * 2048 + k * 1024); } while (0)
#define PG8_LDB(dst, b, h) do { _Pragma("unroll") for (int n = 0; n < 2; ++n) _Pragma("unroll") for (int k = 0; k < 2; ++k) dst[n][k] = *(const PG8_LAS bf16x8*)(lds + PG8_SB(b, h) + boff + n * 2048 + k * 1024); } while (0)
#define PG8_MMA(ai, bj, At, Bt) do { __builtin_amdgcn_s_setprio(1); _Pragma("unroll") for (int m = 0; m < 4; ++m) _Pragma("unroll") for (int n = 0; n < 2; ++n) _Pragma("unroll") for (int k = 0; k < 2; ++k) \
        { if constexpr (Epi::I8) acc[ai][bj][m][n] = __builtin_bit_cast(f32x4, __builtin_amdgcn_mfma_i32_16x16x64_i8(__builtin_bit_cast(i32x4_, Bt[n][k]), __builtin_bit_cast(i32x4_, At[m][k]), __builtin_bit_cast(i32x4_, acc[ai][bj][m][n]), 0, 0, 0)); \
          else acc[ai][bj][m][n] = __builtin_amdgcn_mfma_f32_16x16x32_bf16(Bt[n][k], At[m][k], acc[ai][bj][m][n], 0, 0, 0); } __builtin_amdgcn_s_setprio(0); } while (0)
#define PG8_WAIT_V(n) asm volatile("s_waitcnt vmcnt(" #n ")" ::: "memory")
#define PG8_WAIT_L(n) asm volatile("s_waitcnt lgkmcnt(" #n ")" ::: "memory")
#define PG8_BAR __builtin_amdgcn_s_barrier()
#define PG8_SCHED __builtin_amdgcn_sched_barrier(0)
    Unit cur, nxt; int ui = 0;
    if (!S.next(0, cur)) return;
    f32x4 acc[2][2][4][2];
#pragma unroll
    for (int a = 0; a < 2; ++a)
#pragma unroll
        for (int b = 0; b < 2; ++b)
#pragma unroll
            for (int m = 0; m < 4; ++m)
#pragma unroll
                for (int n = 0; n < 2; ++n) acc[a][b][m][n] = (f32x4){0.f, 0.f, 0.f, 0.f};
    bf16x8 At[4][2], B0[2][2], B1[2][2];
    const char* cA = (const char*)g.A + (size_t)cur.pm * tstepA + (size_t)cur.pn * g.a_pn_bytes; const char* cB = (const char*)g.Bt + (size_t)cur.pn * tstepB;
    S.a_ready(cur);
    if constexpr (SP2) {
        PG8_STAGE(PG8_SB(0, 0), cB, voffB); PG8_STAGE(PG8_SB(0, 1), cB + hstepB, voffB); PG8_STAGE(PG8_SA(0, 0), cA, voffA); PG8_STAGE(PG8_SA(0, 1), cA + hstepA, voffA);
        if (wr == 1) PG8_BAR;
        PG8_WAIT_V(2); PG8_BAR;
        PG8_STAGE(PG8_SB(1, 0), cB + kstep, voffB); PG8_STAGE(PG8_SA(1, 0), cA + kstep, voffA); PG8_STAGE(PG8_SB(1, 1), cB + hstepB + kstep, voffB);
        PG8_WAIT_V(6); PG8_BAR;
    } else {
        PG8_STAGE(PG8_SB(0, 0), cB, voffB); PG8_STAGE(PG8_SA(0, 0), cA, voffA); PG8_STAGE(PG8_SB(0, 1), cB + hstepB, voffB); PG8_STAGE(PG8_SA(0, 1), cA + hstepA, voffA);
        if (wr == 1) PG8_BAR;
        PG8_WAIT_V(4); PG8_BAR;
        PG8_STAGE(PG8_SB(1, 0), cB + kstep, voffB); PG8_STAGE(PG8_SA(1, 0), cA + kstep, voffA); PG8_STAGE(PG8_SB(1, 1), cB + hstepB + kstep, voffB);
        PG8_WAIT_V(6); PG8_BAR;
    }
    for (;;) {
        const bool has_next = S.next(ui + 1, nxt);
        const char* nA = has_next ? (const char*)g.A + (size_t)nxt.pm * tstepA + (size_t)nxt.pn * g.a_pn_bytes : cA; const char* nB = has_next ? (const char*)g.Bt + (size_t)nxt.pn * tstepB : cB;
        for (int t = 0; t < nt; t += 2) {
            const bool last = (t == nt - 2);
            const char* a1 = cA + (size_t)(t + 1) * kstep;
            const char* a2 = last ? nA : cA + (size_t)(t + 2) * kstep; const char* b2 = last ? nB : cB + (size_t)(t + 2) * kstep;
            const char* a3 = a2 + kstep; const char* b3 = b2 + kstep;
            if (last && has_next) S.a_ready(nxt);
            if constexpr (SP2) {
            PG8_LDB(B0, 0, 0); PG8_LDB(B1, 0, 1); PG8_SCHED; PG8_LDA(At, 0, 0); PG8_STAGE(PG8_SA(1, 1), a1 + hstepA, voffA);
            PG8_WAIT_V(8); PG8_WAIT_L(0); PG8_BAR; PG8_MMA(0, 0, At, B0); PG8_MMA(0, 1, At, B1); PG8_BAR; PG8_SCHED;
            PG8_LDA(At, 0, 1); PG8_STAGE(PG8_SB(0, 0), b2, voffB); PG8_STAGE(PG8_SB(0, 1), b2 + hstepB, voffB); PG8_STAGE(PG8_SA(0, 0), a2, voffA);
            PG8_WAIT_V(8); PG8_WAIT_L(0); PG8_BAR; PG8_MMA(1, 0, At, B0); PG8_MMA(1, 1, At, B1); PG8_BAR; PG8_SCHED;
            PG8_LDB(B0, 1, 0); PG8_LDB(B1, 1, 1); PG8_SCHED; PG8_LDA(At, 1, 0); PG8_STAGE(PG8_SA(0, 1), a2 + hstepA, voffA);
            PG8_WAIT_V(8); PG8_WAIT_L(0); PG8_BAR; PG8_MMA(0, 0, At, B0); PG8_MMA(0, 1, At, B1); PG8_BAR; PG8_SCHED;
            PG8_LDA(At, 1, 1); PG8_STAGE(PG8_SB(1, 0), b3, voffB); PG8_STAGE(PG8_SB(1, 1), b3 + hstepB, voffB); PG8_STAGE(PG8_SA(1, 0), a3, voffA);
            PG8_WAIT_V(8); PG8_WAIT_L(0); PG8_BAR; PG8_MMA(1, 0, At, B0); PG8_MMA(1, 1, At, B1); PG8_BAR; PG8_SCHED;
            } else {
            PG8_LDB(B0, 0, 0); PG8_SCHED; PG8_LDA(At, 0, 0); PG8_STAGE(PG8_SA(1, 1), a1 + hstepA, voffA);
            PG8_WAIT_L(8); PG8_BAR; PG8_WAIT_L(0); PG8_MMA(0, 0, At, B0); PG8_BAR; PG8_SCHED;
            PG8_LDB(B1, 0, 1); PG8_STAGE(PG8_SB(0, 0), b2, voffB);
            PG8_BAR; PG8_WAIT_L(0); PG8_MMA(0, 1, At, B1); PG8_BAR;
            PG8_LDA(At, 0, 1); PG8_STAGE(PG8_SA(0, 0), a2, voffA);
            PG8_BAR; PG8_WAIT_L(0); PG8_MMA(1, 0, At, B0); PG8_BAR; PG8_SCHED;
            PG8_STAGE(PG8_SB(0, 1), b2 + hstepB, voffB);
            PG8_WAIT_V(6); PG8_BAR; PG8_MMA(1, 1, At, B1); PG8_BAR;
            PG8_LDB(B0, 1, 0); PG8_SCHED; PG8_LDA(At, 1, 0); PG8_STAGE(PG8_SA(0, 1), a2 + hstepA, voffA);
            PG8_WAIT_L(8); PG8_BAR; PG8_WAIT_L(0); PG8_MMA(0, 0, At, B0); PG8_BAR; PG8_SCHED;
            PG8_LDB(B1, 1, 1); PG8_STAGE(PG8_SB(1, 0), b3, voffB);
            PG8_BAR; PG8_WAIT_L(0); PG8_MMA(0, 1, At, B1); PG8_BAR;
            PG8_LDA(At, 1, 1); PG8_STAGE(PG8_SA(1, 0), a3, voffA);
            PG8_BAR; PG8_WAIT_L(0); PG8_MMA(1, 0, At, B0); PG8_BAR; PG8_SCHED;
            PG8_STAGE(PG8_SB(1, 1), b3 + hstepB, voffB);
            PG8_WAIT_V(6); PG8_BAR; PG8_MMA(1, 1, At, B1); PG8_BAR;
            }
        }
        if constexpr (ALIGN_EPI) { if (wr == 0) PG8_BAR; }
        if constexpr (!Epi::AFTER_DRAIN) { E(acc, cur, wr, wc, fr, fq); S.done(cur); }
        if (!has_next) break;
#pragma unroll
        for (int a = 0; a < 2; ++a)
#pragma unroll
            for (int b = 0; b < 2; ++b)
#pragma unroll
                for (int m = 0; m < 4; ++m)
#pragma unroll
                    for (int n = 0; n < 2; ++n) acc[a][b][m][n] = (f32x4){0.f, 0.f, 0.f, 0.f};
        cur = nxt; cA = nA; cB = nB; ++ui;
        if constexpr (ALIGN_EPI) { if (wr == 1) PG8_BAR; }
    }
    PG8_WAIT_V(0);
    if constexpr (!ALIGN_EPI) { if (wr == 0) PG8_BAR; }
    PG8_BAR;
    if constexpr (Epi::AFTER_DRAIN) { E.fused(acc, cur, wr, wc, fr, fq, lds, wid, lane); S.done(cur); }
#undef PG8_SA
#undef PG8_SB
#undef PG8_STAGE
#undef PG8_LDA
#undef PG8_LDB
#undef PG8_MMA
#undef PG8_WAIT_V
#undef PG8_WAIT_L
#undef PG8_BAR
#undef PG8_SCHED
}
}

__device__ __forceinline__ void cvt_f32_bf16(const float* __restrict__ src, bf16* dst, size_t n8, size_t gtid, size_t gthreads) {
    for (size_t i = gtid; i < n8; i += gthreads) {
        const f32x4 a = ((const f32x4*)src)[2 * i], b = ((const f32x4*)src)[2 * i + 1];
        u32x4 o; o.x = pk2(a.x, a.y); o.y = pk2(a.z, a.w); o.z = pk2(b.x, b.y); o.w = pk2(b.z, b.w);
        ((u32x4*)dst)[i] = o;
    }
}
__device__ __forceinline__ void transpose_tile(const float* __restrict__ W, int ldw, bf16* WT, int ldt, int k0, int n0, int nd0, LAS float* s, int tid, float sc = 1.0f) {
    {
        const int kk = tid >> 3, c8 = (tid & 7) * 8;
        const float* p = W + (size_t)(k0 + kk) * ldw + n0 + c8;
        const f32x4 a = *(const f32x4*)p, b = *(const f32x4*)(p + 4);
        LAS float* q = s + kk * 65 + c8;
        q[0] = a.x; q[1] = a.y; q[2] = a.z; q[3] = a.w; q[4] = b.x; q[5] = b.y; q[6] = b.z; q[7] = b.w;
    }
    __syncthreads();
    {
        const int nn = tid >> 3, k8 = (tid & 7) * 8;
        const LAS float* q = s + k8 * 65 + nn;
        u32x4 o; o.x = pk2(q[0] * sc, q[65] * sc); o.y = pk2(q[2 * 65] * sc, q[3 * 65] * sc); o.z = pk2(q[4 * 65] * sc, q[5 * 65] * sc); o.w = pk2(q[6 * 65] * sc, q[7 * 65] * sc);
        *(u32x4*)(WT + (size_t)(nd0 + nn) * ldt + k0 + k8) = o;
    }
    __syncthreads();
}

template <int NR> __device__ __forceinline__ void quant_rows_i8(const float (&v)[NR][16], unsigned char* const (&dst)[NR], float* const (&scale_out)[NR], int lane) {
    float m[NR];
#pragma unroll
    for (int r = 0; r < NR; ++r) { m[r] = 0.f;
#pragma unroll
        for (int j = 0; j < 16; ++j) m[r] = fmaxf(m[r], fabsf(v[r][j])); }
#pragma unroll
    for (int o = 32; o >= 1; o >>= 1) {
#pragma unroll
        for (int r = 0; r < NR; ++r) m[r] = fmaxf(m[r], __shfl_xor(m[r], o));
    }
#pragma unroll
    for (int r = 0; r < NR; ++r) {
        const float scale = (m[r] > 0.f) ? m[r] * (1.0f / 127.0f) : 1.0f, inv = 1.0f / scale;
        u32x4 q;
#pragma unroll
        for (int w = 0; w < 4; ++w) {
            unsigned pk = 0;
#pragma unroll
            for (int k = 0; k < 4; ++k) { int qi = (int)rintf(v[r][4 * w + k] * inv); qi = qi < -127 ? -127 : (qi > 127 ? 127 : qi); pk |= (unsigned)(qi & 0xff) << (8 * k); }
            q[w] = pk;
        }
        *(u32x4*)(dst[r] + lane * 16) = q;
        if (lane == 0) *scale_out[r] = scale;
    }
}
struct Ctx {
    const float* in[23];
    float* out;
    unsigned char* ws;
};

__device__ __forceinline__ void quant_peer_tables(const Ctx& c, int gw, int NW, int lane) {
    unsigned char* ws = c.ws;
    for (int rw4 = gw * 4; rw4 < 2 * NEXP; rw4 += NW * 4) {
        const int tab = rw4 >= NEXP, row4 = rw4 - tab * NEXP;
        float v[4][16]; unsigned char* dst[4]; float* sc[4];
#pragma unroll
        for (int r = 0; r < 4; ++r) {
            const float* src = (tab ? c.in[20] : c.in[19]) + (size_t)(row4 + r) * 1024 + lane * 16;
            const f32x4 a0 = *(const f32x4*)src, a1 = *(const f32x4*)(src + 4), a2 = *(const f32x4*)(src + 8), a3 = *(const f32x4*)(src + 12);
            v[r][0] = a0.x; v[r][1] = a0.y; v[r][2] = a0.z; v[r][3] = a0.w; v[r][4] = a1.x; v[r][5] = a1.y; v[r][6] = a1.z; v[r][7] = a1.w;
            v[r][8] = a2.x; v[r][9] = a2.y; v[r][10] = a2.z; v[r][11] = a2.w; v[r][12] = a3.x; v[r][13] = a3.y; v[r][14] = a3.z; v[r][15] = a3.w;
            dst[r] = ws + (tab ? WS_VQ : WS_UQ) + (size_t)(row4 + r) * 1024; sc[r] = (float*)(ws + (tab ? WS_VSC : WS_USC)) + row4 + r;
        }
        quant_rows_i8<4>(v, dst, sc, lane);
        if (tab) {
#pragma unroll
            for (int r = 0; r < 4; ++r) { u32x4* q = (u32x4*)(dst[r] + lane * 16); u32x4 w = *q; w ^= (u32x4){0x80808080u, 0x80808080u, 0x80808080u, 0x80808080u}; *q = w; }
        }
    }
}

__device__ __forceinline__ void phase0(const Ctx& c, LAS unsigned char* lds) {
    int tid_ = threadIdx.x; asm volatile("" : "+v"(tid_)); const int tid = tid_;
    const size_t gtid = (size_t)blockIdx.x * NTHR + tid, gthreads = (size_t)gridDim.x * NTHR;
    unsigned char* ws = c.ws;
    cvt_f32_bf16(c.in[18], (bf16*)(ws + WS_KEYS), (size_t)8 * 2 * 128 * 128 / 8, gtid, gthreads);
    {
        const int lane = tid & 63, gw = blockIdx.x * 8 + (tid >> 6), NW = gridDim.x * 8;
        for (int row4 = gw * 4; row4 < T; row4 += NW * 4) {
            float v[4][16]; unsigned char* dst[4]; float* sc[4];
#pragma unroll
            for (int r = 0; r < 4; ++r) {
                const float* src = c.in[0] + (size_t)(row4 + r) * 1024 + lane * 16;
                const f32x4 a0 = *(const f32x4*)src, a1 = *(const f32x4*)(src + 4), a2 = *(const f32x4*)(src + 8), a3 = *(const f32x4*)(src + 12);
                v[r][0] = a0.x; v[r][1] = a0.y; v[r][2] = a0.z; v[r][3] = a0.w; v[r][4] = a1.x; v[r][5] = a1.y; v[r][6] = a1.z; v[r][7] = a1.w;
                v[r][8] = a2.x; v[r][9] = a2.y; v[r][10] = a2.z; v[r][11] = a2.w; v[r][12] = a3.x; v[r][13] = a3.y; v[r][14] = a3.z; v[r][15] = a3.w;
                dst[r] = ws + WS_XQ8 + (size_t)(row4 + r) * 1024; sc[r] = (float*)(ws + WS_SXR) + row4 + r;
            }
            quant_rows_i8<4>(v, dst, sc, lane);
#pragma unroll
            for (int r = 0; r < 4; ++r) {
                u32x4 b0, b1;
#pragma unroll
                for (int j = 0; j < 4; ++j) { b0[j] = pk2(v[r][2 * j], v[r][2 * j + 1]); b1[j] = pk2(v[r][8 + 2 * j], v[r][8 + 2 * j + 1]); }
                bf16* xb = (bf16*)(ws + WS_XB) + (size_t)(row4 + r) * 1024 + lane * 16;
                *(u32x4*)xb = b0; *(u32x4*)(xb + 8) = b1;
            }
        }
    }
    {
        const float* wsrc = c.in[12]; bf16* wt = (bf16*)(ws + WS_WTRIL);
        for (size_t i = gtid; i < (size_t)8 * 128 * 128 / 8; i += gthreads) {
            const int e = (int)i * 8, s0 = e & 127, t = (e >> 7) & 127;
            const f32x4 a = ((const f32x4*)wsrc)[2 * i], b = ((const f32x4*)wsrc)[2 * i + 1];
            float v[8] = {a.x, a.y, a.z, a.w, b.x, b.y, b.z, b.w};
#pragma unroll
            for (int j = 0; j < 8; ++j) v[j] = (s0 + j <= t) ? v[j] : 0.f;
            u32x4 o; o.x = pk2(v[0], v[1]); o.y = pk2(v[2], v[3]); o.z = pk2(v[4], v[5]); o.w = pk2(v[6], v[7]);
            ((u32x4*)wt)[i] = o;
        }
    }
    if (gtid < 1024) { const float lam = c.in[9][gtid]; ((float*)(ws + WS_SPT))[gtid] = 8.0f * NLOG2E * log1pf(expf(-lam));
                       ((float*)(ws + WS_BAS))[gtid] = NLOG2E * c.in[6][gtid]; ((float*)(ws + WS_BXS))[gtid] = NLOG2E * c.in[8][gtid]; }
    if (gtid < 2048) ((float*)(ws + WS_BGS))[gtid] = NLOG2E * c.in[2][gtid];
    {
        LAS float* s = (LAS float*)lds;
        constexpr int N_IN = 16 * 96, N_OUT = 16 * 16, N_Q = 16 * 32, N_G = 64, N_ALL = N_IN + N_OUT + N_Q + N_G;
        for (int it = blockIdx.x; it < N_ALL; it += gridDim.x) {
            int r = it;
            if (r < N_IN) {
                const int n0 = (r % 96) * 64, sec = n0 >> 10, kg = (n0 & 1023) >> 7, j0 = n0 & 127;
                const int ty = (sec == 0 || sec == 3) ? 0 : ((sec == 1 || sec == 4) ? 1 : 2), half = sec >= 3;
                transpose_tile(c.in[1], DIN, (bf16*)(ws + WS_WIN), 1024, (r / 96) * 64, n0, (3 * kg + ty) * 256 + half * 128 + j0, s, tid, sec >= 4 ? NLOG2E : 1.0f); continue;
            }
            r -= N_IN;
            if (r < N_OUT) { transpose_tile(c.in[14], 1024, (bf16*)(ws + WS_WOUT), 1024, (r / 16) * 64, (r % 16) * 64, (r % 16) * 64, s, tid); continue; }
            r -= N_OUT;
            if (r < N_Q) { transpose_tile(c.in[17], 2048, (bf16*)(ws + WS_WQ), 1024, (r / 32) * 64, (r % 32) * 64, (r % 32) * 64, s, tid); continue; }
            r -= N_Q;
            {
                const int h = r >> 3, g = (r >> 2) & 1, kb = (r >> 1) & 1, nb = r & 1;
                const float* W = (g ? c.in[7] : c.in[5]) + (size_t)h * 128 * 128;
                transpose_tile(W, 128, (bf16*)(ws + WS_WAX) + (size_t)h * 256 * 128 + (size_t)g * 128 * 128, 128, kb * 64, nb * 64, nb * 64, s, tid, NLOG2E);
            }
        }
    }
}

__device__ __forceinline__ void phase0b(const Ctx& c) {
    int tid_ = threadIdx.x; asm volatile("" : "+v"(tid_)); const int tid = tid_, lane = tid & 63, wid = tid >> 6;
    unsigned char* ws = c.ws;
    const bf16* W = (const bf16*)(ws + WS_WIN);
    for (int row4 = (blockIdx.x * 8 + wid) * 4; row4 < DIN + (Q_I8 ? 2048 : 0); row4 += gridDim.x * 8 * 4) {
        float v[4][16]; unsigned char* dst[4]; float* sc[4];
#pragma unroll
        for (int r = 0; r < 4; ++r) {
            const int rw = row4 + r; const bool isq = rw >= DIN;
            const bf16* src = (isq ? (const bf16*)(ws + WS_WQ) + (size_t)(rw - DIN) * 1024 : W + (size_t)rw * 1024) + lane * 16;
            const u32x4 a = *(const u32x4*)src, b = *(const u32x4*)(src + 8);
#pragma unroll
            for (int j = 0; j < 4; ++j) { v[r][2 * j] = bf_lo(a[j]); v[r][2 * j + 1] = bf_hi(a[j]); v[r][8 + 2 * j] = bf_lo(b[j]); v[r][8 + 2 * j + 1] = bf_hi(b[j]); }
            dst[r] = isq ? ws + WS_WQQ8 + (size_t)(rw - DIN) * 1024 : ws + WS_WQ8 + (size_t)rw * 1024; sc[r] = isq ? (float*)(ws + WS_SWQ) + (rw - DIN) : (float*)(ws + WS_SWC) + rw;
        }
        quant_rows_i8<4>(v, dst, sc, lane);
    }
}

__device__ __forceinline__ void phase2a(const Ctx& c) {
    int tid_ = threadIdx.x; asm volatile("" : "+v"(tid_)); const int tid = tid_, lane = tid & 63, wid = tid >> 6;
    unsigned char* ws = c.ws;
    const bf16* P4 = (const bf16*)(ws + WS_P4); bf16* XC = (bf16*)c.out; float* STATS = (float*)(ws + WS_STATS);
    const float* conv_w = c.in[3]; const float* conv_b = c.in[4];
    {
        const int gtid = blockIdx.x * NTHR + tid;
        const int cg = gtid & 127, run = gtid >> 7, ch = cg * 8;
        float w[4][8], bias[8];
#pragma unroll
        for (int k = 0; k < 4; ++k) { const f32x4 a = *(const f32x4*)(conv_w + k * 1024 + ch), b = *(const f32x4*)(conv_w + k * 1024 + ch + 4);
            w[k][0] = a.x; w[k][1] = a.y; w[k][2] = a.z; w[k][3] = a.w; w[k][4] = b.x; w[k][5] = b.y; w[k][6] = b.z; w[k][7] = b.w; }
        { const f32x4 a = *(const f32x4*)(conv_b + ch), b = *(const f32x4*)(conv_b + ch + 4);
          bias[0] = a.x; bias[1] = a.y; bias[2] = a.z; bias[3] = a.w; bias[4] = b.x; bias[5] = b.y; bias[6] = b.z; bias[7] = b.w; }
        for (int rn = run; rn < T / 32; rn += (gridDim.x * NTHR) >> 7) {
            const int t0 = rn * 32; const bool first = (t0 & (SEQ - 1)) == 0;
            const bf16* src = P4 + (size_t)t0 * 4096 + ch;
            u32x4 x0 = (u32x4){0u, 0u, 0u, 0u}, x1 = x0, x2 = x0;
            if (!first) { x0 = *(const u32x4*)(src - 3 * 4096); x1 = *(const u32x4*)(src - 2 * 4096); x2 = *(const u32x4*)(src - 4096); }
#pragma unroll 8
            for (int t = 0; t < 32; ++t) {
                const u32x4 x3 = *(const u32x4*)(src + (size_t)t * 4096);
                float o[8];
#pragma unroll
                for (int j = 0; j < 8; ++j) {
                    const float v0 = (j & 1) ? bf_hi(x0[j >> 1]) : bf_lo(x0[j >> 1]), v1 = (j & 1) ? bf_hi(x1[j >> 1]) : bf_lo(x1[j >> 1]);
                    const float v2 = (j & 1) ? bf_hi(x2[j >> 1]) : bf_lo(x2[j >> 1]), v3 = (j & 1) ? bf_hi(x3[j >> 1]) : bf_lo(x3[j >> 1]);
                    o[j] = bias[j] + w[0][j] * v0 + w[1][j] * v1 + w[2][j] * v2 + w[3][j] * v3;
                }
                u32x4 pk; pk.x = pk2(o[0], o[1]); pk.y = pk2(o[2], o[3]); pk.z = pk2(o[4], o[5]); pk.w = pk2(o[6], o[7]);
                *(u32x4*)(XC + (size_t)(t0 + t) * 1024 + ch) = pk;
                x0 = x1; x1 = x2; x2 = x3;
            }
        }
    }
    for (int row4 = (blockIdx.x * 8 + wid) * 4; row4 < T; row4 += gridDim.x * 8 * 4) {
        u32x4 a[4], b[4];
#pragma unroll
        for (int r = 0; r < 4; ++r) { const bf16* p = P4 + (size_t)(row4 + r) * 4096 + 3072 + lane * 16; a[r] = *(const u32x4*)p; b[r] = *(const u32x4*)(p + 8); }
        float mean[4], q[4];
#pragma unroll
        for (int r = 0; r < 4; ++r) {
            float s = 0.f;
#pragma unroll
            for (int j = 0; j < 4; ++j) s += (bf_lo(a[r][j]) + bf_hi(a[r][j])) + (bf_lo(b[r][j]) + bf_hi(b[r][j]));
            mean[r] = s;
        }
#pragma unroll
        for (int o = 32; o >= 1; o >>= 1) {
#pragma unroll
            for (int r = 0; r < 4; ++r) mean[r] += __shfl_xor(mean[r], o);
        }
#pragma unroll
        for (int r = 0; r < 4; ++r) {
            mean[r] *= (1.0f / 1024.0f);
            float s = 0.f;
#pragma unroll
            for (int j = 0; j < 4; ++j) {
                const float d0 = bf_lo(a[r][j]) - mean[r], d1 = bf_hi(a[r][j]) - mean[r], d2 = bf_lo(b[r][j]) - mean[r], d3 = bf_hi(b[r][j]) - mean[r];
                s += (d0 * d0 + d1 * d1) + (d2 * d2 + d3 * d3);
            }
            q[r] = s;
        }
#pragma unroll
        for (int o = 32; o >= 1; o >>= 1) {
#pragma unroll
            for (int r = 0; r < 4; ++r) q[r] += __shfl_xor(q[r], o);
        }
        if (lane < 4) {
            const float mm = lane == 0 ? mean[0] : lane == 1 ? mean[1] : lane == 2 ? mean[2] : mean[3];
            const float qq = lane == 0 ? q[0] : lane == 1 ? q[1] : lane == 2 ? q[2] : q[3];
            *(f32x2*)(STATS + (size_t)(row4 + lane) * 2) = (f32x2){mm, rsqrtf(qq * (1.0f / 1024.0f) + LN_EPS)};
        }
    }
}

typedef short s16x4 __attribute__((ext_vector_type(4)));
struct P2cRegs { u32x4 v[4]; f32x2 st[4]; };
__device__ __forceinline__ void p2c_load_v(P2cRegs& R, const bf16* P4, const float* STATS, int tile, int h, int tid) {
    const int piece = tid & 15, rowb = tid >> 4;
#pragma unroll
    for (int j = 0; j < 4; ++j) {
        const size_t row = (size_t)(tile * CHUNK + rowb + 32 * j);
        R.v[j] = *(const u32x4*)(P4 + row * 4096 + 3072 + h * 128 + piece * 8);
        R.st[j] = *(const f32x2*)(STATS + row * 2);
    }
}
__device__ __forceinline__ void phase2c(const Ctx& c, LAS unsigned char* lds, const int outcol = 2048) {
    int tid_ = threadIdx.x; asm volatile("" : "+v"(tid_)); const int tid = tid_, lane = tid & 63, wid = __builtin_amdgcn_readfirstlane(tid >> 6), fr = lane & 15, fq = lane >> 4, wr = wid >> 1, wc = wid & 1;
    unsigned char* ws = c.ws;
    bf16* P4 = (bf16*)(ws + WS_P4); const float* STATS = (const float*)(ws + WS_STATS);
    const bf16* HL = (const bf16*)(ws + WS_HL); const bf16* PC = (const bf16*)((const unsigned char*)c.out + OUT_PC);
    const float* PEND = (const float*)(ws + WS_PEND); const float* HEND = (const float*)(ws + WS_HEND);
    LAS float* carry = (LAS float*)(lds + 65536);
    const bf16* WTRIL = (const bf16*)(ws + WS_WTRIL);
    const float* ln_g = c.in[10]; const float* ln_b = c.in[11]; const float* gm_bs = c.in[13];
    const int h = blockIdx.x & 7;
    bf16x8 wf[2][4];
#pragma unroll
    for (int m = 0; m < 2; ++m)
#pragma unroll
        for (int ks = 0; ks < 4; ++ks) wf[m][ks] = *(const bf16x8*)(WTRIL + (size_t)h * 128 * 128 + (32 * wr + 16 * m + fr) * 128 + ks * 32 + fq * 8);
    const int piece = tid & 15, rowb = tid >> 4;
    float lg[8], lb[8];
    { const f32x4 g0 = *(const f32x4*)(ln_g + h * 128 + piece * 8), g1 = *(const f32x4*)(ln_g + h * 128 + piece * 8 + 4), b0 = *(const f32x4*)(ln_b + h * 128 + piece * 8), b1 = *(const f32x4*)(ln_b + h * 128 + piece * 8 + 4);
#pragma unroll
      for (int j = 0; j < 4; ++j) { lg[j] = g0[j]; lg[4 + j] = g1[j]; lb[j] = b0[j]; lb[4 + j] = b1[j]; } }
    const int wr_off = rowb * 256 + ((piece ^ ((rowb & 3) << 2)) << 4);
    const bool wr_swap = ((rowb >> 3) & 1) != 0;
    const int q_ = fr >> 2, p_ = fr & 3;
    int rd_off[2][2];
#pragma unroll
    for (int n2 = 0; n2 < 2; ++n2)
#pragma unroll
        for (int np = 0; np < 2; ++np) rd_off[n2][np] = (fq * 8 + q_) * 256 + (((8 * wc + 4 * n2 + p_) ^ (q_ << 2)) << 4) + ((np ^ (fq & 1)) << 3);
    const int nblk_h = gridDim.x >> 3;
    const int tile0 = blockIdx.x >> 3;
    P2cRegs RA, RB;
    if (tile0 < NTILE) p2c_load_v(RA, P4, STATS, tile0, h, tid);
    if (tile0 + nblk_h < NTILE) p2c_load_v(RB, P4, STATS, tile0 + nblk_h, h, tid);
#define P2C_UNIT(R, tile, par) do { \
        const int t0 = (tile) * CHUNK; \
        LAS unsigned char* V = lds + (par) * 32768; \
        _Pragma("unroll") for (int j = 0; j < 4; ++j) { \
            const float mean = R.st[j].x, rstd = R.st[j].y; \
            u32x4 w; \
            _Pragma("unroll") for (int e = 0; e < 4; ++e) w[e] = pk2((bf_lo(R.v[j][e]) - mean) * rstd * lg[2 * e] + lb[2 * e], (bf_hi(R.v[j][e]) - mean) * rstd * lg[2 * e + 1] + lb[2 * e + 1]); \
            if (wr_swap) w = (u32x4){w.z, w.w, w.x, w.y}; \
            *(LAS u32x4*)(V + wr_off + j * 32 * 256) = w; } \
        if (tid < 128) {                                        \
            const int cidx_ = (tile) & (NCHUNK - 1), tb_ = (tile) - cidx_; float hin_ = 0.f; \
            _Pragma("unroll") for (int cc = 0; cc < NCHUNK - 1; ++cc) { \
                const bool on_ = cc < cidx_; const int tl_ = on_ ? tb_ + cc : tb_; \
                const float p_ = PEND[(size_t)tl_ * 1024 + h * 128 + tid], q_ = HEND[(size_t)tl_ * 1024 + h * 128 + tid]; \
                hin_ = on_ ? p_ * hin_ + q_ : hin_; } \
            carry[(par) * 128 + tid] = hin_; } \
        __syncthreads(); \
        if ((tile) + 2 * nblk_h < NTILE) p2c_load_v(R, P4, STATS, (tile) + 2 * nblk_h, h, tid); \
        u32x4 hlv[2][2], pcv[2][2], gvv[2][2], ugv[2][2]; \
        _Pragma("unroll") for (int m = 0; m < 2; ++m) _Pragma("unroll") for (int n2 = 0; n2 < 2; ++n2) { \
            const size_t row_ = (size_t)(t0 + 32 * wr + 16 * m + fr); const int col_ = h * 128 + 64 * wc + 32 * n2 + 8 * fq; \
            hlv[m][n2] = *(const u32x4*)(HL + row_ * 1024 + col_); pcv[m][n2] = *(const u32x4*)(PC + row_ * 1024 + col_); gvv[m][n2] = *(const u32x4*)(P4 + row_ * 4096 + 1024 + col_); ugv[m][n2] = *(const u32x4*)(P4 + row_ * 4096 + 2048 + col_); } \
        f32x4 acc[2][4]; \
        _Pragma("unroll") for (int m = 0; m < 2; ++m) _Pragma("unroll") for (int n = 0; n < 4; ++n) acc[m][n] = (f32x4){0.f, 0.f, 0.f, 0.f}; \
        _Pragma("unroll") for (int ks = 0; ks < 4; ++ks) { \
            if (ks <= wr) { \
                bf16x8 b[4]; \
                _Pragma("unroll") for (int n = 0; n < 4; ++n) { \
                    const s16x4 lo = __builtin_amdgcn_ds_read_tr16_b64_v4i16((LAS s16x4*)(V + rd_off[n >> 1][n & 1] + ks * 32 * 256)); \
                    const s16x4 hi = __builtin_amdgcn_ds_read_tr16_b64_v4i16((LAS s16x4*)(V + rd_off[n >> 1][n & 1] + ks * 32 * 256 + 4 * 256)); \
                    b[n] = __builtin_shufflevector(lo, hi, 0, 1, 2, 3, 4, 5, 6, 7); } \
                _Pragma("unroll") for (int m = 0; m < 2; ++m) _Pragma("unroll") for (int n = 0; n < 4; ++n) acc[m][n] = __builtin_amdgcn_mfma_f32_16x16x32_bf16(b[n], wf[m][ks], acc[m][n], 0, 0, 0); } } \
        _Pragma("unroll") for (int m = 0; m < 2; ++m) { \
            const int tl = 32 * wr + 16 * m + fr; \
            const float bsv = gm_bs[h * 128 + tl]; \
            _Pragma("unroll") for (int n2 = 0; n2 < 2; ++n2) { \
                const f32x4 m0 = acc[m][2 * n2] + bsv, m1 = acc[m][2 * n2 + 1] + bsv; \
                const u32x4 ug = ugv[m][n2], hl_ = hlv[m][n2], pc_ = pcv[m][n2], g_ = gvv[m][n2]; \
                const LAS float* cp_ = carry + (par) * 128 + 64 * wc + 32 * n2 + 8 * fq; \
                const f32x4 h0_ = *(const LAS f32x4*)cp_, h1_ = *(const LAS f32x4*)(cp_ + 4); \
                u32x4 o;                                             \
                o.x = pk2(bf_lo(g_.x) * (bf_lo(hl_.x) + bf_lo(pc_.x) * h0_[0]) + bf_lo(ug.x) * m0[0], bf_hi(g_.x) * (bf_hi(hl_.x) + bf_hi(pc_.x) * h0_[1]) + bf_hi(ug.x) * m0[1]); \
                o.y = pk2(bf_lo(g_.y) * (bf_lo(hl_.y) + bf_lo(pc_.y) * h0_[2]) + bf_lo(ug.y) * m0[2], bf_hi(g_.y) * (bf_hi(hl_.y) + bf_hi(pc_.y) * h0_[3]) + bf_hi(ug.y) * m0[3]); \
                o.z = pk2(bf_lo(g_.z) * (bf_lo(hl_.z) + bf_lo(pc_.z) * h1_[0]) + bf_lo(ug.z) * m1[0], bf_hi(g_.z) * (bf_hi(hl_.z) + bf_hi(pc_.z) * h1_[1]) + bf_hi(ug.z) * m1[1]); \
                o.w = pk2(bf_lo(g_.w) * (bf_lo(hl_.w) + bf_lo(pc_.w) * h1_[2]) + bf_lo(ug.w) * m1[2], bf_hi(g_.w) * (bf_hi(hl_.w) + bf_hi(pc_.w) * h1_[3]) + bf_hi(ug.w) * m1[3]); \
                *(u32x4*)(P4 + (size_t)(t0 + tl) * 4096 + outcol + h * 128 + 64 * wc + 32 * n2 + 8 * fq) = o; } } \
    } while (0)
    for (int tile = tile0; tile < NTILE; tile += 2 * nblk_h) {
        P2C_UNIT(RA, tile, 0);
        if (tile + nblk_h < NTILE) P2C_UNIT(RB, tile + nblk_h, 1);
    }
#undef P2C_UNIT
}

__device__ __forceinline__ void phase5(const Ctx& c) {
    int tid_ = threadIdx.x; asm volatile("" : "+v"(tid_)); const int tid = tid_, lane = tid & 63, wid = tid >> 6;
    unsigned char* ws = c.ws;
    const bf16* Z = (const bf16*)c.out; bf16* X1B = (bf16*)(ws + WS_X1B);
    const float* g = c.in[15]; const float* b = c.in[16];
    float gv[16], bv[16];
#pragma unroll
    for (int j = 0; j < 4; ++j) { const f32x4 a = *(const f32x4*)(g + lane * 16 + 4 * j), d = *(const f32x4*)(b + lane * 16 + 4 * j);
        gv[4 * j] = a.x; gv[4 * j + 1] = a.y; gv[4 * j + 2] = a.z; gv[4 * j + 3] = a.w; bv[4 * j] = d.x; bv[4 * j + 1] = d.y; bv[4 * j + 2] = d.z; bv[4 * j + 3] = d.w; }
    for (int row4 = (blockIdx.x * 8 + wid) * 4; row4 < T; row4 += gridDim.x * 8 * 4) {
        u32x4 za[4], zb[4];
#pragma unroll
        for (int r = 0; r < 4; ++r) { const bf16* p = Z + (size_t)(row4 + r) * 1024 + lane * 16; za[r] = *(const u32x4*)p; zb[r] = *(const u32x4*)(p + 8); }
        float mean[4], q[4];
#pragma unroll
        for (int r = 0; r < 4; ++r) {
            float s = 0.f;
#pragma unroll
            for (int j = 0; j < 4; ++j) s += (bf_lo(za[r][j]) + bf_hi(za[r][j])) + (bf_lo(zb[r][j]) + bf_hi(zb[r][j]));
            mean[r] = s;
        }
#pragma unroll
        for (int o = 32; o >= 1; o >>= 1) {
#pragma unroll
            for (int r = 0; r < 4; ++r) mean[r] += __shfl_xor(mean[r], o);
        }
#pragma unroll
        for (int r = 0; r < 4; ++r) {
            mean[r] *= (1.0f / 1024.0f);
            float s = 0.f;
#pragma unroll
            for (int j = 0; j < 4; ++j) {
                const float d0 = bf_lo(za[r][j]) - mean[r], d1 = bf_hi(za[r][j]) - mean[r], d2 = bf_lo(zb[r][j]) - mean[r], d3 = bf_hi(zb[r][j]) - mean[r];
                s += (d0 * d0 + d1 * d1) + (d2 * d2 + d3 * d3);
            }
            q[r] = s;
        }
#pragma unroll
        for (int o = 32; o >= 1; o >>= 1) {
#pragma unroll
            for (int r = 0; r < 4; ++r) q[r] += __shfl_xor(q[r], o);
        }
#pragma unroll
        for (int r = 0; r < 4; ++r) {
            const float rstd = rsqrtf(q[r] * (1.0f / 1024.0f) + LN_EPS);
            u32x4 oa, ob;
#pragma unroll
            for (int j = 0; j < 4; ++j) {
                oa[j] = pk2((bf_lo(za[r][j]) - mean[r]) * rstd * gv[2 * j] + bv[2 * j], (bf_hi(za[r][j]) - mean[r]) * rstd * gv[2 * j + 1] + bv[2 * j + 1]);
                ob[j] = pk2((bf_lo(zb[r][j]) - mean[r]) * rstd * gv[8 + 2 * j] + bv[8 + 2 * j], (bf_hi(zb[r][j]) - mean[r]) * rstd * gv[8 + 2 * j + 1] + bv[8 + 2 * j + 1]);
            }
            bf16* op = X1B + (size_t)(row4 + r) * 1024 + lane * 16;
            *(u32x4*)op = oa; *(u32x4*)(op + 8) = ob;
#if Q_I8
            {
                float xv[1][16]; unsigned char* dq[1] = {ws + WS_X1Q8 + (size_t)(row4 + r) * 1024}; float* sq[1] = {(float*)(ws + WS_SX1) + row4 + r};
#pragma unroll
                for (int j = 0; j < 4; ++j) { xv[0][2 * j] = bf_lo(oa[j]); xv[0][2 * j + 1] = bf_hi(oa[j]); xv[0][8 + 2 * j] = bf_lo(ob[j]); xv[0][8 + 2 * j + 1] = bf_hi(ob[j]); }
                quant_rows_i8<1>(xv, dq, sq, lane);
            }
#endif
        }
    }
}

__device__ __forceinline__ int f2key(float f) { const int b = __float_as_int(f); return b ^ ((b >> 31) & 0x7fffffff); }
__device__ __forceinline__ float key2f(int k) { return __int_as_float(k ^ ((k >> 31) & 0x7fffffff)); }
#define CE_DESC(a, b) do { const int _mx = max((a), (b)), _mn = min((a), (b)); (a) = _mx; (b) = _mn; } while (0)

template <int OFF, int N> __device__ __forceinline__ void sort16_desc(int (&v)[N]) {
#pragma unroll
    for (int k = 2; k <= 16; k <<= 1) {
#pragma unroll
        for (int j = k >> 1; j > 0; j >>= 1) {
#pragma unroll
            for (int i = 0; i < 16; ++i) {
                const int l = i ^ j;
                if (l > i) { if ((i & k) == 0) CE_DESC(v[OFF + i], v[OFF + l]); else CE_DESC(v[OFF + l], v[OFF + i]); }
            }
        }
    }
}
template <int OA, int OB, int N> __device__ __forceinline__ void merge16_desc(int (&v)[N]) {
#pragma unroll
    for (int i = 0; i < 16; ++i) v[OA + i] = max(v[OA + i], v[OB + 15 - i]);
#pragma unroll
    for (int j = 8; j > 0; j >>= 1) {
#pragma unroll
        for (int i = 0; i < 16; ++i) { const int l = i ^ j; if (l > i) CE_DESC(v[OA + i], v[OA + l]); }
    }
}
__device__ __forceinline__ void top16_of_64(int (&v)[64]) {
    sort16_desc<0>(v); sort16_desc<16>(v); sort16_desc<32>(v); sort16_desc<48>(v);
    merge16_desc<0, 16>(v); merge16_desc<32, 48>(v); merge16_desc<0, 32>(v);
}
__device__ __forceinline__ void merge_partner(int (&L)[16]) {
    int P[16];
#pragma unroll
    for (int i = 0; i < 16; ++i) P[i] = __shfl_xor(L[i], 32);
#pragma unroll
    for (int i = 0; i < 16; ++i) L[i] = max(L[i], P[15 - i]);
#pragma unroll
    for (int j = 8; j > 0; j >>= 1) {
#pragma unroll
        for (int i = 0; i < 16; ++i) { const int l = i ^ j; if (l > i) CE_DESC(L[i], L[l]); }
    }
}
__device__ __forceinline__ unsigned lookup_byte(const unsigned (&t)[4], int i) {
    const int w = i >> 2;
    const unsigned dw = (w == 0) ? t[0] : (w == 1) ? t[1] : (w == 2) ? t[2] : t[3];
    return (dw >> ((i & 3) * 8)) & 0xffu;
}

typedef _Float16 h16x2 __attribute__((ext_vector_type(2)));
__device__ __forceinline__ unsigned pkh2(float lo, float hi) { return __builtin_bit_cast(unsigned, __builtin_amdgcn_cvt_pkrtz(lo, hi)); }
__device__ __forceinline__ float h_lo(unsigned w) { return (float)__builtin_bit_cast(h16x2, w)[0]; }
__device__ __forceinline__ float h_hi(unsigned w) { return (float)__builtin_bit_cast(h16x2, w)[1]; }
constexpr int P7_KP = 272;
__device__ __forceinline__ void phase7(const Ctx& c, LAS unsigned char* lds) {
    int tid_ = threadIdx.x; asm volatile("" : "+v"(tid_)); const int tid = tid_, lane = tid & 63, wid = __builtin_amdgcn_readfirstlane(tid >> 6), r = lane & 31, hh = lane >> 5;
    unsigned char* ws = c.ws;
    const bf16* Q = (const bf16*)(ws + WS_Q); const bf16* KB = (const bf16*)(ws + WS_KEYS);
    int* IDX = (int*)(ws + WS_IDX); float* GATE = (float*)(ws + WS_GATE);
    const int head = blockIdx.x & 7, nblk_h = gridDim.x >> 3;
    {
        const bf16* ksrc = KB + (size_t)head * 256 * 128;
        for (int i = tid; i < 256 * 16; i += NTHR) { const int row = i >> 4, sg = i & 15; *(LAS u32x4*)(lds + row * P7_KP + sg * 16) = *(const u32x4*)(ksrc + row * 128 + sg * 8); }
    }
    __syncthreads();
    const LAS unsigned char* kl = lds + r * P7_KP + hh * 16;
    if (wid & 1) quant_peer_tables(c, blockIdx.x * 8 + wid, gridDim.x * 8, lane);
    for (int grp = (blockIdx.x >> 3) * 8 + wid; grp < T / 32; grp += nblk_h * 8) {
        const int tok = grp * 32 + r;
        int kz = 0; asm volatile("" : "+v"(kz));
        const LAS unsigned char* klz = kl + kz;
        bf16x8 qf[2][8];
        {
            const bf16* qp = Q + (size_t)tok * 2048 + head * 256 + hh * 8;
#pragma unroll
            for (int p = 0; p < 2; ++p)
#pragma unroll
                for (int ks = 0; ks < 8; ++ks) qf[p][ks] = *(const bf16x8*)(qp + p * 128 + ks * 16);
        }
        int S[2][16];
#pragma unroll
        for (int p = 0; p < 2; ++p) {
            f32x16 acc[4];
#pragma unroll
            for (int mb = 0; mb < 4; ++mb)
#pragma unroll
                for (int e = 0; e < 16; ++e) acc[mb][e] = 0.f;
#pragma unroll
            for (int ks = 0; ks < 8; ++ks) {
#pragma unroll
                for (int mb = 0; mb < 4; ++mb) {
                    const bf16x8 a = *(const LAS bf16x8*)(klz + (p * 128 + mb * 32) * P7_KP + ks * 32);
                    acc[mb] = __builtin_amdgcn_mfma_f32_32x32x16_bf16(a, qf[p][ks], acc[mb], 0, 0, 0);
                }
            }
            int v[64];
#pragma unroll
            for (int mb = 0; mb < 4; ++mb)
#pragma unroll
                for (int e = 0; e < 16; ++e) {
                    const int n = mb * 32 + (e & 3) + 8 * (e >> 2);
                    v[mb * 16 + e] = (f2key(acc[mb][e]) & ~0x7f) | n;
                }
            top16_of_64(v);
            int L[16];
#pragma unroll
            for (int i = 0; i < 16; ++i) L[i] = v[i] | (hh << 2);
            merge_partner(L);
#pragma unroll
            for (int i = 0; i < 16; ++i) S[p][i] = L[i];
        }
        float f1[16], f2[16];
#pragma unroll
        for (int i = 0; i < 16; ++i) { f1[i] = key2f(S[0][i]); f2[i] = key2f(S[1][i]); }
        int cv[64];
        {
            int n = 0;
#pragma unroll
            for (int i = 0; i < 16; ++i)
#pragma unroll
                for (int j = 0; j < 16; ++j)
                    if ((i + 1) * (j + 1) <= 16) { cv[n] = (f2key(f1[i] + f2[j]) & ~0xff) | (i * 16 + j); ++n; }
#pragma unroll
            for (int q = 50; q < 64; ++q) cv[q] = (int)0x80000000;
        }
        top16_of_64(cv);
        unsigned t1[4], t2[4];
#pragma unroll
        for (int w = 0; w < 4; ++w) {
            t1[w] = (unsigned)(S[0][4 * w] & 0x7f) | ((unsigned)(S[0][4 * w + 1] & 0x7f) << 8) | ((unsigned)(S[0][4 * w + 2] & 0x7f) << 16) | ((unsigned)(S[0][4 * w + 3] & 0x7f) << 24);
            t2[w] = (unsigned)(S[1][4 * w] & 0x7f) | ((unsigned)(S[1][4 * w + 1] & 0x7f) << 8) | ((unsigned)(S[1][4 * w + 2] & 0x7f) << 16) | ((unsigned)(S[1][4 * w + 3] & 0x7f) << 24);
        }
        int eid[16]; float ev[16];
        const float vmax = key2f(cv[0]);
        float esum = 0.f;
#pragma unroll
        for (int k = 0; k < 16; ++k) {
            const int pos = cv[k] & 0xff;
            eid[k] = (int)(lookup_byte(t1, pos >> 4) * 128u + lookup_byte(t2, pos & 15));
            ev[k] = __expf(key2f(cv[k]) - vmax);
            esum += ev[k];
        }
        const float inv = 1.0f / esum;
        if (hh == 0) {
            i32x4* ip = (i32x4*)(IDX + (size_t)tok * 128 + head * 16); f32x4* gp = (f32x4*)(GATE + (size_t)tok * 128 + head * 16);
#pragma unroll
            for (int w = 0; w < 4; ++w) {
                ip[w] = (i32x4){eid[4 * w], eid[4 * w + 1], eid[4 * w + 2], eid[4 * w + 3]};
                gp[w] = (f32x4){ev[4 * w] * inv, ev[4 * w + 1] * inv, ev[4 * w + 2] * inv, ev[4 * w + 3] * inv};
            }
        }
    }
    if (!(wid & 1)) quant_peer_tables(c, blockIdx.x * 8 + wid, gridDim.x * 8, lane);
}

#define UB0(w) ((float)((w) & 0xffu))
#define UB1(w) ((float)(((w) >> 8) & 0xffu))
#define UB2(w) ((float)(((w) >> 16) & 0xffu))
#define UB3(w) ((float)((w) >> 24))
#ifndef P8_NSH_
#define P8_NSH_ 16
#endif
#ifndef P8_CH_
#define P8_CH_ 12
#endif
#ifndef P8_PACE_
#define P8_PACE_ 0
#endif
#ifndef P8_NT_
#define P8_NT_ 0
#endif
#if P8_NT_
#define P8_LD(p) __builtin_nontemporal_load(p)
#else
#define P8_LD(p) (*(p))
#endif
#ifndef P8_SYNC_
#define P8_SYNC_ 0
#endif
#ifndef P8_GSYNC_
#define P8_GSYNC_ 0
#endif
#ifndef P8_TOK_
#define P8_TOK_ 8
#endif
constexpr int P8_TOK = P8_TOK_, P8_LIST = 1024 + 512, P8_NSH = P8_NSH_, P8_CH = P8_CH_, P8_SHIFT = (P8_NSH_ == 64 ? 8 : (P8_NSH_ == 32 ? 9 : (P8_NSH_ == 16 ? 10 : (P8_NSH_ == 8 ? 11 : (P8_NSH_ == 4 ? 12 : (P8_NSH_ == 2 ? 13 : 14))))));
template <int CTRL> __device__ __forceinline__ float dppf(float v) { return __int_as_float(__builtin_amdgcn_update_dpp(0, __float_as_int(v), CTRL, 0xf, 0xf, false)); }
__device__ __forceinline__ float reduce16(const float (&p)[16], bool b3, bool b2) {
    float q8[8], r4[4], s2[2];
#pragma unroll
    for (int i = 0; i < 8; ++i) { const auto r = __builtin_amdgcn_permlane32_swap(__float_as_uint(p[i]), __float_as_uint(p[8 + i]), false, false); q8[i] = __uint_as_float(r[0]) + __uint_as_float(r[1]); }
#pragma unroll
    for (int i = 0; i < 4; ++i) { const auto r = __builtin_amdgcn_permlane16_swap(__float_as_uint(q8[i]), __float_as_uint(q8[4 + i]), false, false); r4[i] = __uint_as_float(r[0]) + __uint_as_float(r[1]); }
#pragma unroll
    for (int i = 0; i < 2; ++i) { const float ta = r4[i] + dppf<0x128>(r4[i]), tb = r4[2 + i] + dppf<0x128>(r4[2 + i]); s2[i] = b3 ? tb : ta; }
    const float ta = s2[0] + dppf<0x141>(s2[0]), tb = s2[1] + dppf<0x141>(s2[1]);
    float t = b2 ? tb : ta;
    t += dppf<0x4e>(t);
    t += dppf<0xb1>(t);
    return t;
}
__device__ __forceinline__ void phase8(const Ctx& c, LAS unsigned char* lds, const XcdBarrier& xbar) {
    int tid_ = threadIdx.x; asm volatile("" : "+v"(tid_)); const int tid = tid_, lane = tid & 63, wid = __builtin_amdgcn_readfirstlane(tid >> 6);
    unsigned char* ws = c.ws;
    const bf16* X1B = (const bf16*)(ws + WS_X1B);
    const int* IDX = (const int*)(ws + WS_IDX); const float* GATE = (const float*)(ws + WS_GATE);
    const unsigned char* UQ = ws + WS_UQ; const unsigned char* VQ = ws + WS_VQ;
    const float* USC = (const float*)(ws + WS_USC); const float* VSC = (const float*)(ws + WS_VSC);
    const float* lg = c.in[21]; const float* lb = c.in[22];
    float* OUT = c.out;
    const bool b3 = (lane & 8) != 0, b2 = (lane & 4) != 0;
    const int esub = lane >> 2;
    LAS unsigned char* wl = lds + wid * (P8_TOK * P8_LIST);
    const int ntl = (NTILE + gridDim.x - 1) / gridDim.x;
#if P8_PACE_
    if (lane == 0) ((volatile LAS int*)(lds + 8 * P8_TOK * P8_LIST))[wid] = 0;
    __syncthreads();
#endif
    for (int ti = 0; ti < ntl; ++ti) {
        const int tile = blockIdx.x + ti * gridDim.x; const bool live = tile < NTILE;
        for (int rnd = 0; rnd < 16 / P8_TOK; ++rnd) {
            if (P8_GSYNC_) xcd_barrier(xbar);
            const int tok0 = tile * CHUNK + wid * 16 + rnd * P8_TOK;
            int xq[P8_TOK][4]; float sx[P8_TOK], aacc[P8_TOK]; unsigned ob[P8_TOK][8];
            if (live) {
#pragma unroll
                for (int tt = 0; tt < P8_TOK; ++tt) {
                    const int tok = tok0 + tt;
                    {
                        const bf16* xr = X1B + (size_t)tok * 1024 + lane * 16;
                        const u32x4 a0 = *(const u32x4*)xr, a1 = *(const u32x4*)(xr + 8);
                        float x[16];
#pragma unroll
                        for (int j = 0; j < 4; ++j) { x[2 * j] = bf_lo(a0[j]); x[2 * j + 1] = bf_hi(a0[j]); x[8 + 2 * j] = bf_lo(a1[j]); x[8 + 2 * j + 1] = bf_hi(a1[j]); }
                        float m = 0.f;
#pragma unroll
                        for (int j = 0; j < 16; ++j) m = fmaxf(m, fabsf(x[j]));
#pragma unroll
                        for (int of = 32; of >= 1; of >>= 1) m = fmaxf(m, __shfl_xor(m, of));
                        const float sc = (m > 0.f) ? m * (1.0f / 127.0f) : 1.0f, inv = 1.0f / sc;
                        sx[tt] = sc;
#pragma unroll
                        for (int w = 0; w < 4; ++w) {
                            unsigned pk = 0;
#pragma unroll
                            for (int k = 0; k < 4; ++k) pk |= ((unsigned)(int)rintf(x[4 * w + k] * inv) & 0xffu) << (8 * k);
                            xq[tt][w] = (int)pk;
                        }
                    }
                    aacc[tt] = 0.f;
#pragma unroll
                    for (int j = 0; j < 8; ++j) ob[tt][j] = 0u;
                    {
                        LAS unsigned char* L = wl + tt * P8_LIST;
                        const int i0 = IDX[(size_t)tok * 128 + lane], i1 = IDX[(size_t)tok * 128 + 64 + lane];
                        const float g0 = GATE[(size_t)tok * 128 + lane], g1 = GATE[(size_t)tok * 128 + 64 + lane];
                        const int k0 = i0 >> P8_SHIFT, k1 = i1 >> P8_SHIFT;
                        int base = 0, pos0 = 0, pos1 = 0;
#pragma unroll
                        for (int s = 0; s < P8_NSH; ++s) {
                            const unsigned long long m0 = __ballot(k0 == s), m1 = __ballot(k1 == s);
                            const int c0 = __popcll(m0), c1 = __popcll(m1);
                            const int pre0 = __builtin_amdgcn_mbcnt_hi((unsigned)(m0 >> 32), __builtin_amdgcn_mbcnt_lo((unsigned)m0, 0));
                            const int pre1 = __builtin_amdgcn_mbcnt_hi((unsigned)(m1 >> 32), __builtin_amdgcn_mbcnt_lo((unsigned)m1, 0));
                            pos0 = (k0 == s) ? base + pre0 : pos0;
                            pos1 = (k1 == s) ? base + c0 + pre1 : pos1;
                            if (lane == 0) *(LAS int*)(L + 1024 + 4 * s) = base;
                            base += c0 + c1;
                        }
                        if (lane == 0) *(LAS int*)(L + 1024 + 4 * P8_NSH) = base;
                        *(LAS u32x2*)(L + pos0 * 8) = (u32x2){(unsigned)i0, __float_as_uint(g0)};
                        *(LAS u32x2*)(L + pos1 * 8) = (u32x2){(unsigned)i1, __float_as_uint(g1)};
                    }
                }
            }
            for (int s = 0; s < P8_NSH; ++s) {
#if P8_PACE_
                {
                    volatile LAS int* prog = (volatile LAS int*)(lds + 8 * P8_TOK * P8_LIST);
                    const int mine = (ti * (16 / P8_TOK) + rnd) * P8_NSH + s;
                    if (lane == 0) prog[wid] = mine;
                    for (int spin = 0; spin < 4096; ++spin) {
                        int mn = prog[0];
#pragma unroll
                        for (int w = 1; w < 8; ++w) { const int pw = prog[w]; mn = pw < mn ? pw : mn; }
                        if (__builtin_amdgcn_readfirstlane(mn) + P8_PACE_ >= mine) break;
                        __builtin_amdgcn_s_sleep(8);
                    }
                }
#endif
                if (live) {
#pragma unroll
                    for (int tt = 0; tt < P8_TOK; ++tt) {
                        const LAS unsigned char* L = wl + tt * P8_LIST;
                        const int eb = __builtin_amdgcn_readfirstlane(*(const LAS int*)(L + 1024 + 4 * s)), ee = __builtin_amdgcn_readfirstlane(*(const LAS int*)(L + 1024 + 4 * s + 4));
                        for (int c0 = eb; c0 < ee; c0 += P8_CH) {
                            const int ent = c0 + esub; const bool valid = (esub < P8_CH) && (ent < ee);
                            const u32x2 en = *(const LAS u32x2*)(L + (valid ? ent : eb) * 8);
                            const int idv = (int)en.x; const float gv = valid ? __uint_as_float(en.y) : 0.f;
                            const float su = USC[idv], sv = VSC[idv];
                            u32x4 u[P8_CH], v[P8_CH];
#pragma unroll
                            for (int e = 0; e < P8_CH; ++e) {
                                if (c0 + e < ee) {
                                    const int id = __builtin_amdgcn_readlane(idv, e * 4);
                                    u[e] = P8_LD((const u32x4*)(UQ + (size_t)id * 1024 + lane * 16));
                                    v[e] = P8_LD((const u32x4*)(VQ + (size_t)id * 1024 + lane * 16));
                                } else { u[e] = (u32x4){0u, 0u, 0u, 0u}; v[e] = (u32x4){0u, 0u, 0u, 0u}; }
                            }
                            float p[16];
#pragma unroll
                            for (int e = 0; e < 16; ++e) {
                                if (e < P8_CH) {
                                    int a = 0;
#pragma unroll
                                    for (int w = 0; w < 4; ++w) a = __builtin_amdgcn_sdot4((int)u[e][w], xq[tt][w], a, false);
                                    p[e] = (float)a;
                                } else p[e] = 0.f;
                            }
                            const float t1 = reduce16(p, b3, b2);
                            const float act = gelu_tanh(t1 * su * sx[tt]) * gv * sv;
                            aacc[tt] += act;
                            float oc[16];
#pragma unroll
                            for (int j = 0; j < 8; ++j) { oc[2 * j] = h_lo(ob[tt][j]); oc[2 * j + 1] = h_hi(ob[tt][j]); }
#pragma unroll
                            for (int e = 0; e < P8_CH; ++e) {
                                if (c0 + e < ee) {
                                    const float ae = __int_as_float(__builtin_amdgcn_readlane(__float_as_int(act), e * 4));
#pragma unroll
                                    for (int w = 0; w < 4; ++w) {
                                        oc[4 * w] += ae * UB0(v[e][w]); oc[4 * w + 1] += ae * UB1(v[e][w]); oc[4 * w + 2] += ae * UB2(v[e][w]); oc[4 * w + 3] += ae * UB3(v[e][w]);
                                    }
                                }
                            }
#pragma unroll
                            for (int j = 0; j < 8; ++j) ob[tt][j] = pkh2(oc[2 * j], oc[2 * j + 1]);
                        }
                    }
                }
                if (P8_SYNC_) __syncthreads();
            }
            if (live) {
#pragma unroll
                for (int tt = 0; tt < P8_TOK; ++tt) {
                    const int tok = tok0 + tt;
                    const float ooff = -128.0f * 0.25f * wave_sum(aacc[tt]);
                    float x[16];
                    {
                        const bf16* xr = X1B + (size_t)tok * 1024 + lane * 16;
                        const u32x4 a0 = *(const u32x4*)xr, a1 = *(const u32x4*)(xr + 8);
#pragma unroll
                        for (int j = 0; j < 4; ++j) { x[2 * j] = bf_lo(a0[j]); x[2 * j + 1] = bf_hi(a0[j]); x[8 + 2 * j] = bf_lo(a1[j]); x[8 + 2 * j + 1] = bf_hi(a1[j]); }
                    }
                    float sm = 0.f;
                    float o[16];
#pragma unroll
                    for (int j = 0; j < 8; ++j) { o[2 * j] = h_lo(ob[tt][j]); o[2 * j + 1] = h_hi(ob[tt][j]); }
#pragma unroll
                    for (int j = 0; j < 16; ++j) { o[j] = ALPHA * x[j] + (o[j] + ooff); sm += o[j]; }
                    const float mean = wave_sum(sm) * (1.0f / 1024.0f);
                    float qv = 0.f;
#pragma unroll
                    for (int j = 0; j < 16; ++j) { o[j] -= mean; qv += o[j] * o[j]; }
                    const float rstd = rsqrtf(wave_sum(qv) * (1.0f / 1024.0f) + LN_EPS);
                    const float* gp = lg + lane * 16; const float* bp = lb + lane * 16;
                    float* op = OUT + (size_t)tok * 1024 + lane * 16;
#pragma unroll
                    for (int w = 0; w < 4; ++w) {
                        const f32x4 gg = *(const f32x4*)(gp + 4 * w), hb = *(const f32x4*)(bp + 4 * w);
                        *(f32x4*)(op + 4 * w) = (f32x4){o[4 * w], o[4 * w + 1], o[4 * w + 2], o[4 * w + 3]} * rstd * gg + hb;
                    }
                }
            }
        }
    }
}

struct Params { const float* in[23]; float* out; unsigned char* ws; };

__global__ void __launch_bounds__(NTHR, 2) hybrid_fwd(Params p) {
    extern __shared__ __attribute__((aligned(16))) unsigned char lds_raw[];
    LAS unsigned char* lds = (LAS unsigned char*)lds_raw;
    cg::grid_group grid = cg::this_grid();
    Ctx c;
#pragma unroll
    for (int i = 0; i < 23; ++i) c.in[i] = p.in[i];
    c.out = p.out; c.ws = p.ws;
    unsigned char* ws = p.ws;

#ifndef G6_ALIGN
#define G6_ALIGN true
#endif
#ifndef G4_ALIGN
#define G4_ALIGN true
#endif
#ifndef G1_ALIGN
#define G1_ALIGN true
#endif
#ifndef G1_SP2
#define G1_SP2 true
#endif
#ifndef PH_MASK
#define PH_MASK 0x1ff
#endif
#ifndef REP0
#define REP0 1
#endif
#ifndef REP123
#define REP123 1
#endif
#ifndef REP1
#define REP1 1
#endif
#ifndef REP4
#define REP4 1
#endif
#ifndef REP5
#define REP5 1
#endif
#ifndef REP6
#define REP6 1
#endif
#ifndef REP7
#define REP7 1
#endif
#ifndef REP8
#define REP8 1
#endif
    if (threadIdx.x < 4) ((volatile LAS unsigned*)(lds + LDS_BARST))[threadIdx.x] = 0u;
    __syncthreads();
    const XcdBarrier xbar = xcd_barrier_post((unsigned*)(ws + WS_BAR), (volatile LAS unsigned*)(lds + LDS_BARST));
    if (p.ws == nullptr) grid.sync();
#define GSYNC() xcd_barrier(xbar)
    for (int rep = 0; rep < REP0; ++rep) { if (PH_MASK & 1) phase0(c, lds);
    GSYNC(); }
    if (PH_MASK & 1) phase0b(c);
    GSYNC();
    for (int rep123 = 0; rep123 < REP123; ++rep123) {
    for (int rep1 = 0; rep1 < REP1; ++rep1) {
    if (PH_MASK & 2) {
        pg8::Gemm g{(const bf16*)(ws + WS_XQ8), (const bf16*)(ws + WS_WQ8), T, DIN, 512, 512, 512, 0};
        pg8::StaticOrder S; S.init(T, DIN, (int)gridDim.x, (int)blockIdx.x);
        pg8::EpiProj E{(bf16*)(ws + WS_P4), (const float*)(ws + WS_BGS), (const float*)(ws + WS_SXR), (const float*)(ws + WS_SWC)};
        pg8::gemm_phase<pg8::EpiProj, pg8::StaticOrder, G1_ALIGN, G1_SP2>(lds, g, S, E);
    }
    GSYNC(); }
#ifndef REP2A
#define REP2A 1
#endif
#ifndef REP2B
#define REP2B 1
#endif
#ifndef REP3A
#define REP3A 1
#endif
    for (int r2 = 0; r2 < REP2A; ++r2) { if (PH_MASK & 4) phase2a(c);
    GSYNC(); }
    for (int r2 = 0; r2 < REP2B; ++r2) {
    if (PH_MASK & 4) {
        pg8::Gemm g{(const bf16*)p.out, (const bf16*)(ws + WS_WAX), T, 2048, 128, 1024, 128, 256};
        pg8::StaticOrder S; S.init(T, 2048, (int)gridDim.x, (int)blockIdx.x);
        pg8::EpiGate E{(const bf16*)p.out, (bf16*)(ws + WS_HL), (bf16*)((unsigned char*)p.out + OUT_PC), (float*)(ws + WS_PEND), (float*)(ws + WS_HEND), (const float*)(ws + WS_BAS), (const float*)(ws + WS_BXS), (const float*)(ws + WS_SPT)};
        pg8::gemm_phase<pg8::EpiGate, pg8::StaticOrder, true, true>(lds, g, S, E);
    }
    GSYNC(); }
#ifdef REP2C
    phase2c(c, lds, 0); GSYNC();
#endif
    if (PH_MASK & 4) phase2c(c, lds);
    GSYNC(); }
    for (int rep4 = 0; rep4 < REP4; ++rep4) {
    if (PH_MASK & 16) {
        pg8::Gemm g{(const bf16*)(ws + WS_P4) + 2048, (const bf16*)(ws + WS_WOUT), T, 1024, 1024, 4096, 1024, 0};
        pg8::StaticOrder S; S.init(T, 1024, (int)gridDim.x, (int)blockIdx.x);
        pg8::EpiResid E{(const bf16*)(ws + WS_XB), (bf16*)p.out, 1024, ALPHA};
        pg8::gemm_phase<pg8::EpiResid, pg8::StaticOrder, G4_ALIGN, true>(lds, g, S, E);
    }
    GSYNC(); }
    for (int rep5 = 0; rep5 < REP5; ++rep5) { if (PH_MASK & 32) phase5(c);
    GSYNC(); }
    for (int rep6 = 0; rep6 < REP6; ++rep6) {
    if (PH_MASK & 64) {
#if Q_I8
        pg8::Gemm g{(const bf16*)(ws + WS_X1Q8), (const bf16*)(ws + WS_WQQ8), T, 2048, 512, 512, 512, 0};
        pg8::StaticOrder S; S.init(T, 2048, (int)gridDim.x, (int)blockIdx.x);
        pg8::EpiBf16I8 E{(bf16*)(ws + WS_Q), 2048, (const float*)(ws + WS_SX1), (const float*)(ws + WS_SWQ)};
        pg8::gemm_phase<pg8::EpiBf16I8, pg8::StaticOrder, G6_ALIGN, true>(lds, g, S, E);
#else
        pg8::Gemm g{(const bf16*)(ws + WS_X1B), (const bf16*)(ws + WS_WQ), T, 2048, 1024, 1024, 1024, 0};
        pg8::StaticOrder S; S.init(T, 2048, (int)gridDim.x, (int)blockIdx.x);
        pg8::EpiBf16 E{(bf16*)(ws + WS_Q), 2048};
        pg8::gemm_phase<pg8::EpiBf16, pg8::StaticOrder, G6_ALIGN, true>(lds, g, S, E);
#endif
    }
    GSYNC(); }
    for (int rep = 0; rep < REP7; ++rep) { if (PH_MASK & 128) phase7(c, lds);
    GSYNC(); }
#ifdef REP8B
    phase8(c, lds, xbar); GSYNC();
#endif
    if (PH_MASK & 256) phase8(c, lds, xbar);
}

extern "C" void kernel_launch(void* const* d_in, const int* in_sizes, int n_in, void* d_out, int out_size,
                              void* d_ws, size_t ws_size, hipStream_t stream) {
    static int grid_blocks = 0;
    if (grid_blocks == 0) {
        if (n_in != 23 || out_size != T * D || ws_size < WS_END) {
            fprintf(stderr, "kernel_launch: unexpected problem (n_in %d, out %d, ws %zu); nothing launched\n", n_in, out_size, ws_size);
            grid_blocks = -1; return;
        }
        int dev = 0, cus = 0, per_cu = 0;
        (void)hipGetDevice(&dev);
        (void)hipDeviceGetAttribute(&cus, hipDeviceAttributeMultiprocessorCount, dev);
        (void)hipFuncSetAttribute((const void*)hybrid_fwd, hipFuncAttributeMaxDynamicSharedMemorySize, LDS_BYTES);
        (void)hipOccupancyMaxActiveBlocksPerMultiprocessor(&per_cu, (const void*)hybrid_fwd, NTHR, LDS_BYTES);
        if (per_cu < 1) { fprintf(stderr, "kernel_launch: occupancy query reports %d blocks per CU\n", per_cu); grid_blocks = -1; return; }
        grid_blocks = cus;
        (void)hipGetLastError();
    }
    if (grid_blocks < 0) return;
    Params p{};
    for (int i = 0; i < 23; ++i) p.in[i] = (const float*)d_in[i];
    p.out = (float*)d_out; p.ws = (unsigned char*)d_ws;
    if (hipMemsetAsync((unsigned char*)d_ws + WS_BAR, 0, XCD_BAR_WORDS * sizeof(unsigned), stream) != hipSuccess) { fprintf(stderr, "kernel_launch: hipMemsetAsync of the barrier words failed; nothing launched\n"); return; }
    void* args[] = {&p};
    hipError_t e = hipLaunchCooperativeKernel((const void*)hybrid_fwd, dim3(grid_blocks), dim3(NTHR), args, LDS_BYTES, stream);
    if (e != hipSuccess) fprintf(stderr, "cooperative launch failed: %s (grid %d)\n", hipGetErrorString(e), grid_blocks);
}
```

```cpp
#include <hip/hip_runtime.h>
#include <hip/hip_cooperative_groups.h>
#include <cstdio>
#include <cstdint>
namespace cg = cooperative_groups;

#define LAS __attribute__((address_space(3)))
typedef unsigned short bf16;
typedef short bf16x8 __attribute__((ext_vector_type(8)));
typedef float f32x4 __attribute__((ext_vector_type(4)));
typedef float f32x16 __attribute__((ext_vector_type(16)));
typedef float f32x2 __attribute__((ext_vector_type(2)));
typedef unsigned u32x4 __attribute__((ext_vector_type(4)));
typedef unsigned u32x2 __attribute__((ext_vector_type(2)));
typedef int i32x4 __attribute__((ext_vector_type(4)));
typedef __bf16 bf16v2 __attribute__((ext_vector_type(2)));

#ifndef Q_I8
#define Q_I8 0
#endif
constexpr int T = 32768, D = 1024, SEQ = 4096, DIN = 6144, CHUNK = 128, NTILE = T / CHUNK, NCHUNK = SEQ / CHUNK, NH = 8, HD = 128;
constexpr int NEXP = 16384;
constexpr float ALPHA = 1.18920711500272f, LN_EPS = 1e-5f;
constexpr int NTHR = 512;
constexpr int LDS_BYTES = 147456;
constexpr int LDS_BARST = 147440;

constexpr size_t MiB = 1u << 20;
constexpr size_t WS_SPT = 0;
constexpr size_t WS_BAS = 4096;
constexpr size_t WS_BXS = 8192;
constexpr size_t WS_BGS = 12288;
constexpr size_t WS_STATS = 256 * 1024;
constexpr size_t WS_BAR = 64 * 1024;
constexpr size_t WS_WIN = 1 * MiB;
constexpr size_t WS_WOUT = 13 * MiB;
constexpr size_t WS_WQ = 15 * MiB;
constexpr size_t WS_KEYS = 19 * MiB;
constexpr size_t WS_WAX = 20 * MiB;
constexpr size_t WS_WTRIL = 20 * MiB + 512 * 1024;
constexpr size_t WS_UQ = 22 * MiB;
constexpr size_t WS_VQ = 38 * MiB;
constexpr size_t WS_USC = 54 * MiB;
constexpr size_t WS_VSC = 55 * MiB;
constexpr size_t WS_WQ8 = 56 * MiB;
constexpr size_t WS_SXR = 62 * MiB;
constexpr size_t WS_SWC = 63 * MiB;
constexpr size_t WS_WQQ8 = 64 * MiB;
constexpr size_t WS_SWQ = 66 * MiB;
constexpr size_t WS_SX1 = 67 * MiB;
constexpr size_t WS_X1Q8 = 182 * MiB;
constexpr size_t WS_XQ8 = 472 * MiB;
constexpr size_t WS_XB = 86 * MiB;
constexpr size_t OUT_PC = 64 * MiB;
constexpr size_t WS_P4 = 150 * MiB;
constexpr size_t WS_HL = 406 * MiB;
constexpr size_t WS_PEND = 470 * MiB;
constexpr size_t WS_HEND = 471 * MiB;
constexpr size_t WS_Z = 406 * MiB;
constexpr size_t WS_PARTZ = 68 * MiB;
constexpr size_t WS_ST1 = 72 * MiB;
constexpr size_t WS_CQ = 73 * MiB;
constexpr size_t WS_DQ = 73 * MiB + 8192;
constexpr size_t WS_PARTCD = 74 * MiB;
constexpr size_t WS_IDX = 470 * MiB;
constexpr size_t WS_GATE = 486 * MiB;
constexpr size_t WS_END = 504 * MiB;

__device__ __forceinline__ unsigned pk2(float lo, float hi) { f32x2 v = {lo, hi}; return __builtin_bit_cast(unsigned, __builtin_convertvector(v, bf16v2)); }
__device__ __forceinline__ float bf_lo(unsigned w) { return __uint_as_float(w << 16); }
__device__ __forceinline__ float bf_hi(unsigned w) { return __uint_as_float(w & 0xffff0000u); }
constexpr float NLOG2E = -1.4426950408889634f;
__device__ __forceinline__ float sig_pre(float xs) { return __builtin_amdgcn_rcpf(1.0f + __builtin_amdgcn_exp2f(xs)); }
__device__ __forceinline__ float gelu_tanh(float x) { const float u = x * (1.0f + 0.044715f * x * x); return x * __builtin_amdgcn_rcpf(1.0f + __builtin_amdgcn_exp2f(-2.3022081989f * u)); }
__device__ __forceinline__ float wave_sum(float v) {
#pragma unroll
    for (int o = 32; o >= 1; o >>= 1) v += __shfl_xor(v, o);
    return v;
}
#define XB_TMO      128
#define XB_XCNT(j)  (256  + 64 * (j))
#define XB_XSUB(j)  (1280 + 64 * (j))
#define XB_XGEN(j)  (2304 + 64 * (j))
#define XB_TOP      3328
#define XB_TOPGEN   3392
#define XCD_BAR_WORDS 3456
#define XB_SPIN_CAP (1u << 22)

__device__ __forceinline__ unsigned xb_ld(unsigned* p)              { return __hip_atomic_load(p, __ATOMIC_RELAXED, __HIP_MEMORY_SCOPE_AGENT); }
__device__ __forceinline__ unsigned xb_add(unsigned* p, unsigned v) { return __hip_atomic_fetch_add(p, v, __ATOMIC_RELAXED, __HIP_MEMORY_SCOPE_AGENT); }
__device__ __forceinline__ unsigned xb_xcc_id() { return (unsigned)__builtin_amdgcn_s_getreg((3 << 11) | 20) & 0xFu; }
#define XB_SPIN(cond, bar) do { unsigned _sp = 0; while (cond) { __builtin_amdgcn_s_sleep(1); \
    if ((++_sp & 255u) == 0u) { if (xb_ld(&(bar)[XB_TMO])) break; if (_sp > XB_SPIN_CAP) { atomicAdd(&(bar)[XB_TMO], 1u); break; } } } } while (0)

struct XcdBarrier {
    unsigned* bar; unsigned x;
    volatile LAS unsigned* st;
};

__device__ __forceinline__ XcdBarrier xcd_barrier_post(unsigned* bar, volatile LAS unsigned* st) {
    XcdBarrier b; b.bar = bar; b.x = xb_xcc_id(); b.st = st;
    if (threadIdx.x == 0) (void)xb_add(&bar[XB_XCNT(b.x)], 1u);
    return b;
}
__device__ __forceinline__ void xcd_barrier_complete(unsigned* bar, unsigned x, unsigned& nloc, unsigned& nx) {
    const unsigned G = gridDim.x * gridDim.y * gridDim.z;
    unsigned sum, cnt, mine, sp = 0u;
    for (;;) {
        sum = 0u; cnt = 0u; mine = 0u;
#pragma unroll
        for (unsigned j = 0; j < 16; ++j) { const unsigned c = xb_ld(&bar[XB_XCNT(j)]); sum += c; cnt += (c > 0u) ? 1u : 0u; mine = (j == x) ? c : mine; }
        if (sum == G) break;
        __builtin_amdgcn_s_sleep(1);
        if ((++sp & 255u) == 0u) { if (xb_ld(&bar[XB_TMO])) break; if (sp > XB_SPIN_CAP) { atomicAdd(&bar[XB_TMO], 1u); break; } }
    }
    nloc = mine > 0u ? mine : 1u; nx = cnt > 0u ? cnt : 1u;
}

__device__ __forceinline__ void xcd_barrier(const XcdBarrier& b) {
    asm volatile("s_waitcnt vmcnt(0)" ::: "memory");
    __syncthreads();
    if (threadIdx.x == 0) {
        unsigned* bar = b.bar;
        __builtin_amdgcn_s_waitcnt(0);
        unsigned nloc = b.st[0], nx = b.st[1];
        if (nloc == 0u) { xcd_barrier_complete(bar, b.x, nloc, nx); b.st[0] = nloc; b.st[1] = nx; }
        const unsigned old = xb_add(&bar[XB_XSUB(b.x)], 1u);
        const unsigned gen = old / nloc;
        if (old + 1u == (gen + 1u) * nloc) {
            __builtin_amdgcn_fence(__ATOMIC_RELEASE, "agent");
            asm volatile("s_waitcnt vmcnt(0)" ::: "memory");
            const unsigned og = xb_add(&bar[XB_TOP], 1u);
            const unsigned tg = og / nx;
            if (og + 1u == (tg + 1u) * nx) xb_add(&bar[XB_TOPGEN], 1u);
            else XB_SPIN(xb_ld(&bar[XB_TOPGEN]) == tg, bar);
            __builtin_amdgcn_fence(__ATOMIC_ACQUIRE, "agent");
            xb_add(&bar[XB_XGEN(b.x)], 1u);
            asm volatile("s_waitcnt vmcnt(0)" ::: "memory");
        } else {
            XB_SPIN(xb_ld(&bar[XB_XGEN(b.x)]) == gen, bar);
            __builtin_amdgcn_fence(__ATOMIC_ACQUIRE, "agent");
            asm volatile("s_waitcnt vmcnt(0)" ::: "memory");
        }
    }
    __syncthreads();
}
namespace pg8 {
#define PG8_LAS __attribute__((address_space(3)))
typedef unsigned short bf16_t;
typedef short bf16x8 __attribute__((ext_vector_type(8)));
typedef float f32x4 __attribute__((ext_vector_type(4)));
typedef unsigned u32x4 __attribute__((ext_vector_type(4)));
typedef int i32x4_ __attribute__((ext_vector_type(4)));
constexpr int BM = 256, BK = 64, HALF = 128, HTB = HALF * BK * 2  , STAGE_BYTES = 8 * HTB, NXCD = 8, WGM = 8;

__host__ __device__ __forceinline__ int lds_byte(int r, int c) { const int st = (r >> 4) * 2 + (c >> 5), rr = r & 15, cc = c & 31, ob = rr * 64 + cc * 2; return st * 1024 + (ob ^ (((ob >> 9) & 1) << 5)); }
__host__ __device__ __forceinline__ void stage_rc(int b, int& R, int& C) { const int st = b / 1024, sb = b % 1024, swz = sb ^ (((sb >> 9) & 1) << 5); R = (st >> 1) * 16 + swz / 64; C = (st & 1) * 32 + (swz % 64) / 2; }
__host__ __device__ __forceinline__ int perm32(int rho) { const int n = rho >> 4, i = rho & 15; return 8 * (i >> 2) + 4 * n + (i & 3); }

struct Unit { int pm, pn; };
struct Gemm { const bf16_t* A; const bf16_t* Bt; int M, N, K, lda, ldb, a_pn_bytes; };

struct StaticOrder {
    int nM, nN, nwg, G, c;
    __host__ __device__ __forceinline__ void init(int M, int N, int G_, int c_) { nM = M / BM; nN = N / BM; nwg = nM * nN; G = G_; c = c_; }
    __host__ __device__ __forceinline__ bool next(int i, Unit& u) const {
        const long L = (long)i * G + c; if (L >= nwg) return false;
        int wgid = (int)L; { const int q = nwg / NXCD, r = nwg % NXCD, xcd = wgid % NXCD, off = wgid / NXCD; wgid = (xcd < r ? xcd * (q + 1) : r * (q + 1) + (xcd - r) * q) + off; }
        const int nig = WGM * nN, gid = wgid / nig, fm = gid * WGM, gsz = (nM - fm) < WGM ? (nM - fm) : WGM;
        u.pm = fm + ((wgid % nig) % gsz); u.pn = (wgid % nig) / gsz; return true;
    }
    __device__ __forceinline__ void a_ready(const Unit&) const {}
    __device__ __forceinline__ void done(const Unit&) const {}
};


struct EpiProj {
    static constexpr bool PERM = true, AFTER_DRAIN = false, AROWS = false, I8 = true;
    bf16_t* P4; const float* bgate;
    const float* sxr; const float* swc;
    __device__ __forceinline__ void operator()(const f32x4 (&acc)[2][2][4][2], const Unit& u, int, int, int, int) const {
        int t_ = threadIdx.x; asm volatile("" : "+v"(t_)); const int fr = t_ & 15, fq = (t_ >> 4) & 3, wc = (t_ >> 6) & 3, wr = t_ >> 8;
        const int k = u.pn / 3, ty = u.pn - 3 * k;
        const int row0 = u.pm * BM + wr * 64 + fr, cl = k * 128 + wc * 32 + 8 * fq;
        const float* swp = swc + u.pn * BM + wc * 32 + 8 * fq;
        const f32x4 w00 = *(const f32x4*)swp, w01 = *(const f32x4*)(swp + 4), w10 = *(const f32x4*)(swp + HALF), w11 = *(const f32x4*)(swp + HALF + 4);
#define EPI_I2F(v, w, s) ((f32x4){(float)__builtin_bit_cast(i32x4_, v)[0], (float)__builtin_bit_cast(i32x4_, v)[1], (float)__builtin_bit_cast(i32x4_, v)[2], (float)__builtin_bit_cast(i32x4_, v)[3]} * (w) * (s))
        if (ty == 0) {
#pragma unroll
            for (int ai = 0; ai < 2; ++ai)
#pragma unroll
                for (int m = 0; m < 4; ++m) {
                    const int row = row0 + ai * HALF + m * 16; const float sx = sxr[row];
                    bf16_t* rowp = P4 + (size_t)row * 4096 + cl;
                    const f32x4 a0 = EPI_I2F(acc[ai][0][m][0], w00, sx), a1 = EPI_I2F(acc[ai][0][m][1], w01, sx); f32x4 v0 = EPI_I2F(acc[ai][1][m][0], w10, sx), v1 = EPI_I2F(acc[ai][1][m][1], w11, sx);
#pragma unroll
                    for (int j = 0; j < 4; ++j) { v0[j] = gelu_tanh(v0[j]); v1[j] = gelu_tanh(v1[j]); }
                    u32x4 w; w.x = pk2(a0[0], a0[1]); w.y = pk2(a0[2], a0[3]); w.z = pk2(a1[0], a1[1]); w.w = pk2(a1[2], a1[3]);
                    *(u32x4*)rowp = w;
                    w.x = pk2(v0[0], v0[1]); w.y = pk2(v0[2], v0[3]); w.z = pk2(v1[0], v1[1]); w.w = pk2(v1[2], v1[3]);
                    *(u32x4*)(rowp + 3072) = w;
                }
        } else {
            const float* bp = bgate + (ty - 1) * 1024 + cl;
            const f32x4 b0 = *(const f32x4*)bp, b1 = *(const f32x4*)(bp + 4);
#pragma unroll
            for (int ai = 0; ai < 2; ++ai)
#pragma unroll
                for (int m = 0; m < 4; ++m) {
                    const int row = row0 + ai * HALF + m * 16; const float sx = sxr[row];
                    bf16_t* rowp = P4 + (size_t)row * 4096 + ty * 1024 + cl;
                    f32x4 a0 = EPI_I2F(acc[ai][0][m][0], w00, sx), a1 = EPI_I2F(acc[ai][0][m][1], w01, sx); const f32x4 g0 = EPI_I2F(acc[ai][1][m][0], w10, sx) + b0, g1 = EPI_I2F(acc[ai][1][m][1], w11, sx) + b1;
#pragma unroll
                    for (int j = 0; j < 4; ++j) { a0[j] = gelu_tanh(a0[j]) * sig_pre(g0[j]); a1[j] = gelu_tanh(a1[j]) * sig_pre(g1[j]); }
                    u32x4 w; w.x = pk2(a0[0], a0[1]); w.y = pk2(a0[2], a0[3]); w.z = pk2(a1[0], a1[1]); w.w = pk2(a1[2], a1[3]);
                    *(u32x4*)rowp = w;
                }
        }
#undef EPI_I2F
    }
};
template <int S> __device__ __forceinline__ float row_shr_f(float ident, float v) {
    return __int_as_float(__builtin_amdgcn_update_dpp(__float_as_int(ident), __float_as_int(v), 0x110 + S, 0xf, 0xf, false));
}
struct EpiGate {
    static constexpr bool PERM = true, AFTER_DRAIN = false, AROWS = true, I8 = false;
    const bf16_t* XC; bf16_t* HL; bf16_t* PC; float* PEND; float* HEND; const float* b_a; const float* b_x; const float* spt;
    __device__ __forceinline__ void operator()(const f32x4 (&acc)[2][2][4][2], const Unit& u, int, int, int, int) const {
        int t_ = threadIdx.x; asm volatile("" : "+v"(t_)); const int fr = t_ & 15, fq = (t_ >> 4) & 3, wc = (t_ >> 6) & 3, wr = t_ >> 8, lane15 = (t_ & 63) | 15;
        const int row0 = u.pm * BM + wr * 128 + fr, ch = u.pn * 128 + wc * 32 + 8 * fq, chunk = u.pm * 2 + wr;
        float Ac[8], Hc[8];
#pragma unroll
        for (int j = 0; j < 8; ++j) { Ac[j] = 1.0f; Hc[j] = 0.0f; }
#pragma unroll
        for (int ai = 0; ai < 2; ++ai)
#pragma unroll
            for (int m = 0; m < 4; ++m) {
                asm volatile("" ::: "memory");
                int zo = 0; asm volatile("" : "+v"(zo));
                const size_t off = (size_t)(row0 + ai * 64 + m * 16) * 1024 + ch;
                const u32x4 xw = *(const u32x4*)(XC + off);
                float ba[8], bx[8], sp[8];
                { const int cz = ch + zo;
                  const f32x4 t0 = *(const f32x4*)(b_a + cz), t1 = *(const f32x4*)(b_a + cz + 4), t2 = *(const f32x4*)(b_x + cz), t3 = *(const f32x4*)(b_x + cz + 4), t4 = *(const f32x4*)(spt + cz), t5 = *(const f32x4*)(spt + cz + 4);
#pragma unroll
                  for (int j = 0; j < 4; ++j) { ba[j] = t0[j]; ba[4 + j] = t1[j]; bx[j] = t2[j]; bx[4 + j] = t3[j]; sp[j] = t4[j]; sp[4 + j] = t5[j]; } }
                float a[8], b[8];
#pragma unroll
                for (int j = 0; j < 8; ++j) {
                    const float rp = acc[ai][0][m][j >> 2][j & 3], ip = acc[ai][1][m][j >> 2][j & 3];
                    const float xv = (j & 1) ? bf_hi(xw[j >> 1]) : bf_lo(xw[j >> 1]);
                    a[j] = __builtin_amdgcn_exp2f(sig_pre(rp + ba[j]) * sp[j]);
                    b[j] = __builtin_amdgcn_sqrtf(__builtin_fmaxf(1.0f - a[j] * a[j], 0.f)) * sig_pre(ip + bx[j]) * xv;
                }
#pragma unroll
                for (int j = 0; j < 8; ++j) { const float ap = row_shr_f<1>(1.0f, a[j]), bp = row_shr_f<1>(0.0f, b[j]); b[j] = a[j] * bp + b[j]; a[j] = a[j] * ap; }
#pragma unroll
                for (int j = 0; j < 8; ++j) { const float ap = row_shr_f<2>(1.0f, a[j]), bp = row_shr_f<2>(0.0f, b[j]); b[j] = a[j] * bp + b[j]; a[j] = a[j] * ap; }
#pragma unroll
                for (int j = 0; j < 8; ++j) { const float ap = row_shr_f<4>(1.0f, a[j]), bp = row_shr_f<4>(0.0f, b[j]); b[j] = a[j] * bp + b[j]; a[j] = a[j] * ap; }
#pragma unroll
                for (int j = 0; j < 8; ++j) { const float ap = row_shr_f<8>(1.0f, a[j]), bp = row_shr_f<8>(0.0f, b[j]); b[j] = a[j] * bp + b[j]; a[j] = a[j] * ap; }
                float hl[8], pc[8];
#pragma unroll
                for (int j = 0; j < 8; ++j) {
                    const float at = __shfl(a[j], lane15), bt = __shfl(b[j], lane15);
                    hl[j] = b[j] + a[j] * Hc[j]; pc[j] = a[j] * Ac[j];
                    Hc[j] = bt + at * Hc[j]; Ac[j] = at * Ac[j];
                }
                u32x4 w; w.x = pk2(hl[0], hl[1]); w.y = pk2(hl[2], hl[3]); w.z = pk2(hl[4], hl[5]); w.w = pk2(hl[6], hl[7]);
                *(u32x4*)(HL + off) = w;
                w.x = pk2(pc[0], pc[1]); w.y = pk2(pc[2], pc[3]); w.z = pk2(pc[4], pc[5]); w.w = pk2(pc[6], pc[7]);
                *(u32x4*)(PC + off) = w;
            }
        if (fr == 0) {
            float* pp = PEND + (size_t)chunk * 1024 + ch; float* hp = HEND + (size_t)chunk * 1024 + ch;
            *(f32x4*)pp = (f32x4){Ac[0], Ac[1], Ac[2], Ac[3]}; *(f32x4*)(pp + 4) = (f32x4){Ac[4], Ac[5], Ac[6], Ac[7]};
            *(f32x4*)hp = (f32x4){Hc[0], Hc[1], Hc[2], Hc[3]}; *(f32x4*)(hp + 4) = (f32x4){Hc[4], Hc[5], Hc[6], Hc[7]};
        }
    }
};
struct EpiBf16 {
    static constexpr bool PERM = true, AFTER_DRAIN = false, AROWS = false, I8 = false;
    bf16_t* O; int ldc;
    __device__ __forceinline__ void operator()(const f32x4 (&acc)[2][2][4][2], const Unit& u, int, int, int, int) const {
        int t_ = threadIdx.x; asm volatile("" : "+v"(t_)); const int fr = t_ & 15, fq = (t_ >> 4) & 3, wc = (t_ >> 6) & 3, wr = t_ >> 8;
        const int row0 = u.pm * BM + wr * 64 + fr, col0 = u.pn * BM + wc * 32 + 8 * fq;
#pragma unroll
        for (int ai = 0; ai < 2; ++ai)
#pragma unroll
            for (int m = 0; m < 4; ++m) {
                bf16_t* rowp = O + (size_t)(row0 + ai * HALF + m * 16) * ldc + col0;
#pragma unroll
                for (int bj = 0; bj < 2; ++bj) {
                    const f32x4 v0 = acc[ai][bj][m][0], v1 = acc[ai][bj][m][1];
                    u32x4 w; w.x = pk2(v0[0], v0[1]); w.y = pk2(v0[2], v0[3]); w.z = pk2(v1[0], v1[1]); w.w = pk2(v1[2], v1[3]);
                    *(u32x4*)(rowp + bj * HALF) = w;
                }
            }
    }
};
struct EpiResid {
    static constexpr bool PERM = true, AFTER_DRAIN = false, AROWS = false, I8 = false;
    const bf16_t* X; bf16_t* Z; int ldc; float alpha; float* PART;
    __device__ __forceinline__ void operator()(const f32x4 (&acc)[2][2][4][2], const Unit& u, int, int, int, int) const {
        int t_ = threadIdx.x; asm volatile("" : "+v"(t_)); const int fr = t_ & 15, fq = (t_ >> 4) & 3, wc = (t_ >> 6) & 3, wr = t_ >> 8;
        const int row0 = u.pm * BM + wr * 64 + fr, col0 = u.pn * BM + wc * 32 + 8 * fq;
#pragma unroll
        for (int ai = 0; ai < 2; ++ai)
#pragma unroll
            for (int m = 0; m < 4; ++m) {
                const int row = row0 + ai * HALF + m * 16;
                const size_t off = (size_t)row * ldc + col0;
                float s1 = 0.f, s2 = 0.f;
#pragma unroll
                for (int bj = 0; bj < 2; ++bj) {
                    const u32x4 xw = *(const u32x4*)(X + off + bj * HALF);
                    const f32x4 x0 = (f32x4){bf_lo(xw.x), bf_hi(xw.x), bf_lo(xw.y), bf_hi(xw.y)}, x1 = (f32x4){bf_lo(xw.z), bf_hi(xw.z), bf_lo(xw.w), bf_hi(xw.w)};
                    const f32x4 z0 = x0 * alpha + acc[ai][bj][m][0], z1 = x1 * alpha + acc[ai][bj][m][1];
                    u32x4 w; w.x = pk2(z0[0], z0[1]); w.y = pk2(z0[2], z0[3]); w.z = pk2(z1[0], z1[1]); w.w = pk2(z1[2], z1[3]);
                    *(u32x4*)(Z + off + bj * HALF) = w;
#pragma unroll
                    for (int j = 0; j < 4; ++j) { s1 += z0[j] + z1[j]; s2 += z0[j] * z0[j] + z1[j] * z1[j]; }
                }
                s1 += __shfl_xor(s1, 16); s2 += __shfl_xor(s2, 16); s1 += __shfl_xor(s1, 32); s2 += __shfl_xor(s2, 32);
                if (fq == 0) *(f32x2*)(PART + ((size_t)row * 16 + u.pn * 4 + wc) * 2) = (f32x2){s1, s2};
            }
    }
};
struct EpiQ {
    static constexpr bool PERM = true, AFTER_DRAIN = false, AROWS = false, I8 = false;
    bf16_t* O; int ldc; const float* cq; const float* dq; const PG8_LAS float* tab; StaticOrder S;
    __device__ __forceinline__ void operator()(const f32x4 (&acc)[2][2][4][2], const Unit& u, int, int, int, int) const {
        int t_ = threadIdx.x; asm volatile("" : "+v"(t_)); const int fr = t_ & 15, fq = (t_ >> 4) & 3, wc = (t_ >> 6) & 3, wr = t_ >> 8;
        int ord = 0;
#pragma unroll
        for (int i = 1; i < 4; ++i) { Unit v; if (S.next(i, v) && v.pm == u.pm && v.pn == u.pn) ord = i; }
        const int rl0 = wr * 64 + fr, col0 = u.pn * BM + wc * 32 + 8 * fq;
        f32x4 cv[2][2], dv[2][2];
#pragma unroll
        for (int bj = 0; bj < 2; ++bj)
#pragma unroll
            for (int n = 0; n < 2; ++n) { cv[bj][n] = *(const f32x4*)(cq + col0 + bj * HALF + 4 * n); dv[bj][n] = *(const f32x4*)(dq + col0 + bj * HALF + 4 * n); }
#pragma unroll
        for (int ai = 0; ai < 2; ++ai)
#pragma unroll
            for (int m = 0; m < 4; ++m) {
                const int rl = rl0 + ai * HALF + m * 16;
                const float mean = tab[(ord * 256 + rl) * 2], rstd = tab[(ord * 256 + rl) * 2 + 1];
                bf16_t* rowp = O + (size_t)(u.pm * BM + rl) * ldc + col0;
#pragma unroll
                for (int bj = 0; bj < 2; ++bj) {
                    const f32x4 v0 = (acc[ai][bj][m][0] - cv[bj][0] * mean) * rstd + dv[bj][0], v1 = (acc[ai][bj][m][1] - cv[bj][1] * mean) * rstd + dv[bj][1];
                    u32x4 w; w.x = pk2(v0[0], v0[1]); w.y = pk2(v0[2], v0[3]); w.z = pk2(v1[0], v1[1]); w.w = pk2(v1[2], v1[3]);
                    *(u32x4*)(rowp + bj * HALF) = w;
                }
            }
    }
};
struct EpiBf16I8 {
    static constexpr bool PERM = true, AFTER_DRAIN = false, AROWS = false, I8 = true;
    bf16_t* O; int ldc; const float* sxr; const float* swc;
    __device__ __forceinline__ void operator()(const f32x4 (&acc)[2][2][4][2], const Unit& u, int, int, int, int) const {
        int t_ = threadIdx.x; asm volatile("" : "+v"(t_)); const int fr = t_ & 15, fq = (t_ >> 4) & 3, wc = (t_ >> 6) & 3, wr = t_ >> 8;
        const int row0 = u.pm * BM + wr * 64 + fr, col0 = u.pn * BM + wc * 32 + 8 * fq;
        const f32x4 w00 = *(const f32x4*)(swc + col0), w01 = *(const f32x4*)(swc + col0 + 4), w10 = *(const f32x4*)(swc + col0 + HALF), w11 = *(const f32x4*)(swc + col0 + HALF + 4);
#define EPI_I2F(v, w, s) ((f32x4){(float)__builtin_bit_cast(i32x4_, v)[0], (float)__builtin_bit_cast(i32x4_, v)[1], (float)__builtin_bit_cast(i32x4_, v)[2], (float)__builtin_bit_cast(i32x4_, v)[3]} * (w) * (s))
#pragma unroll
        for (int ai = 0; ai < 2; ++ai)
#pragma unroll
            for (int m = 0; m < 4; ++m) {
                const int row = row0 + ai * HALF + m * 16; const float sx = sxr[row];
                bf16_t* rowp = O + (size_t)row * ldc + col0;
                { const f32x4 v0 = EPI_I2F(acc[ai][0][m][0], w00, sx), v1 = EPI_I2F(acc[ai][0][m][1], w01, sx);
                  u32x4 w; w.x = pk2(v0[0], v0[1]); w.y = pk2(v0[2], v0[3]); w.z = pk2(v1[0], v1[1]); w.w = pk2(v1[2], v1[3]); *(u32x4*)rowp = w; }
                { const f32x4 v0 = EPI_I2F(acc[ai][1][m][0], w10, sx), v1 = EPI_I2F(acc[ai][1][m][1], w11, sx);
                  u32x4 w; w.x = pk2(v0[0], v0[1]); w.y = pk2(v0[2], v0[3]); w.z = pk2(v1[0], v1[1]); w.w = pk2(v1[2], v1[3]); *(u32x4*)(rowp + HALF) = w; }
            }
#undef EPI_I2F
    }
};
template <class Epi, class Sched, bool ALIGN_EPI = false, bool SP2 = false>
__device__ __forceinline__ void gemm_phase(PG8_LAS unsigned char* lds, const Gemm g, const Sched& S, const Epi& E) {
    int tid_ = threadIdx.x; asm volatile("" : "+v"(tid_)); const int tid = tid_, wid = __builtin_amdgcn_readfirstlane(tid >> 6), lane = tid & 63, wr = wid >> 2, wc = wid & 3, fr = lane & 15, fq = lane >> 4;
    const int K = g.K, nt = K / BK;
    unsigned voffA[2], voffB[2];
#pragma unroll
    for (int i = 0; i < 2; ++i) { int R, C; stage_rc(tid * 16 + i * 8192, R, C); const int Rb = Epi::PERM ? ((R & ~31) + perm32(R & 31)) : R;
        const int Ra = Epi::AROWS ? ((R >> 6) * 128 + (R & 63)) : R;
        voffA[i] = (unsigned)(Ra * g.lda + C) * 2u; voffB[i] = (unsigned)(Rb * g.ldb + C) * 2u; }
    const size_t kstep = (size_t)(BK * 2);
    const size_t hstepA = (size_t)(Epi::AROWS ? 64 : HALF) * g.lda * 2, hstepB = (size_t)HALF * g.ldb * 2;
    const size_t tstepA = (size_t)2 * HALF * g.lda * 2, tstepB = 2 * hstepB;
    const unsigned ldsw = (unsigned)wid * 1024u;
    const int aoff = lds_byte(wr * 64 + fr, fq * 8), boff = lds_byte(wc * 32 + fr, fq * 8);
#define PG8_SA(b, h) (((b) * 2 + (h)) * HTB)
#define PG8_SB(b, h) ((4 + (b) * 2 + (h)) * HTB)
#define PG8_STAGE(bufoff, gbase, voff) do { _Pragma("unroll") for (int _i = 0; _i < 2; ++_i) \
        __builtin_amdgcn_global_load_lds((const unsigned*)((const char*)(gbase) + (voff)[_i]), (PG8_LAS unsigned*)(lds + (bufoff) + ldsw + _i * 8192), 16, 0, 0); } while (0)
#define PG8_LDA(dst, b, h) do { _Pragma("unroll") for (int m = 0; m < 4; ++m) _Pragma("unroll") for (int k = 0; k < 2; ++k) dst[m][k] = *(const PG8_LAS bf16x8*)(lds + PG8_SA(b, h) + aoff + m * 2048 + k * 1024); } while (0)
#define PG8_LDB(dst, b, h) do { _Pragma("unroll") for (int n = 0; n < 2; ++n) _Pragma("unroll") for (int k = 0; k < 2; ++k) dst[n][k] = *(const PG8_LAS bf16x8*)(lds + PG8_SB(b, h) + boff + n * 2048 + k * 1024); } while (0)
#define PG8_MMA(ai, bj, At, Bt) do { __builtin_amdgcn_s_setprio(1); _Pragma("unroll") for (int m = 0; m < 4; ++m) _Pragma("unroll") for (int n = 0; n < 2; ++n) _Pragma("unroll") for (int k = 0; k < 2; ++k) \
        { if constexpr (Epi::I8) acc[ai][bj][m][n] = __builtin_bit_cast(f32x4, __builtin_amdgcn_mfma_i32_16x16x64_i8(__builtin_bit_cast(i32x4_, Bt[n][k]), __builtin_bit_cast(i32x4_, At[m][k]), __builtin_bit_cast(i32x4_, acc[ai][bj][m][n]), 0, 0, 0)); \
          else acc[ai][bj][m][n] = __builtin_amdgcn_mfma_f32_16x16x32_bf16(Bt[n][k], At[m][k], acc[ai][bj][m][n], 0, 0, 0); } __builtin_amdgcn_s_setprio(0); } while (0)
#define PG8_WAIT_V(n) asm volatile("s_waitcnt vmcnt(" #n ")" ::: "memory")
#define PG8_WAIT_L(n) asm volatile("s_waitcnt lgkmcnt(" #n ")" ::: "memory")
#define PG8_BAR __builtin_amdgcn_s_barrier()
#define PG8_SCHED __builtin_amdgcn_sched_barrier(0)
    Unit cur, nxt; int ui = 0;
    if (!S.next(0, cur)) return;
    f32x4 acc[2][2][4][2];
#pragma unroll
    for (int a = 0; a < 2; ++a)
#pragma unroll
        for (int b = 0; b < 2; ++b)
#pragma unroll
            for (int m = 0; m < 4; ++m)
#pragma unroll
                for (int n = 0; n < 2; ++n) acc[a][b][m][n] = (f32x4){0.f, 0.f, 0.f, 0.f};
    bf16x8 At[4][2], B0[2][2], B1[2][2];
    const char* cA = (const char*)g.A + (size_t)cur.pm * tstepA + (size_t)cur.pn * g.a_pn_bytes; const char* cB = (const char*)g.Bt + (size_t)cur.pn * tstepB;
    S.a_ready(cur);
    if constexpr (SP2) {
        PG8_STAGE(PG8_SB(0, 0), cB, voffB); PG8_STAGE(PG8_SB(0, 1), cB + hstepB, voffB); PG8_STAGE(PG8_SA(0, 0), cA, voffA); PG8_STAGE(PG8_SA(0, 1), cA + hstepA, voffA);
        if (wr == 1) PG8_BAR;
        PG8_WAIT_V(2); PG8_BAR;
        PG8_STAGE(PG8_SB(1, 0), cB + kstep, voffB); PG8_STAGE(PG8_SA(1, 0), cA + kstep, voffA); PG8_STAGE(PG8_SB(1, 1), cB + hstepB + kstep, voffB);
        PG8_WAIT_V(6); PG8_BAR;
    } else {
        PG8_STAGE(PG8_SB(0, 0), cB, voffB); PG8_STAGE(PG8_SA(0, 0), cA, voffA); PG8_STAGE(PG8_SB(0, 1), cB + hstepB, voffB); PG8_STAGE(PG8_SA(0, 1), cA + hstepA, voffA);
        if (wr == 1) PG8_BAR;
        PG8_WAIT_V(4); PG8_BAR;
        PG8_STAGE(PG8_SB(1, 0), cB + kstep, voffB); PG8_STAGE(PG8_SA(1, 0), cA + kstep, voffA); PG8_STAGE(PG8_SB(1, 1), cB + hstepB + kstep, voffB);
        PG8_WAIT_V(6); PG8_BAR;
    }
    for (;;) {
        const bool has_next = S.next(ui + 1, nxt);
        const char* nA = has_next ? (const char*)g.A + (size_t)nxt.pm * tstepA + (size_t)nxt.pn * g.a_pn_bytes : cA; const char* nB = has_next ? (const char*)g.Bt + (size_t)nxt.pn * tstepB : cB;
        for (int t = 0; t < nt; t += 2) {
            const bool last = (t == nt - 2);
            const char* a1 = cA + (size_t)(t + 1) * kstep;
            const char* a2 = last ? nA : cA + (size_t)(t + 2) * kstep; const char* b2 = last ? nB : cB + (size_t)(t + 2) * kstep;
            const char* a3 = a2 + kstep; const char* b3 = b2 + kstep;
            if (last && has_next) S.a_ready(nxt);
            if constexpr (SP2) {
            PG8_LDB(B0, 0, 0); PG8_LDB(B1, 0, 1); PG8_SCHED; PG8_LDA(At, 0, 0); PG8_STAGE(PG8_SA(1, 1), a1 + hstepA, voffA);
            PG8_WAIT_V(8); PG8_WAIT_L(0); PG8_BAR; PG8_MMA(0, 0, At, B0); PG8_MMA(0, 1, At, B1); PG8_BAR; PG8_SCHED;
            PG8_LDA(At, 0, 1); PG8_STAGE(PG8_SB(0, 0), b2, voffB); PG8_STAGE(PG8_SB(0, 1), b2 + hstepB, voffB); PG8_STAGE(PG8_SA(0, 0), a2, voffA);
            PG8_WAIT_V(8); PG8_WAIT_L(0); PG8_BAR; PG8_MMA(1, 0, At, B0); PG8_MMA(1, 1, At, B1); PG8_BAR; PG8_SCHED;
            PG8_LDB(B0, 1, 0); PG8_LDB(B1, 1, 1); PG8_SCHED; PG8_LDA(At, 1, 0); PG8_STAGE(PG8_SA(0, 1), a2 + hstepA, voffA);
            PG8_WAIT_V(8); PG8_WAIT_L(0); PG8_BAR; PG8_MMA(0, 0, At, B0); PG8_MMA(0, 1, At, B1); PG8_BAR; PG8_SCHED;
            PG8_LDA(At, 1, 1); PG8_STAGE(PG8_SB(1, 0), b3, voffB); PG8_STAGE(PG8_SB(1, 1), b3 + hstepB, voffB); PG8_STAGE(PG8_SA(1, 0), a3, voffA);
            PG8_WAIT_V(8); PG8_WAIT_L(0); PG8_BAR; PG8_MMA(1, 0, At, B0); PG8_MMA(1, 1, At, B1); PG8_BAR; PG8_SCHED;
            } else {
            PG8_LDB(B0, 0, 0); PG8_SCHED; PG8_LDA(At, 0, 0); PG8_STAGE(PG8_SA(1, 1), a1 + hstepA, voffA);
            PG8_WAIT_L(8); PG8_BAR; PG8_WAIT_L(0); PG8_MMA(0, 0, At, B0); PG8_BAR; PG8_SCHED;
            PG8_LDB(B1, 0, 1); PG8_STAGE(PG8_SB(0, 0), b2, voffB);
            PG8_BAR; PG8_WAIT_L(0); PG8_MMA(0, 1, At, B1); PG8_BAR;
            PG8_LDA(At, 0, 1); PG8_STAGE(PG8_SA(0, 0), a2, voffA);
            PG8_BAR; PG8_WAIT_L(0); PG8_MMA(1, 0, At, B0); PG8_BAR; PG8_SCHED;
            PG8_STAGE(PG8_SB(0, 1), b2 + hstepB, voffB);
            PG8_WAIT_V(6); PG8_BAR; PG8_MMA(1, 1, At, B1); PG8_BAR;
            PG8_LDB(B0, 1, 0); PG8_SCHED; PG8_LDA(At, 1, 0); PG8_STAGE(PG8_SA(0, 1), a2 + hstepA, voffA);
            PG8_WAIT_L(8); PG8_BAR; PG8_WAIT_L(0); PG8_MMA(0, 0, At, B0); PG8_BAR; PG8_SCHED;
            PG8_LDB(B1, 1, 1); PG8_STAGE(PG8_SB(1, 0), b3, voffB);
            PG8_BAR; PG8_WAIT_L(0); PG8_MMA(0, 1, At, B1); PG8_BAR;
            PG8_LDA(At, 1, 1); PG8_STAGE(PG8_SA(1, 0), a3, voffA);
            PG8_BAR; PG8_WAIT_L(0); PG8_MMA(1, 0, At, B0); PG8_BAR; PG8_SCHED;
            PG8_STAGE(PG8_SB(1, 1), b3 + hstepB, voffB);
            PG8_WAIT_V(6); PG8_BAR; PG8_MMA(1, 1, At, B1); PG8_BAR;
            }
        }
        if constexpr (ALIGN_EPI) { if (wr == 0) PG8_BAR; }
        if constexpr (!Epi::AFTER_DRAIN) { E(acc, cur, wr, wc, fr, fq); S.done(cur); }
        if (!has_next) break;
#pragma unroll
        for (int a = 0; a < 2; ++a)
#pragma unroll
            for (int b = 0; b < 2; ++b)
#pragma unroll
                for (int m = 0; m < 4; ++m)
#pragma unroll
                    for (int n = 0; n < 2; ++n) acc[a][b][m][n] = (f32x4){0.f, 0.f, 0.f, 0.f};
        cur = nxt; cA = nA; cB = nB; ++ui;
        if constexpr (ALIGN_EPI) { if (wr == 1) PG8_BAR; }
    }
    PG8_WAIT_V(0);
    if constexpr (!ALIGN_EPI) { if (wr == 0) PG8_BAR; }
    PG8_BAR;
    if constexpr (Epi::AFTER_DRAIN) { E.fused(acc, cur, wr, wc, fr, fq, lds, wid, lane); S.done(cur); }
#undef PG8_SA
#undef PG8_SB
#undef PG8_STAGE
#undef PG8_LDA
#undef PG8_LDB
#undef PG8_MMA
#undef PG8_WAIT_V
#undef PG8_WAIT_L
#undef PG8_BAR
#undef PG8_SCHED
}
}

__device__ __forceinline__ void cvt_f32_bf16(const float* __restrict__ src, bf16* dst, size_t n8, size_t gtid, size_t gthreads) {
    for (size_t i = gtid; i < n8; i += gthreads) {
        const f32x4 a = ((const f32x4*)src)[2 * i], b = ((const f32x4*)src)[2 * i + 1];
        u32x4 o; o.x = pk2(a.x, a.y); o.y = pk2(a.z, a.w); o.z = pk2(b.x, b.y); o.w = pk2(b.z, b.w);
        ((u32x4*)dst)[i] = o;
    }
}
__device__ __forceinline__ void transpose_tile(const float* __restrict__ W, int ldw, bf16* WT, int ldt, int k0, int n0, int nd0, LAS float* s, int tid, float sc = 1.0f) {
    {
        const int kk = tid >> 3, c8 = (tid & 7) * 8;
        const float* p = W + (size_t)(k0 + kk) * ldw + n0 + c8;
        const f32x4 a = *(const f32x4*)p, b = *(const f32x4*)(p + 4);
        LAS float* q = s + kk * 65 + c8;
        q[0] = a.x; q[1] = a.y; q[2] = a.z; q[3] = a.w; q[4] = b.x; q[5] = b.y; q[6] = b.z; q[7] = b.w;
    }
    __syncthreads();
    {
        const int nn = tid >> 3, k8 = (tid & 7) * 8;
        const LAS float* q = s + k8 * 65 + nn;
        u32x4 o; o.x = pk2(q[0] * sc, q[65] * sc); o.y = pk2(q[2 * 65] * sc, q[3 * 65] * sc); o.z = pk2(q[4 * 65] * sc, q[5 * 65] * sc); o.w = pk2(q[6 * 65] * sc, q[7 * 65] * sc);
        *(u32x4*)(WT + (size_t)(nd0 + nn) * ldt + k0 + k8) = o;
    }
    __syncthreads();
}

template <int NR> __device__ __forceinline__ void quant_rows_i8(const float (&v)[NR][16], unsigned char* const (&dst)[NR], float* const (&scale_out)[NR], int lane) {
    float m[NR];
#pragma unroll
    for (int r = 0; r < NR; ++r) { m[r] = 0.f;
#pragma unroll
        for (int j = 0; j < 16; ++j) m[r] = fmaxf(m[r], fabsf(v[r][j])); }
#pragma unroll
    for (int o = 32; o >= 1; o >>= 1) {
#pragma unroll
        for (int r = 0; r < NR; ++r) m[r] = fmaxf(m[r], __shfl_xor(m[r], o));
    }
#pragma unroll
    for (int r = 0; r < NR; ++r) {
        const float scale = (m[r] > 0.f) ? m[r] * (1.0f / 127.0f) : 1.0f, inv = 1.0f / scale;
        u32x4 q;
#pragma unroll
        for (int w = 0; w < 4; ++w) {
            unsigned pk = 0;
#pragma unroll
            for (int k = 0; k < 4; ++k) { int qi = (int)rintf(v[r][4 * w + k] * inv); qi = qi < -127 ? -127 : (qi > 127 ? 127 : qi); pk |= (unsigned)(qi & 0xff) << (8 * k); }
            q[w] = pk;
        }
        *(u32x4*)(dst[r] + lane * 16) = q;
        if (lane == 0) *scale_out[r] = scale;
    }
}
struct Ctx {
    const float* in[23];
    float* out;
    unsigned char* ws;
};

__device__ __forceinline__ void quant_peer_tables(const Ctx& c, int gw, int NW, int lane) {
    unsigned char* ws = c.ws;
    for (int rw4 = gw * 4; rw4 < 2 * NEXP; rw4 += NW * 4) {
        const int tab = rw4 >= NEXP, row4 = rw4 - tab * NEXP;
        float v[4][16]; unsigned char* dst[4]; float* sc[4];
#pragma unroll
        for (int r = 0; r < 4; ++r) {
            const float* src = (tab ? c.in[20] : c.in[19]) + (size_t)(row4 + r) * 1024 + lane * 16;
            const f32x4 a0 = *(const f32x4*)src, a1 = *(const f32x4*)(src + 4), a2 = *(const f32x4*)(src + 8), a3 = *(const f32x4*)(src + 12);
            v[r][0] = a0.x; v[r][1] = a0.y; v[r][2] = a0.z; v[r][3] = a0.w; v[r][4] = a1.x; v[r][5] = a1.y; v[r][6] = a1.z; v[r][7] = a1.w;
            v[r][8] = a2.x; v[r][9] = a2.y; v[r][10] = a2.z; v[r][11] = a2.w; v[r][12] = a3.x; v[r][13] = a3.y; v[r][14] = a3.z; v[r][15] = a3.w;
            dst[r] = ws + (tab ? WS_VQ : WS_UQ) + (size_t)(row4 + r) * 1024; sc[r] = (float*)(ws + (tab ? WS_VSC : WS_USC)) + row4 + r;
        }
        quant_rows_i8<4>(v, dst, sc, lane);
        if (tab) {
#pragma unroll
            for (int r = 0; r < 4; ++r) { u32x4* q = (u32x4*)(dst[r] + lane * 16); u32x4 w = *q; w ^= (u32x4){0x80808080u, 0x80808080u, 0x80808080u, 0x80808080u}; *q = w; }
        }
    }
}

__device__ __forceinline__ void phase0(const Ctx& c, LAS unsigned char* lds) {
    int tid_ = threadIdx.x; asm volatile("" : "+v"(tid_)); const int tid = tid_;
    const size_t gtid = (size_t)blockIdx.x * NTHR + tid, gthreads = (size_t)gridDim.x * NTHR;
    unsigned char* ws = c.ws;
    cvt_f32_bf16(c.in[18], (bf16*)(ws + WS_KEYS), (size_t)8 * 2 * 128 * 128 / 8, gtid, gthreads);
    {
        const int lane = tid & 63, gw = blockIdx.x * 8 + (tid >> 6), NW = gridDim.x * 8;
        for (int row4 = gw * 4; row4 < T; row4 += NW * 4) {
            float v[4][16]; unsigned char* dst[4]; float* sc[4];
#pragma unroll
            for (int r = 0; r < 4; ++r) {
                const float* src = c.in[0] + (size_t)(row4 + r) * 1024 + lane * 16;
                const f32x4 a0 = *(const f32x4*)src, a1 = *(const f32x4*)(src + 4), a2 = *(const f32x4*)(src + 8), a3 = *(const f32x4*)(src + 12);
                v[r][0] = a0.x; v[r][1] = a0.y; v[r][2] = a0.z; v[r][3] = a0.w; v[r][4] = a1.x; v[r][5] = a1.y; v[r][6] = a1.z; v[r][7] = a1.w;
                v[r][8] = a2.x; v[r][9] = a2.y; v[r][10] = a2.z; v[r][11] = a2.w; v[r][12] = a3.x; v[r][13] = a3.y; v[r][14] = a3.z; v[r][15] = a3.w;
                dst[r] = ws + WS_XQ8 + (size_t)(row4 + r) * 1024; sc[r] = (float*)(ws + WS_SXR) + row4 + r;
            }
            quant_rows_i8<4>(v, dst, sc, lane);
#pragma unroll
            for (int r = 0; r < 4; ++r) {
                u32x4 b0, b1;
#pragma unroll
                for (int j = 0; j < 4; ++j) { b0[j] = pk2(v[r][2 * j], v[r][2 * j + 1]); b1[j] = pk2(v[r][8 + 2 * j], v[r][8 + 2 * j + 1]); }
                bf16* xb = (bf16*)(ws + WS_XB) + (size_t)(row4 + r) * 1024 + lane * 16;
                *(u32x4*)xb = b0; *(u32x4*)(xb + 8) = b1;
            }
        }
    }
    {
        const float* wsrc = c.in[12]; bf16* wt = (bf16*)(ws + WS_WTRIL);
        for (size_t i = gtid; i < (size_t)8 * 128 * 128 / 8; i += gthreads) {
            const int e = (int)i * 8, s0 = e & 127, t = (e >> 7) & 127;
            const f32x4 a = ((const f32x4*)wsrc)[2 * i], b = ((const f32x4*)wsrc)[2 * i + 1];
            float v[8] = {a.x, a.y, a.z, a.w, b.x, b.y, b.z, b.w};
#pragma unroll
            for (int j = 0; j < 8; ++j) v[j] = (s0 + j <= t) ? v[j] : 0.f;
            u32x4 o; o.x = pk2(v[0], v[1]); o.y = pk2(v[2], v[3]); o.z = pk2(v[4], v[5]); o.w = pk2(v[6], v[7]);
            ((u32x4*)wt)[i] = o;
        }
    }
    if (gtid < 1024) { const float lam = c.in[9][gtid]; ((float*)(ws + WS_SPT))[gtid] = 8.0f * NLOG2E * log1pf(expf(-lam));
                       ((float*)(ws + WS_BAS))[gtid] = NLOG2E * c.in[6][gtid]; ((float*)(ws + WS_BXS))[gtid] = NLOG2E * c.in[8][gtid]; }
    if (gtid < 2048) ((float*)(ws + WS_BGS))[gtid] = NLOG2E * c.in[2][gtid];
    {
        LAS float* s = (LAS float*)lds;
        constexpr int N_IN = 16 * 96, N_OUT = 16 * 16, N_Q = 16 * 32, N_G = 64, N_ALL = N_IN + N_OUT + N_Q + N_G;
        for (int it = blockIdx.x; it < N_ALL; it += gridDim.x) {
            int r = it;
            if (r < N_IN) {
                const int n0 = (r % 96) * 64, sec = n0 >> 10, kg = (n0 & 1023) >> 7, j0 = n0 & 127;
                const int ty = (sec == 0 || sec == 3) ? 0 : ((sec == 1 || sec == 4) ? 1 : 2), half = sec >= 3;
                transpose_tile(c.in[1], DIN, (bf16*)(ws + WS_WIN), 1024, (r / 96) * 64, n0, (3 * kg + ty) * 256 + half * 128 + j0, s, tid, sec >= 4 ? NLOG2E : 1.0f); continue;
            }
            r -= N_IN;
            if (r < N_OUT) { transpose_tile(c.in[14], 1024, (bf16*)(ws + WS_WOUT), 1024, (r / 16) * 64, (r % 16) * 64, (r % 16) * 64, s, tid); continue; }
            r -= N_OUT;
            if (r < N_Q) {
                const int k0 = (r / 32) * 64, n0 = (r % 32) * 64;
                {
                    const int kk = tid >> 3, c8 = (tid & 7) * 8;
                    const float* p = c.in[17] + (size_t)(k0 + kk) * 2048 + n0 + c8;
                    const f32x4 a = *(const f32x4*)p, b = *(const f32x4*)(p + 4);
                    LAS float* q = s + kk * 65 + c8;
                    q[0] = a.x; q[1] = a.y; q[2] = a.z; q[3] = a.w; q[4] = b.x; q[5] = b.y; q[6] = b.z; q[7] = b.w;
                }
                __syncthreads();
                if (tid < 64) {
                    float pc = 0.f, pd = 0.f;
                    for (int kk = 0; kk < 64; ++kk) { const float w = s[kk * 65 + tid]; pc += c.in[15][k0 + kk] * w; pd += c.in[16][k0 + kk] * w; }
                    float* part = (float*)(ws + WS_PARTCD) + (size_t)(r / 32) * 4096;
                    part[n0 + tid] = pc; part[2048 + n0 + tid] = pd;
                }
                {
                    const int nn = tid >> 3, k8 = (tid & 7) * 8;
                    const LAS float* q = s + k8 * 65 + nn;
                    const float* g = c.in[15] + k0 + k8;
                    u32x4 o; o.x = pk2(q[0] * g[0], q[65] * g[1]); o.y = pk2(q[2 * 65] * g[2], q[3 * 65] * g[3]); o.z = pk2(q[4 * 65] * g[4], q[5 * 65] * g[5]); o.w = pk2(q[6 * 65] * g[6], q[7 * 65] * g[7]);
                    *(u32x4*)((bf16*)(ws + WS_WQ) + (size_t)(n0 + nn) * 1024 + k0 + k8) = o;
                }
                __syncthreads();
                continue;
            }
            r -= N_Q;
            {
                const int h = r >> 3, g = (r >> 2) & 1, kb = (r >> 1) & 1, nb = r & 1;
                const float* W = (g ? c.in[7] : c.in[5]) + (size_t)h * 128 * 128;
                transpose_tile(W, 128, (bf16*)(ws + WS_WAX) + (size_t)h * 256 * 128 + (size_t)g * 128 * 128, 128, kb * 64, nb * 64, nb * 64, s, tid, NLOG2E);
            }
        }
    }
}

__device__ __forceinline__ void phase0b(const Ctx& c) {
    int tid_ = threadIdx.x; asm volatile("" : "+v"(tid_)); const int tid = tid_, lane = tid & 63, wid = tid >> 6;
    unsigned char* ws = c.ws;
    const bf16* W = (const bf16*)(ws + WS_WIN);
    {
        const int gt = blockIdx.x * NTHR + tid;
        if (gt < 4096) {
            const float* part = (const float*)(ws + WS_PARTCD) + gt;
            float sacc = 0.f;
#pragma unroll
            for (int kb = 0; kb < 16; ++kb) sacc += part[(size_t)kb * 4096];
            ((float*)(ws + WS_CQ))[gt] = sacc;
        }
    }
    for (int row4 = (blockIdx.x * 8 + wid) * 4; row4 < DIN + (Q_I8 ? 2048 : 0); row4 += gridDim.x * 8 * 4) {
        float v[4][16]; unsigned char* dst[4]; float* sc[4];
#pragma unroll
        for (int r = 0; r < 4; ++r) {
            const int rw = row4 + r; const bool isq = rw >= DIN;
            const bf16* src = (isq ? (const bf16*)(ws + WS_WQ) + (size_t)(rw - DIN) * 1024 : W + (size_t)rw * 1024) + lane * 16;
            const u32x4 a = *(const u32x4*)src, b = *(const u32x4*)(src + 8);
#pragma unroll
            for (int j = 0; j < 4; ++j) { v[r][2 * j] = bf_lo(a[j]); v[r][2 * j + 1] = bf_hi(a[j]); v[r][8 + 2 * j] = bf_lo(b[j]); v[r][8 + 2 * j + 1] = bf_hi(b[j]); }
            dst[r] = isq ? ws + WS_WQQ8 + (size_t)(rw - DIN) * 1024 : ws + WS_WQ8 + (size_t)rw * 1024; sc[r] = isq ? (float*)(ws + WS_SWQ) + (rw - DIN) : (float*)(ws + WS_SWC) + rw;
        }
        quant_rows_i8<4>(v, dst, sc, lane);
    }
}

__device__ __forceinline__ void phase2a(const Ctx& c) {
    int tid_ = threadIdx.x; asm volatile("" : "+v"(tid_)); const int tid = tid_, lane = tid & 63, wid = tid >> 6;
    unsigned char* ws = c.ws;
    const bf16* P4 = (const bf16*)(ws + WS_P4); bf16* XC = (bf16*)c.out; float* STATS = (float*)(ws + WS_STATS);
    const float* conv_w = c.in[3]; const float* conv_b = c.in[4];
    {
        const int gtid = blockIdx.x * NTHR + tid;
        const int cg = gtid & 127, run = gtid >> 7, ch = cg * 8;
        float w[4][8], bias[8];
#pragma unroll
        for (int k = 0; k < 4; ++k) { const f32x4 a = *(const f32x4*)(conv_w + k * 1024 + ch), b = *(const f32x4*)(conv_w + k * 1024 + ch + 4);
            w[k][0] = a.x; w[k][1] = a.y; w[k][2] = a.z; w[k][3] = a.w; w[k][4] = b.x; w[k][5] = b.y; w[k][6] = b.z; w[k][7] = b.w; }
        { const f32x4 a = *(const f32x4*)(conv_b + ch), b = *(const f32x4*)(conv_b + ch + 4);
          bias[0] = a.x; bias[1] = a.y; bias[2] = a.z; bias[3] = a.w; bias[4] = b.x; bias[5] = b.y; bias[6] = b.z; bias[7] = b.w; }
        for (int rn = run; rn < T / 32; rn += (gridDim.x * NTHR) >> 7) {
            const int t0 = rn * 32; const bool first = (t0 & (SEQ - 1)) == 0;
            const bf16* src = P4 + (size_t)t0 * 4096 + ch;
            u32x4 x0 = (u32x4){0u, 0u, 0u, 0u}, x1 = x0, x2 = x0;
            if (!first) { x0 = *(const u32x4*)(src - 3 * 4096); x1 = *(const u32x4*)(src - 2 * 4096); x2 = *(const u32x4*)(src - 4096); }
#pragma unroll 8
            for (int t = 0; t < 32; ++t) {
                const u32x4 x3 = *(const u32x4*)(src + (size_t)t * 4096);
                float o[8];
#pragma unroll
                for (int j = 0; j < 8; ++j) {
                    const float v0 = (j & 1) ? bf_hi(x0[j >> 1]) : bf_lo(x0[j >> 1]), v1 = (j & 1) ? bf_hi(x1[j >> 1]) : bf_lo(x1[j >> 1]);
                    const float v2 = (j & 1) ? bf_hi(x2[j >> 1]) : bf_lo(x2[j >> 1]), v3 = (j & 1) ? bf_hi(x3[j >> 1]) : bf_lo(x3[j >> 1]);
                    o[j] = bias[j] + w[0][j] * v0 + w[1][j] * v1 + w[2][j] * v2 + w[3][j] * v3;
                }
                u32x4 pk; pk.x = pk2(o[0], o[1]); pk.y = pk2(o[2], o[3]); pk.z = pk2(o[4], o[5]); pk.w = pk2(o[6], o[7]);
                *(u32x4*)(XC + (size_t)(t0 + t) * 1024 + ch) = pk;
                x0 = x1; x1 = x2; x2 = x3;
            }
        }
    }
    for (int row4 = (blockIdx.x * 8 + wid) * 4; row4 < T; row4 += gridDim.x * 8 * 4) {
        u32x4 a[4], b[4];
#pragma unroll
        for (int r = 0; r < 4; ++r) { const bf16* p = P4 + (size_t)(row4 + r) * 4096 + 3072 + lane * 16; a[r] = *(const u32x4*)p; b[r] = *(const u32x4*)(p + 8); }
        float mean[4], q[4];
#pragma unroll
        for (int r = 0; r < 4; ++r) {
            float s = 0.f;
#pragma unroll
            for (int j = 0; j < 4; ++j) s += (bf_lo(a[r][j]) + bf_hi(a[r][j])) + (bf_lo(b[r][j]) + bf_hi(b[r][j]));
            mean[r] = s;
        }
#pragma unroll
        for (int o = 32; o >= 1; o >>= 1) {
#pragma unroll
            for (int r = 0; r < 4; ++r) mean[r] += __shfl_xor(mean[r], o);
        }
#pragma unroll
        for (int r = 0; r < 4; ++r) {
            mean[r] *= (1.0f / 1024.0f);
            float s = 0.f;
#pragma unroll
            for (int j = 0; j < 4; ++j) {
                const float d0 = bf_lo(a[r][j]) - mean[r], d1 = bf_hi(a[r][j]) - mean[r], d2 = bf_lo(b[r][j]) - mean[r], d3 = bf_hi(b[r][j]) - mean[r];
                s += (d0 * d0 + d1 * d1) + (d2 * d2 + d3 * d3);
            }
            q[r] = s;
        }
#pragma unroll
        for (int o = 32; o >= 1; o >>= 1) {
#pragma unroll
            for (int r = 0; r < 4; ++r) q[r] += __shfl_xor(q[r], o);
        }
        if (lane < 4) {
            const float mm = lane == 0 ? mean[0] : lane == 1 ? mean[1] : lane == 2 ? mean[2] : mean[3];
            const float qq = lane == 0 ? q[0] : lane == 1 ? q[1] : lane == 2 ? q[2] : q[3];
            *(f32x2*)(STATS + (size_t)(row4 + lane) * 2) = (f32x2){mm, rsqrtf(qq * (1.0f / 1024.0f) + LN_EPS)};
        }
    }
}

typedef short s16x4 __attribute__((ext_vector_type(4)));
struct P2cRegs { u32x4 v[4]; f32x2 st[4]; };
__device__ __forceinline__ void p2c_load_v(P2cRegs& R, const bf16* P4, const float* STATS, int tile, int h, int tid) {
    const int piece = tid & 15, rowb = tid >> 4;
#pragma unroll
    for (int j = 0; j < 4; ++j) {
        const size_t row = (size_t)(tile * CHUNK + rowb + 32 * j);
        R.v[j] = *(const u32x4*)(P4 + row * 4096 + 3072 + h * 128 + piece * 8);
        R.st[j] = *(const f32x2*)(STATS + row * 2);
    }
}
__device__ __forceinline__ void phase2c(const Ctx& c, LAS unsigned char* lds, const int outcol = 2048) {
    int tid_ = threadIdx.x; asm volatile("" : "+v"(tid_)); const int tid = tid_, lane = tid & 63, wid = __builtin_amdgcn_readfirstlane(tid >> 6), fr = lane & 15, fq = lane >> 4, wr = wid >> 1, wc = wid & 1;
    unsigned char* ws = c.ws;
    bf16* P4 = (bf16*)(ws + WS_P4); const float* STATS = (const float*)(ws + WS_STATS);
    const bf16* HL = (const bf16*)(ws + WS_HL); const bf16* PC = (const bf16*)((const unsigned char*)c.out + OUT_PC);
    const float* PEND = (const float*)(ws + WS_PEND); const float* HEND = (const float*)(ws + WS_HEND);
    LAS float* carry = (LAS float*)(lds + 65536);
    const bf16* WTRIL = (const bf16*)(ws + WS_WTRIL);
    const float* ln_g = c.in[10]; const float* ln_b = c.in[11]; const float* gm_bs = c.in[13];
    const int h = blockIdx.x & 7;
    bf16x8 wf[2][4];
#pragma unroll
    for (int m = 0; m < 2; ++m)
#pragma unroll
        for (int ks = 0; ks < 4; ++ks) wf[m][ks] = *(const bf16x8*)(WTRIL + (size_t)h * 128 * 128 + (32 * wr + 16 * m + fr) * 128 + ks * 32 + fq * 8);
    const int piece = tid & 15, rowb = tid >> 4;
    float lg[8], lb[8];
    { const f32x4 g0 = *(const f32x4*)(ln_g + h * 128 + piece * 8), g1 = *(const f32x4*)(ln_g + h * 128 + piece * 8 + 4), b0 = *(const f32x4*)(ln_b + h * 128 + piece * 8), b1 = *(const f32x4*)(ln_b + h * 128 + piece * 8 + 4);
#pragma unroll
      for (int j = 0; j < 4; ++j) { lg[j] = g0[j]; lg[4 + j] = g1[j]; lb[j] = b0[j]; lb[4 + j] = b1[j]; } }
    const int wr_off = rowb * 256 + ((piece ^ ((rowb & 3) << 2)) << 4);
    const bool wr_swap = ((rowb >> 3) & 1) != 0;
    const int q_ = fr >> 2, p_ = fr & 3;
    int rd_off[2][2];
#pragma unroll
    for (int n2 = 0; n2 < 2; ++n2)
#pragma unroll
        for (int np = 0; np < 2; ++np) rd_off[n2][np] = (fq * 8 + q_) * 256 + (((8 * wc + 4 * n2 + p_) ^ (q_ << 2)) << 4) + ((np ^ (fq & 1)) << 3);
    const int nblk_h = gridDim.x >> 3;
    const int tile0 = blockIdx.x >> 3;
    P2cRegs RA, RB;
    if (tile0 < NTILE) p2c_load_v(RA, P4, STATS, tile0, h, tid);
    if (tile0 + nblk_h < NTILE) p2c_load_v(RB, P4, STATS, tile0 + nblk_h, h, tid);
#define P2C_UNIT(R, tile, par) do { \
        const int t0 = (tile) * CHUNK; \
        LAS unsigned char* V = lds + (par) * 32768; \
        _Pragma("unroll") for (int j = 0; j < 4; ++j) { \
            const float mean = R.st[j].x, rstd = R.st[j].y; \
            u32x4 w; \
            _Pragma("unroll") for (int e = 0; e < 4; ++e) w[e] = pk2((bf_lo(R.v[j][e]) - mean) * rstd * lg[2 * e] + lb[2 * e], (bf_hi(R.v[j][e]) - mean) * rstd * lg[2 * e + 1] + lb[2 * e + 1]); \
            if (wr_swap) w = (u32x4){w.z, w.w, w.x, w.y}; \
            *(LAS u32x4*)(V + wr_off + j * 32 * 256) = w; } \
        if (tid < 128) {                                        \
            const int cidx_ = (tile) & (NCHUNK - 1), tb_ = (tile) - cidx_; float hin_ = 0.f; \
            _Pragma("unroll") for (int cc = 0; cc < NCHUNK - 1; ++cc) { \
                const bool on_ = cc < cidx_; const int tl_ = on_ ? tb_ + cc : tb_; \
                const float p_ = PEND[(size_t)tl_ * 1024 + h * 128 + tid], q_ = HEND[(size_t)tl_ * 1024 + h * 128 + tid]; \
                hin_ = on_ ? p_ * hin_ + q_ : hin_; } \
            carry[(par) * 128 + tid] = hin_; } \
        __syncthreads(); \
        if ((tile) + 2 * nblk_h < NTILE) p2c_load_v(R, P4, STATS, (tile) + 2 * nblk_h, h, tid); \
        u32x4 hlv[2][2], pcv[2][2], gvv[2][2], ugv[2][2]; \
        _Pragma("unroll") for (int m = 0; m < 2; ++m) _Pragma("unroll") for (int n2 = 0; n2 < 2; ++n2) { \
            const size_t row_ = (size_t)(t0 + 32 * wr + 16 * m + fr); const int col_ = h * 128 + 64 * wc + 32 * n2 + 8 * fq; \
            hlv[m][n2] = *(const u32x4*)(HL + row_ * 1024 + col_); pcv[m][n2] = *(const u32x4*)(PC + row_ * 1024 + col_); gvv[m][n2] = *(const u32x4*)(P4 + row_ * 4096 + 1024 + col_); ugv[m][n2] = *(const u32x4*)(P4 + row_ * 4096 + 2048 + col_); } \
        f32x4 acc[2][4]; \
        _Pragma("unroll") for (int m = 0; m < 2; ++m) _Pragma("unroll") for (int n = 0; n < 4; ++n) acc[m][n] = (f32x4){0.f, 0.f, 0.f, 0.f}; \
        _Pragma("unroll") for (int ks = 0; ks < 4; ++ks) { \
            if (ks <= wr) { \
                bf16x8 b[4]; \
                _Pragma("unroll") for (int n = 0; n < 4; ++n) { \
                    const s16x4 lo = __builtin_amdgcn_ds_read_tr16_b64_v4i16((LAS s16x4*)(V + rd_off[n >> 1][n & 1] + ks * 32 * 256)); \
                    const s16x4 hi = __builtin_amdgcn_ds_read_tr16_b64_v4i16((LAS s16x4*)(V + rd_off[n >> 1][n & 1] + ks * 32 * 256 + 4 * 256)); \
                    b[n] = __builtin_shufflevector(lo, hi, 0, 1, 2, 3, 4, 5, 6, 7); } \
                _Pragma("unroll") for (int m = 0; m < 2; ++m) _Pragma("unroll") for (int n = 0; n < 4; ++n) acc[m][n] = __builtin_amdgcn_mfma_f32_16x16x32_bf16(b[n], wf[m][ks], acc[m][n], 0, 0, 0); } } \
        _Pragma("unroll") for (int m = 0; m < 2; ++m) { \
            const int tl = 32 * wr + 16 * m + fr; \
            const float bsv = gm_bs[h * 128 + tl]; \
            _Pragma("unroll") for (int n2 = 0; n2 < 2; ++n2) { \
                const f32x4 m0 = acc[m][2 * n2] + bsv, m1 = acc[m][2 * n2 + 1] + bsv; \
                const u32x4 ug = ugv[m][n2], hl_ = hlv[m][n2], pc_ = pcv[m][n2], g_ = gvv[m][n2]; \
                const LAS float* cp_ = carry + (par) * 128 + 64 * wc + 32 * n2 + 8 * fq; \
                const f32x4 h0_ = *(const LAS f32x4*)cp_, h1_ = *(const LAS f32x4*)(cp_ + 4); \
                u32x4 o;                                             \
                o.x = pk2(bf_lo(g_.x) * (bf_lo(hl_.x) + bf_lo(pc_.x) * h0_[0]) + bf_lo(ug.x) * m0[0], bf_hi(g_.x) * (bf_hi(hl_.x) + bf_hi(pc_.x) * h0_[1]) + bf_hi(ug.x) * m0[1]); \
                o.y = pk2(bf_lo(g_.y) * (bf_lo(hl_.y) + bf_lo(pc_.y) * h0_[2]) + bf_lo(ug.y) * m0[2], bf_hi(g_.y) * (bf_hi(hl_.y) + bf_hi(pc_.y) * h0_[3]) + bf_hi(ug.y) * m0[3]); \
                o.z = pk2(bf_lo(g_.z) * (bf_lo(hl_.z) + bf_lo(pc_.z) * h1_[0]) + bf_lo(ug.z) * m1[0], bf_hi(g_.z) * (bf_hi(hl_.z) + bf_hi(pc_.z) * h1_[1]) + bf_hi(ug.z) * m1[1]); \
                o.w = pk2(bf_lo(g_.w) * (bf_lo(hl_.w) + bf_lo(pc_.w) * h1_[2]) + bf_lo(ug.w) * m1[2], bf_hi(g_.w) * (bf_hi(hl_.w) + bf_hi(pc_.w) * h1_[3]) + bf_hi(ug.w) * m1[3]); \
                *(u32x4*)(P4 + (size_t)(t0 + tl) * 4096 + outcol + h * 128 + 64 * wc + 32 * n2 + 8 * fq) = o; } } \
    } while (0)
    for (int tile = tile0; tile < NTILE; tile += 2 * nblk_h) {
        P2C_UNIT(RA, tile, 0);
        if (tile + nblk_h < NTILE) P2C_UNIT(RB, tile + nblk_h, 1);
    }
#undef P2C_UNIT
}


__device__ __forceinline__ int f2key(float f) { const int b = __float_as_int(f); return b ^ ((b >> 31) & 0x7fffffff); }
__device__ __forceinline__ float key2f(int k) { return __int_as_float(k ^ ((k >> 31) & 0x7fffffff)); }
#define CE_DESC(a, b) do { const int _mx = max((a), (b)), _mn = min((a), (b)); (a) = _mx; (b) = _mn; } while (0)

template <int OFF, int N> __device__ __forceinline__ void sort16_desc(int (&v)[N]) {
#pragma unroll
    for (int k = 2; k <= 16; k <<= 1) {
#pragma unroll
        for (int j = k >> 1; j > 0; j >>= 1) {
#pragma unroll
            for (int i = 0; i < 16; ++i) {
                const int l = i ^ j;
                if (l > i) { if ((i & k) == 0) CE_DESC(v[OFF + i], v[OFF + l]); else CE_DESC(v[OFF + l], v[OFF + i]); }
            }
        }
    }
}
template <int OA, int OB, int N> __device__ __forceinline__ void merge16_desc(int (&v)[N]) {
#pragma unroll
    for (int i = 0; i < 16; ++i) v[OA + i] = max(v[OA + i], v[OB + 15 - i]);
#pragma unroll
    for (int j = 8; j > 0; j >>= 1) {
#pragma unroll
        for (int i = 0; i < 16; ++i) { const int l = i ^ j; if (l > i) CE_DESC(v[OA + i], v[OA + l]); }
    }
}
__device__ __forceinline__ void top16_of_64(int (&v)[64]) {
    sort16_desc<0>(v); sort16_desc<16>(v); sort16_desc<32>(v); sort16_desc<48>(v);
    merge16_desc<0, 16>(v); merge16_desc<32, 48>(v); merge16_desc<0, 32>(v);
}
__device__ __forceinline__ void merge_partner(int (&L)[16]) {
    int P[16];
#pragma unroll
    for (int i = 0; i < 16; ++i) P[i] = __shfl_xor(L[i], 32);
#pragma unroll
    for (int i = 0; i < 16; ++i) L[i] = max(L[i], P[15 - i]);
#pragma unroll
    for (int j = 8; j > 0; j >>= 1) {
#pragma unroll
        for (int i = 0; i < 16; ++i) { const int l = i ^ j; if (l > i) CE_DESC(L[i], L[l]); }
    }
}
__device__ __forceinline__ unsigned lookup_byte(const unsigned (&t)[4], int i) {
    const int w = i >> 2;
    const unsigned dw = (w == 0) ? t[0] : (w == 1) ? t[1] : (w == 2) ? t[2] : t[3];
    return (dw >> ((i & 3) * 8)) & 0xffu;
}

typedef _Float16 h16x2 __attribute__((ext_vector_type(2)));
__device__ __forceinline__ unsigned pkh2(float lo, float hi) { return __builtin_bit_cast(unsigned, __builtin_amdgcn_cvt_pkrtz(lo, hi)); }
__device__ __forceinline__ float h_lo(unsigned w) { return (float)__builtin_bit_cast(h16x2, w)[0]; }
__device__ __forceinline__ float h_hi(unsigned w) { return (float)__builtin_bit_cast(h16x2, w)[1]; }
constexpr int P7_KP = 272;
__device__ __forceinline__ void phase7(const Ctx& c, LAS unsigned char* lds) {
    int tid_ = threadIdx.x; asm volatile("" : "+v"(tid_)); const int tid = tid_, lane = tid & 63, wid = __builtin_amdgcn_readfirstlane(tid >> 6), r = lane & 31, hh = lane >> 5;
    unsigned char* ws = c.ws;
    const bf16* Q = (const bf16*)c.out; const bf16* KB = (const bf16*)(ws + WS_KEYS);
    int* IDX = (int*)(ws + WS_IDX); float* GATE = (float*)(ws + WS_GATE);
    const int head = blockIdx.x & 7, nblk_h = gridDim.x >> 3;
    {
        const bf16* ksrc = KB + (size_t)head * 256 * 128;
        for (int i = tid; i < 256 * 16; i += NTHR) { const int row = i >> 4, sg = i & 15; *(LAS u32x4*)(lds + row * P7_KP + sg * 16) = *(const u32x4*)(ksrc + row * 128 + sg * 8); }
    }
    __syncthreads();
    const LAS unsigned char* kl = lds + r * P7_KP + hh * 16;
    if (wid & 1) quant_peer_tables(c, blockIdx.x * 8 + wid, gridDim.x * 8, lane);
    for (int grp = (blockIdx.x >> 3) * 8 + wid; grp < T / 32; grp += nblk_h * 8) {
        const int tok = grp * 32 + r;
        int kz = 0; asm volatile("" : "+v"(kz));
        const LAS unsigned char* klz = kl + kz;
        bf16x8 qf[2][8];
        {
            const bf16* qp = Q + (size_t)tok * 2048 + head * 256 + hh * 8;
#pragma unroll
            for (int p = 0; p < 2; ++p)
#pragma unroll
                for (int ks = 0; ks < 8; ++ks) qf[p][ks] = *(const bf16x8*)(qp + p * 128 + ks * 16);
        }
        int S[2][16];
#pragma unroll
        for (int p = 0; p < 2; ++p) {
            f32x16 acc[4];
#pragma unroll
            for (int mb = 0; mb < 4; ++mb)
#pragma unroll
                for (int e = 0; e < 16; ++e) acc[mb][e] = 0.f;
#pragma unroll
            for (int ks = 0; ks < 8; ++ks) {
#pragma unroll
                for (int mb = 0; mb < 4; ++mb) {
                    const bf16x8 a = *(const LAS bf16x8*)(klz + (p * 128 + mb * 32) * P7_KP + ks * 32);
                    acc[mb] = __builtin_amdgcn_mfma_f32_32x32x16_bf16(a, qf[p][ks], acc[mb], 0, 0, 0);
                }
            }
            int v[64];
#pragma unroll
            for (int mb = 0; mb < 4; ++mb)
#pragma unroll
                for (int e = 0; e < 16; ++e) {
                    const int n = mb * 32 + (e & 3) + 8 * (e >> 2);
                    v[mb * 16 + e] = (f2key(acc[mb][e]) & ~0x7f) | n;
                }
            top16_of_64(v);
            int L[16];
#pragma unroll
            for (int i = 0; i < 16; ++i) L[i] = v[i] | (hh << 2);
            merge_partner(L);
#pragma unroll
            for (int i = 0; i < 16; ++i) S[p][i] = L[i];
        }
        float f1[16], f2[16];
#pragma unroll
        for (int i = 0; i < 16; ++i) { f1[i] = key2f(S[0][i]); f2[i] = key2f(S[1][i]); }
        int cv[64];
        {
            int n = 0;
#pragma unroll
            for (int i = 0; i < 16; ++i)
#pragma unroll
                for (int j = 0; j < 16; ++j)
                    if ((i + 1) * (j + 1) <= 16) { cv[n] = (f2key(f1[i] + f2[j]) & ~0xff) | (i * 16 + j); ++n; }
#pragma unroll
            for (int q = 50; q < 64; ++q) cv[q] = (int)0x80000000;
        }
        top16_of_64(cv);
        unsigned t1[4], t2[4];
#pragma unroll
        for (int w = 0; w < 4; ++w) {
            t1[w] = (unsigned)(S[0][4 * w] & 0x7f) | ((unsigned)(S[0][4 * w + 1] & 0x7f) << 8) | ((unsigned)(S[0][4 * w + 2] & 0x7f) << 16) | ((unsigned)(S[0][4 * w + 3] & 0x7f) << 24);
            t2[w] = (unsigned)(S[1][4 * w] & 0x7f) | ((unsigned)(S[1][4 * w + 1] & 0x7f) << 8) | ((unsigned)(S[1][4 * w + 2] & 0x7f) << 16) | ((unsigned)(S[1][4 * w + 3] & 0x7f) << 24);
        }
        int eid[16]; float ev[16];
        const float vmax = key2f(cv[0]);
        float esum = 0.f;
#pragma unroll
        for (int k = 0; k < 16; ++k) {
            const int pos = cv[k] & 0xff;
            eid[k] = (int)(lookup_byte(t1, pos >> 4) * 128u + lookup_byte(t2, pos & 15));
            ev[k] = __expf(key2f(cv[k]) - vmax);
            esum += ev[k];
        }
        const float inv = 1.0f / esum;
        if (hh == 0) {
            i32x4* ip = (i32x4*)(IDX + (size_t)tok * 128 + head * 16); f32x4* gp = (f32x4*)(GATE + (size_t)tok * 128 + head * 16);
#pragma unroll
            for (int w = 0; w < 4; ++w) {
                ip[w] = (i32x4){eid[4 * w], eid[4 * w + 1], eid[4 * w + 2], eid[4 * w + 3]};
                gp[w] = (f32x4){ev[4 * w] * inv, ev[4 * w + 1] * inv, ev[4 * w + 2] * inv, ev[4 * w + 3] * inv};
            }
        }
    }
    if (!(wid & 1)) quant_peer_tables(c, blockIdx.x * 8 + wid, gridDim.x * 8, lane);
}

#define UB0(w) ((float)((w) & 0xffu))
#define UB1(w) ((float)(((w) >> 8) & 0xffu))
#define UB2(w) ((float)(((w) >> 16) & 0xffu))
#define UB3(w) ((float)((w) >> 24))
#ifndef P8_NSH_
#define P8_NSH_ 16
#endif
#ifndef P8_CH_
#define P8_CH_ 12
#endif
#ifndef P8_PACE_
#define P8_PACE_ 0
#endif
#ifndef P8_NT_
#define P8_NT_ 0
#endif
#if P8_NT_
#define P8_LD(p) __builtin_nontemporal_load(p)
#else
#define P8_LD(p) (*(p))
#endif
#ifndef P8_SYNC_
#define P8_SYNC_ 0
#endif
#ifndef P8_GSYNC_
#define P8_GSYNC_ 0
#endif
#ifndef P8_TOK_
#define P8_TOK_ 8
#endif
constexpr int P8_TOK = P8_TOK_, P8_LIST = 1024 + 512, P8_NSH = P8_NSH_, P8_CH = P8_CH_, P8_SHIFT = (P8_NSH_ == 64 ? 8 : (P8_NSH_ == 32 ? 9 : (P8_NSH_ == 16 ? 10 : (P8_NSH_ == 8 ? 11 : (P8_NSH_ == 4 ? 12 : (P8_NSH_ == 2 ? 13 : 14))))));
template <int CTRL> __device__ __forceinline__ float dppf(float v) { return __int_as_float(__builtin_amdgcn_update_dpp(0, __float_as_int(v), CTRL, 0xf, 0xf, false)); }
__device__ __forceinline__ float reduce16(const float (&p)[16], bool b3, bool b2) {
    float q8[8], r4[4], s2[2];
#pragma unroll
    for (int i = 0; i < 8; ++i) { const auto r = __builtin_amdgcn_permlane32_swap(__float_as_uint(p[i]), __float_as_uint(p[8 + i]), false, false); q8[i] = __uint_as_float(r[0]) + __uint_as_float(r[1]); }
#pragma unroll
    for (int i = 0; i < 4; ++i) { const auto r = __builtin_amdgcn_permlane16_swap(__float_as_uint(q8[i]), __float_as_uint(q8[4 + i]), false, false); r4[i] = __uint_as_float(r[0]) + __uint_as_float(r[1]); }
#pragma unroll
    for (int i = 0; i < 2; ++i) { const float ta = r4[i] + dppf<0x128>(r4[i]), tb = r4[2 + i] + dppf<0x128>(r4[2 + i]); s2[i] = b3 ? tb : ta; }
    const float ta = s2[0] + dppf<0x141>(s2[0]), tb = s2[1] + dppf<0x141>(s2[1]);
    float t = b2 ? tb : ta;
    t += dppf<0x4e>(t);
    t += dppf<0xb1>(t);
    return t;
}
#define P8_LOAD_X1(x, tok) do { \
        const bf16* zr_ = ZB + (size_t)(tok) * 1024 + lane * 16; \
        const u32x4 a0_ = *(const u32x4*)zr_, a1_ = *(const u32x4*)(zr_ + 8); \
        const f32x2 st_ = *(const f32x2*)(ST1 + (size_t)(tok) * 2); \
        _Pragma("unroll") for (int j = 0; j < 4; ++j) { x[2 * j] = bf_lo(a0_[j]); x[2 * j + 1] = bf_hi(a0_[j]); x[8 + 2 * j] = bf_lo(a1_[j]); x[8 + 2 * j + 1] = bf_hi(a1_[j]); } \
        _Pragma("unroll") for (int w = 0; w < 4; ++w) { \
            const f32x4 g_ = *(const f32x4*)(l1g + lane * 16 + 4 * w), b_ = *(const f32x4*)(l1b + lane * 16 + 4 * w); \
            _Pragma("unroll") for (int k = 0; k < 4; ++k) x[4 * w + k] = (x[4 * w + k] - st_.x) * st_.y * g_[k] + b_[k]; } \
    } while (0)
__device__ __forceinline__ void phase8(const Ctx& c, LAS unsigned char* lds, const XcdBarrier& xbar) {
    int tid_ = threadIdx.x; asm volatile("" : "+v"(tid_)); const int tid = tid_, lane = tid & 63, wid = __builtin_amdgcn_readfirstlane(tid >> 6);
    unsigned char* ws = c.ws;
    const bf16* ZB = (const bf16*)(ws + WS_Z); const float* ST1 = (const float*)(ws + WS_ST1); const float* l1g = c.in[15]; const float* l1b = c.in[16];
    const int* IDX = (const int*)(ws + WS_IDX); const float* GATE = (const float*)(ws + WS_GATE);
    const unsigned char* UQ = ws + WS_UQ; const unsigned char* VQ = ws + WS_VQ;
    const float* USC = (const float*)(ws + WS_USC); const float* VSC = (const float*)(ws + WS_VSC);
    const float* lg = c.in[21]; const float* lb = c.in[22];
    float* OUT = c.out;
    const bool b3 = (lane & 8) != 0, b2 = (lane & 4) != 0;
    const int esub = lane >> 2;
    LAS unsigned char* wl = lds + wid * (P8_TOK * P8_LIST);
    const int ntl = (NTILE + gridDim.x - 1) / gridDim.x;
#if P8_PACE_
    if (lane == 0) ((volatile LAS int*)(lds + 8 * P8_TOK * P8_LIST))[wid] = 0;
    __syncthreads();
#endif
    for (int ti = 0; ti < ntl; ++ti) {
        const int tile = blockIdx.x + ti * gridDim.x; const bool live = tile < NTILE;
        for (int rnd = 0; rnd < 16 / P8_TOK; ++rnd) {
            if (P8_GSYNC_) xcd_barrier(xbar);
            const int tok0 = tile * CHUNK + wid * 16 + rnd * P8_TOK;
            int xq[P8_TOK][4]; float sx[P8_TOK], aacc[P8_TOK]; unsigned ob[P8_TOK][8];
            if (live) {
#pragma unroll
                for (int tt = 0; tt < P8_TOK; ++tt) {
                    const int tok = tok0 + tt;
                    {
                        float x[16];
                        P8_LOAD_X1(x, tok);
                        float m = 0.f;
#pragma unroll
                        for (int j = 0; j < 16; ++j) m = fmaxf(m, fabsf(x[j]));
#pragma unroll
                        for (int of = 32; of >= 1; of >>= 1) m = fmaxf(m, __shfl_xor(m, of));
                        const float sc = (m > 0.f) ? m * (1.0f / 127.0f) : 1.0f, inv = 1.0f / sc;
                        sx[tt] = sc;
#pragma unroll
                        for (int w = 0; w < 4; ++w) {
                            unsigned pk = 0;
#pragma unroll
                            for (int k = 0; k < 4; ++k) pk |= ((unsigned)(int)rintf(x[4 * w + k] * inv) & 0xffu) << (8 * k);
                            xq[tt][w] = (int)pk;
                        }
                    }
                    aacc[tt] = 0.f;
#pragma unroll
                    for (int j = 0; j < 8; ++j) ob[tt][j] = 0u;
                    {
                        LAS unsigned char* L = wl + tt * P8_LIST;
                        const int i0 = IDX[(size_t)tok * 128 + lane], i1 = IDX[(size_t)tok * 128 + 64 + lane];
                        const float g0 = GATE[(size_t)tok * 128 + lane], g1 = GATE[(size_t)tok * 128 + 64 + lane];
                        const int k0 = i0 >> P8_SHIFT, k1 = i1 >> P8_SHIFT;
                        int base = 0, pos0 = 0, pos1 = 0;
#pragma unroll
                        for (int s = 0; s < P8_NSH; ++s) {
                            const unsigned long long m0 = __ballot(k0 == s), m1 = __ballot(k1 == s);
                            const int c0 = __popcll(m0), c1 = __popcll(m1);
                            const int pre0 = __builtin_amdgcn_mbcnt_hi((unsigned)(m0 >> 32), __builtin_amdgcn_mbcnt_lo((unsigned)m0, 0));
                            const int pre1 = __builtin_amdgcn_mbcnt_hi((unsigned)(m1 >> 32), __builtin_amdgcn_mbcnt_lo((unsigned)m1, 0));
                            pos0 = (k0 == s) ? base + pre0 : pos0;
                            pos1 = (k1 == s) ? base + c0 + pre1 : pos1;
                            if (lane == 0) *(LAS int*)(L + 1024 + 4 * s) = base;
                            base += c0 + c1;
                        }
                        if (lane == 0) *(LAS int*)(L + 1024 + 4 * P8_NSH) = base;
                        *(LAS u32x2*)(L + pos0 * 8) = (u32x2){(unsigned)i0, __float_as_uint(g0)};
                        *(LAS u32x2*)(L + pos1 * 8) = (u32x2){(unsigned)i1, __float_as_uint(g1)};
                    }
                }
            }
            for (int s = 0; s < P8_NSH; ++s) {
#if P8_PACE_
                {
                    volatile LAS int* prog = (volatile LAS int*)(lds + 8 * P8_TOK * P8_LIST);
                    const int mine = (ti * (16 / P8_TOK) + rnd) * P8_NSH + s;
                    if (lane == 0) prog[wid] = mine;
                    for (int spin = 0; spin < 4096; ++spin) {
                        int mn = prog[0];
#pragma unroll
                        for (int w = 1; w < 8; ++w) { const int pw = prog[w]; mn = pw < mn ? pw : mn; }
                        if (__builtin_amdgcn_readfirstlane(mn) + P8_PACE_ >= mine) break;
                        __builtin_amdgcn_s_sleep(8);
                    }
                }
#endif
                if (live) {
#pragma unroll
                    for (int tt = 0; tt < P8_TOK; ++tt) {
                        const LAS unsigned char* L = wl + tt * P8_LIST;
                        const int eb = __builtin_amdgcn_readfirstlane(*(const LAS int*)(L + 1024 + 4 * s)), ee = __builtin_amdgcn_readfirstlane(*(const LAS int*)(L + 1024 + 4 * s + 4));
                        for (int c0 = eb; c0 < ee; c0 += P8_CH) {
                            const int ent = c0 + esub; const bool valid = (esub < P8_CH) && (ent < ee);
                            const u32x2 en = *(const LAS u32x2*)(L + (valid ? ent : eb) * 8);
                            const int idv = (int)en.x; const float gv = valid ? __uint_as_float(en.y) : 0.f;
                            const float su = USC[idv], sv = VSC[idv];
                            u32x4 u[P8_CH], v[P8_CH];
#pragma unroll
                            for (int e = 0; e < P8_CH; ++e) {
                                if (c0 + e < ee) {
                                    const int id = __builtin_amdgcn_readlane(idv, e * 4);
                                    u[e] = P8_LD((const u32x4*)(UQ + (size_t)id * 1024 + lane * 16));
                                    v[e] = P8_LD((const u32x4*)(VQ + (size_t)id * 1024 + lane * 16));
                                } else { u[e] = (u32x4){0u, 0u, 0u, 0u}; v[e] = (u32x4){0u, 0u, 0u, 0u}; }
                            }
                            float p[16];
#pragma unroll
                            for (int e = 0; e < 16; ++e) {
                                if (e < P8_CH) {
                                    int a = 0;
#pragma unroll
                                    for (int w = 0; w < 4; ++w) a = __builtin_amdgcn_sdot4((int)u[e][w], xq[tt][w], a, false);
                                    p[e] = (float)a;
                                } else p[e] = 0.f;
                            }
                            const float t1 = reduce16(p, b3, b2);
                            const float act = gelu_tanh(t1 * su * sx[tt]) * gv * sv;
                            aacc[tt] += act;
                            float oc[16];
#pragma unroll
                            for (int j = 0; j < 8; ++j) { oc[2 * j] = h_lo(ob[tt][j]); oc[2 * j + 1] = h_hi(ob[tt][j]); }
#pragma unroll
                            for (int e = 0; e < P8_CH; ++e) {
                                if (c0 + e < ee) {
                                    const float ae = __int_as_float(__builtin_amdgcn_readlane(__float_as_int(act), e * 4));
#pragma unroll
                                    for (int w = 0; w < 4; ++w) {
                                        oc[4 * w] += ae * UB0(v[e][w]); oc[4 * w + 1] += ae * UB1(v[e][w]); oc[4 * w + 2] += ae * UB2(v[e][w]); oc[4 * w + 3] += ae * UB3(v[e][w]);
                                    }
                                }
                            }
#pragma unroll
                            for (int j = 0; j < 8; ++j) ob[tt][j] = pkh2(oc[2 * j], oc[2 * j + 1]);
                        }
                    }
                }
                if (P8_SYNC_) __syncthreads();
            }
            if (live) {
#pragma unroll
                for (int tt = 0; tt < P8_TOK; ++tt) {
                    const int tok = tok0 + tt;
                    const float ooff = -128.0f * 0.25f * wave_sum(aacc[tt]);
                    float x[16];
                    P8_LOAD_X1(x, tok);
                    float sm = 0.f;
                    float o[16];
#pragma unroll
                    for (int j = 0; j < 8; ++j) { o[2 * j] = h_lo(ob[tt][j]); o[2 * j + 1] = h_hi(ob[tt][j]); }
#pragma unroll
                    for (int j = 0; j < 16; ++j) { o[j] = ALPHA * x[j] + (o[j] + ooff); sm += o[j]; }
                    const float mean = wave_sum(sm) * (1.0f / 1024.0f);
                    float qv = 0.f;
#pragma unroll
                    for (int j = 0; j < 16; ++j) { o[j] -= mean; qv += o[j] * o[j]; }
                    const float rstd = rsqrtf(wave_sum(qv) * (1.0f / 1024.0f) + LN_EPS);
                    const float* gp = lg + lane * 16; const float* bp = lb + lane * 16;
                    float* op = OUT + (size_t)tok * 1024 + lane * 16;
#pragma unroll
                    for (int w = 0; w < 4; ++w) {
                        const f32x4 gg = *(const f32x4*)(gp + 4 * w), hb = *(const f32x4*)(bp + 4 * w);
                        *(f32x4*)(op + 4 * w) = (f32x4){o[4 * w], o[4 * w + 1], o[4 * w + 2], o[4 * w + 3]} * rstd * gg + hb;
                    }
                }
            }
        }
    }
}

struct Params { const float* in[23]; float* out; unsigned char* ws; };

__global__ void __launch_bounds__(NTHR, 2) hybrid_fwd(Params p) {
    extern __shared__ __attribute__((aligned(16))) unsigned char lds_raw[];
    LAS unsigned char* lds = (LAS unsigned char*)lds_raw;
    cg::grid_group grid = cg::this_grid();
    Ctx c;
#pragma unroll
    for (int i = 0; i < 23; ++i) c.in[i] = p.in[i];
    c.out = p.out; c.ws = p.ws;
    unsigned char* ws = p.ws;

#ifndef G6_ALIGN
#define G6_ALIGN true
#endif
#ifndef G4_ALIGN
#define G4_ALIGN true
#endif
#ifndef G1_ALIGN
#define G1_ALIGN true
#endif
#ifndef G1_SP2
#define G1_SP2 true
#endif
#ifndef PH_MASK
#define PH_MASK 0x1ff
#endif
#ifndef REP0
#define REP0 1
#endif
#ifndef REP123
#define REP123 1
#endif
#ifndef REP1
#define REP1 1
#endif
#ifndef REP4
#define REP4 1
#endif
#ifndef REP5
#define REP5 1
#endif
#ifndef REP6
#define REP6 1
#endif
#ifndef REP7
#define REP7 1
#endif
#ifndef REP8
#define REP8 1
#endif
    if (threadIdx.x < 4) ((volatile LAS unsigned*)(lds + LDS_BARST))[threadIdx.x] = 0u;
    __syncthreads();
    const XcdBarrier xbar = xcd_barrier_post((unsigned*)(ws + WS_BAR), (volatile LAS unsigned*)(lds + LDS_BARST));
    if (p.ws == nullptr) grid.sync();
#define GSYNC() xcd_barrier(xbar)
    for (int rep = 0; rep < REP0; ++rep) { if (PH_MASK & 1) phase0(c, lds);
    GSYNC(); }
    if (PH_MASK & 1) phase0b(c);
    GSYNC();
    for (int rep123 = 0; rep123 < REP123; ++rep123) {
    for (int rep1 = 0; rep1 < REP1; ++rep1) {
    if (PH_MASK & 2) {
        pg8::Gemm g{(const bf16*)(ws + WS_XQ8), (const bf16*)(ws + WS_WQ8), T, DIN, 512, 512, 512, 0};
        pg8::StaticOrder S; S.init(T, DIN, (int)gridDim.x, (int)blockIdx.x);
        pg8::EpiProj E{(bf16*)(ws + WS_P4), (const float*)(ws + WS_BGS), (const float*)(ws + WS_SXR), (const float*)(ws + WS_SWC)};
        pg8::gemm_phase<pg8::EpiProj, pg8::StaticOrder, G1_ALIGN, G1_SP2>(lds, g, S, E);
    }
    GSYNC(); }
#ifndef REP2A
#define REP2A 1
#endif
#ifndef REP2B
#define REP2B 1
#endif
#ifndef REP3A
#define REP3A 1
#endif
    for (int r2 = 0; r2 < REP2A; ++r2) { if (PH_MASK & 4) phase2a(c);
    GSYNC(); }
    for (int r2 = 0; r2 < REP2B; ++r2) {
    if (PH_MASK & 4) {
        pg8::Gemm g{(const bf16*)p.out, (const bf16*)(ws + WS_WAX), T, 2048, 128, 1024, 128, 256};
        pg8::StaticOrder S; S.init(T, 2048, (int)gridDim.x, (int)blockIdx.x);
        pg8::EpiGate E{(const bf16*)p.out, (bf16*)(ws + WS_HL), (bf16*)((unsigned char*)p.out + OUT_PC), (float*)(ws + WS_PEND), (float*)(ws + WS_HEND), (const float*)(ws + WS_BAS), (const float*)(ws + WS_BXS), (const float*)(ws + WS_SPT)};
        pg8::gemm_phase<pg8::EpiGate, pg8::StaticOrder, true, true>(lds, g, S, E);
    }
    GSYNC(); }
#ifdef REP2C
    phase2c(c, lds, 0); GSYNC();
#endif
    if (PH_MASK & 4) phase2c(c, lds);
    GSYNC(); }
    for (int rep4 = 0; rep4 < REP4; ++rep4) {
    if (PH_MASK & 16) {
        pg8::Gemm g{(const bf16*)(ws + WS_P4) + 2048, (const bf16*)(ws + WS_WOUT), T, 1024, 1024, 4096, 1024, 0};
        pg8::StaticOrder S; S.init(T, 1024, (int)gridDim.x, (int)blockIdx.x);
        pg8::EpiResid E{(const bf16*)(ws + WS_XB), (bf16*)(ws + WS_Z), 1024, ALPHA, (float*)(ws + WS_PARTZ)};
        pg8::gemm_phase<pg8::EpiResid, pg8::StaticOrder, G4_ALIGN, true>(lds, g, S, E);
    }
    GSYNC(); }
    for (int rep6 = 0; rep6 < REP6; ++rep6) {
    if (PH_MASK & 64) {
#if Q_I8
        pg8::Gemm g{(const bf16*)(ws + WS_X1Q8), (const bf16*)(ws + WS_WQQ8), T, 2048, 512, 512, 512, 0};
        pg8::StaticOrder S; S.init(T, 2048, (int)gridDim.x, (int)blockIdx.x);
        pg8::EpiBf16I8 E{(bf16*)p.out, 2048, (const float*)(ws + WS_SX1), (const float*)(ws + WS_SWQ)};
        pg8::gemm_phase<pg8::EpiBf16I8, pg8::StaticOrder, G6_ALIGN, true>(lds, g, S, E);
#else
        pg8::StaticOrder S; S.init(T, 2048, (int)gridDim.x, (int)blockIdx.x);
        LAS float* tab = (LAS float*)(lds + 131072);
        {
            const int ui = threadIdx.x >> 7; pg8::Unit uu;
            if (S.next(ui, uu)) {
#pragma unroll
                for (int rr = 0; rr < 2; ++rr) {
                    const int rl = (threadIdx.x & 127) * 2 + rr, row = uu.pm * 256 + rl;
                    const f32x4* pp = (const f32x4*)((const float*)(ws + WS_PARTZ) + (size_t)row * 32);
                    float s1 = 0.f, s2 = 0.f;
#pragma unroll
                    for (int k = 0; k < 8; ++k) { const f32x4 v = pp[k]; s1 += v.x + v.z; s2 += v.y + v.w; }
                    const float mean = s1 * (1.0f / 1024.0f), rstd = rsqrtf(fmaxf(s2 * (1.0f / 1024.0f) - mean * mean, 0.f) + LN_EPS);
                    tab[(ui * 256 + rl) * 2] = mean; tab[(ui * 256 + rl) * 2 + 1] = rstd;
                    if (uu.pn == 0) *(f32x2*)((float*)(ws + WS_ST1) + (size_t)row * 2) = (f32x2){mean, rstd};
                }
            }
        }
        __syncthreads();
        pg8::Gemm g{(const bf16*)(ws + WS_Z), (const bf16*)(ws + WS_WQ), T, 2048, 1024, 1024, 1024, 0};
        pg8::EpiQ E{(bf16*)p.out, 2048, (const float*)(ws + WS_CQ), (const float*)(ws + WS_DQ), (const LAS float*)tab, S};
        pg8::gemm_phase<pg8::EpiQ, pg8::StaticOrder, G6_ALIGN, true>(lds, g, S, E);
#endif
    }
    GSYNC(); }
    for (int rep = 0; rep < REP7; ++rep) { if (PH_MASK & 128) phase7(c, lds);
    GSYNC(); }
#ifdef REP8B
    phase8(c, lds, xbar); GSYNC();
#endif
    if (PH_MASK & 256) phase8(c, lds, xbar);
}

extern "C" void kernel_launch(void* const* d_in, const int* in_sizes, int n_in, void* d_out, int out_size,
                              void* d_ws, size_t ws_size, hipStream_t stream) {
    static int grid_blocks = 0;
    if (grid_blocks == 0) {
        if (n_in != 23 || out_size != T * D || ws_size < WS_END) {
            fprintf(stderr, "kernel_launch: unexpected problem (n_in %d, out %d, ws %zu); nothing launched\n", n_in, out_size, ws_size);
            grid_blocks = -1; return;
        }
        int dev = 0, cus = 0, per_cu = 0;
        (void)hipGetDevice(&dev);
        (void)hipDeviceGetAttribute(&cus, hipDeviceAttributeMultiprocessorCount, dev);
        (void)hipFuncSetAttribute((const void*)hybrid_fwd, hipFuncAttributeMaxDynamicSharedMemorySize, LDS_BYTES);
        (void)hipOccupancyMaxActiveBlocksPerMultiprocessor(&per_cu, (const void*)hybrid_fwd, NTHR, LDS_BYTES);
        if (per_cu < 1) { fprintf(stderr, "kernel_launch: occupancy query reports %d blocks per CU\n", per_cu); grid_blocks = -1; return; }
        grid_blocks = cus;
        (void)hipGetLastError();
    }
    if (grid_blocks < 0) return;
    Params p{};
    for (int i = 0; i < 23; ++i) p.in[i] = (const float*)d_in[i];
    p.out = (float*)d_out; p.ws = (unsigned char*)d_ws;
    if (hipMemsetAsync((unsigned char*)d_ws + WS_BAR, 0, XCD_BAR_WORDS * sizeof(unsigned), stream) != hipSuccess) { fprintf(stderr, "kernel_launch: hipMemsetAsync of the barrier words failed; nothing launched\n"); return; }
    void* args[] = {&p};
    hipError_t e = hipLaunchCooperativeKernel((const void*)hybrid_fwd, dim3(grid_blocks), dim3(NTHR), args, LDS_BYTES, stream);
    if (e != hipSuccess) fprintf(stderr, "cooperative launch failed: %s (grid %d)\n", hipGetErrorString(e), grid_blocks);
}
```

```cpp
#include <hip/hip_runtime.h>
#include <hip/hip_cooperative_groups.h>
#include <cstdio>
#include <cstdint>
namespace cg = cooperative_groups;

#define LAS __attribute__((address_space(3)))
typedef unsigned short bf16;
typedef short bf16x8 __attribute__((ext_vector_type(8)));
typedef float f32x4 __attribute__((ext_vector_type(4)));
typedef float f32x16 __attribute__((ext_vector_type(16)));
typedef float f32x2 __attribute__((ext_vector_type(2)));
typedef unsigned u32x4 __attribute__((ext_vector_type(4)));
typedef unsigned u32x2 __attribute__((ext_vector_type(2)));
typedef int i32x4 __attribute__((ext_vector_type(4)));
typedef __bf16 bf16v2 __attribute__((ext_vector_type(2)));

#ifndef Q_I8
#define Q_I8 0
#endif
constexpr int T = 32768, D = 1024, SEQ = 4096, DIN = 6144, CHUNK = 128, NTILE = T / CHUNK, NCHUNK = SEQ / CHUNK, NH = 8, HD = 128;
constexpr int NEXP = 16384;
constexpr float ALPHA = 1.18920711500272f, LN_EPS = 1e-5f;
constexpr int NTHR = 512;
constexpr int LDS_BYTES = 147456;
constexpr int LDS_BARST = 147440;

constexpr size_t MiB = 1u << 20;
constexpr size_t WS_SPT = 0;
constexpr size_t WS_BAS = 4096;
constexpr size_t WS_BXS = 8192;
constexpr size_t WS_BGS = 12288;
constexpr size_t WS_STATS = 256 * 1024;
constexpr size_t WS_BAR = 64 * 1024;
constexpr size_t WS_WIN = 1 * MiB;
constexpr size_t WS_WOUT = 13 * MiB;
constexpr size_t WS_WQ = 15 * MiB;
constexpr size_t WS_KEYS = 19 * MiB;
constexpr size_t WS_WAX = 20 * MiB;
constexpr size_t WS_WTRIL = 20 * MiB + 512 * 1024;
constexpr size_t WS_UQ = 22 * MiB;
constexpr size_t WS_VQ = 38 * MiB;
constexpr size_t WS_USC = 54 * MiB;
constexpr size_t WS_VSC = 55 * MiB;
constexpr size_t WS_WQ8 = 56 * MiB;
constexpr size_t WS_SXR = 62 * MiB;
constexpr size_t WS_SWC = 63 * MiB;
constexpr size_t WS_WQQ8 = 64 * MiB;
constexpr size_t WS_SWQ = 66 * MiB;
constexpr size_t WS_SX1 = 67 * MiB;
constexpr size_t WS_X1Q8 = 182 * MiB;
constexpr size_t WS_XQ8 = 472 * MiB;
constexpr size_t WS_XB = 86 * MiB;
constexpr size_t OUT_PC = 64 * MiB;
constexpr size_t WS_P4 = 150 * MiB;
constexpr size_t WS_HL = 406 * MiB;
constexpr size_t WS_PEND = 470 * MiB;
constexpr size_t WS_HEND = 471 * MiB;
constexpr size_t WS_Z = 406 * MiB;
constexpr size_t WS_PARTZ = 68 * MiB;
constexpr size_t WS_ST1 = 72 * MiB;
constexpr size_t WS_CQ = 73 * MiB;
constexpr size_t WS_DQ = 73 * MiB + 8192;
constexpr size_t WS_PARTCD = 74 * MiB;
constexpr size_t WS_IDX = 470 * MiB;
constexpr size_t WS_GATE = 486 * MiB;
constexpr size_t WS_END = 504 * MiB;

__device__ __forceinline__ unsigned pk2(float lo, float hi) { f32x2 v = {lo, hi}; return __builtin_bit_cast(unsigned, __builtin_convertvector(v, bf16v2)); }
__device__ __forceinline__ float bf_lo(unsigned w) { return __uint_as_float(w << 16); }
__device__ __forceinline__ float bf_hi(unsigned w) { return __uint_as_float(w & 0xffff0000u); }
constexpr float NLOG2E = -1.4426950408889634f;
__device__ __forceinline__ float sig_pre(float xs) { return __builtin_amdgcn_rcpf(1.0f + __builtin_amdgcn_exp2f(xs)); }
__device__ __forceinline__ float gelu_tanh(float x) { const float u = x * (1.0f + 0.044715f * x * x); return x * __builtin_amdgcn_rcpf(1.0f + __builtin_amdgcn_exp2f(-2.3022081989f * u)); }
__device__ __forceinline__ float wave_sum(float v) {
#pragma unroll
    for (int o = 32; o >= 1; o >>= 1) v += __shfl_xor(v, o);
    return v;
}
#define XB_TMO      128
#define XB_XCNT(j)  (256  + 64 * (j))
#define XB_XSUB(j)  (1280 + 64 * (j))
#define XB_XGEN(j)  (2304 + 64 * (j))
#define XB_TOP      3328
#define XB_TOPGEN   3392
#define XCD_BAR_WORDS 3456
#define XB_SPIN_CAP (1u << 22)

__device__ __forceinline__ unsigned xb_ld(unsigned* p)              { return __hip_atomic_load(p, __ATOMIC_RELAXED, __HIP_MEMORY_SCOPE_AGENT); }
__device__ __forceinline__ unsigned xb_add(unsigned* p, unsigned v) { return __hip_atomic_fetch_add(p, v, __ATOMIC_RELAXED, __HIP_MEMORY_SCOPE_AGENT); }
__device__ __forceinline__ unsigned xb_xcc_id() { return (unsigned)__builtin_amdgcn_s_getreg((3 << 11) | 20) & 0xFu; }
#define XB_SPIN(cond, bar) do { unsigned _sp = 0; while (cond) { __builtin_amdgcn_s_sleep(1); \
    if ((++_sp & 255u) == 0u) { if (xb_ld(&(bar)[XB_TMO])) break; if (_sp > XB_SPIN_CAP) { atomicAdd(&(bar)[XB_TMO], 1u); break; } } } } while (0)

struct XcdBarrier {
    unsigned* bar; unsigned x;
    volatile LAS unsigned* st;
};

__device__ __forceinline__ XcdBarrier xcd_barrier_post(unsigned* bar, volatile LAS unsigned* st) {
    XcdBarrier b; b.bar = bar; b.x = xb_xcc_id(); b.st = st;
    if (threadIdx.x == 0) (void)xb_add(&bar[XB_XCNT(b.x)], 1u);
    return b;
}
__device__ __forceinline__ void xcd_barrier_complete(unsigned* bar, unsigned x, unsigned& nloc, unsigned& nx) {
    const unsigned G = gridDim.x * gridDim.y * gridDim.z;
    unsigned sum, cnt, mine, sp = 0u;
    for (;;) {
        sum = 0u; cnt = 0u; mine = 0u;
#pragma unroll
        for (unsigned j = 0; j < 16; ++j) { const unsigned c = xb_ld(&bar[XB_XCNT(j)]); sum += c; cnt += (c > 0u) ? 1u : 0u; mine = (j == x) ? c : mine; }
        if (sum == G) break;
        __builtin_amdgcn_s_sleep(1);
        if ((++sp & 255u) == 0u) { if (xb_ld(&bar[XB_TMO])) break; if (sp > XB_SPIN_CAP) { atomicAdd(&bar[XB_TMO], 1u); break; } }
    }
    nloc = mine > 0u ? mine : 1u; nx = cnt > 0u ? cnt : 1u;
}

__device__ __forceinline__ void xcd_barrier(const XcdBarrier& b) {
    asm volatile("s_waitcnt vmcnt(0)" ::: "memory");
    __syncthreads();
    if (threadIdx.x == 0) {
        unsigned* bar = b.bar;
        __builtin_amdgcn_s_waitcnt(0);
        unsigned nloc = b.st[0], nx = b.st[1];
        if (nloc == 0u) { xcd_barrier_complete(bar, b.x, nloc, nx); b.st[0] = nloc; b.st[1] = nx; }
        const unsigned old = xb_add(&bar[XB_XSUB(b.x)], 1u);
        const unsigned gen = old / nloc;
        if (old + 1u == (gen + 1u) * nloc) {
            __builtin_amdgcn_fence(__ATOMIC_RELEASE, "agent");
            asm volatile("s_waitcnt vmcnt(0)" ::: "memory");
            const unsigned og = xb_add(&bar[XB_TOP], 1u);
            const unsigned tg = og / nx;
            if (og + 1u == (tg + 1u) * nx) xb_add(&bar[XB_TOPGEN], 1u);
            else XB_SPIN(xb_ld(&bar[XB_TOPGEN]) == tg, bar);
            __builtin_amdgcn_fence(__ATOMIC_ACQUIRE, "agent");
            xb_add(&bar[XB_XGEN(b.x)], 1u);
            asm volatile("s_waitcnt vmcnt(0)" ::: "memory");
        } else {
            XB_SPIN(xb_ld(&bar[XB_XGEN(b.x)]) == gen, bar);
            __builtin_amdgcn_fence(__ATOMIC_ACQUIRE, "agent");
            asm volatile("s_waitcnt vmcnt(0)" ::: "memory");
        }
    }
    __syncthreads();
}
namespace pg8 {
#define PG8_LAS __attribute__((address_space(3)))
typedef unsigned short bf16_t;
typedef short bf16x8 __attribute__((ext_vector_type(8)));
typedef float f32x4 __attribute__((ext_vector_type(4)));
typedef unsigned u32x4 __attribute__((ext_vector_type(4)));
typedef int i32x4_ __attribute__((ext_vector_type(4)));
constexpr int BM = 256, BK = 64, HALF = 128, HTB = HALF * BK * 2  , STAGE_BYTES = 8 * HTB, NXCD = 8, WGM = 8;

__host__ __device__ __forceinline__ int lds_byte(int r, int c) { const int st = (r >> 4) * 2 + (c >> 5), rr = r & 15, cc = c & 31, ob = rr * 64 + cc * 2; return st * 1024 + (ob ^ (((ob >> 9) & 1) << 5)); }
__host__ __device__ __forceinline__ void stage_rc(int b, int& R, int& C) { const int st = b / 1024, sb = b % 1024, swz = sb ^ (((sb >> 9) & 1) << 5); R = (st >> 1) * 16 + swz / 64; C = (st & 1) * 32 + (swz % 64) / 2; }
__host__ __device__ __forceinline__ int perm32(int rho) { const int n = rho >> 4, i = rho & 15; return 8 * (i >> 2) + 4 * n + (i & 3); }

struct Unit { int pm, pn; };
struct Gemm { const bf16_t* A; const bf16_t* Bt; int M, N, K, lda, ldb, a_pn_bytes; };

struct StaticOrder {
    int nM, nN, nwg, G, c;
    __host__ __device__ __forceinline__ void init(int M, int N, int G_, int c_) { nM = M / BM; nN = N / BM; nwg = nM * nN; G = G_; c = c_; }
    __host__ __device__ __forceinline__ bool next(int i, Unit& u) const {
        const long L = (long)i * G + c; if (L >= nwg) return false;
        int wgid = (int)L; { const int q = nwg / NXCD, r = nwg % NXCD, xcd = wgid % NXCD, off = wgid / NXCD; wgid = (xcd < r ? xcd * (q + 1) : r * (q + 1) + (xcd - r) * q) + off; }
        const int nig = WGM * nN, gid = wgid / nig, fm = gid * WGM, gsz = (nM - fm) < WGM ? (nM - fm) : WGM;
        u.pm = fm + ((wgid % nig) % gsz); u.pn = (wgid % nig) / gsz; return true;
    }
    __device__ __forceinline__ void a_ready(const Unit&) const {}
    __device__ __forceinline__ void done(const Unit&) const {}
};


struct EpiProj {
    static constexpr bool PERM = true, AFTER_DRAIN = false, AROWS = false, I8 = true;
    bf16_t* P4; const float* bgate;
    const float* sxr; const float* swc;
    __device__ __forceinline__ void operator()(const f32x4 (&acc)[2][2][4][2], const Unit& u, int, int, int, int) const {
        int t_ = threadIdx.x; asm volatile("" : "+v"(t_)); const int fr = t_ & 15, fq = (t_ >> 4) & 3, wc = (t_ >> 6) & 3, wr = t_ >> 8;
        const int k = u.pn / 3, ty = u.pn - 3 * k;
        const int row0 = u.pm * BM + wr * 64 + fr, cl = k * 128 + wc * 32 + 8 * fq;
        const float* swp = swc + u.pn * BM + wc * 32 + 8 * fq;
        const f32x4 w00 = *(const f32x4*)swp, w01 = *(const f32x4*)(swp + 4), w10 = *(const f32x4*)(swp + HALF), w11 = *(const f32x4*)(swp + HALF + 4);
#define EPI_I2F(v, w, s) ((f32x4){(float)__builtin_bit_cast(i32x4_, v)[0], (float)__builtin_bit_cast(i32x4_, v)[1], (float)__builtin_bit_cast(i32x4_, v)[2], (float)__builtin_bit_cast(i32x4_, v)[3]} * (w) * (s))
        if (ty == 0) {
#pragma unroll
            for (int ai = 0; ai < 2; ++ai)
#pragma unroll
                for (int m = 0; m < 4; ++m) {
                    const int row = row0 + ai * HALF + m * 16; const float sx = sxr[row];
                    bf16_t* rowp = P4 + (size_t)row * 4096 + cl;
                    const f32x4 a0 = EPI_I2F(acc[ai][0][m][0], w00, sx), a1 = EPI_I2F(acc[ai][0][m][1], w01, sx); f32x4 v0 = EPI_I2F(acc[ai][1][m][0], w10, sx), v1 = EPI_I2F(acc[ai][1][m][1], w11, sx);
#pragma unroll
                    for (int j = 0; j < 4; ++j) { v0[j] = gelu_tanh(v0[j]); v1[j] = gelu_tanh(v1[j]); }
                    u32x4 w; w.x = pk2(a0[0], a0[1]); w.y = pk2(a0[2], a0[3]); w.z = pk2(a1[0], a1[1]); w.w = pk2(a1[2], a1[3]);
                    *(u32x4*)rowp = w;
                    w.x = pk2(v0[0], v0[1]); w.y = pk2(v0[2], v0[3]); w.z = pk2(v1[0], v1[1]); w.w = pk2(v1[2], v1[3]);
                    *(u32x4*)(rowp + 3072) = w;
                }
        } else {
            const float* bp = bgate + (ty - 1) * 1024 + cl;
            const f32x4 b0 = *(const f32x4*)bp, b1 = *(const f32x4*)(bp + 4);
#pragma unroll
            for (int ai = 0; ai < 2; ++ai)
#pragma unroll
                for (int m = 0; m < 4; ++m) {
                    const int row = row0 + ai * HALF + m * 16; const float sx = sxr[row];
                    bf16_t* rowp = P4 + (size_t)row * 4096 + ty * 1024 + cl;
                    f32x4 a0 = EPI_I2F(acc[ai][0][m][0], w00, sx), a1 = EPI_I2F(acc[ai][0][m][1], w01, sx); const f32x4 g0 = EPI_I2F(acc[ai][1][m][0], w10, sx) + b0, g1 = EPI_I2F(acc[ai][1][m][1], w11, sx) + b1;
#pragma unroll
                    for (int j = 0; j < 4; ++j) { a0[j] = gelu_tanh(a0[j]) * sig_pre(g0[j]); a1[j] = gelu_tanh(a1[j]) * sig_pre(g1[j]); }
                    u32x4 w; w.x = pk2(a0[0], a0[1]); w.y = pk2(a0[2], a0[3]); w.z = pk2(a1[0], a1[1]); w.w = pk2(a1[2], a1[3]);
                    *(u32x4*)rowp = w;
                }
        }
#undef EPI_I2F
    }
};
template <int S> __device__ __forceinline__ float row_shr_f(float ident, float v) {
    return __int_as_float(__builtin_amdgcn_update_dpp(__float_as_int(ident), __float_as_int(v), 0x110 + S, 0xf, 0xf, false));
}
struct EpiGate {
    static constexpr bool PERM = true, AFTER_DRAIN = false, AROWS = true, I8 = false;
    const bf16_t* XC; bf16_t* HL; bf16_t* PC; float* PEND; float* HEND; const float* b_a; const float* b_x; const float* spt;
    __device__ __forceinline__ void operator()(const f32x4 (&acc)[2][2][4][2], const Unit& u, int, int, int, int) const {
        int t_ = threadIdx.x; asm volatile("" : "+v"(t_)); const int fr = t_ & 15, fq = (t_ >> 4) & 3, wc = (t_ >> 6) & 3, wr = t_ >> 8, lane15 = (t_ & 63) | 15;
        const int row0 = u.pm * BM + wr * 128 + fr, ch = u.pn * 128 + wc * 32 + 8 * fq, chunk = u.pm * 2 + wr;
        float Ac[8], Hc[8];
#pragma unroll
        for (int j = 0; j < 8; ++j) { Ac[j] = 1.0f; Hc[j] = 0.0f; }
#pragma unroll
        for (int ai = 0; ai < 2; ++ai)
#pragma unroll
            for (int m = 0; m < 4; ++m) {
                asm volatile("" ::: "memory");
                int zo = 0; asm volatile("" : "+v"(zo));
                const size_t off = (size_t)(row0 + ai * 64 + m * 16) * 1024 + ch;
                const u32x4 xw = *(const u32x4*)(XC + off);
                float ba[8], bx[8], sp[8];
                { const int cz = ch + zo;
                  const f32x4 t0 = *(const f32x4*)(b_a + cz), t1 = *(const f32x4*)(b_a + cz + 4), t2 = *(const f32x4*)(b_x + cz), t3 = *(const f32x4*)(b_x + cz + 4), t4 = *(const f32x4*)(spt + cz), t5 = *(const f32x4*)(spt + cz + 4);
#pragma unroll
                  for (int j = 0; j < 4; ++j) { ba[j] = t0[j]; ba[4 + j] = t1[j]; bx[j] = t2[j]; bx[4 + j] = t3[j]; sp[j] = t4[j]; sp[4 + j] = t5[j]; } }
                float a[8], b[8];
#pragma unroll
                for (int j = 0; j < 8; ++j) {
                    const float rp = acc[ai][0][m][j >> 2][j & 3], ip = acc[ai][1][m][j >> 2][j & 3];
                    const float xv = (j & 1) ? bf_hi(xw[j >> 1]) : bf_lo(xw[j >> 1]);
                    a[j] = __builtin_amdgcn_exp2f(sig_pre(rp + ba[j]) * sp[j]);
                    b[j] = __builtin_amdgcn_sqrtf(__builtin_fmaxf(1.0f - a[j] * a[j], 0.f)) * sig_pre(ip + bx[j]) * xv;
                }
#pragma unroll
                for (int j = 0; j < 8; ++j) { const float ap = row_shr_f<1>(1.0f, a[j]), bp = row_shr_f<1>(0.0f, b[j]); b[j] = a[j] * bp + b[j]; a[j] = a[j] * ap; }
#pragma unroll
                for (int j = 0; j < 8; ++j) { const float ap = row_shr_f<2>(1.0f, a[j]), bp = row_shr_f<2>(0.0f, b[j]); b[j] = a[j] * bp + b[j]; a[j] = a[j] * ap; }
#pragma unroll
                for (int j = 0; j < 8; ++j) { const float ap = row_shr_f<4>(1.0f, a[j]), bp = row_shr_f<4>(0.0f, b[j]); b[j] = a[j] * bp + b[j]; a[j] = a[j] * ap; }
#pragma unroll
                for (int j = 0; j < 8; ++j) { const float ap = row_shr_f<8>(1.0f, a[j]), bp = row_shr_f<8>(0.0f, b[j]); b[j] = a[j] * bp + b[j]; a[j] = a[j] * ap; }
                float hl[8], pc[8];
#pragma unroll
                for (int j = 0; j < 8; ++j) {
                    const float at = __shfl(a[j], lane15), bt = __shfl(b[j], lane15);
                    hl[j] = b[j] + a[j] * Hc[j]; pc[j] = a[j] * Ac[j];
                    Hc[j] = bt + at * Hc[j]; Ac[j] = at * Ac[j];
                }
                u32x4 w; w.x = pk2(hl[0], hl[1]); w.y = pk2(hl[2], hl[3]); w.z = pk2(hl[4], hl[5]); w.w = pk2(hl[6], hl[7]);
                *(u32x4*)(HL + off) = w;
                w.x = pk2(pc[0], pc[1]); w.y = pk2(pc[2], pc[3]); w.z = pk2(pc[4], pc[5]); w.w = pk2(pc[6], pc[7]);
                *(u32x4*)(PC + off) = w;
            }
        if (fr == 0) {
            float* pp = PEND + (size_t)chunk * 1024 + ch; float* hp = HEND + (size_t)chunk * 1024 + ch;
            *(f32x4*)pp = (f32x4){Ac[0], Ac[1], Ac[2], Ac[3]}; *(f32x4*)(pp + 4) = (f32x4){Ac[4], Ac[5], Ac[6], Ac[7]};
            *(f32x4*)hp = (f32x4){Hc[0], Hc[1], Hc[2], Hc[3]}; *(f32x4*)(hp + 4) = (f32x4){Hc[4], Hc[5], Hc[6], Hc[7]};
        }
    }
};
struct EpiBf16 {
    static constexpr bool PERM = true, AFTER_DRAIN = false, AROWS = false, I8 = false;
    bf16_t* O; int ldc;
    __device__ __forceinline__ void operator()(const f32x4 (&acc)[2][2][4][2], const Unit& u, int, int, int, int) const {
        int t_ = threadIdx.x; asm volatile("" : "+v"(t_)); const int fr = t_ & 15, fq = (t_ >> 4) & 3, wc = (t_ >> 6) & 3, wr = t_ >> 8;
        const int row0 = u.pm * BM + wr * 64 + fr, col0 = u.pn * BM + wc * 32 + 8 * fq;
#pragma unroll
        for (int ai = 0; ai < 2; ++ai)
#pragma unroll
            for (int m = 0; m < 4; ++m) {
                bf16_t* rowp = O + (size_t)(row0 + ai * HALF + m * 16) * ldc + col0;
#pragma unroll
                for (int bj = 0; bj < 2; ++bj) {
                    const f32x4 v0 = acc[ai][bj][m][0], v1 = acc[ai][bj][m][1];
                    u32x4 w; w.x = pk2(v0[0], v0[1]); w.y = pk2(v0[2], v0[3]); w.z = pk2(v1[0], v1[1]); w.w = pk2(v1[2], v1[3]);
                    *(u32x4*)(rowp + bj * HALF) = w;
                }
            }
    }
};
struct EpiResid {
    static constexpr bool PERM = true, AFTER_DRAIN = false, AROWS = false, I8 = false;
    const bf16_t* X; bf16_t* Z; int ldc; float alpha; float* PART;
    __device__ __forceinline__ void operator()(const f32x4 (&acc)[2][2][4][2], const Unit& u, int, int, int, int) const {
        int t_ = threadIdx.x; asm volatile("" : "+v"(t_)); const int fr = t_ & 15, fq = (t_ >> 4) & 3, wc = (t_ >> 6) & 3, wr = t_ >> 8;
        const int row0 = u.pm * BM + wr * 64 + fr, col0 = u.pn * BM + wc * 32 + 8 * fq;
#pragma unroll
        for (int ai = 0; ai < 2; ++ai)
#pragma unroll
            for (int m = 0; m < 4; ++m) {
                const int row = row0 + ai * HALF + m * 16;
                const size_t off = (size_t)row * ldc + col0;
                float s1 = 0.f, s2 = 0.f;
#pragma unroll
                for (int bj = 0; bj < 2; ++bj) {
                    const u32x4 xw = *(const u32x4*)(X + off + bj * HALF);
                    const f32x4 x0 = (f32x4){bf_lo(xw.x), bf_hi(xw.x), bf_lo(xw.y), bf_hi(xw.y)}, x1 = (f32x4){bf_lo(xw.z), bf_hi(xw.z), bf_lo(xw.w), bf_hi(xw.w)};
                    const f32x4 z0 = x0 * alpha + acc[ai][bj][m][0], z1 = x1 * alpha + acc[ai][bj][m][1];
                    u32x4 w; w.x = pk2(z0[0], z0[1]); w.y = pk2(z0[2], z0[3]); w.z = pk2(z1[0], z1[1]); w.w = pk2(z1[2], z1[3]);
                    *(u32x4*)(Z + off + bj * HALF) = w;
#pragma unroll
                    for (int j = 0; j < 4; ++j) { s1 += z0[j] + z1[j]; s2 += z0[j] * z0[j] + z1[j] * z1[j]; }
                }
                s1 += __shfl_xor(s1, 16); s2 += __shfl_xor(s2, 16); s1 += __shfl_xor(s1, 32); s2 += __shfl_xor(s2, 32);
                if (fq == 0) *(f32x2*)(PART + ((size_t)row * 16 + u.pn * 4 + wc) * 2) = (f32x2){s1, s2};
            }
    }
};
struct EpiQ {
    static constexpr bool PERM = true, AFTER_DRAIN = false, AROWS = false, I8 = false;
    bf16_t* O; int ldc; const float* cq; const float* dq; const PG8_LAS float* tab; StaticOrder S;
    __device__ __forceinline__ void operator()(const f32x4 (&acc)[2][2][4][2], const Unit& u, int, int, int, int) const {
        int t_ = threadIdx.x; asm volatile("" : "+v"(t_)); const int fr = t_ & 15, fq = (t_ >> 4) & 3, wc = (t_ >> 6) & 3, wr = t_ >> 8;
        int ord = 0;
#pragma unroll
        for (int i = 1; i < 4; ++i) { Unit v; if (S.next(i, v) && v.pm == u.pm && v.pn == u.pn) ord = i; }
        const int rl0 = wr * 64 + fr, col0 = u.pn * BM + wc * 32 + 8 * fq;
        f32x4 cv[2][2], dv[2][2];
#pragma unroll
        for (int bj = 0; bj < 2; ++bj)
#pragma unroll
            for (int n = 0; n < 2; ++n) { cv[bj][n] = *(const f32x4*)(cq + col0 + bj * HALF + 4 * n); dv[bj][n] = *(const f32x4*)(dq + col0 + bj * HALF + 4 * n); }
#pragma unroll
        for (int ai = 0; ai < 2; ++ai)
#pragma unroll
            for (int m = 0; m < 4; ++m) {
                const int rl = rl0 + ai * HALF + m * 16;
                const float mean = tab[(ord * 256 + rl) * 2], rstd = tab[(ord * 256 + rl) * 2 + 1];
                bf16_t* rowp = O + (size_t)(u.pm * BM + rl) * ldc + col0;
#pragma unroll
                for (int bj = 0; bj < 2; ++bj) {
                    const f32x4 v0 = (acc[ai][bj][m][0] - cv[bj][0] * mean) * rstd + dv[bj][0], v1 = (acc[ai][bj][m][1] - cv[bj][1] * mean) * rstd + dv[bj][1];
                    u32x4 w; w.x = pk2(v0[0], v0[1]); w.y = pk2(v0[2], v0[3]); w.z = pk2(v1[0], v1[1]); w.w = pk2(v1[2], v1[3]);
                    *(u32x4*)(rowp + bj * HALF) = w;
                }
            }
    }
};
struct EpiBf16I8 {
    static constexpr bool PERM = true, AFTER_DRAIN = false, AROWS = false, I8 = true;
    bf16_t* O; int ldc; const float* sxr; const float* swc;
    __device__ __forceinline__ void operator()(const f32x4 (&acc)[2][2][4][2], const Unit& u, int, int, int, int) const {
        int t_ = threadIdx.x; asm volatile("" : "+v"(t_)); const int fr = t_ & 15, fq = (t_ >> 4) & 3, wc = (t_ >> 6) & 3, wr = t_ >> 8;
        const int row0 = u.pm * BM + wr * 64 + fr, col0 = u.pn * BM + wc * 32 + 8 * fq;
        const f32x4 w00 = *(const f32x4*)(swc + col0), w01 = *(const f32x4*)(swc + col0 + 4), w10 = *(const f32x4*)(swc + col0 + HALF), w11 = *(const f32x4*)(swc + col0 + HALF + 4);
#define EPI_I2F(v, w, s) ((f32x4){(float)__builtin_bit_cast(i32x4_, v)[0], (float)__builtin_bit_cast(i32x4_, v)[1], (float)__builtin_bit_cast(i32x4_, v)[2], (float)__builtin_bit_cast(i32x4_, v)[3]} * (w) * (s))
#pragma unroll
        for (int ai = 0; ai < 2; ++ai)
#pragma unroll
            for (int m = 0; m < 4; ++m) {
                const int row = row0 + ai * HALF + m * 16; const float sx = sxr[row];
                bf16_t* rowp = O + (size_t)row * ldc + col0;
                { const f32x4 v0 = EPI_I2F(acc[ai][0][m][0], w00, sx), v1 = EPI_I2F(acc[ai][0][m][1], w01, sx);
                  u32x4 w; w.x = pk2(v0[0], v0[1]); w.y = pk2(v0[2], v0[3]); w.z = pk2(v1[0], v1[1]); w.w = pk2(v1[2], v1[3]); *(u32x4*)rowp = w; }
                { const f32x4 v0 = EPI_I2F(acc[ai][1][m][0], w10, sx), v1 = EPI_I2F(acc[ai][1][m][1], w11, sx);
                  u32x4 w; w.x = pk2(v0[0], v0[1]); w.y = pk2(v0[2], v0[3]); w.z = pk2(v1[0], v1[1]); w.w = pk2(v1[2], v1[3]); *(u32x4*)(rowp + HALF) = w; }
            }
#undef EPI_I2F
    }
};
template <class Epi, class Sched, bool ALIGN_EPI = false, bool SP2 = false>
__device__ __forceinline__ void gemm_phase(PG8_LAS unsigned char* lds, const Gemm g, const Sched& S, const Epi& E) {
    int tid_ = threadIdx.x; asm volatile("" : "+v"(tid_)); const int tid = tid_, wid = __builtin_amdgcn_readfirstlane(tid >> 6), lane = tid & 63, wr = wid >> 2, wc = wid & 3, fr = lane & 15, fq = lane >> 4;
    const int K = g.K, nt = K / BK;
    unsigned voffA[2], voffB[2];
#pragma unroll
    for (int i = 0; i < 2; ++i) { int R, C; stage_rc(tid * 16 + i * 8192, R, C); const int Rb = Epi::PERM ? ((R & ~31) + perm32(R & 31)) : R;
        const int Ra = Epi::AROWS ? ((R >> 6) * 128 + (R & 63)) : R;
        voffA[i] = (unsigned)(Ra * g.lda + C) * 2u; voffB[i] = (unsigned)(Rb * g.ldb + C) * 2u; }
    const size_t kstep = (size_t)(BK * 2);
    const size_t hstepA = (size_t)(Epi::AROWS ? 64 : HALF) * g.lda * 2, hstepB = (size_t)HALF * g.ldb * 2;
    const size_t tstepA = (size_t)2 * HALF * g.lda * 2, tstepB = 2 * hstepB;
    const unsigned ldsw = (unsigned)wid * 1024u;
    const int aoff = lds_byte(wr * 64 + fr, fq * 8), boff = lds_byte(wc * 32 + fr, fq * 8);
#define PG8_SA(b, h) (((b) * 2 + (h)) * HTB)
#define PG8_SB(b, h) ((4 + (b) * 2 + (h)) * HTB)
#define PG8_STAGE(bufoff, gbase, voff) do { _Pragma("unroll") for (int _i = 0; _i < 2; ++_i) \
        __builtin_amdgcn_global_load_lds((const unsigned*)((const char*)(gbase) + (voff)[_i]), (PG8_LAS unsigned*)(lds + (bufoff) + ldsw + _i * 8192), 16, 0, 0); } while (0)
#define PG8_LDA(dst, b, h) do { _Pragma("unroll") for (int m = 0; m < 4; ++m) _Pragma("unroll") for (int k = 0; k < 2; ++k) dst[m][k] = *(const PG8_LAS bf16x8*)(lds + PG8_SA(b, h) + aoff + m * 2048 + k * 1024); } while (0)
#define PG8_LDB(dst, b, h) do { _Pragma("unroll") for (int n = 0; n < 2; ++n) _Pragma("unroll") for (int k = 0; k < 2; ++k) dst[n][k] = *(const PG8_LAS bf16x8*)(lds + PG8_SB(b, h) + boff + n * 2048 + k * 1024); } while (0)
#define PG8_MMA(ai, bj, At, Bt) do { __builtin_amdgcn_s_setprio(1); _Pragma("unroll") for (int m = 0; m < 4; ++m) _Pragma("unroll") for (int n = 0; n < 2; ++n) _Pragma("unroll") for (int k = 0; k < 2; ++k) \
        { if constexpr (Epi::I8) acc[ai][bj][m][n] = __builtin_bit_cast(f32x4, __builtin_amdgcn_mfma_i32_16x16x64_i8(__builtin_bit_cast(i32x4_, Bt[n][k]), __builtin_bit_cast(i32x4_, At[m][k]), __builtin_bit_cast(i32x4_, acc[ai][bj][m][n]), 0, 0, 0)); \
          else acc[ai][bj][m][n] = __builtin_amdgcn_mfma_f32_16x16x32_bf16(Bt[n][k], At[m][k], acc[ai][bj][m][n], 0, 0, 0); } __builtin_amdgcn_s_setprio(0); } while (0)
#define PG8_WAIT_V(n) asm volatile("s_waitcnt vmcnt(" #n ")" ::: "memory")
#define PG8_WAIT_L(n) asm volatile("s_waitcnt lgkmcnt(" #n ")" ::: "memory")
#define PG8_BAR __builtin_amdgcn_s_barrier()
#define PG8_SCHED __builtin_amdgcn_sched_barrier(0)
    Unit cur, nxt; int ui = 0;
    if (!S.next(0, cur)) return;
    f32x4 acc[2][2][4][2];
#pragma unroll
    for (int a = 0; a < 2; ++a)
#pragma unroll
        for (int b = 0; b < 2; ++b)
#pragma unroll
            for (int m = 0; m < 4; ++m)
#pragma unroll
                for (int n = 0; n < 2; ++n) acc[a][b][m][n] = (f32x4){0.f, 0.f, 0.f, 0.f};
    bf16x8 At[4][2], B0[2][2], B1[2][2];
    const char* cA = (const char*)g.A + (size_t)cur.pm * tstepA + (size_t)cur.pn * g.a_pn_bytes; const char* cB = (const char*)g.Bt + (size_t)cur.pn * tstepB;
    S.a_ready(cur);
    if constexpr (SP2) {
        PG8_STAGE(PG8_SB(0, 0), cB, voffB); PG8_STAGE(PG8_SB(0, 1), cB + hstepB, voffB); PG8_STAGE(PG8_SA(0, 0), cA, voffA); PG8_STAGE(PG8_SA(0, 1), cA + hstepA, voffA);
        if (wr == 1) PG8_BAR;
        PG8_WAIT_V(2); PG8_BAR;
        PG8_STAGE(PG8_SB(1, 0), cB + kstep, voffB); PG8_STAGE(PG8_SA(1, 0), cA + kstep, voffA); PG8_STAGE(PG8_SB(1, 1), cB + hstepB + kstep, voffB);
        PG8_WAIT_V(6); PG8_BAR;
    } else {
        PG8_STAGE(PG8_SB(0, 0), cB, voffB); PG8_STAGE(PG8_SA(0, 0), cA, voffA); PG8_STAGE(PG8_SB(0, 1), cB + hstepB, voffB); PG8_STAGE(PG8_SA(0, 1), cA + hstepA, voffA);
        if (wr == 1) PG8_BAR;
        PG8_WAIT_V(4); PG8_BAR;
        PG8_STAGE(PG8_SB(1, 0), cB + kstep, voffB); PG8_STAGE(PG8_SA(1, 0), cA + kstep, voffA); PG8_STAGE(PG8_SB(1, 1), cB + hstepB + kstep, voffB);
        PG8_WAIT_V(6); PG8_BAR;
    }
    for (;;) {
        const bool has_next = S.next(ui + 1, nxt);
        const char* nA = has_next ? (const char*)g.A + (size_t)nxt.pm * tstepA + (size_t)nxt.pn * g.a_pn_bytes : cA; const char* nB = has_next ? (const char*)g.Bt + (size_t)nxt.pn * tstepB : cB;
        for (int t = 0; t < nt; t += 2) {
            const bool last = (t == nt - 2);
            const char* a1 = cA + (size_t)(t + 1) * kstep;
            const char* a2 = last ? nA : cA + (size_t)(t + 2) * kstep; const char* b2 = last ? nB : cB + (size_t)(t + 2) * kstep;
            const char* a3 = a2 + kstep; const char* b3 = b2 + kstep;
            if (last && has_next) S.a_ready(nxt);
            if constexpr (SP2) {
            PG8_LDB(B0, 0, 0); PG8_LDB(B1, 0, 1); PG8_SCHED; PG8_LDA(At, 0, 0); PG8_STAGE(PG8_SA(1, 1), a1 + hstepA, voffA);
            PG8_WAIT_V(8); PG8_WAIT_L(0); PG8_BAR; PG8_MMA(0, 0, At, B0); PG8_MMA(0, 1, At, B1); PG8_BAR; PG8_SCHED;
            PG8_LDA(At, 0, 1); PG8_STAGE(PG8_SB(0, 0), b2, voffB); PG8_STAGE(PG8_SB(0, 1), b2 + hstepB, voffB); PG8_STAGE(PG8_SA(0, 0), a2, voffA);
            PG8_WAIT_V(8); PG8_WAIT_L(0); PG8_BAR; PG8_MMA(1, 0, At, B0); PG8_MMA(1, 1, At, B1); PG8_BAR; PG8_SCHED;
            PG8_LDB(B0, 1, 0); PG8_LDB(B1, 1, 1); PG8_SCHED; PG8_LDA(At, 1, 0); PG8_STAGE(PG8_SA(0, 1), a2 + hstepA, voffA);
            PG8_WAIT_V(8); PG8_WAIT_L(0); PG8_BAR; PG8_MMA(0, 0, At, B0); PG8_MMA(0, 1, At, B1); PG8_BAR; PG8_SCHED;
            PG8_LDA(At, 1, 1); PG8_STAGE(PG8_SB(1, 0), b3, voffB); PG8_STAGE(PG8_SB(1, 1), b3 + hstepB, voffB); PG8_STAGE(PG8_SA(1, 0), a3, voffA);
            PG8_WAIT_V(8); PG8_WAIT_L(0); PG8_BAR; PG8_MMA(1, 0, At, B0); PG8_MMA(1, 1, At, B1); PG8_BAR; PG8_SCHED;
            } else {
            PG8_LDB(B0, 0, 0); PG8_SCHED; PG8_LDA(At, 0, 0); PG8_STAGE(PG8_SA(1, 1), a1 + hstepA, voffA);
            PG8_WAIT_L(8); PG8_BAR; PG8_WAIT_L(0); PG8_MMA(0, 0, At, B0); PG8_BAR; PG8_SCHED;
            PG8_LDB(B1, 0, 1); PG8_STAGE(PG8_SB(0, 0), b2, voffB);
            PG8_BAR; PG8_WAIT_L(0); PG8_MMA(0, 1, At, B1); PG8_BAR;
            PG8_LDA(At, 0, 1); PG8_STAGE(PG8_SA(0, 0), a2, voffA);
            PG8_BAR; PG8_WAIT_L(0); PG8_MMA(1, 0, At, B0); PG8_BAR; PG8_SCHED;
            PG8_STAGE(PG8_SB(0, 1), b2 + hstepB, voffB);
            PG8_WAIT_V(6); PG8_BAR; PG8_MMA(1, 1, At, B1); PG8_BAR;
            PG8_LDB(B0, 1, 0); PG8_SCHED; PG8_LDA(At, 1, 0); PG8_STAGE(PG8_SA(0, 1), a2 + hstepA, voffA);
            PG8_WAIT_L(8); PG8_BAR; PG8_WAIT_L(0); PG8_MMA(0, 0, At, B0); PG8_BAR; PG8_SCHED;
            PG8_LDB(B1, 1, 1); PG8_STAGE(PG8_SB(1, 0), b3, voffB);
            PG8_BAR; PG8_WAIT_L(0); PG8_MMA(0, 1, At, B1); PG8_BAR;
            PG8_LDA(At, 1, 1); PG8_STAGE(PG8_SA(1, 0), a3, voffA);
            PG8_BAR; PG8_WAIT_L(0); PG8_MMA(1, 0, At, B0); PG8_BAR; PG8_SCHED;
            PG8_STAGE(PG8_SB(1, 1), b3 + hstepB, voffB);
            PG8_WAIT_V(6); PG8_BAR; PG8_MMA(1, 1, At, B1); PG8_BAR;
            }
        }
        if constexpr (ALIGN_EPI) { if (wr == 0) PG8_BAR; }
        if constexpr (!Epi::AFTER_DRAIN) { E(acc, cur, wr, wc, fr, fq); S.done(cur); }
        if (!has_next) break;
#pragma unroll
        for (int a = 0; a < 2; ++a)
#pragma unroll
            for (int b = 0; b < 2; ++b)
#pragma unroll
                for (int m = 0; m < 4; ++m)
#pragma unroll
                    for (int n = 0; n < 2; ++n) acc[a][b][m][n] = (f32x4){0.f, 0.f, 0.f, 0.f};
        cur = nxt; cA = nA; cB = nB; ++ui;
        if constexpr (ALIGN_EPI) { if (wr == 1) PG8_BAR; }
    }
    PG8_WAIT_V(0);
    if constexpr (!ALIGN_EPI) { if (wr == 0) PG8_BAR; }
    PG8_BAR;
    if constexpr (Epi::AFTER_DRAIN) { E.fused(acc, cur, wr, wc, fr, fq, lds, wid, lane); S.done(cur); }
#undef PG8_SA
#undef PG8_SB
#undef PG8_STAGE
#undef PG8_LDA
#undef PG8_LDB
#undef PG8_MMA
#undef PG8_WAIT_V
#undef PG8_WAIT_L
#undef PG8_BAR
#undef PG8_SCHED
}
}

__device__ __forceinline__ void cvt_f32_bf16(const float* __restrict__ src, bf16* dst, size_t n8, size_t gtid, size_t gthreads) {
    for (size_t i = gtid; i < n8; i += gthreads) {
        const f32x4 a = ((const f32x4*)src)[2 * i], b = ((const f32x4*)src)[2 * i + 1];
        u32x4 o; o.x = pk2(a.x, a.y); o.y = pk2(a.z, a.w); o.z = pk2(b.x, b.y); o.w = pk2(b.z, b.w);
        ((u32x4*)dst)[i] = o;
    }
}
__device__ __forceinline__ void transpose_tile(const float* __restrict__ W, int ldw, bf16* WT, int ldt, int k0, int n0, int nd0, LAS float* s, int tid, float sc = 1.0f) {
    {
        const int kk = tid >> 3, c8 = (tid & 7) * 8;
        const float* p = W + (size_t)(k0 + kk) * ldw + n0 + c8;
        const f32x4 a = *(const f32x4*)p, b = *(const f32x4*)(p + 4);
        LAS float* q = s + kk * 65 + c8;
        q[0] = a.x; q[1] = a.y; q[2] = a.z; q[3] = a.w; q[4] = b.x; q[5] = b.y; q[6] = b.z; q[7] = b.w;
    }
    __syncthreads();
    {
        const int nn = tid >> 3, k8 = (tid & 7) * 8;
        const LAS float* q = s + k8 * 65 + nn;
        u32x4 o; o.x = pk2(q[0] * sc, q[65] * sc); o.y = pk2(q[2 * 65] * sc, q[3 * 65] * sc); o.z = pk2(q[4 * 65] * sc, q[5 * 65] * sc); o.w = pk2(q[6 * 65] * sc, q[7 * 65] * sc);
        *(u32x4*)(WT + (size_t)(nd0 + nn) * ldt + k0 + k8) = o;
    }
    __syncthreads();
}

template <int NR> __device__ __forceinline__ void quant_rows_i8(const float (&v)[NR][16], unsigned char* const (&dst)[NR], float* const (&scale_out)[NR], int lane) {
    float m[NR];
#pragma unroll
    for (int r = 0; r < NR; ++r) { m[r] = 0.f;
#pragma unroll
        for (int j = 0; j < 16; ++j) m[r] = fmaxf(m[r], fabsf(v[r][j])); }
#pragma unroll
    for (int o = 32; o >= 1; o >>= 1) {
#pragma unroll
        for (int r = 0; r < NR; ++r) m[r] = fmaxf(m[r], __shfl_xor(m[r], o));
    }
#pragma unroll
    for (int r = 0; r < NR; ++r) {
        const float scale = (m[r] > 0.f) ? m[r] * (1.0f / 127.0f) : 1.0f, inv = 1.0f / scale;
        u32x4 q;
#pragma unroll
        for (int w = 0; w < 4; ++w) {
            unsigned pk = 0;
#pragma unroll
            for (int k = 0; k < 4; ++k) { int qi = (int)rintf(v[r][4 * w + k] * inv); qi = qi < -127 ? -127 : (qi > 127 ? 127 : qi); pk |= (unsigned)(qi & 0xff) << (8 * k); }
            q[w] = pk;
        }
        *(u32x4*)(dst[r] + lane * 16) = q;
        if (lane == 0) *scale_out[r] = scale;
    }
}
struct Ctx {
    const float* in[23];
    float* out;
    unsigned char* ws;
};

__device__ __forceinline__ void quant_peer_tables(const Ctx& c, int gw, int NW, int lane) {
    unsigned char* ws = c.ws;
    for (int rw4 = gw * 4; rw4 < 2 * NEXP; rw4 += NW * 4) {
        const int tab = rw4 >= NEXP, row4 = rw4 - tab * NEXP;
        float v[4][16]; unsigned char* dst[4]; float* sc[4];
#pragma unroll
        for (int r = 0; r < 4; ++r) {
            const float* src = (tab ? c.in[20] : c.in[19]) + (size_t)(row4 + r) * 1024 + lane * 16;
            const f32x4 a0 = *(const f32x4*)src, a1 = *(const f32x4*)(src + 4), a2 = *(const f32x4*)(src + 8), a3 = *(const f32x4*)(src + 12);
            v[r][0] = a0.x; v[r][1] = a0.y; v[r][2] = a0.z; v[r][3] = a0.w; v[r][4] = a1.x; v[r][5] = a1.y; v[r][6] = a1.z; v[r][7] = a1.w;
            v[r][8] = a2.x; v[r][9] = a2.y; v[r][10] = a2.z; v[r][11] = a2.w; v[r][12] = a3.x; v[r][13] = a3.y; v[r][14] = a3.z; v[r][15] = a3.w;
            dst[r] = ws + (tab ? WS_VQ : WS_UQ) + (size_t)(row4 + r) * 1024; sc[r] = (float*)(ws + (tab ? WS_VSC : WS_USC)) + row4 + r;
        }
        quant_rows_i8<4>(v, dst, sc, lane);
        if (tab) {
#pragma unroll
            for (int r = 0; r < 4; ++r) { u32x4* q = (u32x4*)(dst[r] + lane * 16); u32x4 w = *q; w ^= (u32x4){0x80808080u, 0x80808080u, 0x80808080u, 0x80808080u}; *q = w; }
        }
    }
}

__device__ __forceinline__ void phase0(const Ctx& c, LAS unsigned char* lds) {
    int tid_ = threadIdx.x; asm volatile("" : "+v"(tid_)); const int tid = tid_;
    const size_t gtid = (size_t)blockIdx.x * NTHR + tid, gthreads = (size_t)gridDim.x * NTHR;
    unsigned char* ws = c.ws;
    cvt_f32_bf16(c.in[18], (bf16*)(ws + WS_KEYS), (size_t)8 * 2 * 128 * 128 / 8, gtid, gthreads);
    {
        const int lane = tid & 63, gw = blockIdx.x * 8 + (tid >> 6), NW = gridDim.x * 8;
        for (int row4 = gw * 4; row4 < T; row4 += NW * 4) {
            float v[4][16]; unsigned char* dst[4]; float* sc[4];
#pragma unroll
            for (int r = 0; r < 4; ++r) {
                const float* src = c.in[0] + (size_t)(row4 + r) * 1024 + lane * 16;
                const f32x4 a0 = *(const f32x4*)src, a1 = *(const f32x4*)(src + 4), a2 = *(const f32x4*)(src + 8), a3 = *(const f32x4*)(src + 12);
                v[r][0] = a0.x; v[r][1] = a0.y; v[r][2] = a0.z; v[r][3] = a0.w; v[r][4] = a1.x; v[r][5] = a1.y; v[r][6] = a1.z; v[r][7] = a1.w;
                v[r][8] = a2.x; v[r][9] = a2.y; v[r][10] = a2.z; v[r][11] = a2.w; v[r][12] = a3.x; v[r][13] = a3.y; v[r][14] = a3.z; v[r][15] = a3.w;
                dst[r] = ws + WS_XQ8 + (size_t)(row4 + r) * 1024; sc[r] = (float*)(ws + WS_SXR) + row4 + r;
            }
            quant_rows_i8<4>(v, dst, sc, lane);
#pragma unroll
            for (int r = 0; r < 4; ++r) {
                u32x4 b0, b1;
#pragma unroll
                for (int j = 0; j < 4; ++j) { b0[j] = pk2(v[r][2 * j], v[r][2 * j + 1]); b1[j] = pk2(v[r][8 + 2 * j], v[r][8 + 2 * j + 1]); }
                bf16* xb = (bf16*)(ws + WS_XB) + (size_t)(row4 + r) * 1024 + lane * 16;
                *(u32x4*)xb = b0; *(u32x4*)(xb + 8) = b1;
            }
        }
    }
    {
        const float* wsrc = c.in[12]; bf16* wt = (bf16*)(ws + WS_WTRIL);
        for (size_t i = gtid; i < (size_t)8 * 128 * 128 / 8; i += gthreads) {
            const int e = (int)i * 8, s0 = e & 127, t = (e >> 7) & 127;
            const f32x4 a = ((const f32x4*)wsrc)[2 * i], b = ((const f32x4*)wsrc)[2 * i + 1];
            float v[8] = {a.x, a.y, a.z, a.w, b.x, b.y, b.z, b.w};
#pragma unroll
            for (int j = 0; j < 8; ++j) v[j] = (s0 + j <= t) ? v[j] : 0.f;
            u32x4 o; o.x = pk2(v[0], v[1]); o.y = pk2(v[2], v[3]); o.z = pk2(v[4], v[5]); o.w = pk2(v[6], v[7]);
            ((u32x4*)wt)[i] = o;
        }
    }
    if (gtid < 1024) { const float lam = c.in[9][gtid]; ((float*)(ws + WS_SPT))[gtid] = 8.0f * NLOG2E * log1pf(expf(-lam));
                       ((float*)(ws + WS_BAS))[gtid] = NLOG2E * c.in[6][gtid]; ((float*)(ws + WS_BXS))[gtid] = NLOG2E * c.in[8][gtid]; }
    if (gtid < 2048) ((float*)(ws + WS_BGS))[gtid] = NLOG2E * c.in[2][gtid];
    {
        LAS float* s = (LAS float*)lds;
        constexpr int N_IN = 16 * 96, N_OUT = 16 * 16, N_Q = 16 * 32, N_G = 64, N_ALL = N_IN + N_OUT + N_Q + N_G;
        for (int it = blockIdx.x; it < N_ALL; it += gridDim.x) {
            int r = it;
            if (r < N_IN) {
                const int n0 = (r % 96) * 64, sec = n0 >> 10, kg = (n0 & 1023) >> 7, j0 = n0 & 127;
                const int ty = (sec == 0 || sec == 3) ? 0 : ((sec == 1 || sec == 4) ? 1 : 2), half = sec >= 3;
                transpose_tile(c.in[1], DIN, (bf16*)(ws + WS_WIN), 1024, (r / 96) * 64, n0, (3 * kg + ty) * 256 + half * 128 + j0, s, tid, sec >= 4 ? NLOG2E : 1.0f); continue;
            }
            r -= N_IN;
            if (r < N_OUT) { transpose_tile(c.in[14], 1024, (bf16*)(ws + WS_WOUT), 1024, (r / 16) * 64, (r % 16) * 64, (r % 16) * 64, s, tid); continue; }
            r -= N_OUT;
            if (r < N_Q) {
                const int k0 = (r / 32) * 64, n0 = (r % 32) * 64;
                {
                    const int kk = tid >> 3, c8 = (tid & 7) * 8;
                    const float* p = c.in[17] + (size_t)(k0 + kk) * 2048 + n0 + c8;
                    const f32x4 a = *(const f32x4*)p, b = *(const f32x4*)(p + 4);
                    LAS float* q = s + kk * 65 + c8;
                    q[0] = a.x; q[1] = a.y; q[2] = a.z; q[3] = a.w; q[4] = b.x; q[5] = b.y; q[6] = b.z; q[7] = b.w;
                }
                __syncthreads();
                if (tid < 64) {
                    float pc = 0.f, pd = 0.f;
                    for (int kk = 0; kk < 64; ++kk) { const float w = s[kk * 65 + tid]; pc += c.in[15][k0 + kk] * w; pd += c.in[16][k0 + kk] * w; }
                    float* part = (float*)(ws + WS_PARTCD) + (size_t)(r / 32) * 4096;
                    part[n0 + tid] = pc; part[2048 + n0 + tid] = pd;
                }
                {
                    const int nn = tid >> 3, k8 = (tid & 7) * 8;
                    const LAS float* q = s + k8 * 65 + nn;
                    const float* g = c.in[15] + k0 + k8;
                    u32x4 o; o.x = pk2(q[0] * g[0], q[65] * g[1]); o.y = pk2(q[2 * 65] * g[2], q[3 * 65] * g[3]); o.z = pk2(q[4 * 65] * g[4], q[5 * 65] * g[5]); o.w = pk2(q[6 * 65] * g[6], q[7 * 65] * g[7]);
                    *(u32x4*)((bf16*)(ws + WS_WQ) + (size_t)(n0 + nn) * 1024 + k0 + k8) = o;
                }
                __syncthreads();
                continue;
            }
            r -= N_Q;
            {
                const int h = r >> 3, g = (r >> 2) & 1, kb = (r >> 1) & 1, nb = r & 1;
                const float* W = (g ? c.in[7] : c.in[5]) + (size_t)h * 128 * 128;
                transpose_tile(W, 128, (bf16*)(ws + WS_WAX) + (size_t)h * 256 * 128 + (size_t)g * 128 * 128, 128, kb * 64, nb * 64, nb * 64, s, tid, NLOG2E);
            }
        }
    }
}

__device__ __forceinline__ void phase0b(const Ctx& c) {
    int tid_ = threadIdx.x; asm volatile("" : "+v"(tid_)); const int tid = tid_, lane = tid & 63, wid = tid >> 6;
    unsigned char* ws = c.ws;
    const bf16* W = (const bf16*)(ws + WS_WIN);
    {
        const int gt = blockIdx.x * NTHR + tid;
        if (gt < 4096) {
            const float* part = (const float*)(ws + WS_PARTCD) + gt;
            float sacc = 0.f;
#pragma unroll
            for (int kb = 0; kb < 16; ++kb) sacc += part[(size_t)kb * 4096];
            ((float*)(ws + WS_CQ))[gt] = sacc;
        }
    }
    for (int row4 = (blockIdx.x * 8 + wid) * 4; row4 < DIN + (Q_I8 ? 2048 : 0); row4 += gridDim.x * 8 * 4) {
        float v[4][16]; unsigned char* dst[4]; float* sc[4];
#pragma unroll
        for (int r = 0; r < 4; ++r) {
            const int rw = row4 + r; const bool isq = rw >= DIN;
            const bf16* src = (isq ? (const bf16*)(ws + WS_WQ) + (size_t)(rw - DIN) * 1024 : W + (size_t)rw * 1024) + lane * 16;
            const u32x4 a = *(const u32x4*)src, b = *(const u32x4*)(src + 8);
#pragma unroll
            for (int j = 0; j < 4; ++j) { v[r][2 * j] = bf_lo(a[j]); v[r][2 * j + 1] = bf_hi(a[j]); v[r][8 + 2 * j] = bf_lo(b[j]); v[r][8 + 2 * j + 1] = bf_hi(b[j]); }
            dst[r] = isq ? ws + WS_WQQ8 + (size_t)(rw - DIN) * 1024 : ws + WS_WQ8 + (size_t)rw * 1024; sc[r] = isq ? (float*)(ws + WS_SWQ) + (rw - DIN) : (float*)(ws + WS_SWC) + rw;
        }
        quant_rows_i8<4>(v, dst, sc, lane);
    }
}

__device__ __forceinline__ void phase2a(const Ctx& c, const pg8::StaticOrder& S) {
    int tid_ = threadIdx.x; asm volatile("" : "+v"(tid_)); const int tid = tid_, lane = tid & 63, wid = tid >> 6;
    unsigned char* ws = c.ws;
    const bf16* P4 = (const bf16*)(ws + WS_P4); bf16* XC = (bf16*)c.out; float* STATS = (float*)(ws + WS_STATS);
    const float* conv_w = c.in[3]; const float* conv_b = c.in[4];
    for (int u0 = 0; ; u0 += 4) {
        pg8::Unit uu; bool any = false;
        { pg8::Unit tmp; any = S.next(u0, tmp); }
        if (!any) break;
        if (!S.next(u0 + (tid >> 7), uu)) continue;
        const int cg = tid & 15, run = uu.pm * 8 + ((tid & 127) >> 4), ch = uu.pn * 128 + cg * 8;
        float w[4][8], bias[8];
#pragma unroll
        for (int k = 0; k < 4; ++k) { const f32x4 a = *(const f32x4*)(conv_w + k * 1024 + ch), b = *(const f32x4*)(conv_w + k * 1024 + ch + 4);
            w[k][0] = a.x; w[k][1] = a.y; w[k][2] = a.z; w[k][3] = a.w; w[k][4] = b.x; w[k][5] = b.y; w[k][6] = b.z; w[k][7] = b.w; }
        { const f32x4 a = *(const f32x4*)(conv_b + ch), b = *(const f32x4*)(conv_b + ch + 4);
          bias[0] = a.x; bias[1] = a.y; bias[2] = a.z; bias[3] = a.w; bias[4] = b.x; bias[5] = b.y; bias[6] = b.z; bias[7] = b.w; }
        {
            const int t0 = run * 32; const bool first = (t0 & (SEQ - 1)) == 0;
            const bf16* src = P4 + (size_t)t0 * 4096 + ch;
            u32x4 x0 = (u32x4){0u, 0u, 0u, 0u}, x1 = x0, x2 = x0;
            if (!first) { x0 = *(const u32x4*)(src - 3 * 4096); x1 = *(const u32x4*)(src - 2 * 4096); x2 = *(const u32x4*)(src - 4096); }
#pragma unroll 8
            for (int t = 0; t < 32; ++t) {
                const u32x4 x3 = *(const u32x4*)(src + (size_t)t * 4096);
                float o[8];
#pragma unroll
                for (int j = 0; j < 8; ++j) {
                    const float v0 = (j & 1) ? bf_hi(x0[j >> 1]) : bf_lo(x0[j >> 1]), v1 = (j & 1) ? bf_hi(x1[j >> 1]) : bf_lo(x1[j >> 1]);
                    const float v2 = (j & 1) ? bf_hi(x2[j >> 1]) : bf_lo(x2[j >> 1]), v3 = (j & 1) ? bf_hi(x3[j >> 1]) : bf_lo(x3[j >> 1]);
                    o[j] = bias[j] + w[0][j] * v0 + w[1][j] * v1 + w[2][j] * v2 + w[3][j] * v3;
                }
                u32x4 pk; pk.x = pk2(o[0], o[1]); pk.y = pk2(o[2], o[3]); pk.z = pk2(o[4], o[5]); pk.w = pk2(o[6], o[7]);
                *(u32x4*)(XC + (size_t)(t0 + t) * 1024 + ch) = pk;
                x0 = x1; x1 = x2; x2 = x3;
            }
        }
    }
    for (int row4 = (blockIdx.x * 8 + wid) * 4; row4 < T; row4 += gridDim.x * 8 * 4) {
        u32x4 a[4], b[4];
#pragma unroll
        for (int r = 0; r < 4; ++r) { const bf16* p = P4 + (size_t)(row4 + r) * 4096 + 3072 + lane * 16; a[r] = *(const u32x4*)p; b[r] = *(const u32x4*)(p + 8); }
        float mean[4], q[4];
#pragma unroll
        for (int r = 0; r < 4; ++r) {
            float s = 0.f;
#pragma unroll
            for (int j = 0; j < 4; ++j) s += (bf_lo(a[r][j]) + bf_hi(a[r][j])) + (bf_lo(b[r][j]) + bf_hi(b[r][j]));
            mean[r] = s;
        }
#pragma unroll
        for (int o = 32; o >= 1; o >>= 1) {
#pragma unroll
            for (int r = 0; r < 4; ++r) mean[r] += __shfl_xor(mean[r], o);
        }
#pragma unroll
        for (int r = 0; r < 4; ++r) {
            mean[r] *= (1.0f / 1024.0f);
            float s = 0.f;
#pragma unroll
            for (int j = 0; j < 4; ++j) {
                const float d0 = bf_lo(a[r][j]) - mean[r], d1 = bf_hi(a[r][j]) - mean[r], d2 = bf_lo(b[r][j]) - mean[r], d3 = bf_hi(b[r][j]) - mean[r];
                s += (d0 * d0 + d1 * d1) + (d2 * d2 + d3 * d3);
            }
            q[r] = s;
        }
#pragma unroll
        for (int o = 32; o >= 1; o >>= 1) {
#pragma unroll
            for (int r = 0; r < 4; ++r) q[r] += __shfl_xor(q[r], o);
        }
        if (lane < 4) {
            const float mm = lane == 0 ? mean[0] : lane == 1 ? mean[1] : lane == 2 ? mean[2] : mean[3];
            const float qq = lane == 0 ? q[0] : lane == 1 ? q[1] : lane == 2 ? q[2] : q[3];
            *(f32x2*)(STATS + (size_t)(row4 + lane) * 2) = (f32x2){mm, rsqrtf(qq * (1.0f / 1024.0f) + LN_EPS)};
        }
    }
}

typedef short s16x4 __attribute__((ext_vector_type(4)));
struct P2cRegs { u32x4 v[4]; f32x2 st[4]; };
__device__ __forceinline__ void p2c_load_v(P2cRegs& R, const bf16* P4, const float* STATS, int tile, int h, int tid) {
    const int piece = tid & 15, rowb = tid >> 4;
#pragma unroll
    for (int j = 0; j < 4; ++j) {
        const size_t row = (size_t)(tile * CHUNK + rowb + 32 * j);
        R.v[j] = *(const u32x4*)(P4 + row * 4096 + 3072 + h * 128 + piece * 8);
        R.st[j] = *(const f32x2*)(STATS + row * 2);
    }
}
__device__ __forceinline__ void phase2c(const Ctx& c, LAS unsigned char* lds, const int outcol = 2048) {
    int tid_ = threadIdx.x; asm volatile("" : "+v"(tid_)); const int tid = tid_, lane = tid & 63, wid = __builtin_amdgcn_readfirstlane(tid >> 6), fr = lane & 15, fq = lane >> 4, wr = wid >> 1, wc = wid & 1;
    unsigned char* ws = c.ws;
    bf16* P4 = (bf16*)(ws + WS_P4); const float* STATS = (const float*)(ws + WS_STATS);
    const bf16* HL = (const bf16*)(ws + WS_HL); const bf16* PC = (const bf16*)((const unsigned char*)c.out + OUT_PC);
    const float* PEND = (const float*)(ws + WS_PEND); const float* HEND = (const float*)(ws + WS_HEND);
    LAS float* carry = (LAS float*)(lds + 65536);
    const bf16* WTRIL = (const bf16*)(ws + WS_WTRIL);
    const float* ln_g = c.in[10]; const float* ln_b = c.in[11]; const float* gm_bs = c.in[13];
    const int h = blockIdx.x & 7;
    bf16x8 wf[2][4];
#pragma unroll
    for (int m = 0; m < 2; ++m)
#pragma unroll
        for (int ks = 0; ks < 4; ++ks) wf[m][ks] = *(const bf16x8*)(WTRIL + (size_t)h * 128 * 128 + (32 * wr + 16 * m + fr) * 128 + ks * 32 + fq * 8);
    const int piece = tid & 15, rowb = tid >> 4;
    float lg[8], lb[8];
    { const f32x4 g0 = *(const f32x4*)(ln_g + h * 128 + piece * 8), g1 = *(const f32x4*)(ln_g + h * 128 + piece * 8 + 4), b0 = *(const f32x4*)(ln_b + h * 128 + piece * 8), b1 = *(const f32x4*)(ln_b + h * 128 + piece * 8 + 4);
#pragma unroll
      for (int j = 0; j < 4; ++j) { lg[j] = g0[j]; lg[4 + j] = g1[j]; lb[j] = b0[j]; lb[4 + j] = b1[j]; } }
    const int wr_off = rowb * 256 + ((piece ^ ((rowb & 3) << 2)) << 4);
    const bool wr_swap = ((rowb >> 3) & 1) != 0;
    const int q_ = fr >> 2, p_ = fr & 3;
    int rd_off[2][2];
#pragma unroll
    for (int n2 = 0; n2 < 2; ++n2)
#pragma unroll
        for (int np = 0; np < 2; ++np) rd_off[n2][np] = (fq * 8 + q_) * 256 + (((8 * wc + 4 * n2 + p_) ^ (q_ << 2)) << 4) + ((np ^ (fq & 1)) << 3);
    const int nblk_h = gridDim.x >> 3;
    const int tile0 = blockIdx.x >> 3;
    P2cRegs RA, RB;
    if (tile0 < NTILE) p2c_load_v(RA, P4, STATS, tile0, h, tid);
    if (tile0 + nblk_h < NTILE) p2c_load_v(RB, P4, STATS, tile0 + nblk_h, h, tid);
#define P2C_UNIT(R, tile, par) do { \
        const int t0 = (tile) * CHUNK; \
        LAS unsigned char* V = lds + (par) * 32768; \
        _Pragma("unroll") for (int j = 0; j < 4; ++j) { \
            const float mean = R.st[j].x, rstd = R.st[j].y; \
            u32x4 w; \
            _Pragma("unroll") for (int e = 0; e < 4; ++e) w[e] = pk2((bf_lo(R.v[j][e]) - mean) * rstd * lg[2 * e] + lb[2 * e], (bf_hi(R.v[j][e]) - mean) * rstd * lg[2 * e + 1] + lb[2 * e + 1]); \
            if (wr_swap) w = (u32x4){w.z, w.w, w.x, w.y}; \
            *(LAS u32x4*)(V + wr_off + j * 32 * 256) = w; } \
        if (tid < 128) {                                        \
            const int cidx_ = (tile) & (NCHUNK - 1), tb_ = (tile) - cidx_; float hin_ = 0.f; \
            _Pragma("unroll") for (int cc = 0; cc < NCHUNK - 1; ++cc) { \
                const bool on_ = cc < cidx_; const int tl_ = on_ ? tb_ + cc : tb_; \
                const float p_ = PEND[(size_t)tl_ * 1024 + h * 128 + tid], q_ = HEND[(size_t)tl_ * 1024 + h * 128 + tid]; \
                hin_ = on_ ? p_ * hin_ + q_ : hin_; } \
            carry[(par) * 128 + tid] = hin_; } \
        __syncthreads(); \
        if ((tile) + 2 * nblk_h < NTILE) p2c_load_v(R, P4, STATS, (tile) + 2 * nblk_h, h, tid); \
        u32x4 hlv[2][2], pcv[2][2], gvv[2][2], ugv[2][2]; \
        _Pragma("unroll") for (int m = 0; m < 2; ++m) _Pragma("unroll") for (int n2 = 0; n2 < 2; ++n2) { \
            const size_t row_ = (size_t)(t0 + 32 * wr + 16 * m + fr); const int col_ = h * 128 + 64 * wc + 32 * n2 + 8 * fq; \
            hlv[m][n2] = *(const u32x4*)(HL + row_ * 1024 + col_); pcv[m][n2] = *(const u32x4*)(PC + row_ * 1024 + col_); gvv[m][n2] = *(const u32x4*)(P4 + row_ * 4096 + 1024 + col_); ugv[m][n2] = *(const u32x4*)(P4 + row_ * 4096 + 2048 + col_); } \
        f32x4 acc[2][4]; \
        _Pragma("unroll") for (int m = 0; m < 2; ++m) _Pragma("unroll") for (int n = 0; n < 4; ++n) acc[m][n] = (f32x4){0.f, 0.f, 0.f, 0.f}; \
        _Pragma("unroll") for (int ks = 0; ks < 4; ++ks) { \
            if (ks <= wr) { \
                bf16x8 b[4]; \
                _Pragma("unroll") for (int n = 0; n < 4; ++n) { \
                    const s16x4 lo = __builtin_amdgcn_ds_read_tr16_b64_v4i16((LAS s16x4*)(V + rd_off[n >> 1][n & 1] + ks * 32 * 256)); \
                    const s16x4 hi = __builtin_amdgcn_ds_read_tr16_b64_v4i16((LAS s16x4*)(V + rd_off[n >> 1][n & 1] + ks * 32 * 256 + 4 * 256)); \
                    b[n] = __builtin_shufflevector(lo, hi, 0, 1, 2, 3, 4, 5, 6, 7); } \
                _Pragma("unroll") for (int m = 0; m < 2; ++m) _Pragma("unroll") for (int n = 0; n < 4; ++n) acc[m][n] = __builtin_amdgcn_mfma_f32_16x16x32_bf16(b[n], wf[m][ks], acc[m][n], 0, 0, 0); } } \
        _Pragma("unroll") for (int m = 0; m < 2; ++m) { \
            const int tl = 32 * wr + 16 * m + fr; \
            const float bsv = gm_bs[h * 128 + tl]; \
            _Pragma("unroll") for (int n2 = 0; n2 < 2; ++n2) { \
                const f32x4 m0 = acc[m][2 * n2] + bsv, m1 = acc[m][2 * n2 + 1] + bsv; \
                const u32x4 ug = ugv[m][n2], hl_ = hlv[m][n2], pc_ = pcv[m][n2], g_ = gvv[m][n2]; \
                const LAS float* cp_ = carry + (par) * 128 + 64 * wc + 32 * n2 + 8 * fq; \
                const f32x4 h0_ = *(const LAS f32x4*)cp_, h1_ = *(const LAS f32x4*)(cp_ + 4); \
                u32x4 o;                                             \
                o.x = pk2(bf_lo(g_.x) * (bf_lo(hl_.x) + bf_lo(pc_.x) * h0_[0]) + bf_lo(ug.x) * m0[0], bf_hi(g_.x) * (bf_hi(hl_.x) + bf_hi(pc_.x) * h0_[1]) + bf_hi(ug.x) * m0[1]); \
                o.y = pk2(bf_lo(g_.y) * (bf_lo(hl_.y) + bf_lo(pc_.y) * h0_[2]) + bf_lo(ug.y) * m0[2], bf_hi(g_.y) * (bf_hi(hl_.y) + bf_hi(pc_.y) * h0_[3]) + bf_hi(ug.y) * m0[3]); \
                o.z = pk2(bf_lo(g_.z) * (bf_lo(hl_.z) + bf_lo(pc_.z) * h1_[0]) + bf_lo(ug.z) * m1[0], bf_hi(g_.z) * (bf_hi(hl_.z) + bf_hi(pc_.z) * h1_[1]) + bf_hi(ug.z) * m1[1]); \
                o.w = pk2(bf_lo(g_.w) * (bf_lo(hl_.w) + bf_lo(pc_.w) * h1_[2]) + bf_lo(ug.w) * m1[2], bf_hi(g_.w) * (bf_hi(hl_.w) + bf_hi(pc_.w) * h1_[3]) + bf_hi(ug.w) * m1[3]); \
                *(u32x4*)(P4 + (size_t)(t0 + tl) * 4096 + outcol + h * 128 + 64 * wc + 32 * n2 + 8 * fq) = o; } } \
    } while (0)
    for (int tile = tile0; tile < NTILE; tile += 2 * nblk_h) {
        P2C_UNIT(RA, tile, 0);
        if (tile + nblk_h < NTILE) P2C_UNIT(RB, tile + nblk_h, 1);
    }
#undef P2C_UNIT
}


__device__ __forceinline__ int f2key(float f) { const int b = __float_as_int(f); return b ^ ((b >> 31) & 0x7fffffff); }
__device__ __forceinline__ float key2f(int k) { return __int_as_float(k ^ ((k >> 31) & 0x7fffffff)); }
#define CE_DESC(a, b) do { const int _mx = max((a), (b)), _mn = min((a), (b)); (a) = _mx; (b) = _mn; } while (0)

template <int OFF, int N> __device__ __forceinline__ void sort16_desc(int (&v)[N]) {
#pragma unroll
    for (int k = 2; k <= 16; k <<= 1) {
#pragma unroll
        for (int j = k >> 1; j > 0; j >>= 1) {
#pragma unroll
            for (int i = 0; i < 16; ++i) {
                const int l = i ^ j;
                if (l > i) { if ((i & k) == 0) CE_DESC(v[OFF + i], v[OFF + l]); else CE_DESC(v[OFF + l], v[OFF + i]); }
            }
        }
    }
}
template <int OA, int OB, int N> __device__ __forceinline__ void merge16_desc(int (&v)[N]) {
#pragma unroll
    for (int i = 0; i < 16; ++i) v[OA + i] = max(v[OA + i], v[OB + 15 - i]);
#pragma unroll
    for (int j = 8; j > 0; j >>= 1) {
#pragma unroll
        for (int i = 0; i < 16; ++i) { const int l = i ^ j; if (l > i) CE_DESC(v[OA + i], v[OA + l]); }
    }
}
__device__ __forceinline__ void top16_of_64(int (&v)[64]) {
    sort16_desc<0>(v); sort16_desc<16>(v); sort16_desc<32>(v); sort16_desc<48>(v);
    merge16_desc<0, 16>(v); merge16_desc<32, 48>(v); merge16_desc<0, 32>(v);
}
__device__ __forceinline__ void merge_partner(int (&L)[16]) {
    int P[16];
#pragma unroll
    for (int i = 0; i < 16; ++i) P[i] = __shfl_xor(L[i], 32);
#pragma unroll
    for (int i = 0; i < 16; ++i) L[i] = max(L[i], P[15 - i]);
#pragma unroll
    for (int j = 8; j > 0; j >>= 1) {
#pragma unroll
        for (int i = 0; i < 16; ++i) { const int l = i ^ j; if (l > i) CE_DESC(L[i], L[l]); }
    }
}
__device__ __forceinline__ unsigned lookup_byte(const unsigned (&t)[4], int i) {
    const int w = i >> 2;
    const unsigned dw = (w == 0) ? t[0] : (w == 1) ? t[1] : (w == 2) ? t[2] : t[3];
    return (dw >> ((i & 3) * 8)) & 0xffu;
}

typedef _Float16 h16x2 __attribute__((ext_vector_type(2)));
__device__ __forceinline__ unsigned pkh2(float lo, float hi) { return __builtin_bit_cast(unsigned, __builtin_amdgcn_cvt_pkrtz(lo, hi)); }
__device__ __forceinline__ float h_lo(unsigned w) { return (float)__builtin_bit_cast(h16x2, w)[0]; }
__device__ __forceinline__ float h_hi(unsigned w) { return (float)__builtin_bit_cast(h16x2, w)[1]; }
constexpr int P7_KP = 272;
__device__ __forceinline__ void phase7(const Ctx& c, LAS unsigned char* lds) {
    int tid_ = threadIdx.x; asm volatile("" : "+v"(tid_)); const int tid = tid_, lane = tid & 63, wid = __builtin_amdgcn_readfirstlane(tid >> 6), r = lane & 31, hh = lane >> 5;
    unsigned char* ws = c.ws;
    const bf16* Q = (const bf16*)c.out; const bf16* KB = (const bf16*)(ws + WS_KEYS);
    int* IDX = (int*)(ws + WS_IDX); float* GATE = (float*)(ws + WS_GATE);
    const int head = blockIdx.x & 7, nblk_h = gridDim.x >> 3;
    {
        const bf16* ksrc = KB + (size_t)head * 256 * 128;
        for (int i = tid; i < 256 * 16; i += NTHR) { const int row = i >> 4, sg = i & 15; *(LAS u32x4*)(lds + row * P7_KP + sg * 16) = *(const u32x4*)(ksrc + row * 128 + sg * 8); }
    }
    __syncthreads();
    const LAS unsigned char* kl = lds + r * P7_KP + hh * 16;
    if (wid & 1) quant_peer_tables(c, blockIdx.x * 8 + wid, gridDim.x * 8, lane);
    for (int grp = (blockIdx.x >> 3) * 8 + wid; grp < T / 32; grp += nblk_h * 8) {
        const int tok = grp * 32 + r;
        int kz = 0; asm volatile("" : "+v"(kz));
        const LAS unsigned char* klz = kl + kz;
        bf16x8 qf[2][8];
        {
            const bf16* qp = Q + (size_t)tok * 2048 + head * 256 + hh * 8;
#pragma unroll
            for (int p = 0; p < 2; ++p)
#pragma unroll
                for (int ks = 0; ks < 8; ++ks) qf[p][ks] = *(const bf16x8*)(qp + p * 128 + ks * 16);
        }
        int S[2][16];
#pragma unroll
        for (int p = 0; p < 2; ++p) {
            f32x16 acc[4];
#pragma unroll
            for (int mb = 0; mb < 4; ++mb)
#pragma unroll
                for (int e = 0; e < 16; ++e) acc[mb][e] = 0.f;
#pragma unroll
            for (int ks = 0; ks < 8; ++ks) {
#pragma unroll
                for (int mb = 0; mb < 4; ++mb) {
                    const bf16x8 a = *(const LAS bf16x8*)(klz + (p * 128 + mb * 32) * P7_KP + ks * 32);
                    acc[mb] = __builtin_amdgcn_mfma_f32_32x32x16_bf16(a, qf[p][ks], acc[mb], 0, 0, 0);
                }
            }
            int v[64];
#pragma unroll
            for (int mb = 0; mb < 4; ++mb)
#pragma unroll
                for (int e = 0; e < 16; ++e) {
                    const int n = mb * 32 + (e & 3) + 8 * (e >> 2);
                    v[mb * 16 + e] = (f2key(acc[mb][e]) & ~0x7f) | n;
                }
            top16_of_64(v);
            int L[16];
#pragma unroll
            for (int i = 0; i < 16; ++i) L[i] = v[i] | (hh << 2);
            merge_partner(L);
#pragma unroll
            for (int i = 0; i < 16; ++i) S[p][i] = L[i];
        }
        float f1[16], f2[16];
#pragma unroll
        for (int i = 0; i < 16; ++i) { f1[i] = key2f(S[0][i]); f2[i] = key2f(S[1][i]); }
        int cv[64];
        {
            int n = 0;
#pragma unroll
            for (int i = 0; i < 16; ++i)
#pragma unroll
                for (int j = 0; j < 16; ++j)
                    if ((i + 1) * (j + 1) <= 16) { cv[n] = (f2key(f1[i] + f2[j]) & ~0xff) | (i * 16 + j); ++n; }
#pragma unroll
            for (int q = 50; q < 64; ++q) cv[q] = (int)0x80000000;
        }
        top16_of_64(cv);
        unsigned t1[4], t2[4];
#pragma unroll
        for (int w = 0; w < 4; ++w) {
            t1[w] = (unsigned)(S[0][4 * w] & 0x7f) | ((unsigned)(S[0][4 * w + 1] & 0x7f) << 8) | ((unsigned)(S[0][4 * w + 2] & 0x7f) << 16) | ((unsigned)(S[0][4 * w + 3] & 0x7f) << 24);
            t2[w] = (unsigned)(S[1][4 * w] & 0x7f) | ((unsigned)(S[1][4 * w + 1] & 0x7f) << 8) | ((unsigned)(S[1][4 * w + 2] & 0x7f) << 16) | ((unsigned)(S[1][4 * w + 3] & 0x7f) << 24);
        }
        int eid[16]; float ev[16];
        const float vmax = key2f(cv[0]);
        float esum = 0.f;
#pragma unroll
        for (int k = 0; k < 16; ++k) {
            const int pos = cv[k] & 0xff;
            eid[k] = (int)(lookup_byte(t1, pos >> 4) * 128u + lookup_byte(t2, pos & 15));
            ev[k] = __expf(key2f(cv[k]) - vmax);
            esum += ev[k];
        }
        const float inv = 1.0f / esum;
        if (hh == 0) {
            i32x4* ip = (i32x4*)(IDX + (size_t)tok * 128 + head * 16); f32x4* gp = (f32x4*)(GATE + (size_t)tok * 128 + head * 16);
#pragma unroll
            for (int w = 0; w < 4; ++w) {
                ip[w] = (i32x4){eid[4 * w], eid[4 * w + 1], eid[4 * w + 2], eid[4 * w + 3]};
                gp[w] = (f32x4){ev[4 * w] * inv, ev[4 * w + 1] * inv, ev[4 * w + 2] * inv, ev[4 * w + 3] * inv};
            }
        }
    }
    if (!(wid & 1)) quant_peer_tables(c, blockIdx.x * 8 + wid, gridDim.x * 8, lane);
}

#define UB0(w) ((float)((w) & 0xffu))
#define UB1(w) ((float)(((w) >> 8) & 0xffu))
#define UB2(w) ((float)(((w) >> 16) & 0xffu))
#define UB3(w) ((float)((w) >> 24))
#ifndef P8_NSH_
#define P8_NSH_ 16
#endif
#ifndef P8_CH_
#define P8_CH_ 12
#endif
#ifndef P8_PACE_
#define P8_PACE_ 0
#endif
#ifndef P8_NT_
#define P8_NT_ 0
#endif
#if P8_NT_
#define P8_LD(p) __builtin_nontemporal_load(p)
#else
#define P8_LD(p) (*(p))
#endif
#ifndef P8_SYNC_
#define P8_SYNC_ 0
#endif
#ifndef P8_GSYNC_
#define P8_GSYNC_ 0
#endif
#ifndef P8_TOK_
#define P8_TOK_ 8
#endif
constexpr int P8_TOK = P8_TOK_, P8_LIST = 1024 + 512, P8_NSH = P8_NSH_, P8_CH = P8_CH_, P8_SHIFT = (P8_NSH_ == 64 ? 8 : (P8_NSH_ == 32 ? 9 : (P8_NSH_ == 16 ? 10 : (P8_NSH_ == 8 ? 11 : (P8_NSH_ == 4 ? 12 : (P8_NSH_ == 2 ? 13 : 14))))));
template <int CTRL> __device__ __forceinline__ float dppf(float v) { return __int_as_float(__builtin_amdgcn_update_dpp(0, __float_as_int(v), CTRL, 0xf, 0xf, false)); }
__device__ __forceinline__ float reduce16(const float (&p)[16], bool b3, bool b2) {
    float q8[8], r4[4], s2[2];
#pragma unroll
    for (int i = 0; i < 8; ++i) { const auto r = __builtin_amdgcn_permlane32_swap(__float_as_uint(p[i]), __float_as_uint(p[8 + i]), false, false); q8[i] = __uint_as_float(r[0]) + __uint_as_float(r[1]); }
#pragma unroll
    for (int i = 0; i < 4; ++i) { const auto r = __builtin_amdgcn_permlane16_swap(__float_as_uint(q8[i]), __float_as_uint(q8[4 + i]), false, false); r4[i] = __uint_as_float(r[0]) + __uint_as_float(r[1]); }
#pragma unroll
    for (int i = 0; i < 2; ++i) { const float ta = r4[i] + dppf<0x128>(r4[i]), tb = r4[2 + i] + dppf<0x128>(r4[2 + i]); s2[i] = b3 ? tb : ta; }
    const float ta = s2[0] + dppf<0x141>(s2[0]), tb = s2[1] + dppf<0x141>(s2[1]);
    float t = b2 ? tb : ta;
    t += dppf<0x4e>(t);
    t += dppf<0xb1>(t);
    return t;
}
#define P8_LOAD_X1(x, tok) do { \
        const bf16* zr_ = ZB + (size_t)(tok) * 1024 + lane * 16; \
        const u32x4 a0_ = *(const u32x4*)zr_, a1_ = *(const u32x4*)(zr_ + 8); \
        const f32x2 st_ = *(const f32x2*)(ST1 + (size_t)(tok) * 2); \
        _Pragma("unroll") for (int j = 0; j < 4; ++j) { x[2 * j] = bf_lo(a0_[j]); x[2 * j + 1] = bf_hi(a0_[j]); x[8 + 2 * j] = bf_lo(a1_[j]); x[8 + 2 * j + 1] = bf_hi(a1_[j]); } \
        _Pragma("unroll") for (int w = 0; w < 4; ++w) { \
            const f32x4 g_ = *(const f32x4*)(l1g + lane * 16 + 4 * w), b_ = *(const f32x4*)(l1b + lane * 16 + 4 * w); \
            _Pragma("unroll") for (int k = 0; k < 4; ++k) x[4 * w + k] = (x[4 * w + k] - st_.x) * st_.y * g_[k] + b_[k]; } \
    } while (0)
__device__ __forceinline__ void phase8(const Ctx& c, LAS unsigned char* lds, const XcdBarrier& xbar) {
    int tid_ = threadIdx.x; asm volatile("" : "+v"(tid_)); const int tid = tid_, lane = tid & 63, wid = __builtin_amdgcn_readfirstlane(tid >> 6);
    unsigned char* ws = c.ws;
    const bf16* ZB = (const bf16*)(ws + WS_Z); const float* ST1 = (const float*)(ws + WS_ST1); const float* l1g = c.in[15]; const float* l1b = c.in[16];
    const int* IDX = (const int*)(ws + WS_IDX); const float* GATE = (const float*)(ws + WS_GATE);
    const unsigned char* UQ = ws + WS_UQ; const unsigned char* VQ = ws + WS_VQ;
    const float* USC = (const float*)(ws + WS_USC); const float* VSC = (const float*)(ws + WS_VSC);
    const float* lg = c.in[21]; const float* lb = c.in[22];
    float* OUT = c.out;
    const bool b3 = (lane & 8) != 0, b2 = (lane & 4) != 0;
    const int esub = lane >> 2;
    LAS unsigned char* wl = lds + wid * (P8_TOK * P8_LIST);
    const int ntl = (NTILE + gridDim.x - 1) / gridDim.x;
#if P8_PACE_
    if (lane == 0) ((volatile LAS int*)(lds + 8 * P8_TOK * P8_LIST))[wid] = 0;
    __syncthreads();
#endif
    for (int ti = 0; ti < ntl; ++ti) {
        const int tile = blockIdx.x + ti * gridDim.x; const bool live = tile < NTILE;
        for (int rnd = 0; rnd < 16 / P8_TOK; ++rnd) {
            if (P8_GSYNC_) xcd_barrier(xbar);
            const int tok0 = tile * CHUNK + wid * 16 + rnd * P8_TOK;
            int xq[P8_TOK][4]; float sx[P8_TOK], aacc[P8_TOK]; unsigned ob[P8_TOK][8];
            if (live) {
#pragma unroll
                for (int tt = 0; tt < P8_TOK; ++tt) {
                    const int tok = tok0 + tt;
                    {
                        float x[16];
                        P8_LOAD_X1(x, tok);
                        float m = 0.f;
#pragma unroll
                        for (int j = 0; j < 16; ++j) m = fmaxf(m, fabsf(x[j]));
#pragma unroll
                        for (int of = 32; of >= 1; of >>= 1) m = fmaxf(m, __shfl_xor(m, of));
                        const float sc = (m > 0.f) ? m * (1.0f / 127.0f) : 1.0f, inv = 1.0f / sc;
                        sx[tt] = sc;
#pragma unroll
                        for (int w = 0; w < 4; ++w) {
                            unsigned pk = 0;
#pragma unroll
                            for (int k = 0; k < 4; ++k) pk |= ((unsigned)(int)rintf(x[4 * w + k] * inv) & 0xffu) << (8 * k);
                            xq[tt][w] = (int)pk;
                        }
                    }
                    aacc[tt] = 0.f;
#pragma unroll
                    for (int j = 0; j < 8; ++j) ob[tt][j] = 0u;
                    {
                        LAS unsigned char* L = wl + tt * P8_LIST;
                        const int i0 = IDX[(size_t)tok * 128 + lane], i1 = IDX[(size_t)tok * 128 + 64 + lane];
                        const float g0 = GATE[(size_t)tok * 128 + lane], g1 = GATE[(size_t)tok * 128 + 64 + lane];
                        const int k0 = i0 >> P8_SHIFT, k1 = i1 >> P8_SHIFT;
                        int base = 0, pos0 = 0, pos1 = 0;
#pragma unroll
                        for (int s = 0; s < P8_NSH; ++s) {
                            const unsigned long long m0 = __ballot(k0 == s), m1 = __ballot(k1 == s);
                            const int c0 = __popcll(m0), c1 = __popcll(m1);
                            const int pre0 = __builtin_amdgcn_mbcnt_hi((unsigned)(m0 >> 32), __builtin_amdgcn_mbcnt_lo((unsigned)m0, 0));
                            const int pre1 = __builtin_amdgcn_mbcnt_hi((unsigned)(m1 >> 32), __builtin_amdgcn_mbcnt_lo((unsigned)m1, 0));
                            pos0 = (k0 == s) ? base + pre0 : pos0;
                            pos1 = (k1 == s) ? base + c0 + pre1 : pos1;
                            if (lane == 0) *(LAS int*)(L + 1024 + 4 * s) = base;
                            base += c0 + c1;
                        }
                        if (lane == 0) *(LAS int*)(L + 1024 + 4 * P8_NSH) = base;
                        *(LAS u32x2*)(L + pos0 * 8) = (u32x2){(unsigned)i0, __float_as_uint(g0)};
                        *(LAS u32x2*)(L + pos1 * 8) = (u32x2){(unsigned)i1, __float_as_uint(g1)};
                    }
                }
            }
            for (int s = 0; s < P8_NSH; ++s) {
#if P8_PACE_
                {
                    volatile LAS int* prog = (volatile LAS int*)(lds + 8 * P8_TOK * P8_LIST);
                    const int mine = (ti * (16 / P8_TOK) + rnd) * P8_NSH + s;
                    if (lane == 0) prog[wid] = mine;
                    for (int spin = 0; spin < 4096; ++spin) {
                        int mn = prog[0];
#pragma unroll
                        for (int w = 1; w < 8; ++w) { const int pw = prog[w]; mn = pw < mn ? pw : mn; }
                        if (__builtin_amdgcn_readfirstlane(mn) + P8_PACE_ >= mine) break;
                        __builtin_amdgcn_s_sleep(8);
                    }
                }
#endif
                if (live) {
#pragma unroll
                    for (int tt = 0; tt < P8_TOK; ++tt) {
                        const LAS unsigned char* L = wl + tt * P8_LIST;
                        const int eb = __builtin_amdgcn_readfirstlane(*(const LAS int*)(L + 1024 + 4 * s)), ee = __builtin_amdgcn_readfirstlane(*(const LAS int*)(L + 1024 + 4 * s + 4));
                        for (int c0 = eb; c0 < ee; c0 += P8_CH) {
                            const int ent = c0 + esub; const bool valid = (esub < P8_CH) && (ent < ee);
                            const u32x2 en = *(const LAS u32x2*)(L + (valid ? ent : eb) * 8);
                            const int idv = (int)en.x; const float gv = valid ? __uint_as_float(en.y) : 0.f;
                            const float su = USC[idv], sv = VSC[idv];
                            u32x4 u[P8_CH], v[P8_CH];
#pragma unroll
                            for (int e = 0; e < P8_CH; ++e) {
                                if (c0 + e < ee) {
                                    const int id = __builtin_amdgcn_readlane(idv, e * 4);
                                    u[e] = P8_LD((const u32x4*)(UQ + (size_t)id * 1024 + lane * 16));
                                    v[e] = P8_LD((const u32x4*)(VQ + (size_t)id * 1024 + lane * 16));
                                } else { u[e] = (u32x4){0u, 0u, 0u, 0u}; v[e] = (u32x4){0u, 0u, 0u, 0u}; }
                            }
                            float p[16];
#pragma unroll
                            for (int e = 0; e < 16; ++e) {
                                if (e < P8_CH) {
                                    int a = 0;
#pragma unroll
                                    for (int w = 0; w < 4; ++w) a = __builtin_amdgcn_sdot4((int)u[e][w], xq[tt][w], a, false);
                                    p[e] = (float)a;
                                } else p[e] = 0.f;
                            }
                            const float t1 = reduce16(p, b3, b2);
                            const float act = gelu_tanh(t1 * su * sx[tt]) * gv * sv;
                            aacc[tt] += act;
                            float oc[16];
#pragma unroll
                            for (int j = 0; j < 8; ++j) { oc[2 * j] = h_lo(ob[tt][j]); oc[2 * j + 1] = h_hi(ob[tt][j]); }
#pragma unroll
                            for (int e = 0; e < P8_CH; ++e) {
                                if (c0 + e < ee) {
                                    const float ae = __int_as_float(__builtin_amdgcn_readlane(__float_as_int(act), e * 4));
#pragma unroll
                                    for (int w = 0; w < 4; ++w) {
                                        oc[4 * w] += ae * UB0(v[e][w]); oc[4 * w + 1] += ae * UB1(v[e][w]); oc[4 * w + 2] += ae * UB2(v[e][w]); oc[4 * w + 3] += ae * UB3(v[e][w]);
                                    }
                                }
                            }
#pragma unroll
                            for (int j = 0; j < 8; ++j) ob[tt][j] = pkh2(oc[2 * j], oc[2 * j + 1]);
                        }
                    }
                }
                if (P8_SYNC_) __syncthreads();
            }
            if (live) {
#pragma unroll
                for (int tt = 0; tt < P8_TOK; ++tt) {
                    const int tok = tok0 + tt;
                    const float ooff = -128.0f * 0.25f * wave_sum(aacc[tt]);
                    float x[16];
                    P8_LOAD_X1(x, tok);
                    float sm = 0.f;
                    float o[16];
#pragma unroll
                    for (int j = 0; j < 8; ++j) { o[2 * j] = h_lo(ob[tt][j]); o[2 * j + 1] = h_hi(ob[tt][j]); }
#pragma unroll
                    for (int j = 0; j < 16; ++j) { o[j] = ALPHA * x[j] + (o[j] + ooff); sm += o[j]; }
                    const float mean = wave_sum(sm) * (1.0f / 1024.0f);
                    float qv = 0.f;
#pragma unroll
                    for (int j = 0; j < 16; ++j) { o[j] -= mean; qv += o[j] * o[j]; }
                    const float rstd = rsqrtf(wave_sum(qv) * (1.0f / 1024.0f) + LN_EPS);
                    const float* gp = lg + lane * 16; const float* bp = lb + lane * 16;
                    float* op = OUT + (size_t)tok * 1024 + lane * 16;
#pragma unroll
                    for (int w = 0; w < 4; ++w) {
                        const f32x4 gg = *(const f32x4*)(gp + 4 * w), hb = *(const f32x4*)(bp + 4 * w);
                        *(f32x4*)(op + 4 * w) = (f32x4){o[4 * w], o[4 * w + 1], o[4 * w + 2], o[4 * w + 3]} * rstd * gg + hb;
                    }
                }
            }
        }
    }
}

struct Params { const float* in[23]; float* out; unsigned char* ws; };

__global__ void __launch_bounds__(NTHR, 2) hybrid_fwd(Params p) {
    extern __shared__ __attribute__((aligned(16))) unsigned char lds_raw[];
    LAS unsigned char* lds = (LAS unsigned char*)lds_raw;
    cg::grid_group grid = cg::this_grid();
    Ctx c;
#pragma unroll
    for (int i = 0; i < 23; ++i) c.in[i] = p.in[i];
    c.out = p.out; c.ws = p.ws;
    unsigned char* ws = p.ws;

#ifndef G6_ALIGN
#define G6_ALIGN true
#endif
#ifndef G4_ALIGN
#define G4_ALIGN true
#endif
#ifndef G1_ALIGN
#define G1_ALIGN true
#endif
#ifndef G1_SP2
#define G1_SP2 true
#endif
#ifndef PH_MASK
#define PH_MASK 0x1ff
#endif
#ifndef REP0
#define REP0 1
#endif
#ifndef REP123
#define REP123 1
#endif
#ifndef REP1
#define REP1 1
#endif
#ifndef REP4
#define REP4 1
#endif
#ifndef REP5
#define REP5 1
#endif
#ifndef REP6
#define REP6 1
#endif
#ifndef REP7
#define REP7 1
#endif
#ifndef REP8
#define REP8 1
#endif
    if (threadIdx.x < 4) ((volatile LAS unsigned*)(lds + LDS_BARST))[threadIdx.x] = 0u;
    __syncthreads();
    const XcdBarrier xbar = xcd_barrier_post((unsigned*)(ws + WS_BAR), (volatile LAS unsigned*)(lds + LDS_BARST));
    if (p.ws == nullptr) grid.sync();
#define GSYNC() xcd_barrier(xbar)
    for (int rep = 0; rep < REP0; ++rep) { if (PH_MASK & 1) phase0(c, lds);
    GSYNC(); }
    if (PH_MASK & 1) phase0b(c);
    GSYNC();
    for (int rep123 = 0; rep123 < REP123; ++rep123) {
    for (int rep1 = 0; rep1 < REP1; ++rep1) {
    if (PH_MASK & 2) {
        pg8::Gemm g{(const bf16*)(ws + WS_XQ8), (const bf16*)(ws + WS_WQ8), T, DIN, 512, 512, 512, 0};
        pg8::StaticOrder S; S.init(T, DIN, (int)gridDim.x, (int)blockIdx.x);
        pg8::EpiProj E{(bf16*)(ws + WS_P4), (const float*)(ws + WS_BGS), (const float*)(ws + WS_SXR), (const float*)(ws + WS_SWC)};
        pg8::gemm_phase<pg8::EpiProj, pg8::StaticOrder, G1_ALIGN, G1_SP2>(lds, g, S, E);
    }
    GSYNC(); }
#ifndef REP2A
#define REP2A 1
#endif
#ifndef REP2B
#define REP2B 1
#endif
#ifndef REP3A
#define REP3A 1
#endif
    for (int r2 = 0; r2 < REP2B; ++r2) {
    if (PH_MASK & 4) {
        pg8::Gemm g{(const bf16*)p.out, (const bf16*)(ws + WS_WAX), T, 2048, 128, 1024, 128, 256};
        pg8::StaticOrder S; S.init(T, 2048, (int)gridDim.x, (int)blockIdx.x);
        phase2a(c, S);
        asm volatile("s_waitcnt vmcnt(0)" ::: "memory");
        __syncthreads();
        pg8::EpiGate E{(const bf16*)p.out, (bf16*)(ws + WS_HL), (bf16*)((unsigned char*)p.out + OUT_PC), (float*)(ws + WS_PEND), (float*)(ws + WS_HEND), (const float*)(ws + WS_BAS), (const float*)(ws + WS_BXS), (const float*)(ws + WS_SPT)};
        pg8::gemm_phase<pg8::EpiGate, pg8::StaticOrder, true, true>(lds, g, S, E);
    }
    GSYNC(); }
#ifdef REP2C
    phase2c(c, lds, 0); GSYNC();
#endif
    if (PH_MASK & 4) phase2c(c, lds);
    GSYNC(); }
    for (int rep4 = 0; rep4 < REP4; ++rep4) {
    if (PH_MASK & 16) {
        pg8::Gemm g{(const bf16*)(ws + WS_P4) + 2048, (const bf16*)(ws + WS_WOUT), T, 1024, 1024, 4096, 1024, 0};
        pg8::StaticOrder S; S.init(T, 1024, (int)gridDim.x, (int)blockIdx.x);
        pg8::EpiResid E{(const bf16*)(ws + WS_XB), (bf16*)(ws + WS_Z), 1024, ALPHA, (float*)(ws + WS_PARTZ)};
        pg8::gemm_phase<pg8::EpiResid, pg8::StaticOrder, G4_ALIGN, true>(lds, g, S, E);
    }
    GSYNC(); }
    for (int rep6 = 0; rep6 < REP6; ++rep6) {
    if (PH_MASK & 64) {
#if Q_I8
        pg8::Gemm g{(const bf16*)(ws + WS_X1Q8), (const bf16*)(ws + WS_WQQ8), T, 2048, 512, 512, 512, 0};
        pg8::StaticOrder S; S.init(T, 2048, (int)gridDim.x, (int)blockIdx.x);
        pg8::EpiBf16I8 E{(bf16*)p.out, 2048, (const float*)(ws + WS_SX1), (const float*)(ws + WS_SWQ)};
        pg8::gemm_phase<pg8::EpiBf16I8, pg8::StaticOrder, G6_ALIGN, true>(lds, g, S, E);
#else
        pg8::StaticOrder S; S.init(T, 2048, (int)gridDim.x, (int)blockIdx.x);
        LAS float* tab = (LAS float*)(lds + 131072);
        {
            const int ui = threadIdx.x >> 7; pg8::Unit uu;
            if (S.next(ui, uu)) {
#pragma unroll
                for (int rr = 0; rr < 2; ++rr) {
                    const int rl = (threadIdx.x & 127) * 2 + rr, row = uu.pm * 256 + rl;
                    const f32x4* pp = (const f32x4*)((const float*)(ws + WS_PARTZ) + (size_t)row * 32);
                    float s1 = 0.f, s2 = 0.f;
#pragma unroll
                    for (int k = 0; k < 8; ++k) { const f32x4 v = pp[k]; s1 += v.x + v.z; s2 += v.y + v.w; }
                    const float mean = s1 * (1.0f / 1024.0f), rstd = rsqrtf(fmaxf(s2 * (1.0f / 1024.0f) - mean * mean, 0.f) + LN_EPS);
                    tab[(ui * 256 + rl) * 2] = mean; tab[(ui * 256 + rl) * 2 + 1] = rstd;
                    if (uu.pn == 0) *(f32x2*)((float*)(ws + WS_ST1) + (size_t)row * 2) = (f32x2){mean, rstd};
                }
            }
        }
        __syncthreads();
        pg8::Gemm g{(const bf16*)(ws + WS_Z), (const bf16*)(ws + WS_WQ), T, 2048, 1024, 1024, 1024, 0};
        pg8::EpiQ E{(bf16*)p.out, 2048, (const float*)(ws + WS_CQ), (const float*)(ws + WS_DQ), (const LAS float*)tab, S};
        pg8::gemm_phase<pg8::EpiQ, pg8::StaticOrder, G6_ALIGN, true>(lds, g, S, E);
#endif
    }
    GSYNC(); }
    for (int rep = 0; rep < REP7; ++rep) { if (PH_MASK & 128) phase7(c, lds);
    GSYNC(); }
#ifdef REP8B
    phase8(c, lds, xbar); GSYNC();
#endif
    if (PH_MASK & 256) phase8(c, lds, xbar);
}

extern "C" void kernel_launch(void* const* d_in, const int* in_sizes, int n_in, void* d_out, int out_size,
                              void* d_ws, size_t ws_size, hipStream_t stream) {
    static int grid_blocks = 0;
    if (grid_blocks == 0) {
        if (n_in != 23 || out_size != T * D || ws_size < WS_END) {
            fprintf(stderr, "kernel_launch: unexpected problem (n_in %d, out %d, ws %zu); nothing launched\n", n_in, out_size, ws_size);
            grid_blocks = -1; return;
        }
        int dev = 0, cus = 0, per_cu = 0;
        (void)hipGetDevice(&dev);
        (void)hipDeviceGetAttribute(&cus, hipDeviceAttributeMultiprocessorCount, dev);
        (void)hipFuncSetAttribute((const void*)hybrid_fwd, hipFuncAttributeMaxDynamicSharedMemorySize, LDS_BYTES);
        (void)hipOccupancyMaxActiveBlocksPerMultiprocessor(&per_cu, (const void*)hybrid_fwd, NTHR, LDS_BYTES);
        if (per_cu < 1) { fprintf(stderr, "kernel_launch: occupancy query reports %d blocks per CU\n", per_cu); grid_blocks = -1; return; }
        grid_blocks = cus;
        (void)hipGetLastError();
    }
    if (grid_blocks < 0) return;
    Params p{};
    for (int i = 0; i < 23; ++i) p.in[i] = (const float*)d_in[i];
    p.out = (float*)d_out; p.ws = (unsigned char*)d_ws;
    if (hipMemsetAsync((unsigned char*)d_ws + WS_BAR, 0, XCD_BAR_WORDS * sizeof(unsigned), stream) != hipSuccess) { fprintf(stderr, "kernel_launch: hipMemsetAsync of the barrier words failed; nothing launched\n"); return; }
    void* args[] = {&p};
    hipError_t e = hipLaunchCooperativeKernel((const void*)hybrid_fwd, dim3(grid_blocks), dim3(NTHR), args, LDS_BYTES, stream);
    if (e != hipSuccess) fprintf(stderr, "cooperative launch failed: %s (grid %d)\n", hipGetErrorString(e), grid_blocks);
}
```

```cpp
#include <hip/hip_runtime.h>
#include <hip/hip_cooperative_groups.h>
#include <cstdio>
#include <cstdint>
namespace cg = cooperative_groups;

#define LAS __attribute__((address_space(3)))
typedef unsigned short bf16;
typedef short bf16x8 __attribute__((ext_vector_type(8)));
typedef float f32x4 __attribute__((ext_vector_type(4)));
typedef float f32x16 __attribute__((ext_vector_type(16)));
typedef float f32x2 __attribute__((ext_vector_type(2)));
typedef unsigned u32x4 __attribute__((ext_vector_type(4)));
typedef unsigned u32x2 __attribute__((ext_vector_type(2)));
typedef int i32x4 __attribute__((ext_vector_type(4)));
typedef __bf16 bf16v2 __attribute__((ext_vector_type(2)));

#ifndef Q_I8
#define Q_I8 0
#endif
constexpr int T = 32768, D = 1024, SEQ = 4096, DIN = 6144, CHUNK = 128, NTILE = T / CHUNK, NCHUNK = SEQ / CHUNK, NH = 8, HD = 128;
constexpr int NEXP = 16384;
constexpr float ALPHA = 1.18920711500272f, LN_EPS = 1e-5f;
constexpr int NTHR = 512;
constexpr int LDS_BYTES = 147456;
constexpr int LDS_BARST = 147440;

constexpr size_t MiB = 1u << 20;
constexpr size_t WS_SPT = 0;
constexpr size_t WS_BAS = 4096;
constexpr size_t WS_BXS = 8192;
constexpr size_t WS_BGS = 12288;
constexpr size_t WS_STATS = 256 * 1024;
constexpr size_t WS_BAR = 64 * 1024;
constexpr size_t WS_WIN = 1 * MiB;
constexpr size_t WS_WOUT = 13 * MiB;
constexpr size_t WS_WQ = 15 * MiB;
constexpr size_t WS_KEYS = 19 * MiB;
constexpr size_t WS_WAX = 20 * MiB;
constexpr size_t WS_WTRIL = 20 * MiB + 512 * 1024;
constexpr size_t WS_UQ = 22 * MiB;
constexpr size_t WS_VQ = 38 * MiB;
constexpr size_t WS_USC = 54 * MiB;
constexpr size_t WS_VSC = 55 * MiB;
constexpr size_t WS_WQ8 = 56 * MiB;
constexpr size_t WS_SXR = 62 * MiB;
constexpr size_t WS_SWC = 63 * MiB;
constexpr size_t WS_WQQ8 = 64 * MiB;
constexpr size_t WS_SWQ = 66 * MiB;
constexpr size_t WS_SX1 = 67 * MiB;
constexpr size_t WS_X1Q8 = 182 * MiB;
constexpr size_t WS_XQ8 = 472 * MiB;
constexpr size_t WS_XB = 86 * MiB;
constexpr size_t OUT_PC = 64 * MiB;
constexpr size_t WS_P4 = 150 * MiB;
constexpr size_t WS_HL = 406 * MiB;
constexpr size_t WS_PEND = 470 * MiB;
constexpr size_t WS_HEND = 471 * MiB;
constexpr size_t WS_Z = 406 * MiB;
constexpr size_t WS_PARTZ = 68 * MiB;
constexpr size_t WS_ST1 = 72 * MiB;
constexpr size_t WS_CQ = 73 * MiB;
constexpr size_t WS_DQ = 73 * MiB + 8192;
constexpr size_t WS_PARTCD = 74 * MiB;
constexpr size_t WS_IDX = 470 * MiB;
constexpr size_t WS_GATE = 486 * MiB;
constexpr size_t WS_END = 504 * MiB;

__device__ __forceinline__ unsigned pk2(float lo, float hi) { f32x2 v = {lo, hi}; return __builtin_bit_cast(unsigned, __builtin_convertvector(v, bf16v2)); }
__device__ __forceinline__ float bf_lo(unsigned w) { return __uint_as_float(w << 16); }
__device__ __forceinline__ float bf_hi(unsigned w) { return __uint_as_float(w & 0xffff0000u); }
constexpr float NLOG2E = -1.4426950408889634f;
__device__ __forceinline__ float sig_pre(float xs) { return __builtin_amdgcn_rcpf(1.0f + __builtin_amdgcn_exp2f(xs)); }
__device__ __forceinline__ float gelu_tanh(float x) { const float u = x * (1.0f + 0.044715f * x * x); return x * __builtin_amdgcn_rcpf(1.0f + __builtin_amdgcn_exp2f(-2.3022081989f * u)); }
__device__ __forceinline__ float wave_sum(float v) {
#pragma unroll
    for (int o = 32; o >= 1; o >>= 1) v += __shfl_xor(v, o);
    return v;
}
#define XB_TMO      128
#define XB_XCNT(j)  (256  + 64 * (j))
#define XB_XSUB(j)  (1280 + 64 * (j))
#define XB_XGEN(j)  (2304 + 64 * (j))
#define XB_TOP      3328
#define XB_TOPGEN   3392
#define XCD_BAR_WORDS 3456
#define XB_SPIN_CAP (1u << 22)

__device__ __forceinline__ unsigned xb_ld(unsigned* p)              { return __hip_atomic_load(p, __ATOMIC_RELAXED, __HIP_MEMORY_SCOPE_AGENT); }
__device__ __forceinline__ unsigned xb_add(unsigned* p, unsigned v) { return __hip_atomic_fetch_add(p, v, __ATOMIC_RELAXED, __HIP_MEMORY_SCOPE_AGENT); }
__device__ __forceinline__ unsigned xb_xcc_id() { return (unsigned)__builtin_amdgcn_s_getreg((3 << 11) | 20) & 0xFu; }
#define XB_SPIN(cond, bar) do { unsigned _sp = 0; while (cond) { __builtin_amdgcn_s_sleep(1); \
    if ((++_sp & 255u) == 0u) { if (xb_ld(&(bar)[XB_TMO])) break; if (_sp > XB_SPIN_CAP) { atomicAdd(&(bar)[XB_TMO], 1u); break; } } } } while (0)

struct XcdBarrier {
    unsigned* bar; unsigned x;
    volatile LAS unsigned* st;
};

__device__ __forceinline__ XcdBarrier xcd_barrier_post(unsigned* bar, volatile LAS unsigned* st) {
    XcdBarrier b; b.bar = bar; b.x = xb_xcc_id(); b.st = st;
    if (threadIdx.x == 0) (void)xb_add(&bar[XB_XCNT(b.x)], 1u);
    return b;
}
__device__ __forceinline__ void xcd_barrier_complete(unsigned* bar, unsigned x, unsigned& nloc, unsigned& nx) {
    const unsigned G = gridDim.x * gridDim.y * gridDim.z;
    unsigned sum, cnt, mine, sp = 0u;
    for (;;) {
        sum = 0u; cnt = 0u; mine = 0u;
#pragma unroll
        for (unsigned j = 0; j < 16; ++j) { const unsigned c = xb_ld(&bar[XB_XCNT(j)]); sum += c; cnt += (c > 0u) ? 1u : 0u; mine = (j == x) ? c : mine; }
        if (sum == G) break;
        __builtin_amdgcn_s_sleep(1);
        if ((++sp & 255u) == 0u) { if (xb_ld(&bar[XB_TMO])) break; if (sp > XB_SPIN_CAP) { atomicAdd(&bar[XB_TMO], 1u); break; } }
    }
    nloc = mine > 0u ? mine : 1u; nx = cnt > 0u ? cnt : 1u;
}

__device__ __forceinline__ void xcd_barrier(const XcdBarrier& b) {
    asm volatile("s_waitcnt vmcnt(0)" ::: "memory");
    __syncthreads();
    if (threadIdx.x == 0) {
        unsigned* bar = b.bar;
        __builtin_amdgcn_s_waitcnt(0);
        unsigned nloc = b.st[0], nx = b.st[1];
        if (nloc == 0u) { xcd_barrier_complete(bar, b.x, nloc, nx); b.st[0] = nloc; b.st[1] = nx; }
        const unsigned old = xb_add(&bar[XB_XSUB(b.x)], 1u);
        const unsigned gen = old / nloc;
        if (old + 1u == (gen + 1u) * nloc) {
            __builtin_amdgcn_fence(__ATOMIC_RELEASE, "agent");
            asm volatile("s_waitcnt vmcnt(0)" ::: "memory");
            const unsigned og = xb_add(&bar[XB_TOP], 1u);
            const unsigned tg = og / nx;
            if (og + 1u == (tg + 1u) * nx) xb_add(&bar[XB_TOPGEN], 1u);
            else XB_SPIN(xb_ld(&bar[XB_TOPGEN]) == tg, bar);
            __builtin_amdgcn_fence(__ATOMIC_ACQUIRE, "agent");
            xb_add(&bar[XB_XGEN(b.x)], 1u);
            asm volatile("s_waitcnt vmcnt(0)" ::: "memory");
        } else {
            XB_SPIN(xb_ld(&bar[XB_XGEN(b.x)]) == gen, bar);
            __builtin_amdgcn_fence(__ATOMIC_ACQUIRE, "agent");
            asm volatile("s_waitcnt vmcnt(0)" ::: "memory");
        }
    }
    __syncthreads();
}
namespace pg8 {
#define PG8_LAS __attribute__((address_space(3)))
typedef unsigned short bf16_t;
typedef short bf16x8 __attribute__((ext_vector_type(8)));
typedef float f32x4 __attribute__((ext_vector_type(4)));
typedef unsigned u32x4 __attribute__((ext_vector_type(4)));
typedef int i32x4_ __attribute__((ext_vector_type(4)));
constexpr int BM = 256, BK = 64, HALF = 128, HTB = HALF * BK * 2  , STAGE_BYTES = 8 * HTB, NXCD = 8, WGM = 8;

__host__ __device__ __forceinline__ int lds_byte(int r, int c) { const int st = (r >> 4) * 2 + (c >> 5), rr = r & 15, cc = c & 31, ob = rr * 64 + cc * 2; return st * 1024 + (ob ^ (((ob >> 9) & 1) << 5)); }
__host__ __device__ __forceinline__ void stage_rc(int b, int& R, int& C) { const int st = b / 1024, sb = b % 1024, swz = sb ^ (((sb >> 9) & 1) << 5); R = (st >> 1) * 16 + swz / 64; C = (st & 1) * 32 + (swz % 64) / 2; }
__host__ __device__ __forceinline__ int perm32(int rho) { const int n = rho >> 4, i = rho & 15; return 8 * (i >> 2) + 4 * n + (i & 3); }

struct Unit { int pm, pn; };
struct Gemm { const bf16_t* A; const bf16_t* Bt; int M, N, K, lda, ldb, a_pn_bytes; };

struct StaticOrder {
    int nM, nN, nwg, G, c;
    __host__ __device__ __forceinline__ void init(int M, int N, int G_, int c_) { nM = M / BM; nN = N / BM; nwg = nM * nN; G = G_; c = c_; }
    __host__ __device__ __forceinline__ bool next(int i, Unit& u) const {
        const long L = (long)i * G + c; if (L >= nwg) return false;
        int wgid = (int)L; { const int q = nwg / NXCD, r = nwg % NXCD, xcd = wgid % NXCD, off = wgid / NXCD; wgid = (xcd < r ? xcd * (q + 1) : r * (q + 1) + (xcd - r) * q) + off; }
        const int nig = WGM * nN, gid = wgid / nig, fm = gid * WGM, gsz = (nM - fm) < WGM ? (nM - fm) : WGM;
        u.pm = fm + ((wgid % nig) % gsz); u.pn = (wgid % nig) / gsz; return true;
    }
    __device__ __forceinline__ void a_ready(const Unit&) const {}
    __device__ __forceinline__ void done(const Unit&) const {}
};


struct EpiProj {
    static constexpr bool PERM = true, AFTER_DRAIN = false, AROWS = false, I8 = true;
    bf16_t* P4; const float* bgate;
    const float* sxr; const float* swc;
    __device__ __forceinline__ void operator()(const f32x4 (&acc)[2][2][4][2], const Unit& u, int, int, int, int) const {
        int t_ = threadIdx.x; asm volatile("" : "+v"(t_)); const int fr = t_ & 15, fq = (t_ >> 4) & 3, wc = (t_ >> 6) & 3, wr = t_ >> 8;
        const int k = u.pn / 3, ty = u.pn - 3 * k;
        const int row0 = u.pm * BM + wr * 64 + fr, cl = k * 128 + wc * 32 + 8 * fq;
        const float* swp = swc + u.pn * BM + wc * 32 + 8 * fq;
        const f32x4 w00 = *(const f32x4*)swp, w01 = *(const f32x4*)(swp + 4), w10 = *(const f32x4*)(swp + HALF), w11 = *(const f32x4*)(swp + HALF + 4);
#define EPI_I2F(v, w, s) ((f32x4){(float)__builtin_bit_cast(i32x4_, v)[0], (float)__builtin_bit_cast(i32x4_, v)[1], (float)__builtin_bit_cast(i32x4_, v)[2], (float)__builtin_bit_cast(i32x4_, v)[3]} * (w) * (s))
        if (ty == 0) {
#pragma unroll
            for (int ai = 0; ai < 2; ++ai)
#pragma unroll
                for (int m = 0; m < 4; ++m) {
                    const int row = row0 + ai * HALF + m * 16; const float sx = sxr[row];
                    bf16_t* rowp = P4 + (size_t)row * 4096 + cl;
                    const f32x4 a0 = EPI_I2F(acc[ai][0][m][0], w00, sx), a1 = EPI_I2F(acc[ai][0][m][1], w01, sx); f32x4 v0 = EPI_I2F(acc[ai][1][m][0], w10, sx), v1 = EPI_I2F(acc[ai][1][m][1], w11, sx);
#pragma unroll
                    for (int j = 0; j < 4; ++j) { v0[j] = gelu_tanh(v0[j]); v1[j] = gelu_tanh(v1[j]); }
                    u32x4 w; w.x = pk2(a0[0], a0[1]); w.y = pk2(a0[2], a0[3]); w.z = pk2(a1[0], a1[1]); w.w = pk2(a1[2], a1[3]);
                    *(u32x4*)rowp = w;
                    w.x = pk2(v0[0], v0[1]); w.y = pk2(v0[2], v0[3]); w.z = pk2(v1[0], v1[1]); w.w = pk2(v1[2], v1[3]);
                    *(u32x4*)(rowp + 3072) = w;
                }
        } else {
            const float* bp = bgate + (ty - 1) * 1024 + cl;
            const f32x4 b0 = *(const f32x4*)bp, b1 = *(const f32x4*)(bp + 4);
#pragma unroll
            for (int ai = 0; ai < 2; ++ai)
#pragma unroll
                for (int m = 0; m < 4; ++m) {
                    const int row = row0 + ai * HALF + m * 16; const float sx = sxr[row];
                    bf16_t* rowp = P4 + (size_t)row * 4096 + ty * 1024 + cl;
                    f32x4 a0 = EPI_I2F(acc[ai][0][m][0], w00, sx), a1 = EPI_I2F(acc[ai][0][m][1], w01, sx); const f32x4 g0 = EPI_I2F(acc[ai][1][m][0], w10, sx) + b0, g1 = EPI_I2F(acc[ai][1][m][1], w11, sx) + b1;
#pragma unroll
                    for (int j = 0; j < 4; ++j) { a0[j] = gelu_tanh(a0[j]) * sig_pre(g0[j]); a1[j] = gelu_tanh(a1[j]) * sig_pre(g1[j]); }
                    u32x4 w; w.x = pk2(a0[0], a0[1]); w.y = pk2(a0[2], a0[3]); w.z = pk2(a1[0], a1[1]); w.w = pk2(a1[2], a1[3]);
                    *(u32x4*)rowp = w;
                }
        }
#undef EPI_I2F
    }
};
template <int S> __device__ __forceinline__ float row_shr_f(float ident, float v) {
    return __int_as_float(__builtin_amdgcn_update_dpp(__float_as_int(ident), __float_as_int(v), 0x110 + S, 0xf, 0xf, false));
}
struct EpiGate {
    static constexpr bool PERM = true, AFTER_DRAIN = false, AROWS = true, I8 = false;
    const bf16_t* XC; bf16_t* HL; bf16_t* PC; float* PEND; float* HEND; const float* b_a; const float* b_x; const float* spt;
    __device__ __forceinline__ void operator()(const f32x4 (&acc)[2][2][4][2], const Unit& u, int, int, int, int) const {
        int t_ = threadIdx.x; asm volatile("" : "+v"(t_)); const int fr = t_ & 15, fq = (t_ >> 4) & 3, wc = (t_ >> 6) & 3, wr = t_ >> 8, lane15 = (t_ & 63) | 15;
        const int row0 = u.pm * BM + wr * 128 + fr, ch = u.pn * 128 + wc * 32 + 8 * fq, chunk = u.pm * 2 + wr;
        float Ac[8], Hc[8];
#pragma unroll
        for (int j = 0; j < 8; ++j) { Ac[j] = 1.0f; Hc[j] = 0.0f; }
#pragma unroll
        for (int ai = 0; ai < 2; ++ai)
#pragma unroll
            for (int m = 0; m < 4; ++m) {
                asm volatile("" ::: "memory");
                int zo = 0; asm volatile("" : "+v"(zo));
                const size_t off = (size_t)(row0 + ai * 64 + m * 16) * 1024 + ch;
                const u32x4 xw = *(const u32x4*)(XC + off);
                float ba[8], bx[8], sp[8];
                { const int cz = ch + zo;
                  const f32x4 t0 = *(const f32x4*)(b_a + cz), t1 = *(const f32x4*)(b_a + cz + 4), t2 = *(const f32x4*)(b_x + cz), t3 = *(const f32x4*)(b_x + cz + 4), t4 = *(const f32x4*)(spt + cz), t5 = *(const f32x4*)(spt + cz + 4);
#pragma unroll
                  for (int j = 0; j < 4; ++j) { ba[j] = t0[j]; ba[4 + j] = t1[j]; bx[j] = t2[j]; bx[4 + j] = t3[j]; sp[j] = t4[j]; sp[4 + j] = t5[j]; } }
                float a[8], b[8];
#pragma unroll
                for (int j = 0; j < 8; ++j) {
                    const float rp = acc[ai][0][m][j >> 2][j & 3], ip = acc[ai][1][m][j >> 2][j & 3];
                    const float xv = (j & 1) ? bf_hi(xw[j >> 1]) : bf_lo(xw[j >> 1]);
                    a[j] = __builtin_amdgcn_exp2f(sig_pre(rp + ba[j]) * sp[j]);
                    b[j] = __builtin_amdgcn_sqrtf(__builtin_fmaxf(1.0f - a[j] * a[j], 0.f)) * sig_pre(ip + bx[j]) * xv;
                }
#pragma unroll
                for (int j = 0; j < 8; ++j) { const float ap = row_shr_f<1>(1.0f, a[j]), bp = row_shr_f<1>(0.0f, b[j]); b[j] = a[j] * bp + b[j]; a[j] = a[j] * ap; }
#pragma unroll
                for (int j = 0; j < 8; ++j) { const float ap = row_shr_f<2>(1.0f, a[j]), bp = row_shr_f<2>(0.0f, b[j]); b[j] = a[j] * bp + b[j]; a[j] = a[j] * ap; }
#pragma unroll
                for (int j = 0; j < 8; ++j) { const float ap = row_shr_f<4>(1.0f, a[j]), bp = row_shr_f<4>(0.0f, b[j]); b[j] = a[j] * bp + b[j]; a[j] = a[j] * ap; }
#pragma unroll
                for (int j = 0; j < 8; ++j) { const float ap = row_shr_f<8>(1.0f, a[j]), bp = row_shr_f<8>(0.0f, b[j]); b[j] = a[j] * bp + b[j]; a[j] = a[j] * ap; }
                float hl[8], pc[8];
#pragma unroll
                for (int j = 0; j < 8; ++j) {
                    const float at = __shfl(a[j], lane15), bt = __shfl(b[j], lane15);
                    hl[j] = b[j] + a[j] * Hc[j]; pc[j] = a[j] * Ac[j];
                    Hc[j] = bt + at * Hc[j]; Ac[j] = at * Ac[j];
                }
                u32x4 w; w.x = pk2(hl[0], hl[1]); w.y = pk2(hl[2], hl[3]); w.z = pk2(hl[4], hl[5]); w.w = pk2(hl[6], hl[7]);
                *(u32x4*)(HL + off) = w;
                w.x = pk2(pc[0], pc[1]); w.y = pk2(pc[2], pc[3]); w.z = pk2(pc[4], pc[5]); w.w = pk2(pc[6], pc[7]);
                *(u32x4*)(PC + off) = w;
            }
        if (fr == 0) {
            float* pp = PEND + (size_t)chunk * 1024 + ch; float* hp = HEND + (size_t)chunk * 1024 + ch;
            *(f32x4*)pp = (f32x4){Ac[0], Ac[1], Ac[2], Ac[3]}; *(f32x4*)(pp + 4) = (f32x4){Ac[4], Ac[5], Ac[6], Ac[7]};
            *(f32x4*)hp = (f32x4){Hc[0], Hc[1], Hc[2], Hc[3]}; *(f32x4*)(hp + 4) = (f32x4){Hc[4], Hc[5], Hc[6], Hc[7]};
        }
    }
};
struct EpiBf16 {
    static constexpr bool PERM = true, AFTER_DRAIN = false, AROWS = false, I8 = false;
    bf16_t* O; int ldc;
    __device__ __forceinline__ void operator()(const f32x4 (&acc)[2][2][4][2], const Unit& u, int, int, int, int) const {
        int t_ = threadIdx.x; asm volatile("" : "+v"(t_)); const int fr = t_ & 15, fq = (t_ >> 4) & 3, wc = (t_ >> 6) & 3, wr = t_ >> 8;
        const int row0 = u.pm * BM + wr * 64 + fr, col0 = u.pn * BM + wc * 32 + 8 * fq;
#pragma unroll
        for (int ai = 0; ai < 2; ++ai)
#pragma unroll
            for (int m = 0; m < 4; ++m) {
                bf16_t* rowp = O + (size_t)(row0 + ai * HALF + m * 16) * ldc + col0;
#pragma unroll
                for (int bj = 0; bj < 2; ++bj) {
                    const f32x4 v0 = acc[ai][bj][m][0], v1 = acc[ai][bj][m][1];
                    u32x4 w; w.x = pk2(v0[0], v0[1]); w.y = pk2(v0[2], v0[3]); w.z = pk2(v1[0], v1[1]); w.w = pk2(v1[2], v1[3]);
                    *(u32x4*)(rowp + bj * HALF) = w;
                }
            }
    }
};
struct EpiResid {
    static constexpr bool PERM = true, AFTER_DRAIN = false, AROWS = false, I8 = false;
    const bf16_t* X; bf16_t* Z; int ldc; float alpha; float* PART;
    __device__ __forceinline__ void operator()(const f32x4 (&acc)[2][2][4][2], const Unit& u, int, int, int, int) const {
        int t_ = threadIdx.x; asm volatile("" : "+v"(t_)); const int fr = t_ & 15, fq = (t_ >> 4) & 3, wc = (t_ >> 6) & 3, wr = t_ >> 8;
        const int row0 = u.pm * BM + wr * 64 + fr, col0 = u.pn * BM + wc * 32 + 8 * fq;
#pragma unroll
        for (int ai = 0; ai < 2; ++ai)
#pragma unroll
            for (int m = 0; m < 4; ++m) {
                const int row = row0 + ai * HALF + m * 16;
                const size_t off = (size_t)row * ldc + col0;
                float s1 = 0.f, s2 = 0.f;
#pragma unroll
                for (int bj = 0; bj < 2; ++bj) {
                    const u32x4 xw = *(const u32x4*)(X + off + bj * HALF);
                    const f32x4 x0 = (f32x4){bf_lo(xw.x), bf_hi(xw.x), bf_lo(xw.y), bf_hi(xw.y)}, x1 = (f32x4){bf_lo(xw.z), bf_hi(xw.z), bf_lo(xw.w), bf_hi(xw.w)};
                    const f32x4 z0 = x0 * alpha + acc[ai][bj][m][0], z1 = x1 * alpha + acc[ai][bj][m][1];
                    u32x4 w; w.x = pk2(z0[0], z0[1]); w.y = pk2(z0[2], z0[3]); w.z = pk2(z1[0], z1[1]); w.w = pk2(z1[2], z1[3]);
                    *(u32x4*)(Z + off + bj * HALF) = w;
#pragma unroll
                    for (int j = 0; j < 4; ++j) { s1 += z0[j] + z1[j]; s2 += z0[j] * z0[j] + z1[j] * z1[j]; }
                }
                s1 += __shfl_xor(s1, 16); s2 += __shfl_xor(s2, 16); s1 += __shfl_xor(s1, 32); s2 += __shfl_xor(s2, 32);
                if (fq == 0) *(f32x2*)(PART + ((size_t)row * 16 + u.pn * 4 + wc) * 2) = (f32x2){s1, s2};
            }
    }
};
struct EpiQ {
    static constexpr bool PERM = true, AFTER_DRAIN = false, AROWS = false, I8 = false;
    bf16_t* O; int ldc; const float* cq; const float* dq; const PG8_LAS float* tab; StaticOrder S;
    __device__ __forceinline__ void operator()(const f32x4 (&acc)[2][2][4][2], const Unit& u, int, int, int, int) const {
        int t_ = threadIdx.x; asm volatile("" : "+v"(t_)); const int fr = t_ & 15, fq = (t_ >> 4) & 3, wc = (t_ >> 6) & 3, wr = t_ >> 8;
        int ord = 0;
#pragma unroll
        for (int i = 1; i < 4; ++i) { Unit v; if (S.next(i, v) && v.pm == u.pm && v.pn == u.pn) ord = i; }
        const int rl0 = wr * 64 + fr, col0 = u.pn * BM + wc * 32 + 8 * fq;
        f32x4 cv[2][2], dv[2][2];
#pragma unroll
        for (int bj = 0; bj < 2; ++bj)
#pragma unroll
            for (int n = 0; n < 2; ++n) { cv[bj][n] = *(const f32x4*)(cq + col0 + bj * HALF + 4 * n); dv[bj][n] = *(const f32x4*)(dq + col0 + bj * HALF + 4 * n); }
#pragma unroll
        for (int ai = 0; ai < 2; ++ai)
#pragma unroll
            for (int m = 0; m < 4; ++m) {
                const int rl = rl0 + ai * HALF + m * 16;
                const float mean = tab[(ord * 256 + rl) * 2], rstd = tab[(ord * 256 + rl) * 2 + 1];
                bf16_t* rowp = O + (size_t)(u.pm * BM + rl) * ldc + col0;
#pragma unroll
                for (int bj = 0; bj < 2; ++bj) {
                    const f32x4 v0 = (acc[ai][bj][m][0] - cv[bj][0] * mean) * rstd + dv[bj][0], v1 = (acc[ai][bj][m][1] - cv[bj][1] * mean) * rstd + dv[bj][1];
                    u32x4 w; w.x = pk2(v0[0], v0[1]); w.y = pk2(v0[2], v0[3]); w.z = pk2(v1[0], v1[1]); w.w = pk2(v1[2], v1[3]);
                    *(u32x4*)(rowp + bj * HALF) = w;
                }
            }
    }
};
struct EpiBf16I8 {
    static constexpr bool PERM = true, AFTER_DRAIN = false, AROWS = false, I8 = true;
    bf16_t* O; int ldc; const float* sxr; const float* swc;
    __device__ __forceinline__ void operator()(const f32x4 (&acc)[2][2][4][2], const Unit& u, int, int, int, int) const {
        int t_ = threadIdx.x; asm volatile("" : "+v"(t_)); const int fr = t_ & 15, fq = (t_ >> 4) & 3, wc = (t_ >> 6) & 3, wr = t_ >> 8;
        const int row0 = u.pm * BM + wr * 64 + fr, col0 = u.pn * BM + wc * 32 + 8 * fq;
        const f32x4 w00 = *(const f32x4*)(swc + col0), w01 = *(const f32x4*)(swc + col0 + 4), w10 = *(const f32x4*)(swc + col0 + HALF), w11 = *(const f32x4*)(swc + col0 + HALF + 4);
#define EPI_I2F(v, w, s) ((f32x4){(float)__builtin_bit_cast(i32x4_, v)[0], (float)__builtin_bit_cast(i32x4_, v)[1], (float)__builtin_bit_cast(i32x4_, v)[2], (float)__builtin_bit_cast(i32x4_, v)[3]} * (w) * (s))
#pragma unroll
        for (int ai = 0; ai < 2; ++ai)
#pragma unroll
            for (int m = 0; m < 4; ++m) {
                const int row = row0 + ai * HALF + m * 16; const float sx = sxr[row];
                bf16_t* rowp = O + (size_t)row * ldc + col0;
                { const f32x4 v0 = EPI_I2F(acc[ai][0][m][0], w00, sx), v1 = EPI_I2F(acc[ai][0][m][1], w01, sx);
                  u32x4 w; w.x = pk2(v0[0], v0[1]); w.y = pk2(v0[2], v0[3]); w.z = pk2(v1[0], v1[1]); w.w = pk2(v1[2], v1[3]); *(u32x4*)rowp = w; }
                { const f32x4 v0 = EPI_I2F(acc[ai][1][m][0], w10, sx), v1 = EPI_I2F(acc[ai][1][m][1], w11, sx);
                  u32x4 w; w.x = pk2(v0[0], v0[1]); w.y = pk2(v0[2], v0[3]); w.z = pk2(v1[0], v1[1]); w.w = pk2(v1[2], v1[3]); *(u32x4*)(rowp + HALF) = w; }
            }
#undef EPI_I2F
    }
};
template <class Epi, class Sched, bool ALIGN_EPI = false, bool SP2 = false>
__device__ __forceinline__ void gemm_phase(PG8_LAS unsigned char* lds, const Gemm g, const Sched& S, const Epi& E) {
    int tid_ = threadIdx.x; asm volatile("" : "+v"(tid_)); const int tid = tid_, wid = __builtin_amdgcn_readfirstlane(tid >> 6), lane = tid & 63, wr = wid >> 2, wc = wid & 3, fr = lane & 15, fq = lane >> 4;
    const int K = g.K, nt = K / BK;
    unsigned voffA[2], voffB[2];
#pragma unroll
    for (int i = 0; i < 2; ++i) { int R, C; stage_rc(tid * 16 + i * 8192, R, C); const int Rb = Epi::PERM ? ((R & ~31) + perm32(R & 31)) : R;
        const int Ra = Epi::AROWS ? ((R >> 6) * 128 + (R & 63)) : R;
        voffA[i] = (unsigned)(Ra * g.lda + C) * 2u; voffB[i] = (unsigned)(Rb * g.ldb + C) * 2u; }
    const size_t kstep = (size_t)(BK * 2);
    const size_t hstepA = (size_t)(Epi::AROWS ? 64 : HALF) * g.lda * 2, hstepB = (size_t)HALF * g.ldb * 2;
    const size_t tstepA = (size_t)2 * HALF * g.lda * 2, tstepB = 2 * hstepB;
    const unsigned ldsw = (unsigned)wid * 1024u;
    const int aoff = lds_byte(wr * 64 + fr, fq * 8), boff = lds_byte(wc * 32 + fr, fq * 8);
#define PG8_SA(b, h) (((b) * 2 + (h)) * HTB)
#define PG8_SB(b, h) ((4 + (b) * 2 + (h)) * HTB)
#define PG8_STAGE(bufoff, gbase, voff) do { _Pragma("unroll") for (int _i = 0; _i < 2; ++_i) \
        __builtin_amdgcn_global_load_lds((const unsigned*)((const char*)(gbase) + (voff)[_i]), (PG8_LAS unsigned*)(lds + (bufoff) + ldsw + _i * 8192), 16, 0, 0); } while (0)
#define PG8_LDA(dst, b, h) do { _Pragma("unroll") for (int m = 0; m < 4; ++m) _Pragma("unroll") for (int k = 0; k < 2; ++k) dst[m][k] = *(const PG8_LAS bf16x8*)(lds + PG8_SA(b, h) + aoff + m * 2048 + k * 1024); } while (0)
#define PG8_LDB(dst, b, h) do { _Pragma("unroll") for (int n = 0; n < 2; ++n) _Pragma("unroll") for (int k = 0; k < 2; ++k) dst[n][k] = *(const PG8_LAS bf16x8*)(lds + PG8_SB(b, h) + boff + n * 2048 + k * 1024); } while (0)
#define PG8_MMA(ai, bj, At, Bt) do { __builtin_amdgcn_s_setprio(1); _Pragma("unroll") for (int m = 0; m < 4; ++m) _Pragma("unroll") for (int n = 0; n < 2; ++n) _Pragma("unroll") for (int k = 0; k < 2; ++k) \
        { if constexpr (Epi::I8) acc[ai][bj][m][n] = __builtin_bit_cast(f32x4, __builtin_amdgcn_mfma_i32_16x16x64_i8(__builtin_bit_cast(i32x4_, Bt[n][k]), __builtin_bit_cast(i32x4_, At[m][k]), __builtin_bit_cast(i32x4_, acc[ai][bj][m][n]), 0, 0, 0)); \
          else acc[ai][bj][m][n] = __builtin_amdgcn_mfma_f32_16x16x32_bf16(Bt[n][k], At[m][k], acc[ai][bj][m][n], 0, 0, 0); } __builtin_amdgcn_s_setprio(0); } while (0)
#define PG8_WAIT_V(n) asm volatile("s_waitcnt vmcnt(" #n ")" ::: "memory")
#define PG8_WAIT_L(n) asm volatile("s_waitcnt lgkmcnt(" #n ")" ::: "memory")
#define PG8_BAR __builtin_amdgcn_s_barrier()
#define PG8_SCHED __builtin_amdgcn_sched_barrier(0)
    Unit cur, nxt; int ui = 0;
    if (!S.next(0, cur)) return;
    f32x4 acc[2][2][4][2];
#pragma unroll
    for (int a = 0; a < 2; ++a)
#pragma unroll
        for (int b = 0; b < 2; ++b)
#pragma unroll
            for (int m = 0; m < 4; ++m)
#pragma unroll
                for (int n = 0; n < 2; ++n) acc[a][b][m][n] = (f32x4){0.f, 0.f, 0.f, 0.f};
    bf16x8 At[4][2], B0[2][2], B1[2][2];
    const char* cA = (const char*)g.A + (size_t)cur.pm * tstepA + (size_t)cur.pn * g.a_pn_bytes; const char* cB = (const char*)g.Bt + (size_t)cur.pn * tstepB;
    S.a_ready(cur);
    if constexpr (SP2) {
        PG8_STAGE(PG8_SB(0, 0), cB, voffB); PG8_STAGE(PG8_SB(0, 1), cB + hstepB, voffB); PG8_STAGE(PG8_SA(0, 0), cA, voffA); PG8_STAGE(PG8_SA(0, 1), cA + hstepA, voffA);
        if (wr == 1) PG8_BAR;
        PG8_WAIT_V(2); PG8_BAR;
        PG8_STAGE(PG8_SB(1, 0), cB + kstep, voffB); PG8_STAGE(PG8_SA(1, 0), cA + kstep, voffA); PG8_STAGE(PG8_SB(1, 1), cB + hstepB + kstep, voffB);
        PG8_WAIT_V(6); PG8_BAR;
    } else {
        PG8_STAGE(PG8_SB(0, 0), cB, voffB); PG8_STAGE(PG8_SA(0, 0), cA, voffA); PG8_STAGE(PG8_SB(0, 1), cB + hstepB, voffB); PG8_STAGE(PG8_SA(0, 1), cA + hstepA, voffA);
        if (wr == 1) PG8_BAR;
        PG8_WAIT_V(4); PG8_BAR;
        PG8_STAGE(PG8_SB(1, 0), cB + kstep, voffB); PG8_STAGE(PG8_SA(1, 0), cA + kstep, voffA); PG8_STAGE(PG8_SB(1, 1), cB + hstepB + kstep, voffB);
        PG8_WAIT_V(6); PG8_BAR;
    }
    for (;;) {
        const bool has_next = S.next(ui + 1, nxt);
        const char* nA = has_next ? (const char*)g.A + (size_t)nxt.pm * tstepA + (size_t)nxt.pn * g.a_pn_bytes : cA; const char* nB = has_next ? (const char*)g.Bt + (size_t)nxt.pn * tstepB : cB;
        for (int t = 0; t < nt; t += 2) {
            const bool last = (t == nt - 2);
            const char* a1 = cA + (size_t)(t + 1) * kstep;
            const char* a2 = last ? nA : cA + (size_t)(t + 2) * kstep; const char* b2 = last ? nB : cB + (size_t)(t + 2) * kstep;
            const char* a3 = a2 + kstep; const char* b3 = b2 + kstep;
            if (last && has_next) S.a_ready(nxt);
            if constexpr (SP2) {
            PG8_LDB(B0, 0, 0); PG8_LDB(B1, 0, 1); PG8_SCHED; PG8_LDA(At, 0, 0); PG8_STAGE(PG8_SA(1, 1), a1 + hstepA, voffA);
            PG8_WAIT_V(8); PG8_WAIT_L(0); PG8_BAR; PG8_MMA(0, 0, At, B0); PG8_MMA(0, 1, At, B1); PG8_BAR; PG8_SCHED;
            PG8_LDA(At, 0, 1); PG8_STAGE(PG8_SB(0, 0), b2, voffB); PG8_STAGE(PG8_SB(0, 1), b2 + hstepB, voffB); PG8_STAGE(PG8_SA(0, 0), a2, voffA);
            PG8_WAIT_V(8); PG8_WAIT_L(0); PG8_BAR; PG8_MMA(1, 0, At, B0); PG8_MMA(1, 1, At, B1); PG8_BAR; PG8_SCHED;
            PG8_LDB(B0, 1, 0); PG8_LDB(B1, 1, 1); PG8_SCHED; PG8_LDA(At, 1, 0); PG8_STAGE(PG8_SA(0, 1), a2 + hstepA, voffA);
            PG8_WAIT_V(8); PG8_WAIT_L(0); PG8_BAR; PG8_MMA(0, 0, At, B0); PG8_MMA(0, 1, At, B1); PG8_BAR; PG8_SCHED;
            PG8_LDA(At, 1, 1); PG8_STAGE(PG8_SB(1, 0), b3, voffB); PG8_STAGE(PG8_SB(1, 1), b3 + hstepB, voffB); PG8_STAGE(PG8_SA(1, 0), a3, voffA);
            PG8_WAIT_V(8); PG8_WAIT_L(0); PG8_BAR; PG8_MMA(1, 0, At, B0); PG8_MMA(1, 1, At, B1); PG8_BAR; PG8_SCHED;
            } else {
            PG8_LDB(B0, 0, 0); PG8_SCHED; PG8_LDA(At, 0, 0); PG8_STAGE(PG8_SA(1, 1), a1 + hstepA, voffA);
            PG8_WAIT_L(8); PG8_BAR; PG8_WAIT_L(0); PG8_MMA(0, 0, At, B0); PG8_BAR; PG8_SCHED;
            PG8_LDB(B1, 0, 1); PG8_STAGE(PG8_SB(0, 0), b2, voffB);
            PG8_BAR; PG8_WAIT_L(0); PG8_MMA(0, 1, At, B1); PG8_BAR;
            PG8_LDA(At, 0, 1); PG8_STAGE(PG8_SA(0, 0), a2, voffA);
            PG8_BAR; PG8_WAIT_L(0); PG8_MMA(1, 0, At, B0); PG8_BAR; PG8_SCHED;
            PG8_STAGE(PG8_SB(0, 1), b2 + hstepB, voffB);
            PG8_WAIT_V(6); PG8_BAR; PG8_MMA(1, 1, At, B1); PG8_BAR;
            PG8_LDB(B0, 1, 0); PG8_SCHED; PG8_LDA(At, 1, 0); PG8_STAGE(PG8_SA(0, 1), a2 + hstepA, voffA);
            PG8_WAIT_L(8); PG8_BAR; PG8_WAIT_L(0); PG8_MMA(0, 0, At, B0); PG8_BAR; PG8_SCHED;
            PG8_LDB(B1, 1, 1); PG8_STAGE(PG8_SB(1, 0), b3, voffB);
            PG8_BAR; PG8_WAIT_L(0); PG8_MMA(0, 1, At, B1); PG8_BAR;
            PG8_LDA(At, 1, 1); PG8_STAGE(PG8_SA(1, 0), a3, voffA);
            PG8_BAR; PG8_WAIT_L(0); PG8_MMA(1, 0, At, B0); PG8_BAR; PG8_SCHED;
            PG8_STAGE(PG8_SB(1, 1), b3 + hstepB, voffB);
            PG8_WAIT_V(6); PG8_BAR; PG8_MMA(1, 1, At, B1); PG8_BAR;
            }
        }
        if constexpr (ALIGN_EPI) { if (wr == 0) PG8_BAR; }
        if constexpr (!Epi::AFTER_DRAIN) { E(acc, cur, wr, wc, fr, fq); S.done(cur); }
        if (!has_next) break;
#pragma unroll
        for (int a = 0; a < 2; ++a)
#pragma unroll
            for (int b = 0; b < 2; ++b)
#pragma unroll
                for (int m = 0; m < 4; ++m)
#pragma unroll
                    for (int n = 0; n < 2; ++n) acc[a][b][m][n] = (f32x4){0.f, 0.f, 0.f, 0.f};
        cur = nxt; cA = nA; cB = nB; ++ui;
        if constexpr (ALIGN_EPI) { if (wr == 1) PG8_BAR; }
    }
    PG8_WAIT_V(0);
    if constexpr (!ALIGN_EPI) { if (wr == 0) PG8_BAR; }
    PG8_BAR;
    if constexpr (Epi::AFTER_DRAIN) { E.fused(acc, cur, wr, wc, fr, fq, lds, wid, lane); S.done(cur); }
#undef PG8_SA
#undef PG8_SB
#undef PG8_STAGE
#undef PG8_LDA
#undef PG8_LDB
#undef PG8_MMA
#undef PG8_WAIT_V
#undef PG8_WAIT_L
#undef PG8_BAR
#undef PG8_SCHED
}
}

__device__ __forceinline__ void cvt_f32_bf16(const float* __restrict__ src, bf16* dst, size_t n8, size_t gtid, size_t gthreads) {
    for (size_t i = gtid; i < n8; i += gthreads) {
        const f32x4 a = ((const f32x4*)src)[2 * i], b = ((const f32x4*)src)[2 * i + 1];
        u32x4 o; o.x = pk2(a.x, a.y); o.y = pk2(a.z, a.w); o.z = pk2(b.x, b.y); o.w = pk2(b.z, b.w);
        ((u32x4*)dst)[i] = o;
    }
}
__device__ __forceinline__ void transpose_tile(const float* __restrict__ W, int ldw, bf16* WT, int ldt, int k0, int n0, int nd0, LAS float* s, int tid, float sc = 1.0f) {
    {
        const int kk = tid >> 3, c8 = (tid & 7) * 8;
        const float* p = W + (size_t)(k0 + kk) * ldw + n0 + c8;
        const f32x4 a = *(const f32x4*)p, b = *(const f32x4*)(p + 4);
        LAS float* q = s + kk * 65 + c8;
        q[0] = a.x; q[1] = a.y; q[2] = a.z; q[3] = a.w; q[4] = b.x; q[5] = b.y; q[6] = b.z; q[7] = b.w;
    }
    __syncthreads();
    {
        const int nn = tid >> 3, k8 = (tid & 7) * 8;
        const LAS float* q = s + k8 * 65 + nn;
        u32x4 o; o.x = pk2(q[0] * sc, q[65] * sc); o.y = pk2(q[2 * 65] * sc, q[3 * 65] * sc); o.z = pk2(q[4 * 65] * sc, q[5 * 65] * sc); o.w = pk2(q[6 * 65] * sc, q[7 * 65] * sc);
        *(u32x4*)(WT + (size_t)(nd0 + nn) * ldt + k0 + k8) = o;
    }
    __syncthreads();
}

template <int NR> __device__ __forceinline__ void quant_rows_i8(const float (&v)[NR][16], unsigned char* const (&dst)[NR], float* const (&scale_out)[NR], int lane) {
    float m[NR];
#pragma unroll
    for (int r = 0; r < NR; ++r) { m[r] = 0.f;
#pragma unroll
        for (int j = 0; j < 16; ++j) m[r] = fmaxf(m[r], fabsf(v[r][j])); }
#pragma unroll
    for (int o = 32; o >= 1; o >>= 1) {
#pragma unroll
        for (int r = 0; r < NR; ++r) m[r] = fmaxf(m[r], __shfl_xor(m[r], o));
    }
#pragma unroll
    for (int r = 0; r < NR; ++r) {
        const float scale = (m[r] > 0.f) ? m[r] * (1.0f / 127.0f) : 1.0f, inv = 1.0f / scale;
        u32x4 q;
#pragma unroll
        for (int w = 0; w < 4; ++w) {
            unsigned pk = 0;
#pragma unroll
            for (int k = 0; k < 4; ++k) { int qi = (int)rintf(v[r][4 * w + k] * inv); qi = qi < -127 ? -127 : (qi > 127 ? 127 : qi); pk |= (unsigned)(qi & 0xff) << (8 * k); }
            q[w] = pk;
        }
        *(u32x4*)(dst[r] + lane * 16) = q;
        if (lane == 0) *scale_out[r] = scale;
    }
}
struct Ctx {
    const float* in[23];
    float* out;
    unsigned char* ws;
};

__device__ __forceinline__ void quant_peer_tables(const Ctx& c, int gw, int NW, int lane) {
    unsigned char* ws = c.ws;
    for (int e2 = gw * 2; e2 < NEXP; e2 += NW * 2) {
        float v[4][16];
#pragma unroll
        for (int r = 0; r < 4; ++r) {
            const float* src = ((r & 2) ? c.in[20] : c.in[19]) + (size_t)(e2 + (r & 1)) * 1024 + lane * 16;
            const f32x4 a0 = *(const f32x4*)src, a1 = *(const f32x4*)(src + 4), a2 = *(const f32x4*)(src + 8), a3 = *(const f32x4*)(src + 12);
            v[r][0] = a0.x; v[r][1] = a0.y; v[r][2] = a0.z; v[r][3] = a0.w; v[r][4] = a1.x; v[r][5] = a1.y; v[r][6] = a1.z; v[r][7] = a1.w;
            v[r][8] = a2.x; v[r][9] = a2.y; v[r][10] = a2.z; v[r][11] = a2.w; v[r][12] = a3.x; v[r][13] = a3.y; v[r][14] = a3.z; v[r][15] = a3.w;
        }
        float s2[4];
#pragma unroll
        for (int r = 0; r < 4; ++r) { s2[r] = 0.f;
#pragma unroll
            for (int j = 0; j < 16; ++j) s2[r] += v[r][j] * v[r][j]; }
#pragma unroll
        for (int o = 32; o >= 1; o >>= 1) {
#pragma unroll
            for (int r = 0; r < 4; ++r) s2[r] += __shfl_xor(s2[r], o);
        }
#pragma unroll
        for (int x = 0; x < 2; ++x) {
            const float su = 0.335f * sqrtf(s2[x] * (1.0f / 1024.0f)) + 1e-30f, sv = 0.48f * sqrtf(s2[2 + x] * (1.0f / 1024.0f)) + 1e-30f;
            const float iu = 1.0f / su, iv = 1.0f / sv;
            unsigned w[4] = {0u, 0u, 0u, 0u};
#pragma unroll
            for (int k = 0; k < 16; ++k) {
                int q = (int)floorf(v[x][k] * iu); q = q < -8 ? -8 : (q > 7 ? 7 : q);
                w[k >> 3] |= (unsigned)(q & 15) << (4 * (k & 7));
                const float a = fabsf(v[2 + x][k]) * iv;
                unsigned m = (unsigned)(a > 0.25f) + (unsigned)(a > 0.75f) + (unsigned)(a > 1.25f) + (unsigned)(a > 1.75f) + (unsigned)(a > 2.5f) + (unsigned)(a > 3.5f) + (unsigned)(a > 5.0f);
                m |= (v[2 + x][k] < 0.f) ? 8u : 0u;
                w[2 + (k >> 3)] |= m << (4 * (k & 7));
            }
            *(u32x4*)(ws + WS_UQ + (size_t)(e2 + x) * 1024 + lane * 16) = (u32x4){w[0], w[1], w[2], w[3]};
            if (lane == 0) *(f32x2*)(ws + WS_USC + (size_t)(e2 + x) * 8) = (f32x2){su, sv};
        }
    }
}

__device__ __forceinline__ void phase0(const Ctx& c, LAS unsigned char* lds) {
    int tid_ = threadIdx.x; asm volatile("" : "+v"(tid_)); const int tid = tid_;
    const size_t gtid = (size_t)blockIdx.x * NTHR + tid, gthreads = (size_t)gridDim.x * NTHR;
    unsigned char* ws = c.ws;
    cvt_f32_bf16(c.in[18], (bf16*)(ws + WS_KEYS), (size_t)8 * 2 * 128 * 128 / 8, gtid, gthreads);
    {
        const int lane = tid & 63, gw = blockIdx.x * 8 + (tid >> 6), NW = gridDim.x * 8;
        for (int row4 = gw * 4; row4 < T; row4 += NW * 4) {
            float v[4][16]; unsigned char* dst[4]; float* sc[4];
#pragma unroll
            for (int r = 0; r < 4; ++r) {
                const float* src = c.in[0] + (size_t)(row4 + r) * 1024 + lane * 16;
                const f32x4 a0 = *(const f32x4*)src, a1 = *(const f32x4*)(src + 4), a2 = *(const f32x4*)(src + 8), a3 = *(const f32x4*)(src + 12);
                v[r][0] = a0.x; v[r][1] = a0.y; v[r][2] = a0.z; v[r][3] = a0.w; v[r][4] = a1.x; v[r][5] = a1.y; v[r][6] = a1.z; v[r][7] = a1.w;
                v[r][8] = a2.x; v[r][9] = a2.y; v[r][10] = a2.z; v[r][11] = a2.w; v[r][12] = a3.x; v[r][13] = a3.y; v[r][14] = a3.z; v[r][15] = a3.w;
                dst[r] = ws + WS_XQ8 + (size_t)(row4 + r) * 1024; sc[r] = (float*)(ws + WS_SXR) + row4 + r;
            }
            quant_rows_i8<4>(v, dst, sc, lane);
#pragma unroll
            for (int r = 0; r < 4; ++r) {
                u32x4 b0, b1;
#pragma unroll
                for (int j = 0; j < 4; ++j) { b0[j] = pk2(v[r][2 * j], v[r][2 * j + 1]); b1[j] = pk2(v[r][8 + 2 * j], v[r][8 + 2 * j + 1]); }
                bf16* xb = (bf16*)(ws + WS_XB) + (size_t)(row4 + r) * 1024 + lane * 16;
                *(u32x4*)xb = b0; *(u32x4*)(xb + 8) = b1;
            }
        }
    }
    {
        const float* wsrc = c.in[12]; bf16* wt = (bf16*)(ws + WS_WTRIL);
        for (size_t i = gtid; i < (size_t)8 * 128 * 128 / 8; i += gthreads) {
            const int e = (int)i * 8, s0 = e & 127, t = (e >> 7) & 127;
            const f32x4 a = ((const f32x4*)wsrc)[2 * i], b = ((const f32x4*)wsrc)[2 * i + 1];
            float v[8] = {a.x, a.y, a.z, a.w, b.x, b.y, b.z, b.w};
#pragma unroll
            for (int j = 0; j < 8; ++j) v[j] = (s0 + j <= t) ? v[j] : 0.f;
            u32x4 o; o.x = pk2(v[0], v[1]); o.y = pk2(v[2], v[3]); o.z = pk2(v[4], v[5]); o.w = pk2(v[6], v[7]);
            ((u32x4*)wt)[i] = o;
        }
    }
    if (gtid < 1024) { const float lam = c.in[9][gtid]; ((float*)(ws + WS_SPT))[gtid] = 8.0f * NLOG2E * log1pf(expf(-lam));
                       ((float*)(ws + WS_BAS))[gtid] = NLOG2E * c.in[6][gtid]; ((float*)(ws + WS_BXS))[gtid] = NLOG2E * c.in[8][gtid]; }
    if (gtid < 2048) ((float*)(ws + WS_BGS))[gtid] = NLOG2E * c.in[2][gtid];
    {
        LAS float* s = (LAS float*)lds;
        constexpr int N_IN = 16 * 96, N_OUT = 16 * 16, N_Q = 16 * 32, N_G = 64, N_ALL = N_IN + N_OUT + N_Q + N_G;
        for (int it = blockIdx.x; it < N_ALL; it += gridDim.x) {
            int r = it;
            if (r < N_IN) {
                const int n0 = (r % 96) * 64, sec = n0 >> 10, kg = (n0 & 1023) >> 7, j0 = n0 & 127;
                const int ty = (sec == 0 || sec == 3) ? 0 : ((sec == 1 || sec == 4) ? 1 : 2), half = sec >= 3;
                transpose_tile(c.in[1], DIN, (bf16*)(ws + WS_WIN), 1024, (r / 96) * 64, n0, (3 * kg + ty) * 256 + half * 128 + j0, s, tid, sec >= 4 ? NLOG2E : 1.0f); continue;
            }
            r -= N_IN;
            if (r < N_OUT) { transpose_tile(c.in[14], 1024, (bf16*)(ws + WS_WOUT), 1024, (r / 16) * 64, (r % 16) * 64, (r % 16) * 64, s, tid); continue; }
            r -= N_OUT;
            if (r < N_Q) {
                const int k0 = (r / 32) * 64, n0 = (r % 32) * 64;
                {
                    const int kk = tid >> 3, c8 = (tid & 7) * 8;
                    const float* p = c.in[17] + (size_t)(k0 + kk) * 2048 + n0 + c8;
                    const f32x4 a = *(const f32x4*)p, b = *(const f32x4*)(p + 4);
                    LAS float* q = s + kk * 65 + c8;
                    q[0] = a.x; q[1] = a.y; q[2] = a.z; q[3] = a.w; q[4] = b.x; q[5] = b.y; q[6] = b.z; q[7] = b.w;
                }
                __syncthreads();
                if (tid < 64) {
                    float pc = 0.f, pd = 0.f;
                    for (int kk = 0; kk < 64; ++kk) { const float w = s[kk * 65 + tid]; pc += c.in[15][k0 + kk] * w; pd += c.in[16][k0 + kk] * w; }
                    float* part = (float*)(ws + WS_PARTCD) + (size_t)(r / 32) * 4096;
                    part[n0 + tid] = pc; part[2048 + n0 + tid] = pd;
                }
                {
                    const int nn = tid >> 3, k8 = (tid & 7) * 8;
                    const LAS float* q = s + k8 * 65 + nn;
                    const float* g = c.in[15] + k0 + k8;
                    u32x4 o; o.x = pk2(q[0] * g[0], q[65] * g[1]); o.y = pk2(q[2 * 65] * g[2], q[3 * 65] * g[3]); o.z = pk2(q[4 * 65] * g[4], q[5 * 65] * g[5]); o.w = pk2(q[6 * 65] * g[6], q[7 * 65] * g[7]);
                    *(u32x4*)((bf16*)(ws + WS_WQ) + (size_t)(n0 + nn) * 1024 + k0 + k8) = o;
                }
                __syncthreads();
                continue;
            }
            r -= N_Q;
            {
                const int h = r >> 3, g = (r >> 2) & 1, kb = (r >> 1) & 1, nb = r & 1;
                const float* W = (g ? c.in[7] : c.in[5]) + (size_t)h * 128 * 128;
                transpose_tile(W, 128, (bf16*)(ws + WS_WAX) + (size_t)h * 256 * 128 + (size_t)g * 128 * 128, 128, kb * 64, nb * 64, nb * 64, s, tid, NLOG2E);
            }
        }
    }
}

__device__ __forceinline__ void phase0b(const Ctx& c) {
    int tid_ = threadIdx.x; asm volatile("" : "+v"(tid_)); const int tid = tid_, lane = tid & 63, wid = tid >> 6;
    unsigned char* ws = c.ws;
    const bf16* W = (const bf16*)(ws + WS_WIN);
    {
        const int gt = blockIdx.x * NTHR + tid;
        if (gt < 4096) {
            const float* part = (const float*)(ws + WS_PARTCD) + gt;
            float sacc = 0.f;
#pragma unroll
            for (int kb = 0; kb < 16; ++kb) sacc += part[(size_t)kb * 4096];
            ((float*)(ws + WS_CQ))[gt] = sacc;
        }
    }
    for (int row4 = (blockIdx.x * 8 + wid) * 4; row4 < DIN + (Q_I8 ? 2048 : 0); row4 += gridDim.x * 8 * 4) {
        float v[4][16]; unsigned char* dst[4]; float* sc[4];
#pragma unroll
        for (int r = 0; r < 4; ++r) {
            const int rw = row4 + r; const bool isq = rw >= DIN;
            const bf16* src = (isq ? (const bf16*)(ws + WS_WQ) + (size_t)(rw - DIN) * 1024 : W + (size_t)rw * 1024) + lane * 16;
            const u32x4 a = *(const u32x4*)src, b = *(const u32x4*)(src + 8);
#pragma unroll
            for (int j = 0; j < 4; ++j) { v[r][2 * j] = bf_lo(a[j]); v[r][2 * j + 1] = bf_hi(a[j]); v[r][8 + 2 * j] = bf_lo(b[j]); v[r][8 + 2 * j + 1] = bf_hi(b[j]); }
            dst[r] = isq ? ws + WS_WQQ8 + (size_t)(rw - DIN) * 1024 : ws + WS_WQ8 + (size_t)rw * 1024; sc[r] = isq ? (float*)(ws + WS_SWQ) + (rw - DIN) : (float*)(ws + WS_SWC) + rw;
        }
        quant_rows_i8<4>(v, dst, sc, lane);
    }
}

__device__ __forceinline__ void phase2a(const Ctx& c, const pg8::StaticOrder& S) {
    int tid_ = threadIdx.x; asm volatile("" : "+v"(tid_)); const int tid = tid_, lane = tid & 63, wid = tid >> 6;
    unsigned char* ws = c.ws;
    const bf16* P4 = (const bf16*)(ws + WS_P4); bf16* XC = (bf16*)c.out; float* STATS = (float*)(ws + WS_STATS);
    const float* conv_w = c.in[3]; const float* conv_b = c.in[4];
    for (int u0 = 0; ; u0 += 4) {
        pg8::Unit uu; bool any = false;
        { pg8::Unit tmp; any = S.next(u0, tmp); }
        if (!any) break;
        if (!S.next(u0 + (tid >> 7), uu)) continue;
        const int cg = tid & 15, run = uu.pm * 8 + ((tid & 127) >> 4), ch = uu.pn * 128 + cg * 8;
        float w[4][8], bias[8];
#pragma unroll
        for (int k = 0; k < 4; ++k) { const f32x4 a = *(const f32x4*)(conv_w + k * 1024 + ch), b = *(const f32x4*)(conv_w + k * 1024 + ch + 4);
            w[k][0] = a.x; w[k][1] = a.y; w[k][2] = a.z; w[k][3] = a.w; w[k][4] = b.x; w[k][5] = b.y; w[k][6] = b.z; w[k][7] = b.w; }
        { const f32x4 a = *(const f32x4*)(conv_b + ch), b = *(const f32x4*)(conv_b + ch + 4);
          bias[0] = a.x; bias[1] = a.y; bias[2] = a.z; bias[3] = a.w; bias[4] = b.x; bias[5] = b.y; bias[6] = b.z; bias[7] = b.w; }
        {
            const int t0 = run * 32; const bool first = (t0 & (SEQ - 1)) == 0;
            const bf16* src = P4 + (size_t)t0 * 4096 + ch;
            u32x4 x0 = (u32x4){0u, 0u, 0u, 0u}, x1 = x0, x2 = x0;
            if (!first) { x0 = *(const u32x4*)(src - 3 * 4096); x1 = *(const u32x4*)(src - 2 * 4096); x2 = *(const u32x4*)(src - 4096); }
#pragma unroll 8
            for (int t = 0; t < 32; ++t) {
                const u32x4 x3 = *(const u32x4*)(src + (size_t)t * 4096);
                float o[8];
#pragma unroll
                for (int j = 0; j < 8; ++j) {
                    const float v0 = (j & 1) ? bf_hi(x0[j >> 1]) : bf_lo(x0[j >> 1]), v1 = (j & 1) ? bf_hi(x1[j >> 1]) : bf_lo(x1[j >> 1]);
                    const float v2 = (j & 1) ? bf_hi(x2[j >> 1]) : bf_lo(x2[j >> 1]), v3 = (j & 1) ? bf_hi(x3[j >> 1]) : bf_lo(x3[j >> 1]);
                    o[j] = bias[j] + w[0][j] * v0 + w[1][j] * v1 + w[2][j] * v2 + w[3][j] * v3;
                }
                u32x4 pk; pk.x = pk2(o[0], o[1]); pk.y = pk2(o[2], o[3]); pk.z = pk2(o[4], o[5]); pk.w = pk2(o[6], o[7]);
                *(u32x4*)(XC + (size_t)(t0 + t) * 1024 + ch) = pk;
                x0 = x1; x1 = x2; x2 = x3;
            }
        }
    }
    for (int row4 = (blockIdx.x * 8 + wid) * 4; row4 < T; row4 += gridDim.x * 8 * 4) {
        u32x4 a[4], b[4];
#pragma unroll
        for (int r = 0; r < 4; ++r) { const bf16* p = P4 + (size_t)(row4 + r) * 4096 + 3072 + lane * 16; a[r] = *(const u32x4*)p; b[r] = *(const u32x4*)(p + 8); }
        float mean[4], q[4];
#pragma unroll
        for (int r = 0; r < 4; ++r) {
            float s = 0.f;
#pragma unroll
            for (int j = 0; j < 4; ++j) s += (bf_lo(a[r][j]) + bf_hi(a[r][j])) + (bf_lo(b[r][j]) + bf_hi(b[r][j]));
            mean[r] = s;
        }
#pragma unroll
        for (int o = 32; o >= 1; o >>= 1) {
#pragma unroll
            for (int r = 0; r < 4; ++r) mean[r] += __shfl_xor(mean[r], o);
        }
#pragma unroll
        for (int r = 0; r < 4; ++r) {
            mean[r] *= (1.0f / 1024.0f);
            float s = 0.f;
#pragma unroll
            for (int j = 0; j < 4; ++j) {
                const float d0 = bf_lo(a[r][j]) - mean[r], d1 = bf_hi(a[r][j]) - mean[r], d2 = bf_lo(b[r][j]) - mean[r], d3 = bf_hi(b[r][j]) - mean[r];
                s += (d0 * d0 + d1 * d1) + (d2 * d2 + d3 * d3);
            }
            q[r] = s;
        }
#pragma unroll
        for (int o = 32; o >= 1; o >>= 1) {
#pragma unroll
            for (int r = 0; r < 4; ++r) q[r] += __shfl_xor(q[r], o);
        }
        if (lane < 4) {
            const float mm = lane == 0 ? mean[0] : lane == 1 ? mean[1] : lane == 2 ? mean[2] : mean[3];
            const float qq = lane == 0 ? q[0] : lane == 1 ? q[1] : lane == 2 ? q[2] : q[3];
            *(f32x2*)(STATS + (size_t)(row4 + lane) * 2) = (f32x2){mm, rsqrtf(qq * (1.0f / 1024.0f) + LN_EPS)};
        }
    }
}

typedef short s16x4 __attribute__((ext_vector_type(4)));
struct P2cRegs { u32x4 v[4]; f32x2 st[4]; };
__device__ __forceinline__ void p2c_load_v(P2cRegs& R, const bf16* P4, const float* STATS, int tile, int h, int tid) {
    const int piece = tid & 15, rowb = tid >> 4;
#pragma unroll
    for (int j = 0; j < 4; ++j) {
        const size_t row = (size_t)(tile * CHUNK + rowb + 32 * j);
        R.v[j] = *(const u32x4*)(P4 + row * 4096 + 3072 + h * 128 + piece * 8);
        R.st[j] = *(const f32x2*)(STATS + row * 2);
    }
}
__device__ __forceinline__ void phase2c(const Ctx& c, LAS unsigned char* lds, const int outcol = 2048) {
    int tid_ = threadIdx.x; asm volatile("" : "+v"(tid_)); const int tid = tid_, lane = tid & 63, wid = __builtin_amdgcn_readfirstlane(tid >> 6), fr = lane & 15, fq = lane >> 4, wr = wid >> 1, wc = wid & 1;
    unsigned char* ws = c.ws;
    bf16* P4 = (bf16*)(ws + WS_P4); const float* STATS = (const float*)(ws + WS_STATS);
    const bf16* HL = (const bf16*)(ws + WS_HL); const bf16* PC = (const bf16*)((const unsigned char*)c.out + OUT_PC);
    const float* PEND = (const float*)(ws + WS_PEND); const float* HEND = (const float*)(ws + WS_HEND);
    LAS float* carry = (LAS float*)(lds + 65536);
    const bf16* WTRIL = (const bf16*)(ws + WS_WTRIL);
    const float* ln_g = c.in[10]; const float* ln_b = c.in[11]; const float* gm_bs = c.in[13];
    const int h = blockIdx.x & 7;
    bf16x8 wf[2][4];
#pragma unroll
    for (int m = 0; m < 2; ++m)
#pragma unroll
        for (int ks = 0; ks < 4; ++ks) wf[m][ks] = *(const bf16x8*)(WTRIL + (size_t)h * 128 * 128 + (32 * wr + 16 * m + fr) * 128 + ks * 32 + fq * 8);
    const int piece = tid & 15, rowb = tid >> 4;
    float lg[8], lb[8];
    { const f32x4 g0 = *(const f32x4*)(ln_g + h * 128 + piece * 8), g1 = *(const f32x4*)(ln_g + h * 128 + piece * 8 + 4), b0 = *(const f32x4*)(ln_b + h * 128 + piece * 8), b1 = *(const f32x4*)(ln_b + h * 128 + piece * 8 + 4);
#pragma unroll
      for (int j = 0; j < 4; ++j) { lg[j] = g0[j]; lg[4 + j] = g1[j]; lb[j] = b0[j]; lb[4 + j] = b1[j]; } }
    const int wr_off = rowb * 256 + ((piece ^ ((rowb & 3) << 2)) << 4);
    const bool wr_swap = ((rowb >> 3) & 1) != 0;
    const int q_ = fr >> 2, p_ = fr & 3;
    int rd_off[2][2];
#pragma unroll
    for (int n2 = 0; n2 < 2; ++n2)
#pragma unroll
        for (int np = 0; np < 2; ++np) rd_off[n2][np] = (fq * 8 + q_) * 256 + (((8 * wc + 4 * n2 + p_) ^ (q_ << 2)) << 4) + ((np ^ (fq & 1)) << 3);
    const int nblk_h = gridDim.x >> 3;
    const int tile0 = blockIdx.x >> 3;
    P2cRegs RA, RB;
    if (tile0 < NTILE) p2c_load_v(RA, P4, STATS, tile0, h, tid);
    if (tile0 + nblk_h < NTILE) p2c_load_v(RB, P4, STATS, tile0 + nblk_h, h, tid);
#define P2C_UNIT(R, tile, par) do { \
        const int t0 = (tile) * CHUNK; \
        LAS unsigned char* V = lds + (par) * 32768; \
        _Pragma("unroll") for (int j = 0; j < 4; ++j) { \
            const float mean = R.st[j].x, rstd = R.st[j].y; \
            u32x4 w; \
            _Pragma("unroll") for (int e = 0; e < 4; ++e) w[e] = pk2((bf_lo(R.v[j][e]) - mean) * rstd * lg[2 * e] + lb[2 * e], (bf_hi(R.v[j][e]) - mean) * rstd * lg[2 * e + 1] + lb[2 * e + 1]); \
            if (wr_swap) w = (u32x4){w.z, w.w, w.x, w.y}; \
            *(LAS u32x4*)(V + wr_off + j * 32 * 256) = w; } \
        if (tid < 128) {                                        \
            const int cidx_ = (tile) & (NCHUNK - 1), tb_ = (tile) - cidx_; float hin_ = 0.f; \
            _Pragma("unroll") for (int cc = 0; cc < NCHUNK - 1; ++cc) { \
                const bool on_ = cc < cidx_; const int tl_ = on_ ? tb_ + cc : tb_; \
                const float p_ = PEND[(size_t)tl_ * 1024 + h * 128 + tid], q_ = HEND[(size_t)tl_ * 1024 + h * 128 + tid]; \
                hin_ = on_ ? p_ * hin_ + q_ : hin_; } \
            carry[(par) * 128 + tid] = hin_; } \
        __syncthreads(); \
        if ((tile) + 2 * nblk_h < NTILE) p2c_load_v(R, P4, STATS, (tile) + 2 * nblk_h, h, tid); \
        u32x4 hlv[2][2], pcv[2][2], gvv[2][2], ugv[2][2]; \
        _Pragma("unroll") for (int m = 0; m < 2; ++m) _Pragma("unroll") for (int n2 = 0; n2 < 2; ++n2) { \
            const size_t row_ = (size_t)(t0 + 32 * wr + 16 * m + fr); const int col_ = h * 128 + 64 * wc + 32 * n2 + 8 * fq; \
            hlv[m][n2] = *(const u32x4*)(HL + row_ * 1024 + col_); pcv[m][n2] = *(const u32x4*)(PC + row_ * 1024 + col_); gvv[m][n2] = *(const u32x4*)(P4 + row_ * 4096 + 1024 + col_); ugv[m][n2] = *(const u32x4*)(P4 + row_ * 4096 + 2048 + col_); } \
        f32x4 acc[2][4]; \
        _Pragma("unroll") for (int m = 0; m < 2; ++m) _Pragma("unroll") for (int n = 0; n < 4; ++n) acc[m][n] = (f32x4){0.f, 0.f, 0.f, 0.f}; \
        _Pragma("unroll") for (int ks = 0; ks < 4; ++ks) { \
            if (ks <= wr) { \
                bf16x8 b[4]; \
                _Pragma("unroll") for (int n = 0; n < 4; ++n) { \
                    const s16x4 lo = __builtin_amdgcn_ds_read_tr16_b64_v4i16((LAS s16x4*)(V + rd_off[n >> 1][n & 1] + ks * 32 * 256)); \
                    const s16x4 hi = __builtin_amdgcn_ds_read_tr16_b64_v4i16((LAS s16x4*)(V + rd_off[n >> 1][n & 1] + ks * 32 * 256 + 4 * 256)); \
                    b[n] = __builtin_shufflevector(lo, hi, 0, 1, 2, 3, 4, 5, 6, 7); } \
                _Pragma("unroll") for (int m = 0; m < 2; ++m) _Pragma("unroll") for (int n = 0; n < 4; ++n) acc[m][n] = __builtin_amdgcn_mfma_f32_16x16x32_bf16(b[n], wf[m][ks], acc[m][n], 0, 0, 0); } } \
        _Pragma("unroll") for (int m = 0; m < 2; ++m) { \
            const int tl = 32 * wr + 16 * m + fr; \
            const float bsv = gm_bs[h * 128 + tl]; \
            _Pragma("unroll") for (int n2 = 0; n2 < 2; ++n2) { \
                const f32x4 m0 = acc[m][2 * n2] + bsv, m1 = acc[m][2 * n2 + 1] + bsv; \
                const u32x4 ug = ugv[m][n2], hl_ = hlv[m][n2], pc_ = pcv[m][n2], g_ = gvv[m][n2]; \
                const LAS float* cp_ = carry + (par) * 128 + 64 * wc + 32 * n2 + 8 * fq; \
                const f32x4 h0_ = *(const LAS f32x4*)cp_, h1_ = *(const LAS f32x4*)(cp_ + 4); \
                u32x4 o;                                             \
                o.x = pk2(bf_lo(g_.x) * (bf_lo(hl_.x) + bf_lo(pc_.x) * h0_[0]) + bf_lo(ug.x) * m0[0], bf_hi(g_.x) * (bf_hi(hl_.x) + bf_hi(pc_.x) * h0_[1]) + bf_hi(ug.x) * m0[1]); \
                o.y = pk2(bf_lo(g_.y) * (bf_lo(hl_.y) + bf_lo(pc_.y) * h0_[2]) + bf_lo(ug.y) * m0[2], bf_hi(g_.y) * (bf_hi(hl_.y) + bf_hi(pc_.y) * h0_[3]) + bf_hi(ug.y) * m0[3]); \
                o.z = pk2(bf_lo(g_.z) * (bf_lo(hl_.z) + bf_lo(pc_.z) * h1_[0]) + bf_lo(ug.z) * m1[0], bf_hi(g_.z) * (bf_hi(hl_.z) + bf_hi(pc_.z) * h1_[1]) + bf_hi(ug.z) * m1[1]); \
                o.w = pk2(bf_lo(g_.w) * (bf_lo(hl_.w) + bf_lo(pc_.w) * h1_[2]) + bf_lo(ug.w) * m1[2], bf_hi(g_.w) * (bf_hi(hl_.w) + bf_hi(pc_.w) * h1_[3]) + bf_hi(ug.w) * m1[3]); \
                *(u32x4*)(P4 + (size_t)(t0 + tl) * 4096 + outcol + h * 128 + 64 * wc + 32 * n2 + 8 * fq) = o; } } \
    } while (0)
    for (int tile = tile0; tile < NTILE; tile += 2 * nblk_h) {
        P2C_UNIT(RA, tile, 0);
        if (tile + nblk_h < NTILE) P2C_UNIT(RB, tile + nblk_h, 1);
    }
#undef P2C_UNIT
}


__device__ __forceinline__ int f2key(float f) { const int b = __float_as_int(f); return b ^ ((b >> 31) & 0x7fffffff); }
__device__ __forceinline__ float key2f(int k) { return __int_as_float(k ^ ((k >> 31) & 0x7fffffff)); }
#define CE_DESC(a, b) do { const int _mx = max((a), (b)), _mn = min((a), (b)); (a) = _mx; (b) = _mn; } while (0)

template <int OFF, int N> __device__ __forceinline__ void sort16_desc(int (&v)[N]) {
#pragma unroll
    for (int k = 2; k <= 16; k <<= 1) {
#pragma unroll
        for (int j = k >> 1; j > 0; j >>= 1) {
#pragma unroll
            for (int i = 0; i < 16; ++i) {
                const int l = i ^ j;
                if (l > i) { if ((i & k) == 0) CE_DESC(v[OFF + i], v[OFF + l]); else CE_DESC(v[OFF + l], v[OFF + i]); }
            }
        }
    }
}
template <int OA, int OB, int N> __device__ __forceinline__ void merge16_desc(int (&v)[N]) {
#pragma unroll
    for (int i = 0; i < 16; ++i) v[OA + i] = max(v[OA + i], v[OB + 15 - i]);
#pragma unroll
    for (int j = 8; j > 0; j >>= 1) {
#pragma unroll
        for (int i = 0; i < 16; ++i) { const int l = i ^ j; if (l > i) CE_DESC(v[OA + i], v[OA + l]); }
    }
}
__device__ __forceinline__ void top16_of_64(int (&v)[64]) {
    sort16_desc<0>(v); sort16_desc<16>(v); sort16_desc<32>(v); sort16_desc<48>(v);
    merge16_desc<0, 16>(v); merge16_desc<32, 48>(v); merge16_desc<0, 32>(v);
}
__device__ __forceinline__ void merge_partner(int (&L)[16]) {
    int P[16];
#pragma unroll
    for (int i = 0; i < 16; ++i) P[i] = __shfl_xor(L[i], 32);
#pragma unroll
    for (int i = 0; i < 16; ++i) L[i] = max(L[i], P[15 - i]);
#pragma unroll
    for (int j = 8; j > 0; j >>= 1) {
#pragma unroll
        for (int i = 0; i < 16; ++i) { const int l = i ^ j; if (l > i) CE_DESC(L[i], L[l]); }
    }
}
__device__ __forceinline__ unsigned lookup_byte(const unsigned (&t)[4], int i) {
    const int w = i >> 2;
    const unsigned dw = (w == 0) ? t[0] : (w == 1) ? t[1] : (w == 2) ? t[2] : t[3];
    return (dw >> ((i & 3) * 8)) & 0xffu;
}

typedef _Float16 h16x2 __attribute__((ext_vector_type(2)));
__device__ __forceinline__ unsigned pkh2(float lo, float hi) { return __builtin_bit_cast(unsigned, __builtin_amdgcn_cvt_pkrtz(lo, hi)); }
__device__ __forceinline__ float h_lo(unsigned w) { return (float)__builtin_bit_cast(h16x2, w)[0]; }
__device__ __forceinline__ float h_hi(unsigned w) { return (float)__builtin_bit_cast(h16x2, w)[1]; }
constexpr int P7_KP = 272;
__device__ __forceinline__ void phase7(const Ctx& c, LAS unsigned char* lds) {
    int tid_ = threadIdx.x; asm volatile("" : "+v"(tid_)); const int tid = tid_, lane = tid & 63, wid = __builtin_amdgcn_readfirstlane(tid >> 6), r = lane & 31, hh = lane >> 5;
    unsigned char* ws = c.ws;
    const bf16* Q = (const bf16*)c.out; const bf16* KB = (const bf16*)(ws + WS_KEYS);
    int* IDX = (int*)(ws + WS_IDX); float* GATE = (float*)(ws + WS_GATE);
    const int head = blockIdx.x & 7, nblk_h = gridDim.x >> 3;
    {
        const bf16* ksrc = KB + (size_t)head * 256 * 128;
        for (int i = tid; i < 256 * 16; i += NTHR) { const int row = i >> 4, sg = i & 15; *(LAS u32x4*)(lds + row * P7_KP + sg * 16) = *(const u32x4*)(ksrc + row * 128 + sg * 8); }
    }
    __syncthreads();
    const LAS unsigned char* kl = lds + r * P7_KP + hh * 16;
    if (wid & 1) quant_peer_tables(c, blockIdx.x * 8 + wid, gridDim.x * 8, lane);
    for (int grp = (blockIdx.x >> 3) * 8 + wid; grp < T / 32; grp += nblk_h * 8) {
        const int tok = grp * 32 + r;
        int kz = 0; asm volatile("" : "+v"(kz));
        const LAS unsigned char* klz = kl + kz;
        bf16x8 qf[2][8];
        {
            const bf16* qp = Q + (size_t)tok * 2048 + head * 256 + hh * 8;
#pragma unroll
            for (int p = 0; p < 2; ++p)
#pragma unroll
                for (int ks = 0; ks < 8; ++ks) qf[p][ks] = *(const bf16x8*)(qp + p * 128 + ks * 16);
        }
        int S[2][16];
#pragma unroll
        for (int p = 0; p < 2; ++p) {
            f32x16 acc[4];
#pragma unroll
            for (int mb = 0; mb < 4; ++mb)
#pragma unroll
                for (int e = 0; e < 16; ++e) acc[mb][e] = 0.f;
#pragma unroll
            for (int ks = 0; ks < 8; ++ks) {
#pragma unroll
                for (int mb = 0; mb < 4; ++mb) {
                    const bf16x8 a = *(const LAS bf16x8*)(klz + (p * 128 + mb * 32) * P7_KP + ks * 32);
                    acc[mb] = __builtin_amdgcn_mfma_f32_32x32x16_bf16(a, qf[p][ks], acc[mb], 0, 0, 0);
                }
            }
            int v[64];
#pragma unroll
            for (int mb = 0; mb < 4; ++mb)
#pragma unroll
                for (int e = 0; e < 16; ++e) {
                    const int n = mb * 32 + (e & 3) + 8 * (e >> 2);
                    v[mb * 16 + e] = (f2key(acc[mb][e]) & ~0x7f) | n;
                }
            top16_of_64(v);
            int L[16];
#pragma unroll
            for (int i = 0; i < 16; ++i) L[i] = v[i] | (hh << 2);
            merge_partner(L);
#pragma unroll
            for (int i = 0; i < 16; ++i) S[p][i] = L[i];
        }
        float f1[16], f2[16];
#pragma unroll
        for (int i = 0; i < 16; ++i) { f1[i] = key2f(S[0][i]); f2[i] = key2f(S[1][i]); }
        int cv[64];
        {
            int n = 0;
#pragma unroll
            for (int i = 0; i < 16; ++i)
#pragma unroll
                for (int j = 0; j < 16; ++j)
                    if ((i + 1) * (j + 1) <= 16) { cv[n] = (f2key(f1[i] + f2[j]) & ~0xff) | (i * 16 + j); ++n; }
#pragma unroll
            for (int q = 50; q < 64; ++q) cv[q] = (int)0x80000000;
        }
        top16_of_64(cv);
        unsigned t1[4], t2[4];
#pragma unroll
        for (int w = 0; w < 4; ++w) {
            t1[w] = (unsigned)(S[0][4 * w] & 0x7f) | ((unsigned)(S[0][4 * w + 1] & 0x7f) << 8) | ((unsigned)(S[0][4 * w + 2] & 0x7f) << 16) | ((unsigned)(S[0][4 * w + 3] & 0x7f) << 24);
            t2[w] = (unsigned)(S[1][4 * w] & 0x7f) | ((unsigned)(S[1][4 * w + 1] & 0x7f) << 8) | ((unsigned)(S[1][4 * w + 2] & 0x7f) << 16) | ((unsigned)(S[1][4 * w + 3] & 0x7f) << 24);
        }
        int eid[16]; float ev[16];
        const float vmax = key2f(cv[0]);
        float esum = 0.f;
#pragma unroll
        for (int k = 0; k < 16; ++k) {
            const int pos = cv[k] & 0xff;
            eid[k] = (int)(lookup_byte(t1, pos >> 4) * 128u + lookup_byte(t2, pos & 15));
            ev[k] = __expf(key2f(cv[k]) - vmax);
            esum += ev[k];
        }
        const float inv = 1.0f / esum;
        if (hh == 0) {
            i32x4* ip = (i32x4*)(IDX + (size_t)tok * 128 + head * 16); f32x4* gp = (f32x4*)(GATE + (size_t)tok * 128 + head * 16);
#pragma unroll
            for (int w = 0; w < 4; ++w) {
                ip[w] = (i32x4){eid[4 * w], eid[4 * w + 1], eid[4 * w + 2], eid[4 * w + 3]};
                gp[w] = (f32x4){ev[4 * w] * inv, ev[4 * w + 1] * inv, ev[4 * w + 2] * inv, ev[4 * w + 3] * inv};
            }
        }
    }
    if (!(wid & 1)) quant_peer_tables(c, blockIdx.x * 8 + wid, gridDim.x * 8, lane);
}

#define UB0(w) ((float)((w) & 0xffu))
#define UB1(w) ((float)(((w) >> 8) & 0xffu))
#define UB2(w) ((float)(((w) >> 16) & 0xffu))
#define UB3(w) ((float)((w) >> 24))
#ifndef P8_NSH_
#define P8_NSH_ 16
#endif
#ifndef P8_CH_
#define P8_CH_ 12
#endif
#ifndef P8_PACE_
#define P8_PACE_ 0
#endif
#ifndef P8_NT_
#define P8_NT_ 0
#endif
#if P8_NT_
#define P8_LD(p) __builtin_nontemporal_load(p)
#else
#define P8_LD(p) (*(p))
#endif
#ifndef P8_SYNC_
#define P8_SYNC_ 0
#endif
#ifndef P8_GSYNC_
#define P8_GSYNC_ 0
#endif
#ifndef P8_TOK_
#define P8_TOK_ 8
#endif
constexpr int P8_TOK = P8_TOK_, P8_LIST = 1024 + 512, P8_NSH = P8_NSH_, P8_CH = P8_CH_, P8_SHIFT = (P8_NSH_ == 64 ? 8 : (P8_NSH_ == 32 ? 9 : (P8_NSH_ == 16 ? 10 : (P8_NSH_ == 8 ? 11 : (P8_NSH_ == 4 ? 12 : (P8_NSH_ == 2 ? 13 : 14))))));
template <int CTRL> __device__ __forceinline__ float dppf(float v) { return __int_as_float(__builtin_amdgcn_update_dpp(0, __float_as_int(v), CTRL, 0xf, 0xf, false)); }
__device__ __forceinline__ float reduce16(const float (&p)[16], bool b3, bool b2) {
    float q8[8], r4[4], s2[2];
#pragma unroll
    for (int i = 0; i < 8; ++i) { const auto r = __builtin_amdgcn_permlane32_swap(__float_as_uint(p[i]), __float_as_uint(p[8 + i]), false, false); q8[i] = __uint_as_float(r[0]) + __uint_as_float(r[1]); }
#pragma unroll
    for (int i = 0; i < 4; ++i) { const auto r = __builtin_amdgcn_permlane16_swap(__float_as_uint(q8[i]), __float_as_uint(q8[4 + i]), false, false); r4[i] = __uint_as_float(r[0]) + __uint_as_float(r[1]); }
#pragma unroll
    for (int i = 0; i < 2; ++i) { const float ta = r4[i] + dppf<0x128>(r4[i]), tb = r4[2 + i] + dppf<0x128>(r4[2 + i]); s2[i] = b3 ? tb : ta; }
    const float ta = s2[0] + dppf<0x141>(s2[0]), tb = s2[1] + dppf<0x141>(s2[1]);
    float t = b2 ? tb : ta;
    t += dppf<0x4e>(t);
    t += dppf<0xb1>(t);
    return t;
}
#define P8_LOAD_X1(x, tok) do { \
        const bf16* zr_ = ZB + (size_t)(tok) * 1024 + lane * 16; \
        const u32x4 a0_ = *(const u32x4*)zr_, a1_ = *(const u32x4*)(zr_ + 8); \
        const f32x2 st_ = *(const f32x2*)(ST1 + (size_t)(tok) * 2); \
        _Pragma("unroll") for (int j = 0; j < 4; ++j) { x[2 * j] = bf_lo(a0_[j]); x[2 * j + 1] = bf_hi(a0_[j]); x[8 + 2 * j] = bf_lo(a1_[j]); x[8 + 2 * j + 1] = bf_hi(a1_[j]); } \
        _Pragma("unroll") for (int w = 0; w < 4; ++w) { \
            const f32x4 g_ = *(const f32x4*)(l1g + lane * 16 + 4 * w), b_ = *(const f32x4*)(l1b + lane * 16 + 4 * w); \
            _Pragma("unroll") for (int k = 0; k < 4; ++k) x[4 * w + k] = (x[4 * w + k] - st_.x) * st_.y * g_[k] + b_[k]; } \
    } while (0)
__device__ __forceinline__ void phase8(const Ctx& c, LAS unsigned char* lds, const XcdBarrier& xbar) {
    int tid_ = threadIdx.x; asm volatile("" : "+v"(tid_)); const int tid = tid_, lane = tid & 63, wid = __builtin_amdgcn_readfirstlane(tid >> 6);
    unsigned char* ws = c.ws;
    const bf16* ZB = (const bf16*)(ws + WS_Z); const float* ST1 = (const float*)(ws + WS_ST1); const float* l1g = c.in[15]; const float* l1b = c.in[16];
    const int* IDX = (const int*)(ws + WS_IDX); const float* GATE = (const float*)(ws + WS_GATE);
    const unsigned char* UV = ws + WS_UQ; const f32x2* SC = (const f32x2*)(ws + WS_USC);
    const float* lg = c.in[21]; const float* lb = c.in[22];
    float* OUT = c.out;
    const bool b3 = (lane & 8) != 0, b2 = (lane & 4) != 0;
    const int esub = lane >> 2;
    LAS unsigned char* wl = lds + wid * (P8_TOK * P8_LIST);
    const int ntl = (NTILE + gridDim.x - 1) / gridDim.x;
#if P8_PACE_
    if (lane == 0) ((volatile LAS int*)(lds + 8 * P8_TOK * P8_LIST))[wid] = 0;
    __syncthreads();
#endif
    for (int ti = 0; ti < ntl; ++ti) {
        const int tile = blockIdx.x + ti * gridDim.x; const bool live = tile < NTILE;
        for (int rnd = 0; rnd < 16 / P8_TOK; ++rnd) {
            if (P8_GSYNC_) xcd_barrier(xbar);
            const int tok0 = tile * CHUNK + wid * 16 + rnd * P8_TOK;
            int xq[P8_TOK][4]; float sx[P8_TOK], hoff[P8_TOK]; unsigned ob[P8_TOK][8];
            if (live) {
#pragma unroll
                for (int tt = 0; tt < P8_TOK; ++tt) {
                    const int tok = tok0 + tt;
                    {
                        float x[16];
                        P8_LOAD_X1(x, tok);
                        float m = 0.f;
#pragma unroll
                        for (int j = 0; j < 16; ++j) m = fmaxf(m, fabsf(x[j]));
#pragma unroll
                        for (int of = 32; of >= 1; of >>= 1) m = fmaxf(m, __shfl_xor(m, of));
                        const float sc = (m > 0.f) ? m * (1.0f / 119.0f) : 1.0f, inv = 1.0f / sc;
                        sx[tt] = sc;
                        unsigned xh0 = 0u, xh1 = 0u, xl0 = 0u, xl1 = 0u; int sm = 0;
#pragma unroll
                        for (int k = 0; k < 16; ++k) {
                            const int xi = (int)rintf(x[k] * inv), lo = ((xi + 8) & 15) - 8, hi = (xi - lo) >> 4;
                            sm += xi;
                            if (k < 8) { xh0 |= (unsigned)(hi & 15) << (4 * k); xl0 |= (unsigned)(lo & 15) << (4 * k); }
                            else { xh1 |= (unsigned)(hi & 15) << (4 * (k - 8)); xl1 |= (unsigned)(lo & 15) << (4 * (k - 8)); }
                        }
                        xq[tt][0] = (int)xh0; xq[tt][1] = (int)xh1; xq[tt][2] = (int)xl0; xq[tt][3] = (int)xl1;
                        hoff[tt] = 0.5f * wave_sum((float)sm);
                    }
#pragma unroll
                    for (int j = 0; j < 8; ++j) ob[tt][j] = 0u;
                    {
                        LAS unsigned char* L = wl + tt * P8_LIST;
                        const int i0 = IDX[(size_t)tok * 128 + lane], i1 = IDX[(size_t)tok * 128 + 64 + lane];
                        const float g0 = GATE[(size_t)tok * 128 + lane], g1 = GATE[(size_t)tok * 128 + 64 + lane];
                        const int k0 = i0 >> P8_SHIFT, k1 = i1 >> P8_SHIFT;
                        int base = 0, pos0 = 0, pos1 = 0;
#pragma unroll
                        for (int s = 0; s < P8_NSH; ++s) {
                            const unsigned long long m0 = __ballot(k0 == s), m1 = __ballot(k1 == s);
                            const int c0 = __popcll(m0), c1 = __popcll(m1);
                            const int pre0 = __builtin_amdgcn_mbcnt_hi((unsigned)(m0 >> 32), __builtin_amdgcn_mbcnt_lo((unsigned)m0, 0));
                            const int pre1 = __builtin_amdgcn_mbcnt_hi((unsigned)(m1 >> 32), __builtin_amdgcn_mbcnt_lo((unsigned)m1, 0));
                            pos0 = (k0 == s) ? base + pre0 : pos0;
                            pos1 = (k1 == s) ? base + c0 + pre1 : pos1;
                            if (lane == 0) *(LAS int*)(L + 1024 + 4 * s) = base;
                            base += c0 + c1;
                        }
                        if (lane == 0) *(LAS int*)(L + 1024 + 4 * P8_NSH) = base;
                        *(LAS u32x2*)(L + pos0 * 8) = (u32x2){(unsigned)i0, __float_as_uint(g0)};
                        *(LAS u32x2*)(L + pos1 * 8) = (u32x2){(unsigned)i1, __float_as_uint(g1)};
                    }
                }
            }
            for (int s = 0; s < P8_NSH; ++s) {
#if P8_PACE_
                {
                    volatile LAS int* prog = (volatile LAS int*)(lds + 8 * P8_TOK * P8_LIST);
                    const int mine = (ti * (16 / P8_TOK) + rnd) * P8_NSH + s;
                    if (lane == 0) prog[wid] = mine;
                    for (int spin = 0; spin < 4096; ++spin) {
                        int mn = prog[0];
#pragma unroll
                        for (int w = 1; w < 8; ++w) { const int pw = prog[w]; mn = pw < mn ? pw : mn; }
                        if (__builtin_amdgcn_readfirstlane(mn) + P8_PACE_ >= mine) break;
                        __builtin_amdgcn_s_sleep(8);
                    }
                }
#endif
                if (live) {
#pragma unroll
                    for (int tt = 0; tt < P8_TOK; ++tt) {
                        const LAS unsigned char* L = wl + tt * P8_LIST;
                        const int eb = __builtin_amdgcn_readfirstlane(*(const LAS int*)(L + 1024 + 4 * s)), ee = __builtin_amdgcn_readfirstlane(*(const LAS int*)(L + 1024 + 4 * s + 4));
                        for (int c0 = eb; c0 < ee; c0 += P8_CH) {
                            const int ent = c0 + esub; const bool valid = (esub < P8_CH) && (ent < ee);
                            const u32x2 en = *(const LAS u32x2*)(L + (valid ? ent : eb) * 8);
                            const int idv = (int)en.x; const float gv = valid ? __uint_as_float(en.y) : 0.f;
                            const f32x2 sc2 = SC[idv];
                            u32x4 w[P8_CH];
#pragma unroll
                            for (int e = 0; e < P8_CH; ++e) {
                                if (c0 + e < ee) {
                                    const int id = __builtin_amdgcn_readlane(idv, e * 4);
                                    w[e] = P8_LD((const u32x4*)(UV + (size_t)id * 1024 + lane * 16));
                                } else w[e] = (u32x4){0u, 0u, 0u, 0u};
                            }
                            float p[16];
#pragma unroll
                            for (int e = 0; e < 16; ++e) {
                                if (e < P8_CH) {
                                    const int ah = __builtin_amdgcn_sdot8((int)w[e].x, xq[tt][0], __builtin_amdgcn_sdot8((int)w[e].y, xq[tt][1], 0, false), false);
                                    const int al = __builtin_amdgcn_sdot8((int)w[e].x, xq[tt][2], __builtin_amdgcn_sdot8((int)w[e].y, xq[tt][3], 0, false), false);
                                    p[e] = (float)((ah << 4) + al);
                                } else p[e] = 0.f;
                            }
                            const float t1 = reduce16(p, b3, b2);
                            const float act = gelu_tanh((t1 + hoff[tt]) * sc2.x * sx[tt]) * gv * sc2.y;
                            f32x2 oc[8];
#pragma unroll
                            for (int j = 0; j < 8; ++j) oc[j] = (f32x2){h_lo(ob[tt][j]), h_hi(ob[tt][j])};
#pragma unroll
                            for (int e = 0; e < P8_CH; ++e) {
                                if (c0 + e < ee) {
                                    const float ae = __int_as_float(__builtin_amdgcn_readlane(__float_as_int(act), e * 4));
                                    const f32x2 aa = {ae, ae};
                                    oc[0] = __builtin_elementwise_fma(__builtin_amdgcn_cvt_scalef32_pk_f32_fp4(w[e].z, 1.0f, 0), aa, oc[0]);
                                    oc[1] = __builtin_elementwise_fma(__builtin_amdgcn_cvt_scalef32_pk_f32_fp4(w[e].z, 1.0f, 1), aa, oc[1]);
                                    oc[2] = __builtin_elementwise_fma(__builtin_amdgcn_cvt_scalef32_pk_f32_fp4(w[e].z, 1.0f, 2), aa, oc[2]);
                                    oc[3] = __builtin_elementwise_fma(__builtin_amdgcn_cvt_scalef32_pk_f32_fp4(w[e].z, 1.0f, 3), aa, oc[3]);
                                    oc[4] = __builtin_elementwise_fma(__builtin_amdgcn_cvt_scalef32_pk_f32_fp4(w[e].w, 1.0f, 0), aa, oc[4]);
                                    oc[5] = __builtin_elementwise_fma(__builtin_amdgcn_cvt_scalef32_pk_f32_fp4(w[e].w, 1.0f, 1), aa, oc[5]);
                                    oc[6] = __builtin_elementwise_fma(__builtin_amdgcn_cvt_scalef32_pk_f32_fp4(w[e].w, 1.0f, 2), aa, oc[6]);
                                    oc[7] = __builtin_elementwise_fma(__builtin_amdgcn_cvt_scalef32_pk_f32_fp4(w[e].w, 1.0f, 3), aa, oc[7]);
                                }
                            }
#pragma unroll
                            for (int j = 0; j < 8; ++j) ob[tt][j] = pkh2(oc[j].x, oc[j].y);
                        }
                    }
                }
                if (P8_SYNC_) __syncthreads();
            }
            if (live) {
#pragma unroll
                for (int tt = 0; tt < P8_TOK; ++tt) {
                    const int tok = tok0 + tt;
                    float x[16];
                    P8_LOAD_X1(x, tok);
                    float sm = 0.f;
                    float o[16];
#pragma unroll
                    for (int j = 0; j < 8; ++j) { o[2 * j] = h_lo(ob[tt][j]); o[2 * j + 1] = h_hi(ob[tt][j]); }
#pragma unroll
                    for (int j = 0; j < 16; ++j) { o[j] = ALPHA * x[j] + o[j]; sm += o[j]; }
                    const float mean = wave_sum(sm) * (1.0f / 1024.0f);
                    float qv = 0.f;
#pragma unroll
                    for (int j = 0; j < 16; ++j) { o[j] -= mean; qv += o[j] * o[j]; }
                    const float rstd = rsqrtf(wave_sum(qv) * (1.0f / 1024.0f) + LN_EPS);
                    const float* gp = lg + lane * 16; const float* bp = lb + lane * 16;
                    float* op = OUT + (size_t)tok * 1024 + lane * 16;
#pragma unroll
                    for (int w = 0; w < 4; ++w) {
                        const f32x4 gg = *(const f32x4*)(gp + 4 * w), hb = *(const f32x4*)(bp + 4 * w);
                        *(f32x4*)(op + 4 * w) = (f32x4){o[4 * w], o[4 * w + 1], o[4 * w + 2], o[4 * w + 3]} * rstd * gg + hb;
                    }
                }
            }
        }
    }
}

struct Params { const float* in[23]; float* out; unsigned char* ws; };

__global__ void __launch_bounds__(NTHR, 2) hybrid_fwd(Params p) {
    extern __shared__ __attribute__((aligned(16))) unsigned char lds_raw[];
    LAS unsigned char* lds = (LAS unsigned char*)lds_raw;
    cg::grid_group grid = cg::this_grid();
    Ctx c;
#pragma unroll
    for (int i = 0; i < 23; ++i) c.in[i] = p.in[i];
    c.out = p.out; c.ws = p.ws;
    unsigned char* ws = p.ws;

#ifndef G6_ALIGN
#define G6_ALIGN true
#endif
#ifndef G4_ALIGN
#define G4_ALIGN true
#endif
#ifndef G1_ALIGN
#define G1_ALIGN true
#endif
#ifndef G1_SP2
#define G1_SP2 true
#endif
#ifndef PH_MASK
#define PH_MASK 0x1ff
#endif
#ifndef REP0
#define REP0 1
#endif
#ifndef REP123
#define REP123 1
#endif
#ifndef REP1
#define REP1 1
#endif
#ifndef REP4
#define REP4 1
#endif
#ifndef REP5
#define REP5 1
#endif
#ifndef REP6
#define REP6 1
#endif
#ifndef REP7
#define REP7 1
#endif
#ifndef REP8
#define REP8 1
#endif
    if (threadIdx.x < 4) ((volatile LAS unsigned*)(lds + LDS_BARST))[threadIdx.x] = 0u;
    __syncthreads();
    const XcdBarrier xbar = xcd_barrier_post((unsigned*)(ws + WS_BAR), (volatile LAS unsigned*)(lds + LDS_BARST));
    if (p.ws == nullptr) grid.sync();
#define GSYNC() xcd_barrier(xbar)
    for (int rep = 0; rep < REP0; ++rep) { if (PH_MASK & 1) phase0(c, lds);
    GSYNC(); }
    if (PH_MASK & 1) phase0b(c);
    GSYNC();
    for (int rep123 = 0; rep123 < REP123; ++rep123) {
    for (int rep1 = 0; rep1 < REP1; ++rep1) {
    if (PH_MASK & 2) {
        pg8::Gemm g{(const bf16*)(ws + WS_XQ8), (const bf16*)(ws + WS_WQ8), T, DIN, 512, 512, 512, 0};
        pg8::StaticOrder S; S.init(T, DIN, (int)gridDim.x, (int)blockIdx.x);
        pg8::EpiProj E{(bf16*)(ws + WS_P4), (const float*)(ws + WS_BGS), (const float*)(ws + WS_SXR), (const float*)(ws + WS_SWC)};
        pg8::gemm_phase<pg8::EpiProj, pg8::StaticOrder, G1_ALIGN, G1_SP2>(lds, g, S, E);
    }
    GSYNC(); }
#ifndef REP2A
#define REP2A 1
#endif
#ifndef REP2B
#define REP2B 1
#endif
#ifndef REP3A
#define REP3A 1
#endif
    for (int r2 = 0; r2 < REP2B; ++r2) {
    if (PH_MASK & 4) {
        pg8::Gemm g{(const bf16*)p.out, (const bf16*)(ws + WS_WAX), T, 2048, 128, 1024, 128, 256};
        pg8::StaticOrder S; S.init(T, 2048, (int)gridDim.x, (int)blockIdx.x);
        phase2a(c, S);
        asm volatile("s_waitcnt vmcnt(0)" ::: "memory");
        __syncthreads();
        pg8::EpiGate E{(const bf16*)p.out, (bf16*)(ws + WS_HL), (bf16*)((unsigned char*)p.out + OUT_PC), (float*)(ws + WS_PEND), (float*)(ws + WS_HEND), (const float*)(ws + WS_BAS), (const float*)(ws + WS_BXS), (const float*)(ws + WS_SPT)};
        pg8::gemm_phase<pg8::EpiGate, pg8::StaticOrder, true, true>(lds, g, S, E);
    }
    GSYNC(); }
#ifdef REP2C
    phase2c(c, lds, 0); GSYNC();
#endif
    if (PH_MASK & 4) phase2c(c, lds);
    GSYNC(); }
    for (int rep4 = 0; rep4 < REP4; ++rep4) {
    if (PH_MASK & 16) {
        pg8::Gemm g{(const bf16*)(ws + WS_P4) + 2048, (const bf16*)(ws + WS_WOUT), T, 1024, 1024, 4096, 1024, 0};
        pg8::StaticOrder S; S.init(T, 1024, (int)gridDim.x, (int)blockIdx.x);
        pg8::EpiResid E{(const bf16*)(ws + WS_XB), (bf16*)(ws + WS_Z), 1024, ALPHA, (float*)(ws + WS_PARTZ)};
        pg8::gemm_phase<pg8::EpiResid, pg8::StaticOrder, G4_ALIGN, true>(lds, g, S, E);
    }
    GSYNC(); }
    for (int rep6 = 0; rep6 < REP6; ++rep6) {
    if (PH_MASK & 64) {
#if Q_I8
        pg8::Gemm g{(const bf16*)(ws + WS_X1Q8), (const bf16*)(ws + WS_WQQ8), T, 2048, 512, 512, 512, 0};
        pg8::StaticOrder S; S.init(T, 2048, (int)gridDim.x, (int)blockIdx.x);
        pg8::EpiBf16I8 E{(bf16*)p.out, 2048, (const float*)(ws + WS_SX1), (const float*)(ws + WS_SWQ)};
        pg8::gemm_phase<pg8::EpiBf16I8, pg8::StaticOrder, G6_ALIGN, true>(lds, g, S, E);
#else
        pg8::StaticOrder S; S.init(T, 2048, (int)gridDim.x, (int)blockIdx.x);
        LAS float* tab = (LAS float*)(lds + 131072);
        {
            const int ui = threadIdx.x >> 7; pg8::Unit uu;
            if (S.next(ui, uu)) {
#pragma unroll
                for (int rr = 0; rr < 2; ++rr) {
                    const int rl = (threadIdx.x & 127) * 2 + rr, row = uu.pm * 256 + rl;
                    const f32x4* pp = (const f32x4*)((const float*)(ws + WS_PARTZ) + (size_t)row * 32);
                    float s1 = 0.f, s2 = 0.f;
#pragma unroll
                    for (int k = 0; k < 8; ++k) { const f32x4 v = pp[k]; s1 += v.x + v.z; s2 += v.y + v.w; }
                    const float mean = s1 * (1.0f / 1024.0f), rstd = rsqrtf(fmaxf(s2 * (1.0f / 1024.0f) - mean * mean, 0.f) + LN_EPS);
                    tab[(ui * 256 + rl) * 2] = mean; tab[(ui * 256 + rl) * 2 + 1] = rstd;
                    if (uu.pn == 0) *(f32x2*)((float*)(ws + WS_ST1) + (size_t)row * 2) = (f32x2){mean, rstd};
                }
            }
        }
        __syncthreads();
        pg8::Gemm g{(const bf16*)(ws + WS_Z), (const bf16*)(ws + WS_WQ), T, 2048, 1024, 1024, 1024, 0};
        pg8::EpiQ E{(bf16*)p.out, 2048, (const float*)(ws + WS_CQ), (const float*)(ws + WS_DQ), (const LAS float*)tab, S};
        pg8::gemm_phase<pg8::EpiQ, pg8::StaticOrder, G6_ALIGN, true>(lds, g, S, E);
#endif
    }
    GSYNC(); }
    for (int rep = 0; rep < REP7; ++rep) { if (PH_MASK & 128) phase7(c, lds);
    GSYNC(); }
#ifdef REP8B
    phase8(c, lds, xbar); GSYNC();
#endif
    if (PH_MASK & 256) phase8(c, lds, xbar);
}

extern "C" void kernel_launch(void* const* d_in, const int* in_sizes, int n_in, void* d_out, int out_size,
                              void* d_ws, size_t ws_size, hipStream_t stream) {
    static int grid_blocks = 0;
    if (grid_blocks == 0) {
        if (n_in != 23 || out_size != T * D || ws_size < WS_END) {
            fprintf(stderr, "kernel_launch: unexpected problem (n_in %d, out %d, ws %zu); nothing launched\n", n_in, out_size, ws_size);
            grid_blocks = -1; return;
        }
        int dev = 0, cus = 0, per_cu = 0;
        (void)hipGetDevice(&dev);
        (void)hipDeviceGetAttribute(&cus, hipDeviceAttributeMultiprocessorCount, dev);
        (void)hipFuncSetAttribute((const void*)hybrid_fwd, hipFuncAttributeMaxDynamicSharedMemorySize, LDS_BYTES);
        (void)hipOccupancyMaxActiveBlocksPerMultiprocessor(&per_cu, (const void*)hybrid_fwd, NTHR, LDS_BYTES);
        if (per_cu < 1) { fprintf(stderr, "kernel_launch: occupancy query reports %d blocks per CU\n", per_cu); grid_blocks = -1; return; }
        grid_blocks = cus;
        (void)hipGetLastError();
    }
    if (grid_blocks < 0) return;
    Params p{};
    for (int i = 0; i < 23; ++i) p.in[i] = (const float*)d_in[i];
    p.out = (float*)d_out; p.ws = (unsigned char*)d_ws;
    if (hipMemsetAsync((unsigned char*)d_ws + WS_BAR, 0, XCD_BAR_WORDS * sizeof(unsigned), stream) != hipSuccess) { fprintf(stderr, "kernel_launch: hipMemsetAsync of the barrier words failed; nothing launched\n"); return; }
    void* args[] = {&p};
    hipError_t e = hipLaunchCooperativeKernel((const void*)hybrid_fwd, dim3(grid_blocks), dim3(NTHR), args, LDS_BYTES, stream);
    if (e != hipSuccess) fprintf(stderr, "cooperative launch failed: %s (grid %d)\n", hipGetErrorString(e), grid_blocks);
}
```

```cpp
#include <hip/hip_runtime.h>
#include <hip/hip_cooperative_groups.h>
#include <cstdio>
#include <cstdint>
namespace cg = cooperative_groups;

#define LAS __attribute__((address_space(3)))
typedef unsigned short bf16;
typedef short bf16x8 __attribute__((ext_vector_type(8)));
typedef float f32x4 __attribute__((ext_vector_type(4)));
typedef float f32x16 __attribute__((ext_vector_type(16)));
typedef float f32x2 __attribute__((ext_vector_type(2)));
typedef unsigned u32x4 __attribute__((ext_vector_type(4)));
typedef unsigned u32x2 __attribute__((ext_vector_type(2)));
typedef int i32x4 __attribute__((ext_vector_type(4)));
typedef __bf16 bf16v2 __attribute__((ext_vector_type(2)));

#ifndef Q_I8
#define Q_I8 0
#endif
constexpr int T = 32768, D = 1024, SEQ = 4096, DIN = 6144, CHUNK = 128, NTILE = T / CHUNK, NCHUNK = SEQ / CHUNK, NH = 8, HD = 128;
constexpr int NEXP = 16384;
constexpr float ALPHA = 1.18920711500272f, LN_EPS = 1e-5f;
constexpr int NTHR = 512;
constexpr int LDS_BYTES = 147456;
constexpr int LDS_BARST = 147440;

constexpr size_t MiB = 1u << 20;
constexpr size_t WS_SPT = 0;
constexpr size_t WS_BAS = 4096;
constexpr size_t WS_BXS = 8192;
constexpr size_t WS_BGS = 12288;
constexpr size_t WS_STATS = 256 * 1024;
constexpr size_t WS_BAR = 64 * 1024;
constexpr size_t WS_WIN = 1 * MiB;
constexpr size_t WS_WOUT = 13 * MiB;
constexpr size_t WS_WQ = 15 * MiB;
constexpr size_t WS_KEYS = 19 * MiB;
constexpr size_t WS_WAX = 20 * MiB;
constexpr size_t WS_WTRIL = 20 * MiB + 512 * 1024;
constexpr size_t WS_UQ = 22 * MiB;
constexpr size_t WS_VQ = 38 * MiB;
constexpr size_t WS_USC = 54 * MiB;
constexpr size_t WS_VSC = 55 * MiB;
constexpr size_t WS_WQ8 = 56 * MiB;
constexpr size_t WS_SXR = 62 * MiB;
constexpr size_t WS_SWC = 63 * MiB;
constexpr size_t WS_WQQ8 = 64 * MiB;
constexpr size_t WS_SWQ = 66 * MiB;
constexpr size_t WS_SX1 = 67 * MiB;
constexpr size_t WS_X1Q8 = 182 * MiB;
constexpr size_t WS_XQ8 = 472 * MiB;
constexpr size_t WS_XB = 86 * MiB;
constexpr size_t OUT_PC = 64 * MiB;
constexpr size_t WS_P4 = 150 * MiB;
constexpr size_t WS_HL = 406 * MiB;
constexpr size_t WS_PEND = 470 * MiB;
constexpr size_t WS_HEND = 471 * MiB;
constexpr size_t WS_Z = 406 * MiB;
constexpr size_t WS_PARTZ = 68 * MiB;
constexpr size_t WS_ST1 = 72 * MiB;
constexpr size_t WS_CQ = 73 * MiB;
constexpr size_t WS_DQ = 73 * MiB + 8192;
constexpr size_t WS_PARTCD = 74 * MiB;
constexpr size_t WS_IDX = 470 * MiB;
constexpr size_t WS_GATE = 486 * MiB;
constexpr size_t WS_END = 504 * MiB;

__device__ __forceinline__ unsigned pk2(float lo, float hi) { f32x2 v = {lo, hi}; return __builtin_bit_cast(unsigned, __builtin_convertvector(v, bf16v2)); }
__device__ __forceinline__ float bf_lo(unsigned w) { return __uint_as_float(w << 16); }
__device__ __forceinline__ float bf_hi(unsigned w) { return __uint_as_float(w & 0xffff0000u); }
constexpr float NLOG2E = -1.4426950408889634f;
__device__ __forceinline__ float sig_pre(float xs) { return __builtin_amdgcn_rcpf(1.0f + __builtin_amdgcn_exp2f(xs)); }
__device__ __forceinline__ float gelu_tanh(float x) { const float u = x * (1.0f + 0.044715f * x * x); return x * __builtin_amdgcn_rcpf(1.0f + __builtin_amdgcn_exp2f(-2.3022081989f * u)); }
__device__ __forceinline__ float wave_sum(float v) {
#pragma unroll
    for (int o = 32; o >= 1; o >>= 1) v += __shfl_xor(v, o);
    return v;
}
#define XB_TMO      128
#define XB_XCNT(j)  (256  + 64 * (j))
#define XB_XSUB(j)  (1280 + 64 * (j))
#define XB_XGEN(j)  (2304 + 64 * (j))
#define XB_TOP      3328
#define XB_TOPGEN   3392
#define XCD_BAR_WORDS 3456
#define XB_SPIN_CAP (1u << 22)

__device__ __forceinline__ unsigned xb_ld(unsigned* p)              { return __hip_atomic_load(p, __ATOMIC_RELAXED, __HIP_MEMORY_SCOPE_AGENT); }
__device__ __forceinline__ unsigned xb_add(unsigned* p, unsigned v) { return __hip_atomic_fetch_add(p, v, __ATOMIC_RELAXED, __HIP_MEMORY_SCOPE_AGENT); }
__device__ __forceinline__ unsigned xb_xcc_id() { return (unsigned)__builtin_amdgcn_s_getreg((3 << 11) | 20) & 0xFu; }
#define XB_SPIN(cond, bar) do { unsigned _sp = 0; while (cond) { __builtin_amdgcn_s_sleep(1); \
    if ((++_sp & 255u) == 0u) { if (xb_ld(&(bar)[XB_TMO])) break; if (_sp > XB_SPIN_CAP) { atomicAdd(&(bar)[XB_TMO], 1u); break; } } } } while (0)

struct XcdBarrier {
    unsigned* bar; unsigned x;
    volatile LAS unsigned* st;
};

__device__ __forceinline__ XcdBarrier xcd_barrier_post(unsigned* bar, volatile LAS unsigned* st) {
    XcdBarrier b; b.bar = bar; b.x = xb_xcc_id(); b.st = st;
    if (threadIdx.x == 0) (void)xb_add(&bar[XB_XCNT(b.x)], 1u);
    return b;
}
__device__ __forceinline__ void xcd_barrier_complete(unsigned* bar, unsigned x, unsigned& nloc, unsigned& nx) {
    const unsigned G = gridDim.x * gridDim.y * gridDim.z;
    unsigned sum, cnt, mine, sp = 0u;
    for (;;) {
        sum = 0u; cnt = 0u; mine = 0u;
#pragma unroll
        for (unsigned j = 0; j < 16; ++j) { const unsigned c = xb_ld(&bar[XB_XCNT(j)]); sum += c; cnt += (c > 0u) ? 1u : 0u; mine = (j == x) ? c : mine; }
        if (sum == G) break;
        __builtin_amdgcn_s_sleep(1);
        if ((++sp & 255u) == 0u) { if (xb_ld(&bar[XB_TMO])) break; if (sp > XB_SPIN_CAP) { atomicAdd(&bar[XB_TMO], 1u); break; } }
    }
    nloc = mine > 0u ? mine : 1u; nx = cnt > 0u ? cnt : 1u;
}

__device__ __forceinline__ void xcd_barrier(const XcdBarrier& b) {
    asm volatile("s_waitcnt vmcnt(0)" ::: "memory");
    __syncthreads();
    if (threadIdx.x == 0) {
        unsigned* bar = b.bar;
        __builtin_amdgcn_s_waitcnt(0);
        unsigned nloc = b.st[0], nx = b.st[1];
        if (nloc == 0u) { xcd_barrier_complete(bar, b.x, nloc, nx); b.st[0] = nloc; b.st[1] = nx; }
        const unsigned old = xb_add(&bar[XB_XSUB(b.x)], 1u);
        const unsigned gen = old / nloc;
        if (old + 1u == (gen + 1u) * nloc) {
            __builtin_amdgcn_fence(__ATOMIC_RELEASE, "agent");
            asm volatile("s_waitcnt vmcnt(0)" ::: "memory");
            const unsigned og = xb_add(&bar[XB_TOP], 1u);
            const unsigned tg = og / nx;
            if (og + 1u == (tg + 1u) * nx) xb_add(&bar[XB_TOPGEN], 1u);
            else XB_SPIN(xb_ld(&bar[XB_TOPGEN]) == tg, bar);
            __builtin_amdgcn_fence(__ATOMIC_ACQUIRE, "agent");
            xb_add(&bar[XB_XGEN(b.x)], 1u);
            asm volatile("s_waitcnt vmcnt(0)" ::: "memory");
        } else {
            XB_SPIN(xb_ld(&bar[XB_XGEN(b.x)]) == gen, bar);
            __builtin_amdgcn_fence(__ATOMIC_ACQUIRE, "agent");
            asm volatile("s_waitcnt vmcnt(0)" ::: "memory");
        }
    }
    __syncthreads();
}
namespace pg8 {
#define PG8_LAS __attribute__((address_space(3)))
typedef unsigned short bf16_t;
typedef short bf16x8 __attribute__((ext_vector_type(8)));
typedef float f32x4 __attribute__((ext_vector_type(4)));
typedef unsigned u32x4 __attribute__((ext_vector_type(4)));
typedef int i32x4_ __attribute__((ext_vector_type(4)));
constexpr int BM = 256, BK = 64, HALF = 128, HTB = HALF * BK * 2  , STAGE_BYTES = 8 * HTB, NXCD = 8, WGM = 8;

__host__ __device__ __forceinline__ int lds_byte(int r, int c) { const int st = (r >> 4) * 2 + (c >> 5), rr = r & 15, cc = c & 31, ob = rr * 64 + cc * 2; return st * 1024 + (ob ^ (((ob >> 9) & 1) << 5)); }
__host__ __device__ __forceinline__ void stage_rc(int b, int& R, int& C) { const int st = b / 1024, sb = b % 1024, swz = sb ^ (((sb >> 9) & 1) << 5); R = (st >> 1) * 16 + swz / 64; C = (st & 1) * 32 + (swz % 64) / 2; }
__host__ __device__ __forceinline__ int perm32(int rho) { const int n = rho >> 4, i = rho & 15; return 8 * (i >> 2) + 4 * n + (i & 3); }

struct Unit { int pm, pn; };
struct Gemm { const bf16_t* A; const bf16_t* Bt; int M, N, K, lda, ldb, a_pn_bytes; };

struct StaticOrder {
    int nM, nN, nwg, G, c;
    __host__ __device__ __forceinline__ void init(int M, int N, int G_, int c_) { nM = M / BM; nN = N / BM; nwg = nM * nN; G = G_; c = c_; }
    __host__ __device__ __forceinline__ bool next(int i, Unit& u) const {
        const long L = (long)i * G + c; if (L >= nwg) return false;
        int wgid = (int)L; { const int q = nwg / NXCD, r = nwg % NXCD, xcd = wgid % NXCD, off = wgid / NXCD; wgid = (xcd < r ? xcd * (q + 1) : r * (q + 1) + (xcd - r) * q) + off; }
        const int nig = WGM * nN, gid = wgid / nig, fm = gid * WGM, gsz = (nM - fm) < WGM ? (nM - fm) : WGM;
        u.pm = fm + ((wgid % nig) % gsz); u.pn = (wgid % nig) / gsz; return true;
    }
    __device__ __forceinline__ void a_ready(const Unit&) const {}
    __device__ __forceinline__ void done(const Unit&) const {}
};


struct EpiProj {
    static constexpr bool PERM = true, AFTER_DRAIN = false, AROWS = false, I8 = true;
    bf16_t* P4; const float* bgate;
    const float* sxr; const float* swc;
    __device__ __forceinline__ void operator()(const f32x4 (&acc)[2][2][4][2], const Unit& u, int, int, int, int) const {
        int t_ = threadIdx.x; asm volatile("" : "+v"(t_)); const int fr = t_ & 15, fq = (t_ >> 4) & 3, wc = (t_ >> 6) & 3, wr = t_ >> 8;
        const int k = u.pn / 3, ty = u.pn - 3 * k;
        const int row0 = u.pm * BM + wr * 64 + fr, cl = k * 128 + wc * 32 + 8 * fq;
        const float* swp = swc + u.pn * BM + wc * 32 + 8 * fq;
        const f32x4 w00 = *(const f32x4*)swp, w01 = *(const f32x4*)(swp + 4), w10 = *(const f32x4*)(swp + HALF), w11 = *(const f32x4*)(swp + HALF + 4);
#define EPI_I2F(v, w, s) ((f32x4){(float)__builtin_bit_cast(i32x4_, v)[0], (float)__builtin_bit_cast(i32x4_, v)[1], (float)__builtin_bit_cast(i32x4_, v)[2], (float)__builtin_bit_cast(i32x4_, v)[3]} * (w) * (s))
        if (ty == 0) {
#pragma unroll
            for (int ai = 0; ai < 2; ++ai)
#pragma unroll
                for (int m = 0; m < 4; ++m) {
                    const int row = row0 + ai * HALF + m * 16; const float sx = sxr[row];
                    bf16_t* rowp = P4 + (size_t)row * 4096 + cl;
                    const f32x4 a0 = EPI_I2F(acc[ai][0][m][0], w00, sx), a1 = EPI_I2F(acc[ai][0][m][1], w01, sx); f32x4 v0 = EPI_I2F(acc[ai][1][m][0], w10, sx), v1 = EPI_I2F(acc[ai][1][m][1], w11, sx);
#pragma unroll
                    for (int j = 0; j < 4; ++j) { v0[j] = gelu_tanh(v0[j]); v1[j] = gelu_tanh(v1[j]); }
                    u32x4 w; w.x = pk2(a0[0], a0[1]); w.y = pk2(a0[2], a0[3]); w.z = pk2(a1[0], a1[1]); w.w = pk2(a1[2], a1[3]);
                    *(u32x4*)rowp = w;
                    w.x = pk2(v0[0], v0[1]); w.y = pk2(v0[2], v0[3]); w.z = pk2(v1[0], v1[1]); w.w = pk2(v1[2], v1[3]);
                    *(u32x4*)(rowp + 3072) = w;
                }
        } else {
            const float* bp = bgate + (ty - 1) * 1024 + cl;
            const f32x4 b0 = *(const f32x4*)bp, b1 = *(const f32x4*)(bp + 4);
#pragma unroll
            for (int ai = 0; ai < 2; ++ai)
#pragma unroll
                for (int m = 0; m < 4; ++m) {
                    const int row = row0 + ai * HALF + m * 16; const float sx = sxr[row];
                    bf16_t* rowp = P4 + (size_t)row * 4096 + ty * 1024 + cl;
                    f32x4 a0 = EPI_I2F(acc[ai][0][m][0], w00, sx), a1 = EPI_I2F(acc[ai][0][m][1], w01, sx); const f32x4 g0 = EPI_I2F(acc[ai][1][m][0], w10, sx) + b0, g1 = EPI_I2F(acc[ai][1][m][1], w11, sx) + b1;
#pragma unroll
                    for (int j = 0; j < 4; ++j) { a0[j] = gelu_tanh(a0[j]) * sig_pre(g0[j]); a1[j] = gelu_tanh(a1[j]) * sig_pre(g1[j]); }
                    u32x4 w; w.x = pk2(a0[0], a0[1]); w.y = pk2(a0[2], a0[3]); w.z = pk2(a1[0], a1[1]); w.w = pk2(a1[2], a1[3]);
                    *(u32x4*)rowp = w;
                }
        }
#undef EPI_I2F
    }
};
template <int S> __device__ __forceinline__ float row_shr_f(float ident, float v) {
    return __int_as_float(__builtin_amdgcn_update_dpp(__float_as_int(ident), __float_as_int(v), 0x110 + S, 0xf, 0xf, false));
}
struct EpiGate {
    static constexpr bool PERM = true, AFTER_DRAIN = false, AROWS = true, I8 = false;
    const bf16_t* XC; bf16_t* HL; bf16_t* PC; float* PEND; float* HEND; const float* b_a; const float* b_x; const float* spt;
    __device__ __forceinline__ void operator()(const f32x4 (&acc)[2][2][4][2], const Unit& u, int, int, int, int) const {
        int t_ = threadIdx.x; asm volatile("" : "+v"(t_)); const int fr = t_ & 15, fq = (t_ >> 4) & 3, wc = (t_ >> 6) & 3, wr = t_ >> 8, lane15 = (t_ & 63) | 15;
        const int row0 = u.pm * BM + wr * 128 + fr, ch = u.pn * 128 + wc * 32 + 8 * fq, chunk = u.pm * 2 + wr;
        float Ac[8], Hc[8];
#pragma unroll
        for (int j = 0; j < 8; ++j) { Ac[j] = 1.0f; Hc[j] = 0.0f; }
#pragma unroll
        for (int ai = 0; ai < 2; ++ai)
#pragma unroll
            for (int m = 0; m < 4; ++m) {
                asm volatile("" ::: "memory");
                int zo = 0; asm volatile("" : "+v"(zo));
                const size_t off = (size_t)(row0 + ai * 64 + m * 16) * 1024 + ch;
                const u32x4 xw = *(const u32x4*)(XC + off);
                float ba[8], bx[8], sp[8];
                { const int cz = ch + zo;
                  const f32x4 t0 = *(const f32x4*)(b_a + cz), t1 = *(const f32x4*)(b_a + cz + 4), t2 = *(const f32x4*)(b_x + cz), t3 = *(const f32x4*)(b_x + cz + 4), t4 = *(const f32x4*)(spt + cz), t5 = *(const f32x4*)(spt + cz + 4);
#pragma unroll
                  for (int j = 0; j < 4; ++j) { ba[j] = t0[j]; ba[4 + j] = t1[j]; bx[j] = t2[j]; bx[4 + j] = t3[j]; sp[j] = t4[j]; sp[4 + j] = t5[j]; } }
                float a[8], b[8];
#pragma unroll
                for (int j = 0; j < 8; ++j) {
                    const float rp = acc[ai][0][m][j >> 2][j & 3], ip = acc[ai][1][m][j >> 2][j & 3];
                    const float xv = (j & 1) ? bf_hi(xw[j >> 1]) : bf_lo(xw[j >> 1]);
                    a[j] = __builtin_amdgcn_exp2f(sig_pre(rp + ba[j]) * sp[j]);
                    b[j] = __builtin_amdgcn_sqrtf(__builtin_fmaxf(1.0f - a[j] * a[j], 0.f)) * sig_pre(ip + bx[j]) * xv;
                }
#pragma unroll
                for (int j = 0; j < 8; ++j) { const float ap = row_shr_f<1>(1.0f, a[j]), bp = row_shr_f<1>(0.0f, b[j]); b[j] = a[j] * bp + b[j]; a[j] = a[j] * ap; }
#pragma unroll
                for (int j = 0; j < 8; ++j) { const float ap = row_shr_f<2>(1.0f, a[j]), bp = row_shr_f<2>(0.0f, b[j]); b[j] = a[j] * bp + b[j]; a[j] = a[j] * ap; }
#pragma unroll
                for (int j = 0; j < 8; ++j) { const float ap = row_shr_f<4>(1.0f, a[j]), bp = row_shr_f<4>(0.0f, b[j]); b[j] = a[j] * bp + b[j]; a[j] = a[j] * ap; }
#pragma unroll
                for (int j = 0; j < 8; ++j) { const float ap = row_shr_f<8>(1.0f, a[j]), bp = row_shr_f<8>(0.0f, b[j]); b[j] = a[j] * bp + b[j]; a[j] = a[j] * ap; }
                float hl[8], pc[8];
#pragma unroll
                for (int j = 0; j < 8; ++j) {
                    const float at = __shfl(a[j], lane15), bt = __shfl(b[j], lane15);
                    hl[j] = b[j] + a[j] * Hc[j]; pc[j] = a[j] * Ac[j];
                    Hc[j] = bt + at * Hc[j]; Ac[j] = at * Ac[j];
                }
                u32x4 w; w.x = pk2(hl[0], hl[1]); w.y = pk2(hl[2], hl[3]); w.z = pk2(hl[4], hl[5]); w.w = pk2(hl[6], hl[7]);
                *(u32x4*)(HL + off) = w;
                w.x = pk2(pc[0], pc[1]); w.y = pk2(pc[2], pc[3]); w.z = pk2(pc[4], pc[5]); w.w = pk2(pc[6], pc[7]);
                *(u32x4*)(PC + off) = w;
            }
        if (fr == 0) {
            float* pp = PEND + (size_t)chunk * 1024 + ch; float* hp = HEND + (size_t)chunk * 1024 + ch;
            *(f32x4*)pp = (f32x4){Ac[0], Ac[1], Ac[2], Ac[3]}; *(f32x4*)(pp + 4) = (f32x4){Ac[4], Ac[5], Ac[6], Ac[7]};
            *(f32x4*)hp = (f32x4){Hc[0], Hc[1], Hc[2], Hc[3]}; *(f32x4*)(hp + 4) = (f32x4){Hc[4], Hc[5], Hc[6], Hc[7]};
        }
    }
};
struct EpiBf16 {
    static constexpr bool PERM = true, AFTER_DRAIN = false, AROWS = false, I8 = false;
    bf16_t* O; int ldc;
    __device__ __forceinline__ void operator()(const f32x4 (&acc)[2][2][4][2], const Unit& u, int, int, int, int) const {
        int t_ = threadIdx.x; asm volatile("" : "+v"(t_)); const int fr = t_ & 15, fq = (t_ >> 4) & 3, wc = (t_ >> 6) & 3, wr = t_ >> 8;
        const int row0 = u.pm * BM + wr * 64 + fr, col0 = u.pn * BM + wc * 32 + 8 * fq;
#pragma unroll
        for (int ai = 0; ai < 2; ++ai)
#pragma unroll
            for (int m = 0; m < 4; ++m) {
                bf16_t* rowp = O + (size_t)(row0 + ai * HALF + m * 16) * ldc + col0;
#pragma unroll
                for (int bj = 0; bj < 2; ++bj) {
                    const f32x4 v0 = acc[ai][bj][m][0], v1 = acc[ai][bj][m][1];
                    u32x4 w; w.x = pk2(v0[0], v0[1]); w.y = pk2(v0[2], v0[3]); w.z = pk2(v1[0], v1[1]); w.w = pk2(v1[2], v1[3]);
                    *(u32x4*)(rowp + bj * HALF) = w;
                }
            }
    }
};
struct EpiResid {
    static constexpr bool PERM = true, AFTER_DRAIN = false, AROWS = false, I8 = false;
    const bf16_t* X; bf16_t* Z; int ldc; float alpha; float* PART;
    __device__ __forceinline__ void operator()(const f32x4 (&acc)[2][2][4][2], const Unit& u, int, int, int, int) const {
        int t_ = threadIdx.x; asm volatile("" : "+v"(t_)); const int fr = t_ & 15, fq = (t_ >> 4) & 3, wc = (t_ >> 6) & 3, wr = t_ >> 8;
        const int row0 = u.pm * BM + wr * 64 + fr, col0 = u.pn * BM + wc * 32 + 8 * fq;
#pragma unroll
        for (int ai = 0; ai < 2; ++ai)
#pragma unroll
            for (int m = 0; m < 4; ++m) {
                const int row = row0 + ai * HALF + m * 16;
                const size_t off = (size_t)row * ldc + col0;
                float s1 = 0.f, s2 = 0.f;
#pragma unroll
                for (int bj = 0; bj < 2; ++bj) {
                    const u32x4 xw = *(const u32x4*)(X + off + bj * HALF);
                    const f32x4 x0 = (f32x4){bf_lo(xw.x), bf_hi(xw.x), bf_lo(xw.y), bf_hi(xw.y)}, x1 = (f32x4){bf_lo(xw.z), bf_hi(xw.z), bf_lo(xw.w), bf_hi(xw.w)};
                    const f32x4 z0 = x0 * alpha + acc[ai][bj][m][0], z1 = x1 * alpha + acc[ai][bj][m][1];
                    u32x4 w; w.x = pk2(z0[0], z0[1]); w.y = pk2(z0[2], z0[3]); w.z = pk2(z1[0], z1[1]); w.w = pk2(z1[2], z1[3]);
                    *(u32x4*)(Z + off + bj * HALF) = w;
#pragma unroll
                    for (int j = 0; j < 4; ++j) { s1 += z0[j] + z1[j]; s2 += z0[j] * z0[j] + z1[j] * z1[j]; }
                }
                s1 += __shfl_xor(s1, 16); s2 += __shfl_xor(s2, 16); s1 += __shfl_xor(s1, 32); s2 += __shfl_xor(s2, 32);
                if (fq == 0) *(f32x2*)(PART + ((size_t)row * 16 + u.pn * 4 + wc) * 2) = (f32x2){s1, s2};
            }
    }
};
struct EpiQ {
    static constexpr bool PERM = true, AFTER_DRAIN = false, AROWS = false, I8 = false;
    bf16_t* O; int ldc; const float* cq; const float* dq; const PG8_LAS float* tab; StaticOrder S;
    __device__ __forceinline__ void operator()(const f32x4 (&acc)[2][2][4][2], const Unit& u, int, int, int, int) const {
        int t_ = threadIdx.x; asm volatile("" : "+v"(t_)); const int fr = t_ & 15, fq = (t_ >> 4) & 3, wc = (t_ >> 6) & 3, wr = t_ >> 8;
        int ord = 0;
#pragma unroll
        for (int i = 1; i < 4; ++i) { Unit v; if (S.next(i, v) && v.pm == u.pm && v.pn == u.pn) ord = i; }
        const int rl0 = wr * 64 + fr, col0 = u.pn * BM + wc * 32 + 8 * fq;
        f32x4 cv[2][2], dv[2][2];
#pragma unroll
        for (int bj = 0; bj < 2; ++bj)
#pragma unroll
            for (int n = 0; n < 2; ++n) { cv[bj][n] = *(const f32x4*)(cq + col0 + bj * HALF + 4 * n); dv[bj][n] = *(const f32x4*)(dq + col0 + bj * HALF + 4 * n); }
#pragma unroll
        for (int ai = 0; ai < 2; ++ai)
#pragma unroll
            for (int m = 0; m < 4; ++m) {
                const int rl = rl0 + ai * HALF + m * 16;
                const float mean = tab[(ord * 256 + rl) * 2], rstd = tab[(ord * 256 + rl) * 2 + 1];
                bf16_t* rowp = O + (size_t)(u.pm * BM + rl) * ldc + col0;
#pragma unroll
                for (int bj = 0; bj < 2; ++bj) {
                    const f32x4 v0 = (acc[ai][bj][m][0] - cv[bj][0] * mean) * rstd + dv[bj][0], v1 = (acc[ai][bj][m][1] - cv[bj][1] * mean) * rstd + dv[bj][1];
                    u32x4 w; w.x = pk2(v0[0], v0[1]); w.y = pk2(v0[2], v0[3]); w.z = pk2(v1[0], v1[1]); w.w = pk2(v1[2], v1[3]);
                    *(u32x4*)(rowp + bj * HALF) = w;
                }
            }
    }
};
struct EpiBf16I8 {
    static constexpr bool PERM = true, AFTER_DRAIN = false, AROWS = false, I8 = true;
    bf16_t* O; int ldc; const float* sxr; const float* swc;
    __device__ __forceinline__ void operator()(const f32x4 (&acc)[2][2][4][2], const Unit& u, int, int, int, int) const {
        int t_ = threadIdx.x; asm volatile("" : "+v"(t_)); const int fr = t_ & 15, fq = (t_ >> 4) & 3, wc = (t_ >> 6) & 3, wr = t_ >> 8;
        const int row0 = u.pm * BM + wr * 64 + fr, col0 = u.pn * BM + wc * 32 + 8 * fq;
        const f32x4 w00 = *(const f32x4*)(swc + col0), w01 = *(const f32x4*)(swc + col0 + 4), w10 = *(const f32x4*)(swc + col0 + HALF), w11 = *(const f32x4*)(swc + col0 + HALF + 4);
#define EPI_I2F(v, w, s) ((f32x4){(float)__builtin_bit_cast(i32x4_, v)[0], (float)__builtin_bit_cast(i32x4_, v)[1], (float)__builtin_bit_cast(i32x4_, v)[2], (float)__builtin_bit_cast(i32x4_, v)[3]} * (w) * (s))
#pragma unroll
        for (int ai = 0; ai < 2; ++ai)
#pragma unroll
            for (int m = 0; m < 4; ++m) {
                const int row = row0 + ai * HALF + m * 16; const float sx = sxr[row];
                bf16_t* rowp = O + (size_t)row * ldc + col0;
                { const f32x4 v0 = EPI_I2F(acc[ai][0][m][0], w00, sx), v1 = EPI_I2F(acc[ai][0][m][1], w01, sx);
                  u32x4 w; w.x = pk2(v0[0], v0[1]); w.y = pk2(v0[2], v0[3]); w.z = pk2(v1[0], v1[1]); w.w = pk2(v1[2], v1[3]); *(u32x4*)rowp = w; }
                { const f32x4 v0 = EPI_I2F(acc[ai][1][m][0], w10, sx), v1 = EPI_I2F(acc[ai][1][m][1], w11, sx);
                  u32x4 w; w.x = pk2(v0[0], v0[1]); w.y = pk2(v0[2], v0[3]); w.z = pk2(v1[0], v1[1]); w.w = pk2(v1[2], v1[3]); *(u32x4*)(rowp + HALF) = w; }
            }
#undef EPI_I2F
    }
};
template <class Epi, class Sched, bool ALIGN_EPI = false, bool SP2 = false>
__device__ __forceinline__ void gemm_phase(PG8_LAS unsigned char* lds, const Gemm g, const Sched& S, const Epi& E) {
    int tid_ = threadIdx.x; asm volatile("" : "+v"(tid_)); const int tid = tid_, wid = __builtin_amdgcn_readfirstlane(tid >> 6), lane = tid & 63, wr = wid >> 2, wc = wid & 3, fr = lane & 15, fq = lane >> 4;
    const int K = g.K, nt = K / BK;
    unsigned voffA[2], voffB[2];
#pragma unroll
    for (int i = 0; i < 2; ++i) { int R, C; stage_rc(tid * 16 + i * 8192, R, C); const int Rb = Epi::PERM ? ((R & ~31) + perm32(R & 31)) : R;
        const int Ra = Epi::AROWS ? ((R >> 6) * 128 + (R & 63)) : R;
        voffA[i] = (unsigned)(Ra * g.lda + C) * 2u; voffB[i] = (unsigned)(Rb * g.ldb + C) * 2u; }
    const size_t kstep = (size_t)(BK * 2);
    const size_t hstepA = (size_t)(Epi::AROWS ? 64 : HALF) * g.lda * 2, hstepB = (size_t)HALF * g.ldb * 2;
    const size_t tstepA = (size_t)2 * HALF * g.lda * 2, tstepB = 2 * hstepB;
    const unsigned ldsw = (unsigned)wid * 1024u;
    const int aoff = lds_byte(wr * 64 + fr, fq * 8), boff = lds_byte(wc * 32 + fr, fq * 8);
#define PG8_SA(b, h) (((b) * 2 + (h)) * HTB)
#define PG8_SB(b, h) ((4 + (b) * 2 + (h)) * HTB)
#define PG8_STAGE(bufoff, gbase, voff) do { _Pragma("unroll") for (int _i = 0; _i < 2; ++_i) \
        __builtin_amdgcn_global_load_lds((const unsigned*)((const char*)(gbase) + (voff)[_i]), (PG8_LAS unsigned*)(lds + (bufoff) + ldsw + _i * 8192), 16, 0, 0); } while (0)
#define PG8_LDA(dst, b, h) do { _Pragma("unroll") for (int m = 0; m < 4; ++m) _Pragma("unroll") for (int k = 0; k < 2; ++k) dst[m][k] = *(const PG8_LAS bf16x8*)(lds + PG8_SA(b, h) + aoff + m * 2048 + k * 1024); } while (0)
#define PG8_LDB(dst, b, h) do { _Pragma("unroll") for (int n = 0; n < 2; ++n) _Pragma("unroll") for (int k = 0; k < 2; ++k) dst[n][k] = *(const PG8_LAS bf16x8*)(lds + PG8_SB(b, h) + boff + n * 2048 + k * 1024); } while (0)
#define PG8_MMA(ai, bj, At, Bt) do { __builtin_amdgcn_s_setprio(1); _Pragma("unroll") for (int m = 0; m < 4; ++m) _Pragma("unroll") for (int n = 0; n < 2; ++n) _Pragma("unroll") for (int k = 0; k < 2; ++k) \
        { if constexpr (Epi::I8) acc[ai][bj][m][n] = __builtin_bit_cast(f32x4, __builtin_amdgcn_mfma_i32_16x16x64_i8(__builtin_bit_cast(i32x4_, Bt[n][k]), __builtin_bit_cast(i32x4_, At[m][k]), __builtin_bit_cast(i32x4_, acc[ai][bj][m][n]), 0, 0, 0)); \
          else acc[ai][bj][m][n] = __builtin_amdgcn_mfma_f32_16x16x32_bf16(Bt[n][k], At[m][k], acc[ai][bj][m][n], 0, 0, 0); } __builtin_amdgcn_s_setprio(0); } while (0)
#define PG8_WAIT_V(n) asm volatile("s_waitcnt vmcnt(" #n ")" ::: "memory")
#define PG8_WAIT_L(n) asm volatile("s_waitcnt lgkmcnt(" #n ")" ::: "memory")
#define PG8_BAR __builtin_amdgcn_s_barrier()
#define PG8_SCHED __builtin_amdgcn_sched_barrier(0)
    Unit cur, nxt; int ui = 0;
    if (!S.next(0, cur)) return;
    f32x4 acc[2][2][4][2];
#pragma unroll
    for (int a = 0; a < 2; ++a)
#pragma unroll
        for (int b = 0; b < 2; ++b)
#pragma unroll
            for (int m = 0; m < 4; ++m)
#pragma unroll
                for (int n = 0; n < 2; ++n) acc[a][b][m][n] = (f32x4){0.f, 0.f, 0.f, 0.f};
    bf16x8 At[4][2], B0[2][2], B1[2][2];
    const char* cA = (const char*)g.A + (size_t)cur.pm * tstepA + (size_t)cur.pn * g.a_pn_bytes; const char* cB = (const char*)g.Bt + (size_t)cur.pn * tstepB;
    S.a_ready(cur);
    if constexpr (SP2) {
        PG8_STAGE(PG8_SB(0, 0), cB, voffB); PG8_STAGE(PG8_SB(0, 1), cB + hstepB, voffB); PG8_STAGE(PG8_SA(0, 0), cA, voffA); PG8_STAGE(PG8_SA(0, 1), cA + hstepA, voffA);
        if (wr == 1) PG8_BAR;
        PG8_WAIT_V(2); PG8_BAR;
        PG8_STAGE(PG8_SB(1, 0), cB + kstep, voffB); PG8_STAGE(PG8_SA(1, 0), cA + kstep, voffA); PG8_STAGE(PG8_SB(1, 1), cB + hstepB + kstep, voffB);
        PG8_WAIT_V(6); PG8_BAR;
    } else {
        PG8_STAGE(PG8_SB(0, 0), cB, voffB); PG8_STAGE(PG8_SA(0, 0), cA, voffA); PG8_STAGE(PG8_SB(0, 1), cB + hstepB, voffB); PG8_STAGE(PG8_SA(0, 1), cA + hstepA, voffA);
        if (wr == 1) PG8_BAR;
        PG8_WAIT_V(4); PG8_BAR;
        PG8_STAGE(PG8_SB(1, 0), cB + kstep, voffB); PG8_STAGE(PG8_SA(1, 0), cA + kstep, voffA); PG8_STAGE(PG8_SB(1, 1), cB + hstepB + kstep, voffB);
        PG8_WAIT_V(6); PG8_BAR;
    }
    for (;;) {
        const bool has_next = S.next(ui + 1, nxt);
        const char* nA = has_next ? (const char*)g.A + (size_t)nxt.pm * tstepA + (size_t)nxt.pn * g.a_pn_bytes : cA; const char* nB = has_next ? (const char*)g.Bt + (size_t)nxt.pn * tstepB : cB;
        for (int t = 0; t < nt; t += 2) {
            const bool last = (t == nt - 2);
            const char* a1 = cA + (size_t)(t + 1) * kstep;
            const char* a2 = last ? nA : cA + (size_t)(t + 2) * kstep; const char* b2 = last ? nB : cB + (size_t)(t + 2) * kstep;
            const char* a3 = a2 + kstep; const char* b3 = b2 + kstep;
            if (last && has_next) S.a_ready(nxt);
            if constexpr (SP2) {
            PG8_LDB(B0, 0, 0); PG8_LDB(B1, 0, 1); PG8_SCHED; PG8_LDA(At, 0, 0); PG8_STAGE(PG8_SA(1, 1), a1 + hstepA, voffA);
            PG8_WAIT_V(8); PG8_WAIT_L(0); PG8_BAR; PG8_MMA(0, 0, At, B0); PG8_MMA(0, 1, At, B1); PG8_BAR; PG8_SCHED;
            PG8_LDA(At, 0, 1); PG8_STAGE(PG8_SB(0, 0), b2, voffB); PG8_STAGE(PG8_SB(0, 1), b2 + hstepB, voffB); PG8_STAGE(PG8_SA(0, 0), a2, voffA);
            PG8_WAIT_V(8); PG8_WAIT_L(0); PG8_BAR; PG8_MMA(1, 0, At, B0); PG8_MMA(1, 1, At, B1); PG8_BAR; PG8_SCHED;
            PG8_LDB(B0, 1, 0); PG8_LDB(B1, 1, 1); PG8_SCHED; PG8_LDA(At, 1, 0); PG8_STAGE(PG8_SA(0, 1), a2 + hstepA, voffA);
            PG8_WAIT_V(8); PG8_WAIT_L(0); PG8_BAR; PG8_MMA(0, 0, At, B0); PG8_MMA(0, 1, At, B1); PG8_BAR; PG8_SCHED;
            PG8_LDA(At, 1, 1); PG8_STAGE(PG8_SB(1, 0), b3, voffB); PG8_STAGE(PG8_SB(1, 1), b3 + hstepB, voffB); PG8_STAGE(PG8_SA(1, 0), a3, voffA);
            PG8_WAIT_V(8); PG8_WAIT_L(0); PG8_BAR; PG8_MMA(1, 0, At, B0); PG8_MMA(1, 1, At, B1); PG8_BAR; PG8_SCHED;
            } else {
            PG8_LDB(B0, 0, 0); PG8_SCHED; PG8_LDA(At, 0, 0); PG8_STAGE(PG8_SA(1, 1), a1 + hstepA, voffA);
            PG8_WAIT_L(8); PG8_BAR; PG8_WAIT_L(0); PG8_MMA(0, 0, At, B0); PG8_BAR; PG8_SCHED;
            PG8_LDB(B1, 0, 1); PG8_STAGE(PG8_SB(0, 0), b2, voffB);
            PG8_BAR; PG8_WAIT_L(0); PG8_MMA(0, 1, At, B1); PG8_BAR;
            PG8_LDA(At, 0, 1); PG8_STAGE(PG8_SA(0, 0), a2, voffA);
            PG8_BAR; PG8_WAIT_L(0); PG8_MMA(1, 0, At, B0); PG8_BAR; PG8_SCHED;
            PG8_STAGE(PG8_SB(0, 1), b2 + hstepB, voffB);
            PG8_WAIT_V(6); PG8_BAR; PG8_MMA(1, 1, At, B1); PG8_BAR;
            PG8_LDB(B0, 1, 0); PG8_SCHED; PG8_LDA(At, 1, 0); PG8_STAGE(PG8_SA(0, 1), a2 + hstepA, voffA);
            PG8_WAIT_L(8); PG8_BAR; PG8_WAIT_L(0); PG8_MMA(0, 0, At, B0); PG8_BAR; PG8_SCHED;
            PG8_LDB(B1, 1, 1); PG8_STAGE(PG8_SB(1, 0), b3, voffB);
            PG8_BAR; PG8_WAIT_L(0); PG8_MMA(0, 1, At, B1); PG8_BAR;
            PG8_LDA(At, 1, 1); PG8_STAGE(PG8_SA(1, 0), a3, voffA);
            PG8_BAR; PG8_WAIT_L(0); PG8_MMA(1, 0, At, B0); PG8_BAR; PG8_SCHED;
            PG8_STAGE(PG8_SB(1, 1), b3 + hstepB, voffB);
            PG8_WAIT_V(6); PG8_BAR; PG8_MMA(1, 1, At, B1); PG8_BAR;
            }
        }
        if constexpr (ALIGN_EPI) { if (wr == 0) PG8_BAR; }
        if constexpr (!Epi::AFTER_DRAIN) { E(acc, cur, wr, wc, fr, fq); S.done(cur); }
        if (!has_next) break;
#pragma unroll
        for (int a = 0; a < 2; ++a)
#pragma unroll
            for (int b = 0; b < 2; ++b)
#pragma unroll
                for (int m = 0; m < 4; ++m)
#pragma unroll
                    for (int n = 0; n < 2; ++n) acc[a][b][m][n] = (f32x4){0.f, 0.f, 0.f, 0.f};
        cur = nxt; cA = nA; cB = nB; ++ui;
        if constexpr (ALIGN_EPI) { if (wr == 1) PG8_BAR; }
    }
    PG8_WAIT_V(0);
    if constexpr (!ALIGN_EPI) { if (wr == 0) PG8_BAR; }
    PG8_BAR;
    if constexpr (Epi::AFTER_DRAIN) { E.fused(acc, cur, wr, wc, fr, fq, lds, wid, lane); S.done(cur); }
#undef PG8_SA
#undef PG8_SB
#undef PG8_STAGE
#undef PG8_LDA
#undef PG8_LDB
#undef PG8_MMA
#undef PG8_WAIT_V
#undef PG8_WAIT_L
#undef PG8_BAR
#undef PG8_SCHED
}
}

__device__ __forceinline__ void cvt_f32_bf16(const float* __restrict__ src, bf16* dst, size_t n8, size_t gtid, size_t gthreads) {
    for (size_t i = gtid; i < n8; i += gthreads) {
        const f32x4 a = ((const f32x4*)src)[2 * i], b = ((const f32x4*)src)[2 * i + 1];
        u32x4 o; o.x = pk2(a.x, a.y); o.y = pk2(a.z, a.w); o.z = pk2(b.x, b.y); o.w = pk2(b.z, b.w);
        ((u32x4*)dst)[i] = o;
    }
}
__device__ __forceinline__ void transpose_tile(const float* __restrict__ W, int ldw, bf16* WT, int ldt, int k0, int n0, int nd0, LAS float* s, int tid, float sc = 1.0f) {
    {
        const int kk = tid >> 3, c8 = (tid & 7) * 8;
        const float* p = W + (size_t)(k0 + kk) * ldw + n0 + c8;
        const f32x4 a = *(const f32x4*)p, b = *(const f32x4*)(p + 4);
        LAS float* q = s + kk * 65 + c8;
        q[0] = a.x; q[1] = a.y; q[2] = a.z; q[3] = a.w; q[4] = b.x; q[5] = b.y; q[6] = b.z; q[7] = b.w;
    }
    __syncthreads();
    {
        const int nn = tid >> 3, k8 = (tid & 7) * 8;
        const LAS float* q = s + k8 * 65 + nn;
        u32x4 o; o.x = pk2(q[0] * sc, q[65] * sc); o.y = pk2(q[2 * 65] * sc, q[3 * 65] * sc); o.z = pk2(q[4 * 65] * sc, q[5 * 65] * sc); o.w = pk2(q[6 * 65] * sc, q[7 * 65] * sc);
        *(u32x4*)(WT + (size_t)(nd0 + nn) * ldt + k0 + k8) = o;
    }
    __syncthreads();
}

template <int NR> __device__ __forceinline__ void quant_rows_i8(const float (&v)[NR][16], unsigned char* const (&dst)[NR], float* const (&scale_out)[NR], int lane) {
    float m[NR];
#pragma unroll
    for (int r = 0; r < NR; ++r) { m[r] = 0.f;
#pragma unroll
        for (int j = 0; j < 16; ++j) m[r] = fmaxf(m[r], fabsf(v[r][j])); }
#pragma unroll
    for (int o = 32; o >= 1; o >>= 1) {
#pragma unroll
        for (int r = 0; r < NR; ++r) m[r] = fmaxf(m[r], __shfl_xor(m[r], o));
    }
#pragma unroll
    for (int r = 0; r < NR; ++r) {
        const float scale = (m[r] > 0.f) ? m[r] * (1.0f / 127.0f) : 1.0f, inv = 1.0f / scale;
        u32x4 q;
#pragma unroll
        for (int w = 0; w < 4; ++w) {
            unsigned pk = 0;
#pragma unroll
            for (int k = 0; k < 4; ++k) { int qi = (int)rintf(v[r][4 * w + k] * inv); qi = qi < -127 ? -127 : (qi > 127 ? 127 : qi); pk |= (unsigned)(qi & 0xff) << (8 * k); }
            q[w] = pk;
        }
        *(u32x4*)(dst[r] + lane * 16) = q;
        if (lane == 0) *scale_out[r] = scale;
    }
}
struct Ctx {
    const float* in[23];
    float* out;
    unsigned char* ws;
};

__device__ __forceinline__ void quant_peer_tables(const Ctx& c, int gw, int NW, int lane) {
    unsigned char* ws = c.ws;
    for (int e2 = gw * 2; e2 < NEXP; e2 += NW * 2) {
        float v[4][16];
#pragma unroll
        for (int r = 0; r < 4; ++r) {
            const float* src = ((r & 2) ? c.in[20] : c.in[19]) + (size_t)(e2 + (r & 1)) * 1024 + lane * 16;
            const f32x4 a0 = *(const f32x4*)src, a1 = *(const f32x4*)(src + 4), a2 = *(const f32x4*)(src + 8), a3 = *(const f32x4*)(src + 12);
            v[r][0] = a0.x; v[r][1] = a0.y; v[r][2] = a0.z; v[r][3] = a0.w; v[r][4] = a1.x; v[r][5] = a1.y; v[r][6] = a1.z; v[r][7] = a1.w;
            v[r][8] = a2.x; v[r][9] = a2.y; v[r][10] = a2.z; v[r][11] = a2.w; v[r][12] = a3.x; v[r][13] = a3.y; v[r][14] = a3.z; v[r][15] = a3.w;
        }
        float s2[4];
#pragma unroll
        for (int r = 0; r < 4; ++r) { s2[r] = 0.f;
#pragma unroll
            for (int j = 0; j < 16; ++j) s2[r] += v[r][j] * v[r][j]; }
#pragma unroll
        for (int o = 32; o >= 1; o >>= 1) {
#pragma unroll
            for (int r = 0; r < 4; ++r) s2[r] += __shfl_xor(s2[r], o);
        }
#pragma unroll
        for (int x = 0; x < 2; ++x) {
            const float su = 0.335f * sqrtf(s2[x] * (1.0f / 1024.0f)) + 1e-30f, sv = 0.48f * sqrtf(s2[2 + x] * (1.0f / 1024.0f)) + 1e-30f;
            const float iu = 1.0f / su, iv = 1.0f / sv;
            unsigned w[4] = {0u, 0u, 0u, 0u};
#pragma unroll
            for (int k = 0; k < 16; ++k) {
                int q = (int)floorf(v[x][k] * iu); q = q < -8 ? -8 : (q > 7 ? 7 : q);
                w[k >> 3] |= (unsigned)(q & 15) << (4 * (k & 7));
                const float a = fabsf(v[2 + x][k]) * iv;
                unsigned m = (unsigned)(a > 0.25f) + (unsigned)(a > 0.75f) + (unsigned)(a > 1.25f) + (unsigned)(a > 1.75f) + (unsigned)(a > 2.5f) + (unsigned)(a > 3.5f) + (unsigned)(a > 5.0f);
                m |= (v[2 + x][k] < 0.f) ? 8u : 0u;
                w[2 + (k >> 3)] |= m << (4 * (k & 7));
            }
            *(u32x2*)(ws + WS_UQ + (size_t)(e2 + x) * 1024 + lane * 8) = (u32x2){w[0], w[1]};
            *(u32x2*)(ws + WS_UQ + (size_t)(e2 + x) * 1024 + 512 + lane * 8) = (u32x2){w[2], w[3]};
            if (lane == 0) *(f32x2*)(ws + WS_USC + (size_t)(e2 + x) * 8) = (f32x2){su, sv};
        }
    }
}

__device__ __forceinline__ void phase0(const Ctx& c, LAS unsigned char* lds) {
    int tid_ = threadIdx.x; asm volatile("" : "+v"(tid_)); const int tid = tid_;
    const size_t gtid = (size_t)blockIdx.x * NTHR + tid, gthreads = (size_t)gridDim.x * NTHR;
    unsigned char* ws = c.ws;
    cvt_f32_bf16(c.in[18], (bf16*)(ws + WS_KEYS), (size_t)8 * 2 * 128 * 128 / 8, gtid, gthreads);
    {
        const int lane = tid & 63, gw = blockIdx.x * 8 + (tid >> 6), NW = gridDim.x * 8;
        for (int row4 = gw * 4; row4 < T; row4 += NW * 4) {
            float v[4][16]; unsigned char* dst[4]; float* sc[4];
#pragma unroll
            for (int r = 0; r < 4; ++r) {
                const float* src = c.in[0] + (size_t)(row4 + r) * 1024 + lane * 16;
                const f32x4 a0 = *(const f32x4*)src, a1 = *(const f32x4*)(src + 4), a2 = *(const f32x4*)(src + 8), a3 = *(const f32x4*)(src + 12);
                v[r][0] = a0.x; v[r][1] = a0.y; v[r][2] = a0.z; v[r][3] = a0.w; v[r][4] = a1.x; v[r][5] = a1.y; v[r][6] = a1.z; v[r][7] = a1.w;
                v[r][8] = a2.x; v[r][9] = a2.y; v[r][10] = a2.z; v[r][11] = a2.w; v[r][12] = a3.x; v[r][13] = a3.y; v[r][14] = a3.z; v[r][15] = a3.w;
                dst[r] = ws + WS_XQ8 + (size_t)(row4 + r) * 1024; sc[r] = (float*)(ws + WS_SXR) + row4 + r;
            }
            quant_rows_i8<4>(v, dst, sc, lane);
#pragma unroll
            for (int r = 0; r < 4; ++r) {
                u32x4 b0, b1;
#pragma unroll
                for (int j = 0; j < 4; ++j) { b0[j] = pk2(v[r][2 * j], v[r][2 * j + 1]); b1[j] = pk2(v[r][8 + 2 * j], v[r][8 + 2 * j + 1]); }
                bf16* xb = (bf16*)(ws + WS_XB) + (size_t)(row4 + r) * 1024 + lane * 16;
                *(u32x4*)xb = b0; *(u32x4*)(xb + 8) = b1;
            }
        }
    }
    {
        const float* wsrc = c.in[12]; bf16* wt = (bf16*)(ws + WS_WTRIL);
        for (size_t i = gtid; i < (size_t)8 * 128 * 128 / 8; i += gthreads) {
            const int e = (int)i * 8, s0 = e & 127, t = (e >> 7) & 127;
            const f32x4 a = ((const f32x4*)wsrc)[2 * i], b = ((const f32x4*)wsrc)[2 * i + 1];
            float v[8] = {a.x, a.y, a.z, a.w, b.x, b.y, b.z, b.w};
#pragma unroll
            for (int j = 0; j < 8; ++j) v[j] = (s0 + j <= t) ? v[j] : 0.f;
            u32x4 o; o.x = pk2(v[0], v[1]); o.y = pk2(v[2], v[3]); o.z = pk2(v[4], v[5]); o.w = pk2(v[6], v[7]);
            ((u32x4*)wt)[i] = o;
        }
    }
    if (gtid < 1024) { const float lam = c.in[9][gtid]; ((float*)(ws + WS_SPT))[gtid] = 8.0f * NLOG2E * log1pf(expf(-lam));
                       ((float*)(ws + WS_BAS))[gtid] = NLOG2E * c.in[6][gtid]; ((float*)(ws + WS_BXS))[gtid] = NLOG2E * c.in[8][gtid]; }
    if (gtid < 2048) ((float*)(ws + WS_BGS))[gtid] = NLOG2E * c.in[2][gtid];
    {
        LAS float* s = (LAS float*)lds;
        constexpr int N_IN = 16 * 96, N_OUT = 16 * 16, N_Q = 16 * 32, N_G = 64, N_ALL = N_IN + N_OUT + N_Q + N_G;
        for (int it = blockIdx.x; it < N_ALL; it += gridDim.x) {
            int r = it;
            if (r < N_IN) {
                const int n0 = (r % 96) * 64, sec = n0 >> 10, kg = (n0 & 1023) >> 7, j0 = n0 & 127;
                const int ty = (sec == 0 || sec == 3) ? 0 : ((sec == 1 || sec == 4) ? 1 : 2), half = sec >= 3;
                transpose_tile(c.in[1], DIN, (bf16*)(ws + WS_WIN), 1024, (r / 96) * 64, n0, (3 * kg + ty) * 256 + half * 128 + j0, s, tid, sec >= 4 ? NLOG2E : 1.0f); continue;
            }
            r -= N_IN;
            if (r < N_OUT) { transpose_tile(c.in[14], 1024, (bf16*)(ws + WS_WOUT), 1024, (r / 16) * 64, (r % 16) * 64, (r % 16) * 64, s, tid); continue; }
            r -= N_OUT;
            if (r < N_Q) {
                const int k0 = (r / 32) * 64, n0 = (r % 32) * 64;
                {
                    const int kk = tid >> 3, c8 = (tid & 7) * 8;
                    const float* p = c.in[17] + (size_t)(k0 + kk) * 2048 + n0 + c8;
                    const f32x4 a = *(const f32x4*)p, b = *(const f32x4*)(p + 4);
                    LAS float* q = s + kk * 65 + c8;
                    q[0] = a.x; q[1] = a.y; q[2] = a.z; q[3] = a.w; q[4] = b.x; q[5] = b.y; q[6] = b.z; q[7] = b.w;
                }
                __syncthreads();
                if (tid < 64) {
                    float pc = 0.f, pd = 0.f;
                    for (int kk = 0; kk < 64; ++kk) { const float w = s[kk * 65 + tid]; pc += c.in[15][k0 + kk] * w; pd += c.in[16][k0 + kk] * w; }
                    float* part = (float*)(ws + WS_PARTCD) + (size_t)(r / 32) * 4096;
                    part[n0 + tid] = pc; part[2048 + n0 + tid] = pd;
                }
                {
                    const int nn = tid >> 3, k8 = (tid & 7) * 8;
                    const LAS float* q = s + k8 * 65 + nn;
                    const float* g = c.in[15] + k0 + k8;
                    u32x4 o; o.x = pk2(q[0] * g[0], q[65] * g[1]); o.y = pk2(q[2 * 65] * g[2], q[3 * 65] * g[3]); o.z = pk2(q[4 * 65] * g[4], q[5 * 65] * g[5]); o.w = pk2(q[6 * 65] * g[6], q[7 * 65] * g[7]);
                    *(u32x4*)((bf16*)(ws + WS_WQ) + (size_t)(n0 + nn) * 1024 + k0 + k8) = o;
                }
                __syncthreads();
                continue;
            }
            r -= N_Q;
            {
                const int h = r >> 3, g = (r >> 2) & 1, kb = (r >> 1) & 1, nb = r & 1;
                const float* W = (g ? c.in[7] : c.in[5]) + (size_t)h * 128 * 128;
                transpose_tile(W, 128, (bf16*)(ws + WS_WAX) + (size_t)h * 256 * 128 + (size_t)g * 128 * 128, 128, kb * 64, nb * 64, nb * 64, s, tid, NLOG2E);
            }
        }
    }
}

__device__ __forceinline__ void phase0b(const Ctx& c) {
    int tid_ = threadIdx.x; asm volatile("" : "+v"(tid_)); const int tid = tid_, lane = tid & 63, wid = tid >> 6;
    unsigned char* ws = c.ws;
    const bf16* W = (const bf16*)(ws + WS_WIN);
    {
        const int gt = blockIdx.x * NTHR + tid;
        if (gt < 4096) {
            const float* part = (const float*)(ws + WS_PARTCD) + gt;
            float sacc = 0.f;
#pragma unroll
            for (int kb = 0; kb < 16; ++kb) sacc += part[(size_t)kb * 4096];
            ((float*)(ws + WS_CQ))[gt] = sacc;
        }
    }
    for (int row4 = (blockIdx.x * 8 + wid) * 4; row4 < DIN + (Q_I8 ? 2048 : 0); row4 += gridDim.x * 8 * 4) {
        float v[4][16]; unsigned char* dst[4]; float* sc[4];
#pragma unroll
        for (int r = 0; r < 4; ++r) {
            const int rw = row4 + r; const bool isq = rw >= DIN;
            const bf16* src = (isq ? (const bf16*)(ws + WS_WQ) + (size_t)(rw - DIN) * 1024 : W + (size_t)rw * 1024) + lane * 16;
            const u32x4 a = *(const u32x4*)src, b = *(const u32x4*)(src + 8);
#pragma unroll
            for (int j = 0; j < 4; ++j) { v[r][2 * j] = bf_lo(a[j]); v[r][2 * j + 1] = bf_hi(a[j]); v[r][8 + 2 * j] = bf_lo(b[j]); v[r][8 + 2 * j + 1] = bf_hi(b[j]); }
            dst[r] = isq ? ws + WS_WQQ8 + (size_t)(rw - DIN) * 1024 : ws + WS_WQ8 + (size_t)rw * 1024; sc[r] = isq ? (float*)(ws + WS_SWQ) + (rw - DIN) : (float*)(ws + WS_SWC) + rw;
        }
        quant_rows_i8<4>(v, dst, sc, lane);
    }
}

__device__ __forceinline__ void phase2a(const Ctx& c, const pg8::StaticOrder& S) {
    int tid_ = threadIdx.x; asm volatile("" : "+v"(tid_)); const int tid = tid_, lane = tid & 63, wid = tid >> 6;
    unsigned char* ws = c.ws;
    const bf16* P4 = (const bf16*)(ws + WS_P4); bf16* XC = (bf16*)c.out; float* STATS = (float*)(ws + WS_STATS);
    const float* conv_w = c.in[3]; const float* conv_b = c.in[4];
    for (int u0 = 0; ; u0 += 4) {
        pg8::Unit uu; bool any = false;
        { pg8::Unit tmp; any = S.next(u0, tmp); }
        if (!any) break;
        if (!S.next(u0 + (tid >> 7), uu)) continue;
        const int cg = tid & 15, run = uu.pm * 8 + ((tid & 127) >> 4), ch = uu.pn * 128 + cg * 8;
        float w[4][8], bias[8];
#pragma unroll
        for (int k = 0; k < 4; ++k) { const f32x4 a = *(const f32x4*)(conv_w + k * 1024 + ch), b = *(const f32x4*)(conv_w + k * 1024 + ch + 4);
            w[k][0] = a.x; w[k][1] = a.y; w[k][2] = a.z; w[k][3] = a.w; w[k][4] = b.x; w[k][5] = b.y; w[k][6] = b.z; w[k][7] = b.w; }
        { const f32x4 a = *(const f32x4*)(conv_b + ch), b = *(const f32x4*)(conv_b + ch + 4);
          bias[0] = a.x; bias[1] = a.y; bias[2] = a.z; bias[3] = a.w; bias[4] = b.x; bias[5] = b.y; bias[6] = b.z; bias[7] = b.w; }
        {
            const int t0 = run * 32; const bool first = (t0 & (SEQ - 1)) == 0;
            const bf16* src = P4 + (size_t)t0 * 4096 + ch;
            u32x4 x0 = (u32x4){0u, 0u, 0u, 0u}, x1 = x0, x2 = x0;
            if (!first) { x0 = *(const u32x4*)(src - 3 * 4096); x1 = *(const u32x4*)(src - 2 * 4096); x2 = *(const u32x4*)(src - 4096); }
#pragma unroll 8
            for (int t = 0; t < 32; ++t) {
                const u32x4 x3 = *(const u32x4*)(src + (size_t)t * 4096);
                float o[8];
#pragma unroll
                for (int j = 0; j < 8; ++j) {
                    const float v0 = (j & 1) ? bf_hi(x0[j >> 1]) : bf_lo(x0[j >> 1]), v1 = (j & 1) ? bf_hi(x1[j >> 1]) : bf_lo(x1[j >> 1]);
                    const float v2 = (j & 1) ? bf_hi(x2[j >> 1]) : bf_lo(x2[j >> 1]), v3 = (j & 1) ? bf_hi(x3[j >> 1]) : bf_lo(x3[j >> 1]);
                    o[j] = bias[j] + w[0][j] * v0 + w[1][j] * v1 + w[2][j] * v2 + w[3][j] * v3;
                }
                u32x4 pk; pk.x = pk2(o[0], o[1]); pk.y = pk2(o[2], o[3]); pk.z = pk2(o[4], o[5]); pk.w = pk2(o[6], o[7]);
                *(u32x4*)(XC + (size_t)(t0 + t) * 1024 + ch) = pk;
                x0 = x1; x1 = x2; x2 = x3;
            }
        }
    }
    for (int row4 = (blockIdx.x * 8 + wid) * 4; row4 < T; row4 += gridDim.x * 8 * 4) {
        u32x4 a[4], b[4];
#pragma unroll
        for (int r = 0; r < 4; ++r) { const bf16* p = P4 + (size_t)(row4 + r) * 4096 + 3072 + lane * 16; a[r] = *(const u32x4*)p; b[r] = *(const u32x4*)(p + 8); }
        float mean[4], q[4];
#pragma unroll
        for (int r = 0; r < 4; ++r) {
            float s = 0.f;
#pragma unroll
            for (int j = 0; j < 4; ++j) s += (bf_lo(a[r][j]) + bf_hi(a[r][j])) + (bf_lo(b[r][j]) + bf_hi(b[r][j]));
            mean[r] = s;
        }
#pragma unroll
        for (int o = 32; o >= 1; o >>= 1) {
#pragma unroll
            for (int r = 0; r < 4; ++r) mean[r] += __shfl_xor(mean[r], o);
        }
#pragma unroll
        for (int r = 0; r < 4; ++r) {
            mean[r] *= (1.0f / 1024.0f);
            float s = 0.f;
#pragma unroll
            for (int j = 0; j < 4; ++j) {
                const float d0 = bf_lo(a[r][j]) - mean[r], d1 = bf_hi(a[r][j]) - mean[r], d2 = bf_lo(b[r][j]) - mean[r], d3 = bf_hi(b[r][j]) - mean[r];
                s += (d0 * d0 + d1 * d1) + (d2 * d2 + d3 * d3);
            }
            q[r] = s;
        }
#pragma unroll
        for (int o = 32; o >= 1; o >>= 1) {
#pragma unroll
            for (int r = 0; r < 4; ++r) q[r] += __shfl_xor(q[r], o);
        }
        if (lane < 4) {
            const float mm = lane == 0 ? mean[0] : lane == 1 ? mean[1] : lane == 2 ? mean[2] : mean[3];
            const float qq = lane == 0 ? q[0] : lane == 1 ? q[1] : lane == 2 ? q[2] : q[3];
            *(f32x2*)(STATS + (size_t)(row4 + lane) * 2) = (f32x2){mm, rsqrtf(qq * (1.0f / 1024.0f) + LN_EPS)};
        }
    }
}

typedef short s16x4 __attribute__((ext_vector_type(4)));
struct P2cRegs { u32x4 v[4]; f32x2 st[4]; };
__device__ __forceinline__ void p2c_load_v(P2cRegs& R, const bf16* P4, const float* STATS, int tile, int h, int tid) {
    const int piece = tid & 15, rowb = tid >> 4;
#pragma unroll
    for (int j = 0; j < 4; ++j) {
        const size_t row = (size_t)(tile * CHUNK + rowb + 32 * j);
        R.v[j] = *(const u32x4*)(P4 + row * 4096 + 3072 + h * 128 + piece * 8);
        R.st[j] = *(const f32x2*)(STATS + row * 2);
    }
}
__device__ __forceinline__ void phase2c(const Ctx& c, LAS unsigned char* lds, const int outcol = 2048) {
    int tid_ = threadIdx.x; asm volatile("" : "+v"(tid_)); const int tid = tid_, lane = tid & 63, wid = __builtin_amdgcn_readfirstlane(tid >> 6), fr = lane & 15, fq = lane >> 4, wr = wid >> 1, wc = wid & 1;
    unsigned char* ws = c.ws;
    bf16* P4 = (bf16*)(ws + WS_P4); const float* STATS = (const float*)(ws + WS_STATS);
    const bf16* HL = (const bf16*)(ws + WS_HL); const bf16* PC = (const bf16*)((const unsigned char*)c.out + OUT_PC);
    const float* PEND = (const float*)(ws + WS_PEND); const float* HEND = (const float*)(ws + WS_HEND);
    LAS float* carry = (LAS float*)(lds + 65536);
    const bf16* WTRIL = (const bf16*)(ws + WS_WTRIL);
    const float* ln_g = c.in[10]; const float* ln_b = c.in[11]; const float* gm_bs = c.in[13];
    const int h = blockIdx.x & 7;
    bf16x8 wf[2][4];
#pragma unroll
    for (int m = 0; m < 2; ++m)
#pragma unroll
        for (int ks = 0; ks < 4; ++ks) wf[m][ks] = *(const bf16x8*)(WTRIL + (size_t)h * 128 * 128 + (32 * wr + 16 * m + fr) * 128 + ks * 32 + fq * 8);
    const int piece = tid & 15, rowb = tid >> 4;
    float lg[8], lb[8];
    { const f32x4 g0 = *(const f32x4*)(ln_g + h * 128 + piece * 8), g1 = *(const f32x4*)(ln_g + h * 128 + piece * 8 + 4), b0 = *(const f32x4*)(ln_b + h * 128 + piece * 8), b1 = *(const f32x4*)(ln_b + h * 128 + piece * 8 + 4);
#pragma unroll
      for (int j = 0; j < 4; ++j) { lg[j] = g0[j]; lg[4 + j] = g1[j]; lb[j] = b0[j]; lb[4 + j] = b1[j]; } }
    const int wr_off = rowb * 256 + ((piece ^ ((rowb & 3) << 2)) << 4);
    const bool wr_swap = ((rowb >> 3) & 1) != 0;
    const int q_ = fr >> 2, p_ = fr & 3;
    int rd_off[2][2];
#pragma unroll
    for (int n2 = 0; n2 < 2; ++n2)
#pragma unroll
        for (int np = 0; np < 2; ++np) rd_off[n2][np] = (fq * 8 + q_) * 256 + (((8 * wc + 4 * n2 + p_) ^ (q_ << 2)) << 4) + ((np ^ (fq & 1)) << 3);
    const int nblk_h = gridDim.x >> 3;
    const int tile0 = blockIdx.x >> 3;
    P2cRegs RA, RB;
    if (tile0 < NTILE) p2c_load_v(RA, P4, STATS, tile0, h, tid);
    if (tile0 + nblk_h < NTILE) p2c_load_v(RB, P4, STATS, tile0 + nblk_h, h, tid);
#define P2C_UNIT(R, tile, par) do { \
        const int t0 = (tile) * CHUNK; \
        LAS unsigned char* V = lds + (par) * 32768; \
        _Pragma("unroll") for (int j = 0; j < 4; ++j) { \
            const float mean = R.st[j].x, rstd = R.st[j].y; \
            u32x4 w; \
            _Pragma("unroll") for (int e = 0; e < 4; ++e) w[e] = pk2((bf_lo(R.v[j][e]) - mean) * rstd * lg[2 * e] + lb[2 * e], (bf_hi(R.v[j][e]) - mean) * rstd * lg[2 * e + 1] + lb[2 * e + 1]); \
            if (wr_swap) w = (u32x4){w.z, w.w, w.x, w.y}; \
            *(LAS u32x4*)(V + wr_off + j * 32 * 256) = w; } \
        if (tid < 128) {                                        \
            const int cidx_ = (tile) & (NCHUNK - 1), tb_ = (tile) - cidx_; float hin_ = 0.f; \
            _Pragma("unroll") for (int cc = 0; cc < NCHUNK - 1; ++cc) { \
                const bool on_ = cc < cidx_; const int tl_ = on_ ? tb_ + cc : tb_; \
                const float p_ = PEND[(size_t)tl_ * 1024 + h * 128 + tid], q_ = HEND[(size_t)tl_ * 1024 + h * 128 + tid]; \
                hin_ = on_ ? p_ * hin_ + q_ : hin_; } \
            carry[(par) * 128 + tid] = hin_; } \
        __syncthreads(); \
        if ((tile) + 2 * nblk_h < NTILE) p2c_load_v(R, P4, STATS, (tile) + 2 * nblk_h, h, tid); \
        u32x4 hlv[2][2], pcv[2][2], gvv[2][2], ugv[2][2]; \
        _Pragma("unroll") for (int m = 0; m < 2; ++m) _Pragma("unroll") for (int n2 = 0; n2 < 2; ++n2) { \
            const size_t row_ = (size_t)(t0 + 32 * wr + 16 * m + fr); const int col_ = h * 128 + 64 * wc + 32 * n2 + 8 * fq; \
            hlv[m][n2] = *(const u32x4*)(HL + row_ * 1024 + col_); pcv[m][n2] = *(const u32x4*)(PC + row_ * 1024 + col_); gvv[m][n2] = *(const u32x4*)(P4 + row_ * 4096 + 1024 + col_); ugv[m][n2] = *(const u32x4*)(P4 + row_ * 4096 + 2048 + col_); } \
        f32x4 acc[2][4]; \
        _Pragma("unroll") for (int m = 0; m < 2; ++m) _Pragma("unroll") for (int n = 0; n < 4; ++n) acc[m][n] = (f32x4){0.f, 0.f, 0.f, 0.f}; \
        _Pragma("unroll") for (int ks = 0; ks < 4; ++ks) { \
            if (ks <= wr) { \
                bf16x8 b[4]; \
                _Pragma("unroll") for (int n = 0; n < 4; ++n) { \
                    const s16x4 lo = __builtin_amdgcn_ds_read_tr16_b64_v4i16((LAS s16x4*)(V + rd_off[n >> 1][n & 1] + ks * 32 * 256)); \
                    const s16x4 hi = __builtin_amdgcn_ds_read_tr16_b64_v4i16((LAS s16x4*)(V + rd_off[n >> 1][n & 1] + ks * 32 * 256 + 4 * 256)); \
                    b[n] = __builtin_shufflevector(lo, hi, 0, 1, 2, 3, 4, 5, 6, 7); } \
                _Pragma("unroll") for (int m = 0; m < 2; ++m) _Pragma("unroll") for (int n = 0; n < 4; ++n) acc[m][n] = __builtin_amdgcn_mfma_f32_16x16x32_bf16(b[n], wf[m][ks], acc[m][n], 0, 0, 0); } } \
        _Pragma("unroll") for (int m = 0; m < 2; ++m) { \
            const int tl = 32 * wr + 16 * m + fr; \
            const float bsv = gm_bs[h * 128 + tl]; \
            _Pragma("unroll") for (int n2 = 0; n2 < 2; ++n2) { \
                const f32x4 m0 = acc[m][2 * n2] + bsv, m1 = acc[m][2 * n2 + 1] + bsv; \
                const u32x4 ug = ugv[m][n2], hl_ = hlv[m][n2], pc_ = pcv[m][n2], g_ = gvv[m][n2]; \
                const LAS float* cp_ = carry + (par) * 128 + 64 * wc + 32 * n2 + 8 * fq; \
                const f32x4 h0_ = *(const LAS f32x4*)cp_, h1_ = *(const LAS f32x4*)(cp_ + 4); \
                u32x4 o;                                             \
                o.x = pk2(bf_lo(g_.x) * (bf_lo(hl_.x) + bf_lo(pc_.x) * h0_[0]) + bf_lo(ug.x) * m0[0], bf_hi(g_.x) * (bf_hi(hl_.x) + bf_hi(pc_.x) * h0_[1]) + bf_hi(ug.x) * m0[1]); \
                o.y = pk2(bf_lo(g_.y) * (bf_lo(hl_.y) + bf_lo(pc_.y) * h0_[2]) + bf_lo(ug.y) * m0[2], bf_hi(g_.y) * (bf_hi(hl_.y) + bf_hi(pc_.y) * h0_[3]) + bf_hi(ug.y) * m0[3]); \
                o.z = pk2(bf_lo(g_.z) * (bf_lo(hl_.z) + bf_lo(pc_.z) * h1_[0]) + bf_lo(ug.z) * m1[0], bf_hi(g_.z) * (bf_hi(hl_.z) + bf_hi(pc_.z) * h1_[1]) + bf_hi(ug.z) * m1[1]); \
                o.w = pk2(bf_lo(g_.w) * (bf_lo(hl_.w) + bf_lo(pc_.w) * h1_[2]) + bf_lo(ug.w) * m1[2], bf_hi(g_.w) * (bf_hi(hl_.w) + bf_hi(pc_.w) * h1_[3]) + bf_hi(ug.w) * m1[3]); \
                *(u32x4*)(P4 + (size_t)(t0 + tl) * 4096 + outcol + h * 128 + 64 * wc + 32 * n2 + 8 * fq) = o; } } \
    } while (0)
    for (int tile = tile0; tile < NTILE; tile += 2 * nblk_h) {
        P2C_UNIT(RA, tile, 0);
        if (tile + nblk_h < NTILE) P2C_UNIT(RB, tile + nblk_h, 1);
    }
#undef P2C_UNIT
}


__device__ __forceinline__ int f2key(float f) { const int b = __float_as_int(f); return b ^ ((b >> 31) & 0x7fffffff); }
__device__ __forceinline__ float key2f(int k) { return __int_as_float(k ^ ((k >> 31) & 0x7fffffff)); }
#define CE_DESC(a, b) do { const int _mx = max((a), (b)), _mn = min((a), (b)); (a) = _mx; (b) = _mn; } while (0)

template <int OFF, int N> __device__ __forceinline__ void sort16_desc(int (&v)[N]) {
#pragma unroll
    for (int k = 2; k <= 16; k <<= 1) {
#pragma unroll
        for (int j = k >> 1; j > 0; j >>= 1) {
#pragma unroll
            for (int i = 0; i < 16; ++i) {
                const int l = i ^ j;
                if (l > i) { if ((i & k) == 0) CE_DESC(v[OFF + i], v[OFF + l]); else CE_DESC(v[OFF + l], v[OFF + i]); }
            }
        }
    }
}
template <int OA, int OB, int N> __device__ __forceinline__ void merge16_desc(int (&v)[N]) {
#pragma unroll
    for (int i = 0; i < 16; ++i) v[OA + i] = max(v[OA + i], v[OB + 15 - i]);
#pragma unroll
    for (int j = 8; j > 0; j >>= 1) {
#pragma unroll
        for (int i = 0; i < 16; ++i) { const int l = i ^ j; if (l > i) CE_DESC(v[OA + i], v[OA + l]); }
    }
}
__device__ __forceinline__ void top16_of_64(int (&v)[64]) {
    sort16_desc<0>(v); sort16_desc<16>(v); sort16_desc<32>(v); sort16_desc<48>(v);
    merge16_desc<0, 16>(v); merge16_desc<32, 48>(v); merge16_desc<0, 32>(v);
}
__device__ __forceinline__ void merge_partner(int (&L)[16]) {
    int P[16];
#pragma unroll
    for (int i = 0; i < 16; ++i) P[i] = __shfl_xor(L[i], 32);
#pragma unroll
    for (int i = 0; i < 16; ++i) L[i] = max(L[i], P[15 - i]);
#pragma unroll
    for (int j = 8; j > 0; j >>= 1) {
#pragma unroll
        for (int i = 0; i < 16; ++i) { const int l = i ^ j; if (l > i) CE_DESC(L[i], L[l]); }
    }
}
__device__ __forceinline__ unsigned lookup_byte(const unsigned (&t)[4], int i) {
    const int w = i >> 2;
    const unsigned dw = (w == 0) ? t[0] : (w == 1) ? t[1] : (w == 2) ? t[2] : t[3];
    return (dw >> ((i & 3) * 8)) & 0xffu;
}

typedef _Float16 h16x2 __attribute__((ext_vector_type(2)));
__device__ __forceinline__ unsigned pkh2(float lo, float hi) { return __builtin_bit_cast(unsigned, __builtin_amdgcn_cvt_pkrtz(lo, hi)); }
__device__ __forceinline__ float h_lo(unsigned w) { return (float)__builtin_bit_cast(h16x2, w)[0]; }
__device__ __forceinline__ float h_hi(unsigned w) { return (float)__builtin_bit_cast(h16x2, w)[1]; }
constexpr int P7_KP = 272;
__device__ __forceinline__ void phase7(const Ctx& c, LAS unsigned char* lds) {
    int tid_ = threadIdx.x; asm volatile("" : "+v"(tid_)); const int tid = tid_, lane = tid & 63, wid = __builtin_amdgcn_readfirstlane(tid >> 6), r = lane & 31, hh = lane >> 5;
    unsigned char* ws = c.ws;
    const bf16* Q = (const bf16*)c.out; const bf16* KB = (const bf16*)(ws + WS_KEYS);
    int* IDX = (int*)(ws + WS_IDX); float* GATE = (float*)(ws + WS_GATE);
    const int head = blockIdx.x & 7, nblk_h = gridDim.x >> 3;
    {
        const bf16* ksrc = KB + (size_t)head * 256 * 128;
        for (int i = tid; i < 256 * 16; i += NTHR) { const int row = i >> 4, sg = i & 15; *(LAS u32x4*)(lds + row * P7_KP + sg * 16) = *(const u32x4*)(ksrc + row * 128 + sg * 8); }
    }
    __syncthreads();
    const LAS unsigned char* kl = lds + r * P7_KP + hh * 16;
    if (wid & 1) quant_peer_tables(c, blockIdx.x * 8 + wid, gridDim.x * 8, lane);
    for (int grp = (blockIdx.x >> 3) * 8 + wid; grp < T / 32; grp += nblk_h * 8) {
        const int tok = grp * 32 + r;
        int kz = 0; asm volatile("" : "+v"(kz));
        const LAS unsigned char* klz = kl + kz;
        bf16x8 qf[2][8];
        {
            const bf16* qp = Q + (size_t)tok * 2048 + head * 256 + hh * 8;
#pragma unroll
            for (int p = 0; p < 2; ++p)
#pragma unroll
                for (int ks = 0; ks < 8; ++ks) qf[p][ks] = *(const bf16x8*)(qp + p * 128 + ks * 16);
        }
        int S[2][16];
#pragma unroll
        for (int p = 0; p < 2; ++p) {
            f32x16 acc[4];
#pragma unroll
            for (int mb = 0; mb < 4; ++mb)
#pragma unroll
                for (int e = 0; e < 16; ++e) acc[mb][e] = 0.f;
#pragma unroll
            for (int ks = 0; ks < 8; ++ks) {
#pragma unroll
                for (int mb = 0; mb < 4; ++mb) {
                    const bf16x8 a = *(const LAS bf16x8*)(klz + (p * 128 + mb * 32) * P7_KP + ks * 32);
                    acc[mb] = __builtin_amdgcn_mfma_f32_32x32x16_bf16(a, qf[p][ks], acc[mb], 0, 0, 0);
                }
            }
            int v[64];
#pragma unroll
            for (int mb = 0; mb < 4; ++mb)
#pragma unroll
                for (int e = 0; e < 16; ++e) {
                    const int n = mb * 32 + (e & 3) + 8 * (e >> 2);
                    v[mb * 16 + e] = (f2key(acc[mb][e]) & ~0x7f) | n;
                }
            top16_of_64(v);
            int L[16];
#pragma unroll
            for (int i = 0; i < 16; ++i) L[i] = v[i] | (hh << 2);
            merge_partner(L);
#pragma unroll
            for (int i = 0; i < 16; ++i) S[p][i] = L[i];
        }
        float f1[16], f2[16];
#pragma unroll
        for (int i = 0; i < 16; ++i) { f1[i] = key2f(S[0][i]); f2[i] = key2f(S[1][i]); }
        int cv[64];
        {
            int n = 0;
#pragma unroll
            for (int i = 0; i < 16; ++i)
#pragma unroll
                for (int j = 0; j < 16; ++j)
                    if ((i + 1) * (j + 1) <= 16) { cv[n] = (f2key(f1[i] + f2[j]) & ~0xff) | (i * 16 + j); ++n; }
#pragma unroll
            for (int q = 50; q < 64; ++q) cv[q] = (int)0x80000000;
        }
        top16_of_64(cv);
        unsigned t1[4], t2[4];
#pragma unroll
        for (int w = 0; w < 4; ++w) {
            t1[w] = (unsigned)(S[0][4 * w] & 0x7f) | ((unsigned)(S[0][4 * w + 1] & 0x7f) << 8) | ((unsigned)(S[0][4 * w + 2] & 0x7f) << 16) | ((unsigned)(S[0][4 * w + 3] & 0x7f) << 24);
            t2[w] = (unsigned)(S[1][4 * w] & 0x7f) | ((unsigned)(S[1][4 * w + 1] & 0x7f) << 8) | ((unsigned)(S[1][4 * w + 2] & 0x7f) << 16) | ((unsigned)(S[1][4 * w + 3] & 0x7f) << 24);
        }
        int eid[16]; float ev[16];
        const float vmax = key2f(cv[0]);
        float esum = 0.f;
#pragma unroll
        for (int k = 0; k < 16; ++k) {
            const int pos = cv[k] & 0xff;
            eid[k] = (int)(lookup_byte(t1, pos >> 4) * 128u + lookup_byte(t2, pos & 15));
            ev[k] = __expf(key2f(cv[k]) - vmax);
            esum += ev[k];
        }
        const float inv = 1.0f / esum;
        if (hh == 0) {
            i32x4* ip = (i32x4*)(IDX + (size_t)tok * 128 + head * 16); f32x4* gp = (f32x4*)(GATE + (size_t)tok * 128 + head * 16);
#pragma unroll
            for (int w = 0; w < 4; ++w) {
                ip[w] = (i32x4){eid[4 * w], eid[4 * w + 1], eid[4 * w + 2], eid[4 * w + 3]};
                gp[w] = (f32x4){ev[4 * w] * inv, ev[4 * w + 1] * inv, ev[4 * w + 2] * inv, ev[4 * w + 3] * inv};
            }
        }
    }
    if (!(wid & 1)) quant_peer_tables(c, blockIdx.x * 8 + wid, gridDim.x * 8, lane);
}

#ifndef P8_TOK_
#define P8_TOK_ 8
#endif
#ifndef P8_EARLY_
#define P8_EARLY_ 1
#endif
constexpr int P8_TOK = P8_TOK_, P8_WAVE_LDS = P8_TOK * 2048 + 512;
template <int CTRL> __device__ __forceinline__ int dppi(int v) { return __builtin_amdgcn_update_dpp(0, v, CTRL, 0xf, 0xf, false); }
__device__ __forceinline__ int reduce16i(const int (&p)[16], bool b3, bool b2) {
    int q8[8], r4[4], s2[2];
#pragma unroll
    for (int i = 0; i < 8; ++i) { const auto r = __builtin_amdgcn_permlane32_swap((unsigned)p[i], (unsigned)p[8 + i], false, false); q8[i] = (int)(r[0] + r[1]); }
#pragma unroll
    for (int i = 0; i < 4; ++i) { const auto r = __builtin_amdgcn_permlane16_swap((unsigned)q8[i], (unsigned)q8[4 + i], false, false); r4[i] = (int)(r[0] + r[1]); }
#pragma unroll
    for (int i = 0; i < 2; ++i) { const int ta = r4[i] + dppi<0x128>(r4[i]), tb = r4[2 + i] + dppi<0x128>(r4[2 + i]); s2[i] = b3 ? tb : ta; }
    const int ta = s2[0] + dppi<0x141>(s2[0]), tb = s2[1] + dppi<0x141>(s2[1]);
    int t = b2 ? tb : ta;
    t += dppi<0x4e>(t);
    t += dppi<0xb1>(t);
    return t;
}
#define P8_LOAD_X1(x, tok) do { \
        const bf16* zr_ = ZB + (size_t)(tok) * 1024 + lane * 16; \
        const u32x4 a0_ = *(const u32x4*)zr_, a1_ = *(const u32x4*)(zr_ + 8); \
        const f32x2 st_ = *(const f32x2*)(ST1 + (size_t)(tok) * 2); \
        _Pragma("unroll") for (int j = 0; j < 4; ++j) { x[2 * j] = bf_lo(a0_[j]); x[2 * j + 1] = bf_hi(a0_[j]); x[8 + 2 * j] = bf_lo(a1_[j]); x[8 + 2 * j + 1] = bf_hi(a1_[j]); } \
        _Pragma("unroll") for (int w = 0; w < 4; ++w) { \
            const f32x4 g_ = *(const f32x4*)(l1g + lane * 16 + 4 * w), b_ = *(const f32x4*)(l1b + lane * 16 + 4 * w); \
            _Pragma("unroll") for (int k = 0; k < 4; ++k) x[4 * w + k] = (x[4 * w + k] - st_.x) * st_.y * g_[k] + b_[k]; } \
    } while (0)
#define P8_ISSUE_U(U, IDV, GV, SC2, tt_, k_) do { \
        const u32x2 en_ = *(const LAS u32x2*)(wl + (tt_) * 1024 + ((k_) * 16 + esub) * 8); \
        IDV = (int)en_.x; GV = __uint_as_float(en_.y); SC2 = SC[IDV]; \
        unsigned l8_ = lane8; asm volatile("" : "+v"(l8_)); \
        _Pragma("unroll") for (int e = 0; e < 16; ++e) { \
            unsigned long long rb_ = (unsigned long long)UV + ((unsigned long long)(unsigned)__builtin_amdgcn_readlane(IDV, e * 4) << 10); \
            asm volatile("" : "+s"(rb_));                              \
            U[e] = *(const __attribute__((address_space(1))) u32x2*)(rb_ + l8_); } \
    } while (0)
#define P8_ISSUE_V(V, IDV) do { \
        unsigned l8_ = lane8; asm volatile("" : "+v"(l8_)); \
        _Pragma("unroll") for (int e = 0; e < 16; ++e) { \
            unsigned long long rb_ = (unsigned long long)UV + ((unsigned long long)(unsigned)__builtin_amdgcn_readlane(IDV, e * 4) << 10); \
            asm volatile("" : "+s"(rb_)); \
            V[e] = *(const __attribute__((address_space(1))) u32x2*)(rb_ + 512 + l8_); } \
    } while (0)
#define P8_USIDE(U, GV, SC2, tt_, ACT) do { \
        const u32x4 xq_ = *(const LAS u32x4*)(wx + (tt_) * 1024 + lane8 * 2); \
        int p_[16]; \
        _Pragma("unroll") for (int e = 0; e < 16; ++e) { \
            int t_; asm("v_dot8_i32_i4 %0, %1, %2, 0" : "=v"(t_) : "v"(U[e].x), "v"(xq_.x)); \
            t_ = __builtin_amdgcn_sdot8((int)U[e].y, (int)xq_.y, t_, false); t_ <<= 4; \
            t_ = __builtin_amdgcn_sdot8((int)U[e].x, (int)xq_.z, t_, false); t_ = __builtin_amdgcn_sdot8((int)U[e].y, (int)xq_.w, t_, false); p_[e] = t_; } \
        const int t1_ = reduce16i(p_, b3, b2); \
        ACT = gelu_tanh(((float)t1_ + hoff[tt_]) * SC2.x * sx[tt_]) * GV * SC2.y; \
    } while (0)
#define P8_FP4(w_, b_) __builtin_amdgcn_cvt_scalef32_pk_f32_fp4(w_, 1.0f, b_)
#define P8_VSIDE(V, tt_, ACT) do { \
        f32x2 oc_[8]; \
        _Pragma("unroll") for (int j = 0; j < 8; ++j) oc_[j] = (f32x2){h_lo(ob[tt_][j]), h_hi(ob[tt_][j])}; \
        _Pragma("unroll") for (int e = 0; e < 16; ++e) { \
            const float ae_ = __int_as_float(__builtin_amdgcn_readlane(__float_as_int(ACT), e * 4)); const f32x2 aa_ = {ae_, ae_}; \
            oc_[0] = __builtin_elementwise_fma(P8_FP4(V[e].x, 0), aa_, oc_[0]); oc_[1] = __builtin_elementwise_fma(P8_FP4(V[e].x, 1), aa_, oc_[1]); \
            oc_[2] = __builtin_elementwise_fma(P8_FP4(V[e].x, 2), aa_, oc_[2]); oc_[3] = __builtin_elementwise_fma(P8_FP4(V[e].x, 3), aa_, oc_[3]); \
            oc_[4] = __builtin_elementwise_fma(P8_FP4(V[e].y, 0), aa_, oc_[4]); oc_[5] = __builtin_elementwise_fma(P8_FP4(V[e].y, 1), aa_, oc_[5]); \
            oc_[6] = __builtin_elementwise_fma(P8_FP4(V[e].y, 2), aa_, oc_[6]); oc_[7] = __builtin_elementwise_fma(P8_FP4(V[e].y, 3), aa_, oc_[7]); } \
        _Pragma("unroll") for (int j = 0; j < 8; ++j) ob[tt_][j] = pkh2(oc_[j].x, oc_[j].y); \
    } while (0)
#define P8_STEP(UC, VC, GC, SCC, tt_, UN, VN, IDN, GN, SCN, ttn_, kn_) do { \
        P8_ISSUE_U(UN, IDN, GN, SCN, ttn_, kn_); __builtin_amdgcn_sched_barrier(0); \
        float act_; P8_USIDE(UC, GC, SCC, tt_, act_); __builtin_amdgcn_sched_barrier(0); \
        P8_ISSUE_V(VN, IDN); __builtin_amdgcn_sched_barrier(0); \
        P8_VSIDE(VC, tt_, act_); __builtin_amdgcn_sched_barrier(0); \
    } while (0)
__device__ __forceinline__ void phase8(const Ctx& c, LAS unsigned char* lds, const XcdBarrier& xbar) {
    int tid_ = threadIdx.x; asm volatile("" : "+v"(tid_)); const int tid = tid_, lane = tid & 63, wid = __builtin_amdgcn_readfirstlane(tid >> 6);
    unsigned char* ws = c.ws;
    const bf16* ZB = (const bf16*)(ws + WS_Z); const float* ST1 = (const float*)(ws + WS_ST1); const float* l1g = c.in[15]; const float* l1b = c.in[16];
    const int* IDX = (const int*)(ws + WS_IDX); const float* GATE = (const float*)(ws + WS_GATE);
    const unsigned char* UV = ws + WS_UQ; const f32x2* SC = (const f32x2*)(ws + WS_USC);
    const float* lg = c.in[21]; const float* lb = c.in[22];
    float* OUT = c.out;
    const bool b3 = (lane & 8) != 0, b2 = (lane & 4) != 0;
    const int esub = lane >> 2; const unsigned lane8 = (unsigned)lane * 8u;
    LAS unsigned char* wl = lds + wid * P8_WAVE_LDS;
    LAS unsigned char* wx = wl + P8_TOK * 1024;
    LAS int* hist = (LAS int*)(wx + P8_TOK * 1024);
    const int ntl = (NTILE + gridDim.x - 1) / gridDim.x;
    for (int ti = 0; ti < ntl; ++ti) {
        const int tile = blockIdx.x + ti * gridDim.x; const bool live = tile < NTILE;
        for (int rnd = 0; rnd < 16 / P8_TOK; ++rnd) {
            const int tok0 = tile * CHUNK + wid * 16 + rnd * P8_TOK;
            float sx[P8_TOK], hoff[P8_TOK]; unsigned ob[P8_TOK][8];
            if (live) {
#pragma unroll
                for (int tt = 0; tt < P8_TOK; ++tt) {
                    const int tok = tok0 + tt;
                    {
                        float x[16];
                        P8_LOAD_X1(x, tok);
                        float m = 0.f;
#pragma unroll
                        for (int j = 0; j < 16; ++j) m = fmaxf(m, fabsf(x[j]));
#pragma unroll
                        for (int of = 32; of >= 1; of >>= 1) m = fmaxf(m, __shfl_xor(m, of));
                        const float sc = (m > 0.f) ? m * (1.0f / 119.0f) : 1.0f, inv = 1.0f / sc;
                        sx[tt] = __int_as_float(__builtin_amdgcn_readfirstlane(__float_as_int(sc)));
                        unsigned xh0 = 0u, xh1 = 0u, xl0 = 0u, xl1 = 0u; int sm = 0;
#pragma unroll
                        for (int k = 0; k < 16; ++k) {
                            const int xi = (int)rintf(x[k] * inv), lo = ((xi + 8) & 15) - 8, hi = (xi - lo) >> 4;
                            sm += xi;
                            if (k < 8) { xh0 |= (unsigned)(hi & 15) << (4 * k); xl0 |= (unsigned)(lo & 15) << (4 * k); }
                            else { xh1 |= (unsigned)(hi & 15) << (4 * (k - 8)); xl1 |= (unsigned)(lo & 15) << (4 * (k - 8)); }
                        }
                        *(LAS u32x4*)(wx + tt * 1024 + lane8 * 2) = (u32x4){xh0, xh1, xl0, xl1};
                        hoff[tt] = __int_as_float(__builtin_amdgcn_readfirstlane(__float_as_int(0.5f * wave_sum((float)sm))));
                    }
#pragma unroll
                    for (int j = 0; j < 8; ++j) ob[tt][j] = 0u;
                    {
                        LAS unsigned char* L = wl + tt * 1024;
                        const int i0 = IDX[(size_t)tok * 128 + lane], i1 = IDX[(size_t)tok * 128 + 64 + lane];
                        const float g0 = GATE[(size_t)tok * 128 + lane], g1 = GATE[(size_t)tok * 128 + 64 + lane];
                        const int k0 = i0 >> 7, k1 = i1 >> 7;
                        *(LAS u32x2*)(hist + 2 * lane) = (u32x2){0u, 0u};
                        asm volatile("" ::: "memory");
                        const int w0 = __hip_atomic_fetch_add(hist + k0, 1, __ATOMIC_RELAXED, __HIP_MEMORY_SCOPE_WORKGROUP);
                        const int w1 = __hip_atomic_fetch_add(hist + k1, 1, __ATOMIC_RELAXED, __HIP_MEMORY_SCOPE_WORKGROUP);
                        asm volatile("" ::: "memory");
                        const u32x2 cc = *(const LAS u32x2*)(hist + 2 * lane);
                        const int s = (int)(cc.x + cc.y); int incl = s;
#pragma unroll
                        for (int o = 1; o < 64; o <<= 1) { const int t = __shfl_up(incl, o); incl += (lane >= o) ? t : 0; }
                        const int excl = incl - s;
                        asm volatile("" ::: "memory");
                        *(LAS u32x2*)(hist + 2 * lane) = (u32x2){(unsigned)excl, (unsigned)excl + cc.x};
                        asm volatile("" ::: "memory");
                        const int pos0 = hist[k0] + w0, pos1 = hist[k1] + w1;
                        asm volatile("" ::: "memory");
                        *(LAS u32x2*)(L + pos0 * 8) = (u32x2){(unsigned)i0, __float_as_uint(g0)};
                        *(LAS u32x2*)(L + pos1 * 8) = (u32x2){(unsigned)i1, __float_as_uint(g1)};
                        asm volatile("" ::: "memory");
                    }
                }
                u32x2 ua[16], ub[16], va[16], vb[16]; int ida, idb; float ga, gb; f32x2 sa, sb;
                P8_ISSUE_U(ua, ida, ga, sa, 0, 0);
                P8_ISSUE_V(va, ida);
                for (int k = 0; k < 8; ++k) {
                    const int kn = k < 7 ? k + 1 : 7;
#pragma unroll
                    for (int tt = 0; tt < P8_TOK; tt += 2) {
                        P8_STEP(ua, va, ga, sa, tt, ub, vb, idb, gb, sb, tt + 1, k);
                        if (tt + 2 < P8_TOK) P8_STEP(ub, vb, gb, sb, tt + 1, ua, va, ida, ga, sa, tt + 2, k);
                        else P8_STEP(ub, vb, gb, sb, tt + 1, ua, va, ida, ga, sa, 0, kn);
                    }
                }
                int tok0e = tok0; asm volatile("" : "+s"(tok0e));
#pragma unroll
                for (int tt = 0; tt < P8_TOK; ++tt) {
                    const int tok = tok0e + tt;
                    float x[16];
                    P8_LOAD_X1(x, tok);
                    float sm = 0.f;
                    float o[16];
#pragma unroll
                    for (int j = 0; j < 8; ++j) { o[2 * j] = h_lo(ob[tt][j]); o[2 * j + 1] = h_hi(ob[tt][j]); }
#pragma unroll
                    for (int j = 0; j < 16; ++j) { o[j] = ALPHA * x[j] + o[j]; sm += o[j]; }
                    const float mean = wave_sum(sm) * (1.0f / 1024.0f);
                    float qv = 0.f;
#pragma unroll
                    for (int j = 0; j < 16; ++j) { o[j] -= mean; qv += o[j] * o[j]; }
                    const float rstd = rsqrtf(wave_sum(qv) * (1.0f / 1024.0f) + LN_EPS);
                    const float* gp = lg + lane * 16; const float* bp = lb + lane * 16;
                    float* op = OUT + (size_t)tok * 1024 + lane * 16;
#pragma unroll
                    for (int w = 0; w < 4; ++w) {
                        const f32x4 gg = *(const f32x4*)(gp + 4 * w), hb = *(const f32x4*)(bp + 4 * w);
                        *(f32x4*)(op + 4 * w) = (f32x4){o[4 * w], o[4 * w + 1], o[4 * w + 2], o[4 * w + 3]} * rstd * gg + hb;
                    }
                }
            }
        }
    }
}

struct Params { const float* in[23]; float* out; unsigned char* ws; };

__global__ void __launch_bounds__(NTHR, 2) hybrid_fwd(Params p) {
    extern __shared__ __attribute__((aligned(16))) unsigned char lds_raw[];
    LAS unsigned char* lds = (LAS unsigned char*)lds_raw;
    cg::grid_group grid = cg::this_grid();
    Ctx c;
#pragma unroll
    for (int i = 0; i < 23; ++i) c.in[i] = p.in[i];
    c.out = p.out; c.ws = p.ws;
    unsigned char* ws = p.ws;

#ifndef G6_ALIGN
#define G6_ALIGN true
#endif
#ifndef G4_ALIGN
#define G4_ALIGN true
#endif
#ifndef G1_ALIGN
#define G1_ALIGN true
#endif
#ifndef G1_SP2
#define G1_SP2 true
#endif
#ifndef PH_MASK
#define PH_MASK 0x1ff
#endif
#ifndef REP0
#define REP0 1
#endif
#ifndef REP123
#define REP123 1
#endif
#ifndef REP1
#define REP1 1
#endif
#ifndef REP4
#define REP4 1
#endif
#ifndef REP5
#define REP5 1
#endif
#ifndef REP6
#define REP6 1
#endif
#ifndef REP7
#define REP7 1
#endif
#ifndef REP8
#define REP8 1
#endif
    if (threadIdx.x < 4) ((volatile LAS unsigned*)(lds + LDS_BARST))[threadIdx.x] = 0u;
    __syncthreads();
    const XcdBarrier xbar = xcd_barrier_post((unsigned*)(ws + WS_BAR), (volatile LAS unsigned*)(lds + LDS_BARST));
    if (p.ws == nullptr) grid.sync();
#define GSYNC() xcd_barrier(xbar)
    for (int rep = 0; rep < REP0; ++rep) { if (PH_MASK & 1) phase0(c, lds);
    GSYNC(); }
    if (PH_MASK & 1) phase0b(c);
    GSYNC();
    for (int rep123 = 0; rep123 < REP123; ++rep123) {
    for (int rep1 = 0; rep1 < REP1; ++rep1) {
    if (PH_MASK & 2) {
        pg8::Gemm g{(const bf16*)(ws + WS_XQ8), (const bf16*)(ws + WS_WQ8), T, DIN, 512, 512, 512, 0};
        pg8::StaticOrder S; S.init(T, DIN, (int)gridDim.x, (int)blockIdx.x);
        pg8::EpiProj E{(bf16*)(ws + WS_P4), (const float*)(ws + WS_BGS), (const float*)(ws + WS_SXR), (const float*)(ws + WS_SWC)};
        pg8::gemm_phase<pg8::EpiProj, pg8::StaticOrder, G1_ALIGN, G1_SP2>(lds, g, S, E);
    }
    GSYNC(); }
#ifndef REP2A
#define REP2A 1
#endif
#ifndef REP2B
#define REP2B 1
#endif
#ifndef REP3A
#define REP3A 1
#endif
    for (int r2 = 0; r2 < REP2B; ++r2) {
    if (PH_MASK & 4) {
        pg8::Gemm g{(const bf16*)p.out, (const bf16*)(ws + WS_WAX), T, 2048, 128, 1024, 128, 256};
        pg8::StaticOrder S; S.init(T, 2048, (int)gridDim.x, (int)blockIdx.x);
        phase2a(c, S);
        asm volatile("s_waitcnt vmcnt(0)" ::: "memory");
        __syncthreads();
        pg8::EpiGate E{(const bf16*)p.out, (bf16*)(ws + WS_HL), (bf16*)((unsigned char*)p.out + OUT_PC), (float*)(ws + WS_PEND), (float*)(ws + WS_HEND), (const float*)(ws + WS_BAS), (const float*)(ws + WS_BXS), (const float*)(ws + WS_SPT)};
        pg8::gemm_phase<pg8::EpiGate, pg8::StaticOrder, true, true>(lds, g, S, E);
    }
    GSYNC(); }
#ifdef REP2C
    phase2c(c, lds, 0); GSYNC();
#endif
    if (PH_MASK & 4) phase2c(c, lds);
    GSYNC(); }
    for (int rep4 = 0; rep4 < REP4; ++rep4) {
    if (PH_MASK & 16) {
        pg8::Gemm g{(const bf16*)(ws + WS_P4) + 2048, (const bf16*)(ws + WS_WOUT), T, 1024, 1024, 4096, 1024, 0};
        pg8::StaticOrder S; S.init(T, 1024, (int)gridDim.x, (int)blockIdx.x);
        pg8::EpiResid E{(const bf16*)(ws + WS_XB), (bf16*)(ws + WS_Z), 1024, ALPHA, (float*)(ws + WS_PARTZ)};
        pg8::gemm_phase<pg8::EpiResid, pg8::StaticOrder, G4_ALIGN, true>(lds, g, S, E);
    }
    GSYNC(); }
    for (int rep6 = 0; rep6 < REP6; ++rep6) {
    if (PH_MASK & 64) {
#if Q_I8
        pg8::Gemm g{(const bf16*)(ws + WS_X1Q8), (const bf16*)(ws + WS_WQQ8), T, 2048, 512, 512, 512, 0};
        pg8::StaticOrder S; S.init(T, 2048, (int)gridDim.x, (int)blockIdx.x);
        pg8::EpiBf16I8 E{(bf16*)p.out, 2048, (const float*)(ws + WS_SX1), (const float*)(ws + WS_SWQ)};
        pg8::gemm_phase<pg8::EpiBf16I8, pg8::StaticOrder, G6_ALIGN, true>(lds, g, S, E);
#else
        pg8::StaticOrder S; S.init(T, 2048, (int)gridDim.x, (int)blockIdx.x);
        LAS float* tab = (LAS float*)(lds + 131072);
        {
            const int ui = threadIdx.x >> 7; pg8::Unit uu;
            if (S.next(ui, uu)) {
#pragma unroll
                for (int rr = 0; rr < 2; ++rr) {
                    const int rl = (threadIdx.x & 127) * 2 + rr, row = uu.pm * 256 + rl;
                    const f32x4* pp = (const f32x4*)((const float*)(ws + WS_PARTZ) + (size_t)row * 32);
                    float s1 = 0.f, s2 = 0.f;
#pragma unroll
                    for (int k = 0; k < 8; ++k) { const f32x4 v = pp[k]; s1 += v.x + v.z; s2 += v.y + v.w; }
                    const float mean = s1 * (1.0f / 1024.0f), rstd = rsqrtf(fmaxf(s2 * (1.0f / 1024.0f) - mean * mean, 0.f) + LN_EPS);
                    tab[(ui * 256 + rl) * 2] = mean; tab[(ui * 256 + rl) * 2 + 1] = rstd;
                    if (uu.pn == 0) *(f32x2*)((float*)(ws + WS_ST1) + (size_t)row * 2) = (f32x2){mean, rstd};
                }
            }
        }
        __syncthreads();
        pg8::Gemm g{(const bf16*)(ws + WS_Z), (const bf16*)(ws + WS_WQ), T, 2048, 1024, 1024, 1024, 0};
        pg8::EpiQ E{(bf16*)p.out, 2048, (const float*)(ws + WS_CQ), (const float*)(ws + WS_DQ), (const LAS float*)tab, S};
        pg8::gemm_phase<pg8::EpiQ, pg8::StaticOrder, G6_ALIGN, true>(lds, g, S, E);
#endif
    }
    GSYNC(); }
    for (int rep = 0; rep < REP7; ++rep) { if (PH_MASK & 128) phase7(c, lds);
    GSYNC(); }
#ifdef REP8B
    phase8(c, lds, xbar); GSYNC();
#endif
    if (PH_MASK & 256) phase8(c, lds, xbar);
}

extern "C" void kernel_launch(void* const* d_in, const int* in_sizes, int n_in, void* d_out, int out_size,
                              void* d_ws, size_t ws_size, hipStream_t stream) {
    static int grid_blocks = 0;
    if (grid_blocks == 0) {
        if (n_in != 23 || out_size != T * D || ws_size < WS_END) {
            fprintf(stderr, "kernel_launch: unexpected problem (n_in %d, out %d, ws %zu); nothing launched\n", n_in, out_size, ws_size);
            grid_blocks = -1; return;
        }
        int dev = 0, cus = 0, per_cu = 0;
        (void)hipGetDevice(&dev);
        (void)hipDeviceGetAttribute(&cus, hipDeviceAttributeMultiprocessorCount, dev);
        (void)hipFuncSetAttribute((const void*)hybrid_fwd, hipFuncAttributeMaxDynamicSharedMemorySize, LDS_BYTES);
        (void)hipOccupancyMaxActiveBlocksPerMultiprocessor(&per_cu, (const void*)hybrid_fwd, NTHR, LDS_BYTES);
        if (per_cu < 1) { fprintf(stderr, "kernel_launch: occupancy query reports %d blocks per CU\n", per_cu); grid_blocks = -1; return; }
        grid_blocks = cus;
        (void)hipGetLastError();
    }
    if (grid_blocks < 0) return;
    Params p{};
    for (int i = 0; i < 23; ++i) p.in[i] = (const float*)d_in[i];
    p.out = (float*)d_out; p.ws = (unsigned char*)d_ws;
    if (hipMemsetAsync((unsigned char*)d_ws + WS_BAR, 0, XCD_BAR_WORDS * sizeof(unsigned), stream) != hipSuccess) { fprintf(stderr, "kernel_launch: hipMemsetAsync of the barrier words failed; nothing launched\n"); return; }
    void* args[] = {&p};
    hipError_t e = hipLaunchCooperativeKernel((const void*)hybrid_fwd, dim3(grid_blocks), dim3(NTHR), args, LDS_BYTES, stream);
    if (e != hipSuccess) fprintf(stderr, "cooperative launch failed: %s (grid %d)\n", hipGetErrorString(e), grid_blocks);
}
```

```cpp
#include <hip/hip_runtime.h>
#include <hip/hip_cooperative_groups.h>
#include <cstdio>
#include <cstdint>
namespace cg = cooperative_groups;

#define LAS __attribute__((address_space(3)))
typedef unsigned short bf16;
typedef short bf16x8 __attribute__((ext_vector_type(8)));
typedef float f32x4 __attribute__((ext_vector_type(4)));
typedef float f32x16 __attribute__((ext_vector_type(16)));
typedef float f32x2 __attribute__((ext_vector_type(2)));
typedef unsigned u32x4 __attribute__((ext_vector_type(4)));
typedef unsigned u32x2 __attribute__((ext_vector_type(2)));
typedef int i32x4 __attribute__((ext_vector_type(4)));
typedef __bf16 bf16v2 __attribute__((ext_vector_type(2)));

#ifndef P8_X4_
#define P8_X4_ 1
#endif
#ifndef Q_I8
#define Q_I8 0
#endif
constexpr int T = 32768, D = 1024, SEQ = 4096, DIN = 6144, CHUNK = 128, NTILE = T / CHUNK, NCHUNK = SEQ / CHUNK, NH = 8, HD = 128;
constexpr int NEXP = 16384;
constexpr float ALPHA = 1.18920711500272f, LN_EPS = 1e-5f;
constexpr int NTHR = 512;
constexpr int LDS_BYTES = 147456;
constexpr int LDS_BARST = 147440;

constexpr size_t MiB = 1u << 20;
constexpr size_t WS_SPT = 0;
constexpr size_t WS_BAS = 4096;
constexpr size_t WS_BXS = 8192;
constexpr size_t WS_BGS = 12288;
constexpr size_t WS_STATS = 256 * 1024;
constexpr size_t WS_BAR = 64 * 1024;
constexpr size_t WS_WIN = 1 * MiB;
constexpr size_t WS_WOUT = 13 * MiB;
constexpr size_t WS_WQ = 15 * MiB;
constexpr size_t WS_KEYS = 19 * MiB;
constexpr size_t WS_WAX = 20 * MiB;
constexpr size_t WS_WTRIL = 20 * MiB + 512 * 1024;
constexpr size_t WS_UQ = 22 * MiB;
constexpr size_t WS_VQ = 38 * MiB;
constexpr size_t WS_USC = 54 * MiB;
constexpr size_t WS_VSC = 55 * MiB;
constexpr size_t WS_WQ8 = 56 * MiB;
constexpr size_t WS_SXR = 62 * MiB;
constexpr size_t WS_SWC = 63 * MiB;
constexpr size_t WS_WQQ8 = 64 * MiB;
constexpr size_t WS_SWQ = 66 * MiB;
constexpr size_t WS_SX1 = 67 * MiB;
constexpr size_t WS_X1Q8 = 182 * MiB;
constexpr size_t WS_XQ8 = 472 * MiB;
constexpr size_t WS_XB = 86 * MiB;
constexpr size_t OUT_PC = 64 * MiB;
constexpr size_t WS_P4 = 150 * MiB;
constexpr size_t WS_HL = 406 * MiB;
constexpr size_t WS_PEND = 470 * MiB;
constexpr size_t WS_HEND = 471 * MiB;
constexpr size_t WS_Z = 406 * MiB;
constexpr size_t WS_PARTZ = 68 * MiB;
constexpr size_t WS_ST1 = 72 * MiB;
constexpr size_t WS_CQ = 73 * MiB;
constexpr size_t WS_DQ = 73 * MiB + 8192;
constexpr size_t WS_PARTCD = 74 * MiB;
constexpr size_t WS_IDX = 470 * MiB;
constexpr size_t WS_GATE = 486 * MiB;
constexpr size_t WS_END = 504 * MiB;

__device__ __forceinline__ unsigned pk2(float lo, float hi) { f32x2 v = {lo, hi}; return __builtin_bit_cast(unsigned, __builtin_convertvector(v, bf16v2)); }
__device__ __forceinline__ float bf_lo(unsigned w) { return __uint_as_float(w << 16); }
__device__ __forceinline__ float bf_hi(unsigned w) { return __uint_as_float(w & 0xffff0000u); }
constexpr float NLOG2E = -1.4426950408889634f;
__device__ __forceinline__ float sig_pre(float xs) { return __builtin_amdgcn_rcpf(1.0f + __builtin_amdgcn_exp2f(xs)); }
__device__ __forceinline__ float gelu_tanh(float x) { const float u = x * (1.0f + 0.044715f * x * x); return x * __builtin_amdgcn_rcpf(1.0f + __builtin_amdgcn_exp2f(-2.3022081989f * u)); }
__device__ __forceinline__ float wave_sum(float v) {
#pragma unroll
    for (int o = 32; o >= 1; o >>= 1) v += __shfl_xor(v, o);
    return v;
}
#define XB_TMO      128
#define XB_XCNT(j)  (256  + 64 * (j))
#define XB_XSUB(j)  (1280 + 64 * (j))
#define XB_XGEN(j)  (2304 + 64 * (j))
#define XB_TOP      3328
#define XB_TOPGEN   3392
#define XCD_BAR_WORDS 3456
#define XB_SPIN_CAP (1u << 22)

__device__ __forceinline__ unsigned xb_ld(unsigned* p)              { return __hip_atomic_load(p, __ATOMIC_RELAXED, __HIP_MEMORY_SCOPE_AGENT); }
__device__ __forceinline__ unsigned xb_add(unsigned* p, unsigned v) { return __hip_atomic_fetch_add(p, v, __ATOMIC_RELAXED, __HIP_MEMORY_SCOPE_AGENT); }
__device__ __forceinline__ unsigned xb_xcc_id() { return (unsigned)__builtin_amdgcn_s_getreg((3 << 11) | 20) & 0xFu; }
#define XB_SPIN(cond, bar) do { unsigned _sp = 0; while (cond) { __builtin_amdgcn_s_sleep(1); \
    if ((++_sp & 255u) == 0u) { if (xb_ld(&(bar)[XB_TMO])) break; if (_sp > XB_SPIN_CAP) { atomicAdd(&(bar)[XB_TMO], 1u); break; } } } } while (0)

struct XcdBarrier {
    unsigned* bar; unsigned x;
    volatile LAS unsigned* st;
};

__device__ __forceinline__ XcdBarrier xcd_barrier_post(unsigned* bar, volatile LAS unsigned* st) {
    XcdBarrier b; b.bar = bar; b.x = xb_xcc_id(); b.st = st;
    if (threadIdx.x == 0) (void)xb_add(&bar[XB_XCNT(b.x)], 1u);
    return b;
}
__device__ __forceinline__ void xcd_barrier_complete(unsigned* bar, unsigned x, unsigned& nloc, unsigned& nx) {
    const unsigned G = gridDim.x * gridDim.y * gridDim.z;
    unsigned sum, cnt, mine, sp = 0u;
    for (;;) {
        sum = 0u; cnt = 0u; mine = 0u;
#pragma unroll
        for (unsigned j = 0; j < 16; ++j) { const unsigned c = xb_ld(&bar[XB_XCNT(j)]); sum += c; cnt += (c > 0u) ? 1u : 0u; mine = (j == x) ? c : mine; }
        if (sum == G) break;
        __builtin_amdgcn_s_sleep(1);
        if ((++sp & 255u) == 0u) { if (xb_ld(&bar[XB_TMO])) break; if (sp > XB_SPIN_CAP) { atomicAdd(&bar[XB_TMO], 1u); break; } }
    }
    nloc = mine > 0u ? mine : 1u; nx = cnt > 0u ? cnt : 1u;
}

__device__ __forceinline__ void xcd_barrier(const XcdBarrier& b) {
    asm volatile("s_waitcnt vmcnt(0)" ::: "memory");
    __syncthreads();
    if (threadIdx.x == 0) {
        unsigned* bar = b.bar;
        __builtin_amdgcn_s_waitcnt(0);
        unsigned nloc = b.st[0], nx = b.st[1];
        if (nloc == 0u) { xcd_barrier_complete(bar, b.x, nloc, nx); b.st[0] = nloc; b.st[1] = nx; }
        const unsigned old = xb_add(&bar[XB_XSUB(b.x)], 1u);
        const unsigned gen = old / nloc;
        if (old + 1u == (gen + 1u) * nloc) {
            __builtin_amdgcn_fence(__ATOMIC_RELEASE, "agent");
            asm volatile("s_waitcnt vmcnt(0)" ::: "memory");
            const unsigned og = xb_add(&bar[XB_TOP], 1u);
            const unsigned tg = og / nx;
            if (og + 1u == (tg + 1u) * nx) xb_add(&bar[XB_TOPGEN], 1u);
            else XB_SPIN(xb_ld(&bar[XB_TOPGEN]) == tg, bar);
            __builtin_amdgcn_fence(__ATOMIC_ACQUIRE, "agent");
            xb_add(&bar[XB_XGEN(b.x)], 1u);
            asm volatile("s_waitcnt vmcnt(0)" ::: "memory");
        } else {
            XB_SPIN(xb_ld(&bar[XB_XGEN(b.x)]) == gen, bar);
            __builtin_amdgcn_fence(__ATOMIC_ACQUIRE, "agent");
            asm volatile("s_waitcnt vmcnt(0)" ::: "memory");
        }
    }
    __syncthreads();
}
namespace pg8 {
#define PG8_LAS __attribute__((address_space(3)))
typedef unsigned short bf16_t;
typedef short bf16x8 __attribute__((ext_vector_type(8)));
typedef float f32x4 __attribute__((ext_vector_type(4)));
typedef unsigned u32x4 __attribute__((ext_vector_type(4)));
typedef int i32x4_ __attribute__((ext_vector_type(4)));
constexpr int BM = 256, BK = 64, HALF = 128, HTB = HALF * BK * 2  , STAGE_BYTES = 8 * HTB, NXCD = 8, WGM = 8;

__host__ __device__ __forceinline__ int lds_byte(int r, int c) { const int st = (r >> 4) * 2 + (c >> 5), rr = r & 15, cc = c & 31, ob = rr * 64 + cc * 2; return st * 1024 + (ob ^ (((ob >> 9) & 1) << 5)); }
__host__ __device__ __forceinline__ void stage_rc(int b, int& R, int& C) { const int st = b / 1024, sb = b % 1024, swz = sb ^ (((sb >> 9) & 1) << 5); R = (st >> 1) * 16 + swz / 64; C = (st & 1) * 32 + (swz % 64) / 2; }
__host__ __device__ __forceinline__ int perm32(int rho) { const int n = rho >> 4, i = rho & 15; return 8 * (i >> 2) + 4 * n + (i & 3); }

struct Unit { int pm, pn; };
struct Gemm { const bf16_t* A; const bf16_t* Bt; int M, N, K, lda, ldb, a_pn_bytes; };

struct StaticOrder {
    int nM, nN, nwg, G, c;
    __host__ __device__ __forceinline__ void init(int M, int N, int G_, int c_) { nM = M / BM; nN = N / BM; nwg = nM * nN; G = G_; c = c_; }
    __host__ __device__ __forceinline__ bool next(int i, Unit& u) const {
        const long L = (long)i * G + c; if (L >= nwg) return false;
        int wgid = (int)L; { const int q = nwg / NXCD, r = nwg % NXCD, xcd = wgid % NXCD, off = wgid / NXCD; wgid = (xcd < r ? xcd * (q + 1) : r * (q + 1) + (xcd - r) * q) + off; }
        const int nig = WGM * nN, gid = wgid / nig, fm = gid * WGM, gsz = (nM - fm) < WGM ? (nM - fm) : WGM;
        u.pm = fm + ((wgid % nig) % gsz); u.pn = (wgid % nig) / gsz; return true;
    }
    __device__ __forceinline__ void a_ready(const Unit&) const {}
    __device__ __forceinline__ void done(const Unit&) const {}
};


struct EpiProj {
    static constexpr bool PERM = true, AFTER_DRAIN = false, AROWS = false, I8 = true;
    bf16_t* P4; const float* bgate;
    const float* sxr; const float* swc;
    __device__ __forceinline__ void operator()(const f32x4 (&acc)[2][2][4][2], const Unit& u, int, int, int, int) const {
        int t_ = threadIdx.x; asm volatile("" : "+v"(t_)); const int fr = t_ & 15, fq = (t_ >> 4) & 3, wc = (t_ >> 6) & 3, wr = t_ >> 8;
        const int k = u.pn / 3, ty = u.pn - 3 * k;
        const int row0 = u.pm * BM + wr * 64 + fr, cl = k * 128 + wc * 32 + 8 * fq;
        const float* swp = swc + u.pn * BM + wc * 32 + 8 * fq;
        const f32x4 w00 = *(const f32x4*)swp, w01 = *(const f32x4*)(swp + 4), w10 = *(const f32x4*)(swp + HALF), w11 = *(const f32x4*)(swp + HALF + 4);
#define EPI_I2F(v, w, s) ((f32x4){(float)__builtin_bit_cast(i32x4_, v)[0], (float)__builtin_bit_cast(i32x4_, v)[1], (float)__builtin_bit_cast(i32x4_, v)[2], (float)__builtin_bit_cast(i32x4_, v)[3]} * (w) * (s))
        if (ty == 0) {
#pragma unroll
            for (int ai = 0; ai < 2; ++ai)
#pragma unroll
                for (int m = 0; m < 4; ++m) {
                    const int row = row0 + ai * HALF + m * 16; const float sx = sxr[row];
                    bf16_t* rowp = P4 + (size_t)row * 4096 + cl;
                    const f32x4 a0 = EPI_I2F(acc[ai][0][m][0], w00, sx), a1 = EPI_I2F(acc[ai][0][m][1], w01, sx); f32x4 v0 = EPI_I2F(acc[ai][1][m][0], w10, sx), v1 = EPI_I2F(acc[ai][1][m][1], w11, sx);
#pragma unroll
                    for (int j = 0; j < 4; ++j) { v0[j] = gelu_tanh(v0[j]); v1[j] = gelu_tanh(v1[j]); }
                    u32x4 w; w.x = pk2(a0[0], a0[1]); w.y = pk2(a0[2], a0[3]); w.z = pk2(a1[0], a1[1]); w.w = pk2(a1[2], a1[3]);
                    *(u32x4*)rowp = w;
                    w.x = pk2(v0[0], v0[1]); w.y = pk2(v0[2], v0[3]); w.z = pk2(v1[0], v1[1]); w.w = pk2(v1[2], v1[3]);
                    *(u32x4*)(rowp + 3072) = w;
                }
        } else {
            const float* bp = bgate + (ty - 1) * 1024 + cl;
            const f32x4 b0 = *(const f32x4*)bp, b1 = *(const f32x4*)(bp + 4);
#pragma unroll
            for (int ai = 0; ai < 2; ++ai)
#pragma unroll
                for (int m = 0; m < 4; ++m) {
                    const int row = row0 + ai * HALF + m * 16; const float sx = sxr[row];
                    bf16_t* rowp = P4 + (size_t)row * 4096 + ty * 1024 + cl;
                    f32x4 a0 = EPI_I2F(acc[ai][0][m][0], w00, sx), a1 = EPI_I2F(acc[ai][0][m][1], w01, sx); const f32x4 g0 = EPI_I2F(acc[ai][1][m][0], w10, sx) + b0, g1 = EPI_I2F(acc[ai][1][m][1], w11, sx) + b1;
#pragma unroll
                    for (int j = 0; j < 4; ++j) { a0[j] = gelu_tanh(a0[j]) * sig_pre(g0[j]); a1[j] = gelu_tanh(a1[j]) * sig_pre(g1[j]); }
                    u32x4 w; w.x = pk2(a0[0], a0[1]); w.y = pk2(a0[2], a0[3]); w.z = pk2(a1[0], a1[1]); w.w = pk2(a1[2], a1[3]);
                    *(u32x4*)rowp = w;
                }
        }
#undef EPI_I2F
    }
};
template <int S> __device__ __forceinline__ float row_shr_f(float ident, float v) {
    return __int_as_float(__builtin_amdgcn_update_dpp(__float_as_int(ident), __float_as_int(v), 0x110 + S, 0xf, 0xf, false));
}
struct EpiGate {
    static constexpr bool PERM = true, AFTER_DRAIN = false, AROWS = true, I8 = false;
    const bf16_t* XC; bf16_t* HL; bf16_t* PC; float* PEND; float* HEND; const float* b_a; const float* b_x; const float* spt;
    __device__ __forceinline__ void operator()(const f32x4 (&acc)[2][2][4][2], const Unit& u, int, int, int, int) const {
        int t_ = threadIdx.x; asm volatile("" : "+v"(t_)); const int fr = t_ & 15, fq = (t_ >> 4) & 3, wc = (t_ >> 6) & 3, wr = t_ >> 8, lane15 = (t_ & 63) | 15;
        const int row0 = u.pm * BM + wr * 128 + fr, ch = u.pn * 128 + wc * 32 + 8 * fq, chunk = u.pm * 2 + wr;
        float Ac[8], Hc[8];
#pragma unroll
        for (int j = 0; j < 8; ++j) { Ac[j] = 1.0f; Hc[j] = 0.0f; }
#pragma unroll
        for (int ai = 0; ai < 2; ++ai)
#pragma unroll
            for (int m = 0; m < 4; ++m) {
                asm volatile("" ::: "memory");
                int zo = 0; asm volatile("" : "+v"(zo));
                const size_t off = (size_t)(row0 + ai * 64 + m * 16) * 1024 + ch;
                const u32x4 xw = *(const u32x4*)(XC + off);
                float ba[8], bx[8], sp[8];
                { const int cz = ch + zo;
                  const f32x4 t0 = *(const f32x4*)(b_a + cz), t1 = *(const f32x4*)(b_a + cz + 4), t2 = *(const f32x4*)(b_x + cz), t3 = *(const f32x4*)(b_x + cz + 4), t4 = *(const f32x4*)(spt + cz), t5 = *(const f32x4*)(spt + cz + 4);
#pragma unroll
                  for (int j = 0; j < 4; ++j) { ba[j] = t0[j]; ba[4 + j] = t1[j]; bx[j] = t2[j]; bx[4 + j] = t3[j]; sp[j] = t4[j]; sp[4 + j] = t5[j]; } }
                float a[8], b[8];
#pragma unroll
                for (int j = 0; j < 8; ++j) {
                    const float rp = acc[ai][0][m][j >> 2][j & 3], ip = acc[ai][1][m][j >> 2][j & 3];
                    const float xv = (j & 1) ? bf_hi(xw[j >> 1]) : bf_lo(xw[j >> 1]);
                    a[j] = __builtin_amdgcn_exp2f(sig_pre(rp + ba[j]) * sp[j]);
                    b[j] = __builtin_amdgcn_sqrtf(__builtin_fmaxf(1.0f - a[j] * a[j], 0.f)) * sig_pre(ip + bx[j]) * xv;
                }
#pragma unroll
                for (int j = 0; j < 8; ++j) { const float ap = row_shr_f<1>(1.0f, a[j]), bp = row_shr_f<1>(0.0f, b[j]); b[j] = a[j] * bp + b[j]; a[j] = a[j] * ap; }
#pragma unroll
                for (int j = 0; j < 8; ++j) { const float ap = row_shr_f<2>(1.0f, a[j]), bp = row_shr_f<2>(0.0f, b[j]); b[j] = a[j] * bp + b[j]; a[j] = a[j] * ap; }
#pragma unroll
                for (int j = 0; j < 8; ++j) { const float ap = row_shr_f<4>(1.0f, a[j]), bp = row_shr_f<4>(0.0f, b[j]); b[j] = a[j] * bp + b[j]; a[j] = a[j] * ap; }
#pragma unroll
                for (int j = 0; j < 8; ++j) { const float ap = row_shr_f<8>(1.0f, a[j]), bp = row_shr_f<8>(0.0f, b[j]); b[j] = a[j] * bp + b[j]; a[j] = a[j] * ap; }
                float hl[8], pc[8];
#pragma unroll
                for (int j = 0; j < 8; ++j) {
                    const float at = __shfl(a[j], lane15), bt = __shfl(b[j], lane15);
                    hl[j] = b[j] + a[j] * Hc[j]; pc[j] = a[j] * Ac[j];
                    Hc[j] = bt + at * Hc[j]; Ac[j] = at * Ac[j];
                }
                u32x4 w; w.x = pk2(hl[0], hl[1]); w.y = pk2(hl[2], hl[3]); w.z = pk2(hl[4], hl[5]); w.w = pk2(hl[6], hl[7]);
                *(u32x4*)(HL + off) = w;
                w.x = pk2(pc[0], pc[1]); w.y = pk2(pc[2], pc[3]); w.z = pk2(pc[4], pc[5]); w.w = pk2(pc[6], pc[7]);
                *(u32x4*)(PC + off) = w;
            }
        if (fr == 0) {
            float* pp = PEND + (size_t)chunk * 1024 + ch; float* hp = HEND + (size_t)chunk * 1024 + ch;
            *(f32x4*)pp = (f32x4){Ac[0], Ac[1], Ac[2], Ac[3]}; *(f32x4*)(pp + 4) = (f32x4){Ac[4], Ac[5], Ac[6], Ac[7]};
            *(f32x4*)hp = (f32x4){Hc[0], Hc[1], Hc[2], Hc[3]}; *(f32x4*)(hp + 4) = (f32x4){Hc[4], Hc[5], Hc[6], Hc[7]};
        }
    }
};
struct EpiBf16 {
    static constexpr bool PERM = true, AFTER_DRAIN = false, AROWS = false, I8 = false;
    bf16_t* O; int ldc;
    __device__ __forceinline__ void operator()(const f32x4 (&acc)[2][2][4][2], const Unit& u, int, int, int, int) const {
        int t_ = threadIdx.x; asm volatile("" : "+v"(t_)); const int fr = t_ & 15, fq = (t_ >> 4) & 3, wc = (t_ >> 6) & 3, wr = t_ >> 8;
        const int row0 = u.pm * BM + wr * 64 + fr, col0 = u.pn * BM + wc * 32 + 8 * fq;
#pragma unroll
        for (int ai = 0; ai < 2; ++ai)
#pragma unroll
            for (int m = 0; m < 4; ++m) {
                bf16_t* rowp = O + (size_t)(row0 + ai * HALF + m * 16) * ldc + col0;
#pragma unroll
                for (int bj = 0; bj < 2; ++bj) {
                    const f32x4 v0 = acc[ai][bj][m][0], v1 = acc[ai][bj][m][1];
                    u32x4 w; w.x = pk2(v0[0], v0[1]); w.y = pk2(v0[2], v0[3]); w.z = pk2(v1[0], v1[1]); w.w = pk2(v1[2], v1[3]);
                    *(u32x4*)(rowp + bj * HALF) = w;
                }
            }
    }
};
struct EpiResid {
    static constexpr bool PERM = true, AFTER_DRAIN = false, AROWS = false, I8 = false;
    const bf16_t* X; bf16_t* Z; int ldc; float alpha; float* PART;
    __device__ __forceinline__ void operator()(const f32x4 (&acc)[2][2][4][2], const Unit& u, int, int, int, int) const {
        int t_ = threadIdx.x; asm volatile("" : "+v"(t_)); const int fr = t_ & 15, fq = (t_ >> 4) & 3, wc = (t_ >> 6) & 3, wr = t_ >> 8;
        const int row0 = u.pm * BM + wr * 64 + fr, col0 = u.pn * BM + wc * 32 + 8 * fq;
#pragma unroll
        for (int ai = 0; ai < 2; ++ai)
#pragma unroll
            for (int m = 0; m < 4; ++m) {
                const int row = row0 + ai * HALF + m * 16;
                const size_t off = (size_t)row * ldc + col0;
                float s1 = 0.f, s2 = 0.f;
#pragma unroll
                for (int bj = 0; bj < 2; ++bj) {
                    const u32x4 xw = *(const u32x4*)(X + off + bj * HALF);
                    const f32x4 x0 = (f32x4){bf_lo(xw.x), bf_hi(xw.x), bf_lo(xw.y), bf_hi(xw.y)}, x1 = (f32x4){bf_lo(xw.z), bf_hi(xw.z), bf_lo(xw.w), bf_hi(xw.w)};
                    const f32x4 z0 = x0 * alpha + acc[ai][bj][m][0], z1 = x1 * alpha + acc[ai][bj][m][1];
                    u32x4 w; w.x = pk2(z0[0], z0[1]); w.y = pk2(z0[2], z0[3]); w.z = pk2(z1[0], z1[1]); w.w = pk2(z1[2], z1[3]);
                    *(u32x4*)(Z + off + bj * HALF) = w;
#pragma unroll
                    for (int j = 0; j < 4; ++j) { s1 += z0[j] + z1[j]; s2 += z0[j] * z0[j] + z1[j] * z1[j]; }
                }
                s1 += __shfl_xor(s1, 16); s2 += __shfl_xor(s2, 16); s1 += __shfl_xor(s1, 32); s2 += __shfl_xor(s2, 32);
                if (fq == 0) *(f32x2*)(PART + ((size_t)row * 16 + u.pn * 4 + wc) * 2) = (f32x2){s1, s2};
            }
    }
};
struct EpiQ {
    static constexpr bool PERM = true, AFTER_DRAIN = false, AROWS = false, I8 = false;
    bf16_t* O; int ldc; const float* cq; const float* dq; const PG8_LAS float* tab; StaticOrder S;
    __device__ __forceinline__ void operator()(const f32x4 (&acc)[2][2][4][2], const Unit& u, int, int, int, int) const {
        int t_ = threadIdx.x; asm volatile("" : "+v"(t_)); const int fr = t_ & 15, fq = (t_ >> 4) & 3, wc = (t_ >> 6) & 3, wr = t_ >> 8;
        int ord = 0;
#pragma unroll
        for (int i = 1; i < 4; ++i) { Unit v; if (S.next(i, v) && v.pm == u.pm && v.pn == u.pn) ord = i; }
        const int rl0 = wr * 64 + fr, col0 = u.pn * BM + wc * 32 + 8 * fq;
        f32x4 cv[2][2], dv[2][2];
#pragma unroll
        for (int bj = 0; bj < 2; ++bj)
#pragma unroll
            for (int n = 0; n < 2; ++n) { cv[bj][n] = *(const f32x4*)(cq + col0 + bj * HALF + 4 * n); dv[bj][n] = *(const f32x4*)(dq + col0 + bj * HALF + 4 * n); }
#pragma unroll
        for (int ai = 0; ai < 2; ++ai)
#pragma unroll
            for (int m = 0; m < 4; ++m) {
                const int rl = rl0 + ai * HALF + m * 16;
                const float mean = tab[(ord * 256 + rl) * 2], rstd = tab[(ord * 256 + rl) * 2 + 1];
                bf16_t* rowp = O + (size_t)(u.pm * BM + rl) * ldc + col0;
#pragma unroll
                for (int bj = 0; bj < 2; ++bj) {
                    const f32x4 v0 = (acc[ai][bj][m][0] - cv[bj][0] * mean) * rstd + dv[bj][0], v1 = (acc[ai][bj][m][1] - cv[bj][1] * mean) * rstd + dv[bj][1];
                    u32x4 w; w.x = pk2(v0[0], v0[1]); w.y = pk2(v0[2], v0[3]); w.z = pk2(v1[0], v1[1]); w.w = pk2(v1[2], v1[3]);
                    *(u32x4*)(rowp + bj * HALF) = w;
                }
            }
    }
};
struct EpiBf16I8 {
    static constexpr bool PERM = true, AFTER_DRAIN = false, AROWS = false, I8 = true;
    bf16_t* O; int ldc; const float* sxr; const float* swc;
    __device__ __forceinline__ void operator()(const f32x4 (&acc)[2][2][4][2], const Unit& u, int, int, int, int) const {
        int t_ = threadIdx.x; asm volatile("" : "+v"(t_)); const int fr = t_ & 15, fq = (t_ >> 4) & 3, wc = (t_ >> 6) & 3, wr = t_ >> 8;
        const int row0 = u.pm * BM + wr * 64 + fr, col0 = u.pn * BM + wc * 32 + 8 * fq;
        const f32x4 w00 = *(const f32x4*)(swc + col0), w01 = *(const f32x4*)(swc + col0 + 4), w10 = *(const f32x4*)(swc + col0 + HALF), w11 = *(const f32x4*)(swc + col0 + HALF + 4);
#define EPI_I2F(v, w, s) ((f32x4){(float)__builtin_bit_cast(i32x4_, v)[0], (float)__builtin_bit_cast(i32x4_, v)[1], (float)__builtin_bit_cast(i32x4_, v)[2], (float)__builtin_bit_cast(i32x4_, v)[3]} * (w) * (s))
#pragma unroll
        for (int ai = 0; ai < 2; ++ai)
#pragma unroll
            for (int m = 0; m < 4; ++m) {
                const int row = row0 + ai * HALF + m * 16; const float sx = sxr[row];
                bf16_t* rowp = O + (size_t)row * ldc + col0;
                { const f32x4 v0 = EPI_I2F(acc[ai][0][m][0], w00, sx), v1 = EPI_I2F(acc[ai][0][m][1], w01, sx);
                  u32x4 w; w.x = pk2(v0[0], v0[1]); w.y = pk2(v0[2], v0[3]); w.z = pk2(v1[0], v1[1]); w.w = pk2(v1[2], v1[3]); *(u32x4*)rowp = w; }
                { const f32x4 v0 = EPI_I2F(acc[ai][1][m][0], w10, sx), v1 = EPI_I2F(acc[ai][1][m][1], w11, sx);
                  u32x4 w; w.x = pk2(v0[0], v0[1]); w.y = pk2(v0[2], v0[3]); w.z = pk2(v1[0], v1[1]); w.w = pk2(v1[2], v1[3]); *(u32x4*)(rowp + HALF) = w; }
            }
#undef EPI_I2F
    }
};
template <class Epi, class Sched, bool ALIGN_EPI = false, bool SP2 = false>
__device__ __forceinline__ void gemm_phase(PG8_LAS unsigned char* lds, const Gemm g, const Sched& S, const Epi& E) {
    int tid_ = threadIdx.x; asm volatile("" : "+v"(tid_)); const int tid = tid_, wid = __builtin_amdgcn_readfirstlane(tid >> 6), lane = tid & 63, wr = wid >> 2, wc = wid & 3, fr = lane & 15, fq = lane >> 4;
    const int K = g.K, nt = K / BK;
    unsigned voffA[2], voffB[2];
#pragma unroll
    for (int i = 0; i < 2; ++i) { int R, C; stage_rc(tid * 16 + i * 8192, R, C); const int Rb = Epi::PERM ? ((R & ~31) + perm32(R & 31)) : R;
        const int Ra = Epi::AROWS ? ((R >> 6) * 128 + (R & 63)) : R;
        voffA[i] = (unsigned)(Ra * g.lda + C) * 2u; voffB[i] = (unsigned)(Rb * g.ldb + C) * 2u; }
    const size_t kstep = (size_t)(BK * 2);
    const size_t hstepA = (size_t)(Epi::AROWS ? 64 : HALF) * g.lda * 2, hstepB = (size_t)HALF * g.ldb * 2;
    const size_t tstepA = (size_t)2 * HALF * g.lda * 2, tstepB = 2 * hstepB;
    const unsigned ldsw = (unsigned)wid * 1024u;
    const int aoff = lds_byte(wr * 64 + fr, fq * 8), boff = lds_byte(wc * 32 + fr, fq * 8);
#define PG8_SA(b, h) (((b) * 2 + (h)) * HTB)
#define PG8_SB(b, h) ((4 + (b) * 2 + (h)) * HTB)
#define PG8_STAGE(bufoff, gbase, voff) do { _Pragma("unroll") for (int _i = 0; _i < 2; ++_i) \
        __builtin_amdgcn_global_load_lds((const unsigned*)((const char*)(gbase) + (voff)[_i]), (PG8_LAS unsigned*)(lds + (bufoff) + ldsw + _i * 8192), 16, 0, 0); } while (0)
#define PG8_LDA(dst, b, h) do { _Pragma("unroll") for (int m = 0; m < 4; ++m) _Pragma("unroll") for (int k = 0; k < 2; ++k) dst[m][k] = *(const PG8_LAS bf16x8*)(lds + PG8_SA(b, h) + aoff + m * 2048 + k * 1024); } while (0)
#define PG8_LDB(dst, b, h) do { _Pragma("unroll") for (int n = 0; n < 2; ++n) _Pragma("unroll") for (int k = 0; k < 2; ++k) dst[n][k] = *(const PG8_LAS bf16x8*)(lds + PG8_SB(b, h) + boff + n * 2048 + k * 1024); } while (0)
#define PG8_MMA(ai, bj, At, Bt) do { __builtin_amdgcn_s_setprio(1); _Pragma("unroll") for (int m = 0; m < 4; ++m) _Pragma("unroll") for (int n = 0; n < 2; ++n) _Pragma("unroll") for (int k = 0; k < 2; ++k) \
        { if constexpr (Epi::I8) acc[ai][bj][m][n] = __builtin_bit_cast(f32x4, __builtin_amdgcn_mfma_i32_16x16x64_i8(__builtin_bit_cast(i32x4_, Bt[n][k]), __builtin_bit_cast(i32x4_, At[m][k]), __builtin_bit_cast(i32x4_, acc[ai][bj][m][n]), 0, 0, 0)); \
          else acc[ai][bj][m][n] = __builtin_amdgcn_mfma_f32_16x16x32_bf16(Bt[n][k], At[m][k], acc[ai][bj][m][n], 0, 0, 0); } __builtin_amdgcn_s_setprio(0); } while (0)
#define PG8_WAIT_V(n) asm volatile("s_waitcnt vmcnt(" #n ")" ::: "memory")
#define PG8_WAIT_L(n) asm volatile("s_waitcnt lgkmcnt(" #n ")" ::: "memory")
#define PG8_BAR __builtin_amdgcn_s_barrier()
#define PG8_SCHED __builtin_amdgcn_sched_barrier(0)
    Unit cur, nxt; int ui = 0;
    if (!S.next(0, cur)) return;
    f32x4 acc[2][2][4][2];
#pragma unroll
    for (int a = 0; a < 2; ++a)
#pragma unroll
        for (int b = 0; b < 2; ++b)
#pragma unroll
            for (int m = 0; m < 4; ++m)
#pragma unroll
                for (int n = 0; n < 2; ++n) acc[a][b][m][n] = (f32x4){0.f, 0.f, 0.f, 0.f};
    bf16x8 At[4][2], B0[2][2], B1[2][2];
    const char* cA = (const char*)g.A + (size_t)cur.pm * tstepA + (size_t)cur.pn * g.a_pn_bytes; const char* cB = (const char*)g.Bt + (size_t)cur.pn * tstepB;
    S.a_ready(cur);
    if constexpr (SP2) {
        PG8_STAGE(PG8_SB(0, 0), cB, voffB); PG8_STAGE(PG8_SB(0, 1), cB + hstepB, voffB); PG8_STAGE(PG8_SA(0, 0), cA, voffA); PG8_STAGE(PG8_SA(0, 1), cA + hstepA, voffA);
        if (wr == 1) PG8_BAR;
        PG8_WAIT_V(2); PG8_BAR;
        PG8_STAGE(PG8_SB(1, 0), cB + kstep, voffB); PG8_STAGE(PG8_SA(1, 0), cA + kstep, voffA); PG8_STAGE(PG8_SB(1, 1), cB + hstepB + kstep, voffB);
        PG8_WAIT_V(6); PG8_BAR;
    } else {
        PG8_STAGE(PG8_SB(0, 0), cB, voffB); PG8_STAGE(PG8_SA(0, 0), cA, voffA); PG8_STAGE(PG8_SB(0, 1), cB + hstepB, voffB); PG8_STAGE(PG8_SA(0, 1), cA + hstepA, voffA);
        if (wr == 1) PG8_BAR;
        PG8_WAIT_V(4); PG8_BAR;
        PG8_STAGE(PG8_SB(1, 0), cB + kstep, voffB); PG8_STAGE(PG8_SA(1, 0), cA + kstep, voffA); PG8_STAGE(PG8_SB(1, 1), cB + hstepB + kstep, voffB);
        PG8_WAIT_V(6); PG8_BAR;
    }
    for (;;) {
        const bool has_next = S.next(ui + 1, nxt);
        const char* nA = has_next ? (const char*)g.A + (size_t)nxt.pm * tstepA + (size_t)nxt.pn * g.a_pn_bytes : cA; const char* nB = has_next ? (const char*)g.Bt + (size_t)nxt.pn * tstepB : cB;
        for (int t = 0; t < nt; t += 2) {
            const bool last = (t == nt - 2);
            const char* a1 = cA + (size_t)(t + 1) * kstep;
            const char* a2 = last ? nA : cA + (size_t)(t + 2) * kstep; const char* b2 = last ? nB : cB + (size_t)(t + 2) * kstep;
            const char* a3 = a2 + kstep; const char* b3 = b2 + kstep;
            if (last && has_next) S.a_ready(nxt);
            if constexpr (SP2) {
            PG8_LDB(B0, 0, 0); PG8_LDB(B1, 0, 1); PG8_SCHED; PG8_LDA(At, 0, 0); PG8_STAGE(PG8_SA(1, 1), a1 + hstepA, voffA);
            PG8_WAIT_V(8); PG8_WAIT_L(0); PG8_BAR; PG8_MMA(0, 0, At, B0); PG8_MMA(0, 1, At, B1); PG8_BAR; PG8_SCHED;
            PG8_LDA(At, 0, 1); PG8_STAGE(PG8_SB(0, 0), b2, voffB); PG8_STAGE(PG8_SB(0, 1), b2 + hstepB, voffB); PG8_STAGE(PG8_SA(0, 0), a2, voffA);
            PG8_WAIT_V(8); PG8_WAIT_L(0); PG8_BAR; PG8_MMA(1, 0, At, B0); PG8_MMA(1, 1, At, B1); PG8_BAR; PG8_SCHED;
            PG8_LDB(B0, 1, 0); PG8_LDB(B1, 1, 1); PG8_SCHED; PG8_LDA(At, 1, 0); PG8_STAGE(PG8_SA(0, 1), a2 + hstepA, voffA);
            PG8_WAIT_V(8); PG8_WAIT_L(0); PG8_BAR; PG8_MMA(0, 0, At, B0); PG8_MMA(0, 1, At, B1); PG8_BAR; PG8_SCHED;
            PG8_LDA(At, 1, 1); PG8_STAGE(PG8_SB(1, 0), b3, voffB); PG8_STAGE(PG8_SB(1, 1), b3 + hstepB, voffB); PG8_STAGE(PG8_SA(1, 0), a3, voffA);
            PG8_WAIT_V(8); PG8_WAIT_L(0); PG8_BAR; PG8_MMA(1, 0, At, B0); PG8_MMA(1, 1, At, B1); PG8_BAR; PG8_SCHED;
            } else {
            PG8_LDB(B0, 0, 0); PG8_SCHED; PG8_LDA(At, 0, 0); PG8_STAGE(PG8_SA(1, 1), a1 + hstepA, voffA);
            PG8_WAIT_L(8); PG8_BAR; PG8_WAIT_L(0); PG8_MMA(0, 0, At, B0); PG8_BAR; PG8_SCHED;
            PG8_LDB(B1, 0, 1); PG8_STAGE(PG8_SB(0, 0), b2, voffB);
            PG8_BAR; PG8_WAIT_L(0); PG8_MMA(0, 1, At, B1); PG8_BAR;
            PG8_LDA(At, 0, 1); PG8_STAGE(PG8_SA(0, 0), a2, voffA);
            PG8_BAR; PG8_WAIT_L(0); PG8_MMA(1, 0, At, B0); PG8_BAR; PG8_SCHED;
            PG8_STAGE(PG8_SB(0, 1), b2 + hstepB, voffB);
            PG8_WAIT_V(6); PG8_BAR; PG8_MMA(1, 1, At, B1); PG8_BAR;
            PG8_LDB(B0, 1, 0); PG8_SCHED; PG8_LDA(At, 1, 0); PG8_STAGE(PG8_SA(0, 1), a2 + hstepA, voffA);
            PG8_WAIT_L(8); PG8_BAR; PG8_WAIT_L(0); PG8_MMA(0, 0, At, B0); PG8_BAR; PG8_SCHED;
            PG8_LDB(B1, 1, 1); PG8_STAGE(PG8_SB(1, 0), b3, voffB);
            PG8_BAR; PG8_WAIT_L(0); PG8_MMA(0, 1, At, B1); PG8_BAR;
            PG8_LDA(At, 1, 1); PG8_STAGE(PG8_SA(1, 0), a3, voffA);
            PG8_BAR; PG8_WAIT_L(0); PG8_MMA(1, 0, At, B0); PG8_BAR; PG8_SCHED;
            PG8_STAGE(PG8_SB(1, 1), b3 + hstepB, voffB);
            PG8_WAIT_V(6); PG8_BAR; PG8_MMA(1, 1, At, B1); PG8_BAR;
            }
        }
        if constexpr (ALIGN_EPI) { if (wr == 0) PG8_BAR; }
        if constexpr (!Epi::AFTER_DRAIN) { E(acc, cur, wr, wc, fr, fq); S.done(cur); }
        if (!has_next) break;
#pragma unroll
        for (int a = 0; a < 2; ++a)
#pragma unroll
            for (int b = 0; b < 2; ++b)
#pragma unroll
                for (int m = 0; m < 4; ++m)
#pragma unroll
                    for (int n = 0; n < 2; ++n) acc[a][b][m][n] = (f32x4){0.f, 0.f, 0.f, 0.f};
        cur = nxt; cA = nA; cB = nB; ++ui;
        if constexpr (ALIGN_EPI) { if (wr == 1) PG8_BAR; }
    }
    PG8_WAIT_V(0);
    if constexpr (!ALIGN_EPI) { if (wr == 0) PG8_BAR; }
    PG8_BAR;
    if constexpr (Epi::AFTER_DRAIN) { E.fused(acc, cur, wr, wc, fr, fq, lds, wid, lane); S.done(cur); }
#undef PG8_SA
#undef PG8_SB
#undef PG8_STAGE
#undef PG8_LDA
#undef PG8_LDB
#undef PG8_MMA
#undef PG8_WAIT_V
#undef PG8_WAIT_L
#undef PG8_BAR
#undef PG8_SCHED
}
}

__device__ __forceinline__ void cvt_f32_bf16(const float* __restrict__ src, bf16* dst, size_t n8, size_t gtid, size_t gthreads) {
    for (size_t i = gtid; i < n8; i += gthreads) {
        const f32x4 a = ((const f32x4*)src)[2 * i], b = ((const f32x4*)src)[2 * i + 1];
        u32x4 o; o.x = pk2(a.x, a.y); o.y = pk2(a.z, a.w); o.z = pk2(b.x, b.y); o.w = pk2(b.z, b.w);
        ((u32x4*)dst)[i] = o;
    }
}
__device__ __forceinline__ void transpose_tile(const float* __restrict__ W, int ldw, bf16* WT, int ldt, int k0, int n0, int nd0, LAS float* s, int tid, float sc = 1.0f) {
    {
        const int kk = tid >> 3, c8 = (tid & 7) * 8;
        const float* p = W + (size_t)(k0 + kk) * ldw + n0 + c8;
        const f32x4 a = *(const f32x4*)p, b = *(const f32x4*)(p + 4);
        LAS float* q = s + kk * 65 + c8;
        q[0] = a.x; q[1] = a.y; q[2] = a.z; q[3] = a.w; q[4] = b.x; q[5] = b.y; q[6] = b.z; q[7] = b.w;
    }
    __syncthreads();
    {
        const int nn = tid >> 3, k8 = (tid & 7) * 8;
        const LAS float* q = s + k8 * 65 + nn;
        u32x4 o; o.x = pk2(q[0] * sc, q[65] * sc); o.y = pk2(q[2 * 65] * sc, q[3 * 65] * sc); o.z = pk2(q[4 * 65] * sc, q[5 * 65] * sc); o.w = pk2(q[6 * 65] * sc, q[7 * 65] * sc);
        *(u32x4*)(WT + (size_t)(nd0 + nn) * ldt + k0 + k8) = o;
    }
    __syncthreads();
}

template <int NR> __device__ __forceinline__ void quant_rows_i8(const float (&v)[NR][16], unsigned char* const (&dst)[NR], float* const (&scale_out)[NR], int lane) {
    float m[NR];
#pragma unroll
    for (int r = 0; r < NR; ++r) { m[r] = 0.f;
#pragma unroll
        for (int j = 0; j < 16; ++j) m[r] = fmaxf(m[r], fabsf(v[r][j])); }
#pragma unroll
    for (int o = 32; o >= 1; o >>= 1) {
#pragma unroll
        for (int r = 0; r < NR; ++r) m[r] = fmaxf(m[r], __shfl_xor(m[r], o));
    }
#pragma unroll
    for (int r = 0; r < NR; ++r) {
        const float scale = (m[r] > 0.f) ? m[r] * (1.0f / 127.0f) : 1.0f, inv = 1.0f / scale;
        u32x4 q;
#pragma unroll
        for (int w = 0; w < 4; ++w) {
            unsigned pk = 0;
#pragma unroll
            for (int k = 0; k < 4; ++k) { int qi = (int)rintf(v[r][4 * w + k] * inv); qi = qi < -127 ? -127 : (qi > 127 ? 127 : qi); pk |= (unsigned)(qi & 0xff) << (8 * k); }
            q[w] = pk;
        }
        *(u32x4*)(dst[r] + lane * 16) = q;
        if (lane == 0) *scale_out[r] = scale;
    }
}
struct Ctx {
    const float* in[23];
    float* out;
    unsigned char* ws;
};

__device__ __forceinline__ void quant_peer_tables(const Ctx& c, int gw, int NW, int lane) {
    unsigned char* ws = c.ws;
    for (int e2 = gw * 2; e2 < NEXP; e2 += NW * 2) {
        float v[4][16];
#pragma unroll
        for (int r = 0; r < 4; ++r) {
            const float* src = ((r & 2) ? c.in[20] : c.in[19]) + (size_t)(e2 + (r & 1)) * 1024 + lane * 16;
            const f32x4 a0 = *(const f32x4*)src, a1 = *(const f32x4*)(src + 4), a2 = *(const f32x4*)(src + 8), a3 = *(const f32x4*)(src + 12);
            v[r][0] = a0.x; v[r][1] = a0.y; v[r][2] = a0.z; v[r][3] = a0.w; v[r][4] = a1.x; v[r][5] = a1.y; v[r][6] = a1.z; v[r][7] = a1.w;
            v[r][8] = a2.x; v[r][9] = a2.y; v[r][10] = a2.z; v[r][11] = a2.w; v[r][12] = a3.x; v[r][13] = a3.y; v[r][14] = a3.z; v[r][15] = a3.w;
        }
        float s2[4];
#pragma unroll
        for (int r = 0; r < 4; ++r) { s2[r] = 0.f;
#pragma unroll
            for (int j = 0; j < 16; ++j) s2[r] += v[r][j] * v[r][j]; }
#pragma unroll
        for (int o = 32; o >= 1; o >>= 1) {
#pragma unroll
            for (int r = 0; r < 4; ++r) s2[r] += __shfl_xor(s2[r], o);
        }
#pragma unroll
        for (int x = 0; x < 2; ++x) {
            const float su = 0.335f * sqrtf(s2[x] * (1.0f / 1024.0f)) + 1e-30f, sv = 0.48f * sqrtf(s2[2 + x] * (1.0f / 1024.0f)) + 1e-30f;
            const float iu = 1.0f / su, iv = 1.0f / sv;
            unsigned w[4] = {0u, 0u, 0u, 0u};
#pragma unroll
            for (int k = 0; k < 16; ++k) {
                int q = (int)floorf(v[x][k] * iu); q = q < -8 ? -8 : (q > 7 ? 7 : q);
                w[k >> 3] |= (unsigned)(q & 15) << (4 * (k & 7));
                const float a = fabsf(v[2 + x][k]) * iv;
                unsigned m = (unsigned)(a > 0.25f) + (unsigned)(a > 0.75f) + (unsigned)(a > 1.25f) + (unsigned)(a > 1.75f) + (unsigned)(a > 2.5f) + (unsigned)(a > 3.5f) + (unsigned)(a > 5.0f);
                m |= (v[2 + x][k] < 0.f) ? 8u : 0u;
                w[2 + (k >> 3)] |= m << (4 * (k & 7));
            }
#if P8_X4_
            *(u32x4*)(ws + WS_UQ + (size_t)(e2 + x) * 1024 + lane * 16) = (u32x4){w[0], w[1], w[2], w[3]};
#else
            *(u32x2*)(ws + WS_UQ + (size_t)(e2 + x) * 1024 + lane * 8) = (u32x2){w[0], w[1]};
            *(u32x2*)(ws + WS_UQ + (size_t)(e2 + x) * 1024 + 512 + lane * 8) = (u32x2){w[2], w[3]};
#endif
            if (lane == 0) *(f32x2*)(ws + WS_USC + (size_t)(e2 + x) * 8) = (f32x2){su, sv};
        }
    }
}

__device__ __forceinline__ void phase0(const Ctx& c, LAS unsigned char* lds) {
    int tid_ = threadIdx.x; asm volatile("" : "+v"(tid_)); const int tid = tid_;
    const size_t gtid = (size_t)blockIdx.x * NTHR + tid, gthreads = (size_t)gridDim.x * NTHR;
    unsigned char* ws = c.ws;
    cvt_f32_bf16(c.in[18], (bf16*)(ws + WS_KEYS), (size_t)8 * 2 * 128 * 128 / 8, gtid, gthreads);
    {
        const int lane = tid & 63, gw = blockIdx.x * 8 + (tid >> 6), NW = gridDim.x * 8;
        for (int row4 = gw * 4; row4 < T; row4 += NW * 4) {
            float v[4][16]; unsigned char* dst[4]; float* sc[4];
#pragma unroll
            for (int r = 0; r < 4; ++r) {
                const float* src = c.in[0] + (size_t)(row4 + r) * 1024 + lane * 16;
                const f32x4 a0 = *(const f32x4*)src, a1 = *(const f32x4*)(src + 4), a2 = *(const f32x4*)(src + 8), a3 = *(const f32x4*)(src + 12);
                v[r][0] = a0.x; v[r][1] = a0.y; v[r][2] = a0.z; v[r][3] = a0.w; v[r][4] = a1.x; v[r][5] = a1.y; v[r][6] = a1.z; v[r][7] = a1.w;
                v[r][8] = a2.x; v[r][9] = a2.y; v[r][10] = a2.z; v[r][11] = a2.w; v[r][12] = a3.x; v[r][13] = a3.y; v[r][14] = a3.z; v[r][15] = a3.w;
                dst[r] = ws + WS_XQ8 + (size_t)(row4 + r) * 1024; sc[r] = (float*)(ws + WS_SXR) + row4 + r;
            }
            quant_rows_i8<4>(v, dst, sc, lane);
#pragma unroll
            for (int r = 0; r < 4; ++r) {
                u32x4 b0, b1;
#pragma unroll
                for (int j = 0; j < 4; ++j) { b0[j] = pk2(v[r][2 * j], v[r][2 * j + 1]); b1[j] = pk2(v[r][8 + 2 * j], v[r][8 + 2 * j + 1]); }
                bf16* xb = (bf16*)(ws + WS_XB) + (size_t)(row4 + r) * 1024 + lane * 16;
                *(u32x4*)xb = b0; *(u32x4*)(xb + 8) = b1;
            }
        }
    }
    {
        const float* wsrc = c.in[12]; bf16* wt = (bf16*)(ws + WS_WTRIL);
        for (size_t i = gtid; i < (size_t)8 * 128 * 128 / 8; i += gthreads) {
            const int e = (int)i * 8, s0 = e & 127, t = (e >> 7) & 127;
            const f32x4 a = ((const f32x4*)wsrc)[2 * i], b = ((const f32x4*)wsrc)[2 * i + 1];
            float v[8] = {a.x, a.y, a.z, a.w, b.x, b.y, b.z, b.w};
#pragma unroll
            for (int j = 0; j < 8; ++j) v[j] = (s0 + j <= t) ? v[j] : 0.f;
            u32x4 o; o.x = pk2(v[0], v[1]); o.y = pk2(v[2], v[3]); o.z = pk2(v[4], v[5]); o.w = pk2(v[6], v[7]);
            ((u32x4*)wt)[i] = o;
        }
    }
    if (gtid < 1024) { const float lam = c.in[9][gtid]; ((float*)(ws + WS_SPT))[gtid] = 8.0f * NLOG2E * log1pf(expf(-lam));
                       ((float*)(ws + WS_BAS))[gtid] = NLOG2E * c.in[6][gtid]; ((float*)(ws + WS_BXS))[gtid] = NLOG2E * c.in[8][gtid]; }
    if (gtid < 2048) ((float*)(ws + WS_BGS))[gtid] = NLOG2E * c.in[2][gtid];
    {
        LAS float* s = (LAS float*)lds;
        constexpr int N_IN = 16 * 96, N_OUT = 16 * 16, N_Q = 16 * 32, N_G = 64, N_ALL = N_IN + N_OUT + N_Q + N_G;
        for (int it = blockIdx.x; it < N_ALL; it += gridDim.x) {
            int r = it;
            if (r < N_IN) {
                const int n0 = (r % 96) * 64, sec = n0 >> 10, kg = (n0 & 1023) >> 7, j0 = n0 & 127;
                const int ty = (sec == 0 || sec == 3) ? 0 : ((sec == 1 || sec == 4) ? 1 : 2), half = sec >= 3;
                transpose_tile(c.in[1], DIN, (bf16*)(ws + WS_WIN), 1024, (r / 96) * 64, n0, (3 * kg + ty) * 256 + half * 128 + j0, s, tid, sec >= 4 ? NLOG2E : 1.0f); continue;
            }
            r -= N_IN;
            if (r < N_OUT) { transpose_tile(c.in[14], 1024, (bf16*)(ws + WS_WOUT), 1024, (r / 16) * 64, (r % 16) * 64, (r % 16) * 64, s, tid); continue; }
            r -= N_OUT;
            if (r < N_Q) {
                const int k0 = (r / 32) * 64, n0 = (r % 32) * 64;
                {
                    const int kk = tid >> 3, c8 = (tid & 7) * 8;
                    const float* p = c.in[17] + (size_t)(k0 + kk) * 2048 + n0 + c8;
                    const f32x4 a = *(const f32x4*)p, b = *(const f32x4*)(p + 4);
                    LAS float* q = s + kk * 65 + c8;
                    q[0] = a.x; q[1] = a.y; q[2] = a.z; q[3] = a.w; q[4] = b.x; q[5] = b.y; q[6] = b.z; q[7] = b.w;
                }
                __syncthreads();
                if (tid < 64) {
                    float pc = 0.f, pd = 0.f;
                    for (int kk = 0; kk < 64; ++kk) { const float w = s[kk * 65 + tid]; pc += c.in[15][k0 + kk] * w; pd += c.in[16][k0 + kk] * w; }
                    float* part = (float*)(ws + WS_PARTCD) + (size_t)(r / 32) * 4096;
                    part[n0 + tid] = pc; part[2048 + n0 + tid] = pd;
                }
                {
                    const int nn = tid >> 3, k8 = (tid & 7) * 8;
                    const LAS float* q = s + k8 * 65 + nn;
                    const float* g = c.in[15] + k0 + k8;
                    u32x4 o; o.x = pk2(q[0] * g[0], q[65] * g[1]); o.y = pk2(q[2 * 65] * g[2], q[3 * 65] * g[3]); o.z = pk2(q[4 * 65] * g[4], q[5 * 65] * g[5]); o.w = pk2(q[6 * 65] * g[6], q[7 * 65] * g[7]);
                    *(u32x4*)((bf16*)(ws + WS_WQ) + (size_t)(n0 + nn) * 1024 + k0 + k8) = o;
                }
                __syncthreads();
                continue;
            }
            r -= N_Q;
            {
                const int h = r >> 3, g = (r >> 2) & 1, kb = (r >> 1) & 1, nb = r & 1;
                const float* W = (g ? c.in[7] : c.in[5]) + (size_t)h * 128 * 128;
                transpose_tile(W, 128, (bf16*)(ws + WS_WAX) + (size_t)h * 256 * 128 + (size_t)g * 128 * 128, 128, kb * 64, nb * 64, nb * 64, s, tid, NLOG2E);
            }
        }
    }
}

__device__ __forceinline__ void phase0b(const Ctx& c) {
    int tid_ = threadIdx.x; asm volatile("" : "+v"(tid_)); const int tid = tid_, lane = tid & 63, wid = tid >> 6;
    unsigned char* ws = c.ws;
    const bf16* W = (const bf16*)(ws + WS_WIN);
    {
        const int gt = blockIdx.x * NTHR + tid;
        if (gt < 4096) {
            const float* part = (const float*)(ws + WS_PARTCD) + gt;
            float sacc = 0.f;
#pragma unroll
            for (int kb = 0; kb < 16; ++kb) sacc += part[(size_t)kb * 4096];
            ((float*)(ws + WS_CQ))[gt] = sacc;
        }
    }
    for (int row4 = (blockIdx.x * 8 + wid) * 4; row4 < DIN + (Q_I8 ? 2048 : 0); row4 += gridDim.x * 8 * 4) {
        float v[4][16]; unsigned char* dst[4]; float* sc[4];
#pragma unroll
        for (int r = 0; r < 4; ++r) {
            const int rw = row4 + r; const bool isq = rw >= DIN;
            const bf16* src = (isq ? (const bf16*)(ws + WS_WQ) + (size_t)(rw - DIN) * 1024 : W + (size_t)rw * 1024) + lane * 16;
            const u32x4 a = *(const u32x4*)src, b = *(const u32x4*)(src + 8);
#pragma unroll
            for (int j = 0; j < 4; ++j) { v[r][2 * j] = bf_lo(a[j]); v[r][2 * j + 1] = bf_hi(a[j]); v[r][8 + 2 * j] = bf_lo(b[j]); v[r][8 + 2 * j + 1] = bf_hi(b[j]); }
            dst[r] = isq ? ws + WS_WQQ8 + (size_t)(rw - DIN) * 1024 : ws + WS_WQ8 + (size_t)rw * 1024; sc[r] = isq ? (float*)(ws + WS_SWQ) + (rw - DIN) : (float*)(ws + WS_SWC) + rw;
        }
        quant_rows_i8<4>(v, dst, sc, lane);
    }
}

__device__ __forceinline__ void phase2a(const Ctx& c, const pg8::StaticOrder& S) {
    int tid_ = threadIdx.x; asm volatile("" : "+v"(tid_)); const int tid = tid_, lane = tid & 63, wid = tid >> 6;
    unsigned char* ws = c.ws;
    const bf16* P4 = (const bf16*)(ws + WS_P4); bf16* XC = (bf16*)c.out; float* STATS = (float*)(ws + WS_STATS);
    const float* conv_w = c.in[3]; const float* conv_b = c.in[4];
    for (int u0 = 0; ; u0 += 4) {
        pg8::Unit uu; bool any = false;
        { pg8::Unit tmp; any = S.next(u0, tmp); }
        if (!any) break;
        if (!S.next(u0 + (tid >> 7), uu)) continue;
        const int cg = tid & 15, run = uu.pm * 8 + ((tid & 127) >> 4), ch = uu.pn * 128 + cg * 8;
        float w[4][8], bias[8];
#pragma unroll
        for (int k = 0; k < 4; ++k) { const f32x4 a = *(const f32x4*)(conv_w + k * 1024 + ch), b = *(const f32x4*)(conv_w + k * 1024 + ch + 4);
            w[k][0] = a.x; w[k][1] = a.y; w[k][2] = a.z; w[k][3] = a.w; w[k][4] = b.x; w[k][5] = b.y; w[k][6] = b.z; w[k][7] = b.w; }
        { const f32x4 a = *(const f32x4*)(conv_b + ch), b = *(const f32x4*)(conv_b + ch + 4);
          bias[0] = a.x; bias[1] = a.y; bias[2] = a.z; bias[3] = a.w; bias[4] = b.x; bias[5] = b.y; bias[6] = b.z; bias[7] = b.w; }
        {
            const int t0 = run * 32; const bool first = (t0 & (SEQ - 1)) == 0;
            const bf16* src = P4 + (size_t)t0 * 4096 + ch;
            u32x4 x0 = (u32x4){0u, 0u, 0u, 0u}, x1 = x0, x2 = x0;
            if (!first) { x0 = *(const u32x4*)(src - 3 * 4096); x1 = *(const u32x4*)(src - 2 * 4096); x2 = *(const u32x4*)(src - 4096); }
#pragma unroll 8
            for (int t = 0; t < 32; ++t) {
                const u32x4 x3 = *(const u32x4*)(src + (size_t)t * 4096);
                float o[8];
#pragma unroll
                for (int j = 0; j < 8; ++j) {
                    const float v0 = (j & 1) ? bf_hi(x0[j >> 1]) : bf_lo(x0[j >> 1]), v1 = (j & 1) ? bf_hi(x1[j >> 1]) : bf_lo(x1[j >> 1]);
                    const float v2 = (j & 1) ? bf_hi(x2[j >> 1]) : bf_lo(x2[j >> 1]), v3 = (j & 1) ? bf_hi(x3[j >> 1]) : bf_lo(x3[j >> 1]);
                    o[j] = bias[j] + w[0][j] * v0 + w[1][j] * v1 + w[2][j] * v2 + w[3][j] * v3;
                }
                u32x4 pk; pk.x = pk2(o[0], o[1]); pk.y = pk2(o[2], o[3]); pk.z = pk2(o[4], o[5]); pk.w = pk2(o[6], o[7]);
                *(u32x4*)(XC + (size_t)(t0 + t) * 1024 + ch) = pk;
                x0 = x1; x1 = x2; x2 = x3;
            }
        }
    }
    for (int row4 = (blockIdx.x * 8 + wid) * 4; row4 < T; row4 += gridDim.x * 8 * 4) {
        u32x4 a[4], b[4];
#pragma unroll
        for (int r = 0; r < 4; ++r) { const bf16* p = P4 + (size_t)(row4 + r) * 4096 + 3072 + lane * 16; a[r] = *(const u32x4*)p; b[r] = *(const u32x4*)(p + 8); }
        float mean[4], q[4];
#pragma unroll
        for (int r = 0; r < 4; ++r) {
            float s = 0.f;
#pragma unroll
            for (int j = 0; j < 4; ++j) s += (bf_lo(a[r][j]) + bf_hi(a[r][j])) + (bf_lo(b[r][j]) + bf_hi(b[r][j]));
            mean[r] = s;
        }
#pragma unroll
        for (int o = 32; o >= 1; o >>= 1) {
#pragma unroll
            for (int r = 0; r < 4; ++r) mean[r] += __shfl_xor(mean[r], o);
        }
#pragma unroll
        for (int r = 0; r < 4; ++r) {
            mean[r] *= (1.0f / 1024.0f);
            float s = 0.f;
#pragma unroll
            for (int j = 0; j < 4; ++j) {
                const float d0 = bf_lo(a[r][j]) - mean[r], d1 = bf_hi(a[r][j]) - mean[r], d2 = bf_lo(b[r][j]) - mean[r], d3 = bf_hi(b[r][j]) - mean[r];
                s += (d0 * d0 + d1 * d1) + (d2 * d2 + d3 * d3);
            }
            q[r] = s;
        }
#pragma unroll
        for (int o = 32; o >= 1; o >>= 1) {
#pragma unroll
            for (int r = 0; r < 4; ++r) q[r] += __shfl_xor(q[r], o);
        }
        if (lane < 4) {
            const float mm = lane == 0 ? mean[0] : lane == 1 ? mean[1] : lane == 2 ? mean[2] : mean[3];
            const float qq = lane == 0 ? q[0] : lane == 1 ? q[1] : lane == 2 ? q[2] : q[3];
            *(f32x2*)(STATS + (size_t)(row4 + lane) * 2) = (f32x2){mm, rsqrtf(qq * (1.0f / 1024.0f) + LN_EPS)};
        }
    }
}

typedef short s16x4 __attribute__((ext_vector_type(4)));
struct P2cRegs { u32x4 v[4]; f32x2 st[4]; };
__device__ __forceinline__ void p2c_load_v(P2cRegs& R, const bf16* P4, const float* STATS, int tile, int h, int tid) {
    const int piece = tid & 15, rowb = tid >> 4;
#pragma unroll
    for (int j = 0; j < 4; ++j) {
        const size_t row = (size_t)(tile * CHUNK + rowb + 32 * j);
        R.v[j] = *(const u32x4*)(P4 + row * 4096 + 3072 + h * 128 + piece * 8);
        R.st[j] = *(const f32x2*)(STATS + row * 2);
    }
}
__device__ __forceinline__ void phase2c(const Ctx& c, LAS unsigned char* lds, const int outcol = 2048) {
    int tid_ = threadIdx.x; asm volatile("" : "+v"(tid_)); const int tid = tid_, lane = tid & 63, wid = __builtin_amdgcn_readfirstlane(tid >> 6), fr = lane & 15, fq = lane >> 4, wr = wid >> 1, wc = wid & 1;
    unsigned char* ws = c.ws;
    bf16* P4 = (bf16*)(ws + WS_P4); const float* STATS = (const float*)(ws + WS_STATS);
    const bf16* HL = (const bf16*)(ws + WS_HL); const bf16* PC = (const bf16*)((const unsigned char*)c.out + OUT_PC);
    const float* PEND = (const float*)(ws + WS_PEND); const float* HEND = (const float*)(ws + WS_HEND);
    LAS float* carry = (LAS float*)(lds + 65536);
    const bf16* WTRIL = (const bf16*)(ws + WS_WTRIL);
    const float* ln_g = c.in[10]; const float* ln_b = c.in[11]; const float* gm_bs = c.in[13];
    const int h = blockIdx.x & 7;
    bf16x8 wf[2][4];
#pragma unroll
    for (int m = 0; m < 2; ++m)
#pragma unroll
        for (int ks = 0; ks < 4; ++ks) wf[m][ks] = *(const bf16x8*)(WTRIL + (size_t)h * 128 * 128 + (32 * wr + 16 * m + fr) * 128 + ks * 32 + fq * 8);
    const int piece = tid & 15, rowb = tid >> 4;
    float lg[8], lb[8];
    { const f32x4 g0 = *(const f32x4*)(ln_g + h * 128 + piece * 8), g1 = *(const f32x4*)(ln_g + h * 128 + piece * 8 + 4), b0 = *(const f32x4*)(ln_b + h * 128 + piece * 8), b1 = *(const f32x4*)(ln_b + h * 128 + piece * 8 + 4);
#pragma unroll
      for (int j = 0; j < 4; ++j) { lg[j] = g0[j]; lg[4 + j] = g1[j]; lb[j] = b0[j]; lb[4 + j] = b1[j]; } }
    const int wr_off = rowb * 256 + ((piece ^ ((rowb & 3) << 2)) << 4);
    const bool wr_swap = ((rowb >> 3) & 1) != 0;
    const int q_ = fr >> 2, p_ = fr & 3;
    int rd_off[2][2];
#pragma unroll
    for (int n2 = 0; n2 < 2; ++n2)
#pragma unroll
        for (int np = 0; np < 2; ++np) rd_off[n2][np] = (fq * 8 + q_) * 256 + (((8 * wc + 4 * n2 + p_) ^ (q_ << 2)) << 4) + ((np ^ (fq & 1)) << 3);
    const int nblk_h = gridDim.x >> 3;
    const int tile0 = blockIdx.x >> 3;
    P2cRegs RA, RB;
    if (tile0 < NTILE) p2c_load_v(RA, P4, STATS, tile0, h, tid);
    if (tile0 + nblk_h < NTILE) p2c_load_v(RB, P4, STATS, tile0 + nblk_h, h, tid);
#define P2C_UNIT(R, tile, par) do { \
        const int t0 = (tile) * CHUNK; \
        LAS unsigned char* V = lds + (par) * 32768; \
        _Pragma("unroll") for (int j = 0; j < 4; ++j) { \
            const float mean = R.st[j].x, rstd = R.st[j].y; \
            u32x4 w; \
            _Pragma("unroll") for (int e = 0; e < 4; ++e) w[e] = pk2((bf_lo(R.v[j][e]) - mean) * rstd * lg[2 * e] + lb[2 * e], (bf_hi(R.v[j][e]) - mean) * rstd * lg[2 * e + 1] + lb[2 * e + 1]); \
            if (wr_swap) w = (u32x4){w.z, w.w, w.x, w.y}; \
            *(LAS u32x4*)(V + wr_off + j * 32 * 256) = w; } \
        if (tid < 128) {                                        \
            const int cidx_ = (tile) & (NCHUNK - 1), tb_ = (tile) - cidx_; float hin_ = 0.f; \
            _Pragma("unroll") for (int cc = 0; cc < NCHUNK - 1; ++cc) { \
                const bool on_ = cc < cidx_; const int tl_ = on_ ? tb_ + cc : tb_; \
                const float p_ = PEND[(size_t)tl_ * 1024 + h * 128 + tid], q_ = HEND[(size_t)tl_ * 1024 + h * 128 + tid]; \
                hin_ = on_ ? p_ * hin_ + q_ : hin_; } \
            carry[(par) * 128 + tid] = hin_; } \
        __syncthreads(); \
        if ((tile) + 2 * nblk_h < NTILE) p2c_load_v(R, P4, STATS, (tile) + 2 * nblk_h, h, tid); \
        u32x4 hlv[2][2], pcv[2][2], gvv[2][2], ugv[2][2]; \
        _Pragma("unroll") for (int m = 0; m < 2; ++m) _Pragma("unroll") for (int n2 = 0; n2 < 2; ++n2) { \
            const size_t row_ = (size_t)(t0 + 32 * wr + 16 * m + fr); const int col_ = h * 128 + 64 * wc + 32 * n2 + 8 * fq; \
            hlv[m][n2] = *(const u32x4*)(HL + row_ * 1024 + col_); pcv[m][n2] = *(const u32x4*)(PC + row_ * 1024 + col_); gvv[m][n2] = *(const u32x4*)(P4 + row_ * 4096 + 1024 + col_); ugv[m][n2] = *(const u32x4*)(P4 + row_ * 4096 + 2048 + col_); } \
        f32x4 acc[2][4]; \
        _Pragma("unroll") for (int m = 0; m < 2; ++m) _Pragma("unroll") for (int n = 0; n < 4; ++n) acc[m][n] = (f32x4){0.f, 0.f, 0.f, 0.f}; \
        _Pragma("unroll") for (int ks = 0; ks < 4; ++ks) { \
            if (ks <= wr) { \
                bf16x8 b[4]; \
                _Pragma("unroll") for (int n = 0; n < 4; ++n) { \
                    const s16x4 lo = __builtin_amdgcn_ds_read_tr16_b64_v4i16((LAS s16x4*)(V + rd_off[n >> 1][n & 1] + ks * 32 * 256)); \
                    const s16x4 hi = __builtin_amdgcn_ds_read_tr16_b64_v4i16((LAS s16x4*)(V + rd_off[n >> 1][n & 1] + ks * 32 * 256 + 4 * 256)); \
                    b[n] = __builtin_shufflevector(lo, hi, 0, 1, 2, 3, 4, 5, 6, 7); } \
                _Pragma("unroll") for (int m = 0; m < 2; ++m) _Pragma("unroll") for (int n = 0; n < 4; ++n) acc[m][n] = __builtin_amdgcn_mfma_f32_16x16x32_bf16(b[n], wf[m][ks], acc[m][n], 0, 0, 0); } } \
        _Pragma("unroll") for (int m = 0; m < 2; ++m) { \
            const int tl = 32 * wr + 16 * m + fr; \
            const float bsv = gm_bs[h * 128 + tl]; \
            _Pragma("unroll") for (int n2 = 0; n2 < 2; ++n2) { \
                const f32x4 m0 = acc[m][2 * n2] + bsv, m1 = acc[m][2 * n2 + 1] + bsv; \
                const u32x4 ug = ugv[m][n2], hl_ = hlv[m][n2], pc_ = pcv[m][n2], g_ = gvv[m][n2]; \
                const LAS float* cp_ = carry + (par) * 128 + 64 * wc + 32 * n2 + 8 * fq; \
                const f32x4 h0_ = *(const LAS f32x4*)cp_, h1_ = *(const LAS f32x4*)(cp_ + 4); \
                u32x4 o;                                             \
                o.x = pk2(bf_lo(g_.x) * (bf_lo(hl_.x) + bf_lo(pc_.x) * h0_[0]) + bf_lo(ug.x) * m0[0], bf_hi(g_.x) * (bf_hi(hl_.x) + bf_hi(pc_.x) * h0_[1]) + bf_hi(ug.x) * m0[1]); \
                o.y = pk2(bf_lo(g_.y) * (bf_lo(hl_.y) + bf_lo(pc_.y) * h0_[2]) + bf_lo(ug.y) * m0[2], bf_hi(g_.y) * (bf_hi(hl_.y) + bf_hi(pc_.y) * h0_[3]) + bf_hi(ug.y) * m0[3]); \
                o.z = pk2(bf_lo(g_.z) * (bf_lo(hl_.z) + bf_lo(pc_.z) * h1_[0]) + bf_lo(ug.z) * m1[0], bf_hi(g_.z) * (bf_hi(hl_.z) + bf_hi(pc_.z) * h1_[1]) + bf_hi(ug.z) * m1[1]); \
                o.w = pk2(bf_lo(g_.w) * (bf_lo(hl_.w) + bf_lo(pc_.w) * h1_[2]) + bf_lo(ug.w) * m1[2], bf_hi(g_.w) * (bf_hi(hl_.w) + bf_hi(pc_.w) * h1_[3]) + bf_hi(ug.w) * m1[3]); \
                *(u32x4*)(P4 + (size_t)(t0 + tl) * 4096 + outcol + h * 128 + 64 * wc + 32 * n2 + 8 * fq) = o; } } \
    } while (0)
    for (int tile = tile0; tile < NTILE; tile += 2 * nblk_h) {
        P2C_UNIT(RA, tile, 0);
        if (tile + nblk_h < NTILE) P2C_UNIT(RB, tile + nblk_h, 1);
    }
#undef P2C_UNIT
}


__device__ __forceinline__ int f2key(float f) { const int b = __float_as_int(f); return b ^ ((b >> 31) & 0x7fffffff); }
__device__ __forceinline__ float key2f(int k) { return __int_as_float(k ^ ((k >> 31) & 0x7fffffff)); }
#define CE_DESC(a, b) do { const int _mx = max((a), (b)), _mn = min((a), (b)); (a) = _mx; (b) = _mn; } while (0)

template <int OFF, int N> __device__ __forceinline__ void sort16_desc(int (&v)[N]) {
#pragma unroll
    for (int k = 2; k <= 16; k <<= 1) {
#pragma unroll
        for (int j = k >> 1; j > 0; j >>= 1) {
#pragma unroll
            for (int i = 0; i < 16; ++i) {
                const int l = i ^ j;
                if (l > i) { if ((i & k) == 0) CE_DESC(v[OFF + i], v[OFF + l]); else CE_DESC(v[OFF + l], v[OFF + i]); }
            }
        }
    }
}
template <int OA, int OB, int N> __device__ __forceinline__ void merge16_desc(int (&v)[N]) {
#pragma unroll
    for (int i = 0; i < 16; ++i) v[OA + i] = max(v[OA + i], v[OB + 15 - i]);
#pragma unroll
    for (int j = 8; j > 0; j >>= 1) {
#pragma unroll
        for (int i = 0; i < 16; ++i) { const int l = i ^ j; if (l > i) CE_DESC(v[OA + i], v[OA + l]); }
    }
}
__device__ __forceinline__ void top16_of_64(int (&v)[64]) {
    sort16_desc<0>(v); sort16_desc<16>(v); sort16_desc<32>(v); sort16_desc<48>(v);
    merge16_desc<0, 16>(v); merge16_desc<32, 48>(v); merge16_desc<0, 32>(v);
}
__device__ __forceinline__ void merge_partner(int (&L)[16]) {
    int P[16];
#pragma unroll
    for (int i = 0; i < 16; ++i) P[i] = __shfl_xor(L[i], 32);
#pragma unroll
    for (int i = 0; i < 16; ++i) L[i] = max(L[i], P[15 - i]);
#pragma unroll
    for (int j = 8; j > 0; j >>= 1) {
#pragma unroll
        for (int i = 0; i < 16; ++i) { const int l = i ^ j; if (l > i) CE_DESC(L[i], L[l]); }
    }
}
__device__ __forceinline__ unsigned lookup_byte(const unsigned (&t)[4], int i) {
    const int w = i >> 2;
    const unsigned dw = (w == 0) ? t[0] : (w == 1) ? t[1] : (w == 2) ? t[2] : t[3];
    return (dw >> ((i & 3) * 8)) & 0xffu;
}

typedef _Float16 h16x2 __attribute__((ext_vector_type(2)));
__device__ __forceinline__ unsigned pkh2(float lo, float hi) { return __builtin_bit_cast(unsigned, __builtin_amdgcn_cvt_pkrtz(lo, hi)); }
__device__ __forceinline__ float h_lo(unsigned w) { return (float)__builtin_bit_cast(h16x2, w)[0]; }
__device__ __forceinline__ float h_hi(unsigned w) { return (float)__builtin_bit_cast(h16x2, w)[1]; }
constexpr int P7_KP = 272;
__device__ __forceinline__ void phase7(const Ctx& c, LAS unsigned char* lds) {
    int tid_ = threadIdx.x; asm volatile("" : "+v"(tid_)); const int tid = tid_, lane = tid & 63, wid = __builtin_amdgcn_readfirstlane(tid >> 6), r = lane & 31, hh = lane >> 5;
    unsigned char* ws = c.ws;
    const bf16* Q = (const bf16*)c.out; const bf16* KB = (const bf16*)(ws + WS_KEYS);
    int* IDX = (int*)(ws + WS_IDX); float* GATE = (float*)(ws + WS_GATE);
    const int head = blockIdx.x & 7, nblk_h = gridDim.x >> 3;
    {
        const bf16* ksrc = KB + (size_t)head * 256 * 128;
        for (int i = tid; i < 256 * 16; i += NTHR) { const int row = i >> 4, sg = i & 15; *(LAS u32x4*)(lds + row * P7_KP + sg * 16) = *(const u32x4*)(ksrc + row * 128 + sg * 8); }
    }
    __syncthreads();
    const LAS unsigned char* kl = lds + r * P7_KP + hh * 16;
    if (wid & 1) quant_peer_tables(c, blockIdx.x * 8 + wid, gridDim.x * 8, lane);
    for (int grp = (blockIdx.x >> 3) * 8 + wid; grp < T / 32; grp += nblk_h * 8) {
        const int tok = grp * 32 + r;
        int kz = 0; asm volatile("" : "+v"(kz));
        const LAS unsigned char* klz = kl + kz;
        bf16x8 qf[2][8];
        {
            const bf16* qp = Q + (size_t)tok * 2048 + head * 256 + hh * 8;
#pragma unroll
            for (int p = 0; p < 2; ++p)
#pragma unroll
                for (int ks = 0; ks < 8; ++ks) qf[p][ks] = *(const bf16x8*)(qp + p * 128 + ks * 16);
        }
        int S[2][16];
#pragma unroll
        for (int p = 0; p < 2; ++p) {
            f32x16 acc[4];
#pragma unroll
            for (int mb = 0; mb < 4; ++mb)
#pragma unroll
                for (int e = 0; e < 16; ++e) acc[mb][e] = 0.f;
#pragma unroll
            for (int ks = 0; ks < 8; ++ks) {
#pragma unroll
                for (int mb = 0; mb < 4; ++mb) {
                    const bf16x8 a = *(const LAS bf16x8*)(klz + (p * 128 + mb * 32) * P7_KP + ks * 32);
                    acc[mb] = __builtin_amdgcn_mfma_f32_32x32x16_bf16(a, qf[p][ks], acc[mb], 0, 0, 0);
                }
            }
            int v[64];
#pragma unroll
            for (int mb = 0; mb < 4; ++mb)
#pragma unroll
                for (int e = 0; e < 16; ++e) {
                    const int n = mb * 32 + (e & 3) + 8 * (e >> 2);
                    v[mb * 16 + e] = (f2key(acc[mb][e]) & ~0x7f) | n;
                }
            top16_of_64(v);
            int L[16];
#pragma unroll
            for (int i = 0; i < 16; ++i) L[i] = v[i] | (hh << 2);
            merge_partner(L);
#pragma unroll
            for (int i = 0; i < 16; ++i) S[p][i] = L[i];
        }
        float f1[16], f2[16];
#pragma unroll
        for (int i = 0; i < 16; ++i) { f1[i] = key2f(S[0][i]); f2[i] = key2f(S[1][i]); }
        int cv[64];
        {
            int n = 0;
#pragma unroll
            for (int i = 0; i < 16; ++i)
#pragma unroll
                for (int j = 0; j < 16; ++j)
                    if ((i + 1) * (j + 1) <= 16) { cv[n] = (f2key(f1[i] + f2[j]) & ~0xff) | (i * 16 + j); ++n; }
#pragma unroll
            for (int q = 50; q < 64; ++q) cv[q] = (int)0x80000000;
        }
        top16_of_64(cv);
        unsigned t1[4], t2[4];
#pragma unroll
        for (int w = 0; w < 4; ++w) {
            t1[w] = (unsigned)(S[0][4 * w] & 0x7f) | ((unsigned)(S[0][4 * w + 1] & 0x7f) << 8) | ((unsigned)(S[0][4 * w + 2] & 0x7f) << 16) | ((unsigned)(S[0][4 * w + 3] & 0x7f) << 24);
            t2[w] = (unsigned)(S[1][4 * w] & 0x7f) | ((unsigned)(S[1][4 * w + 1] & 0x7f) << 8) | ((unsigned)(S[1][4 * w + 2] & 0x7f) << 16) | ((unsigned)(S[1][4 * w + 3] & 0x7f) << 24);
        }
        int eid[16]; float ev[16];
        const float vmax = key2f(cv[0]);
        float esum = 0.f;
#pragma unroll
        for (int k = 0; k < 16; ++k) {
            const int pos = cv[k] & 0xff;
            eid[k] = (int)(lookup_byte(t1, pos >> 4) * 128u + lookup_byte(t2, pos & 15));
            ev[k] = __expf(key2f(cv[k]) - vmax);
            esum += ev[k];
        }
        const float inv = 1.0f / esum;
        if (hh == 0) {
            i32x4* ip = (i32x4*)(IDX + (size_t)tok * 128 + head * 16); f32x4* gp = (f32x4*)(GATE + (size_t)tok * 128 + head * 16);
#pragma unroll
            for (int w = 0; w < 4; ++w) {
                ip[w] = (i32x4){eid[4 * w], eid[4 * w + 1], eid[4 * w + 2], eid[4 * w + 3]};
                gp[w] = (f32x4){ev[4 * w] * inv, ev[4 * w + 1] * inv, ev[4 * w + 2] * inv, ev[4 * w + 3] * inv};
            }
        }
    }
    if (!(wid & 1)) quant_peer_tables(c, blockIdx.x * 8 + wid, gridDim.x * 8, lane);
}

#ifndef P8_TOK_
#define P8_TOK_ 8
#endif
#ifndef P8_EARLY_
#define P8_EARLY_ 1
#endif
#ifndef P8_X4_
#define P8_X4_ 1
#endif
constexpr int P8_TOK = P8_TOK_, P8_WAVE_LDS = P8_TOK * 2048 + 512;
template <int CTRL> __device__ __forceinline__ int dppi(int v) { return __builtin_amdgcn_update_dpp(0, v, CTRL, 0xf, 0xf, false); }
__device__ __forceinline__ int reduce16i(const int (&p)[16], bool b3, bool b2) {
    int q8[8], r4[4], s2[2];
#pragma unroll
    for (int i = 0; i < 8; ++i) { const auto r = __builtin_amdgcn_permlane32_swap((unsigned)p[i], (unsigned)p[8 + i], false, false); q8[i] = (int)(r[0] + r[1]); }
#pragma unroll
    for (int i = 0; i < 4; ++i) { const auto r = __builtin_amdgcn_permlane16_swap((unsigned)q8[i], (unsigned)q8[4 + i], false, false); r4[i] = (int)(r[0] + r[1]); }
#pragma unroll
    for (int i = 0; i < 2; ++i) { const int ta = r4[i] + dppi<0x128>(r4[i]), tb = r4[2 + i] + dppi<0x128>(r4[2 + i]); s2[i] = b3 ? tb : ta; }
    const int ta = s2[0] + dppi<0x141>(s2[0]), tb = s2[1] + dppi<0x141>(s2[1]);
    int t = b2 ? tb : ta;
    t += dppi<0x4e>(t);
    t += dppi<0xb1>(t);
    return t;
}
__device__ __forceinline__ int reduce8i(const int (&q8)[8], bool b3, bool b2) {
    int r4[4], s2[2];
#pragma unroll
    for (int i = 0; i < 4; ++i) { const auto r = __builtin_amdgcn_permlane16_swap((unsigned)q8[i], (unsigned)q8[4 + i], false, false); r4[i] = (int)(r[0] + r[1]); }
#pragma unroll
    for (int i = 0; i < 2; ++i) { const int ta = r4[i] + dppi<0x128>(r4[i]), tb = r4[2 + i] + dppi<0x128>(r4[2 + i]); s2[i] = b3 ? tb : ta; }
    const int ta = s2[0] + dppi<0x141>(s2[0]), tb = s2[1] + dppi<0x141>(s2[1]);
    int t = b2 ? tb : ta;
    t += dppi<0x4e>(t);
    t += dppi<0xb1>(t);
    return t;
}
__device__ __forceinline__ float p8_shx(float v, int of, int lane) { return __int_as_float(__builtin_amdgcn_ds_bpermute((lane ^ of) << 2, __float_as_int(v))); }
__device__ __forceinline__ float p8_sum(float v, int lane) {
#pragma unroll
    for (int of = 32; of >= 1; of >>= 1) v += p8_shx(v, of, lane);
    return v;
}
#define P8_LOAD_X1(x, tok) do { \
        const bf16* zr_ = ZB + (size_t)(tok) * 1024 + lane * 16; \
        const u32x4 a0_ = *(const u32x4*)zr_, a1_ = *(const u32x4*)(zr_ + 8); \
        const f32x2 st_ = *(const f32x2*)(ST1 + (size_t)(tok) * 2); \
        _Pragma("unroll") for (int j = 0; j < 4; ++j) { x[2 * j] = bf_lo(a0_[j]); x[2 * j + 1] = bf_hi(a0_[j]); x[8 + 2 * j] = bf_lo(a1_[j]); x[8 + 2 * j + 1] = bf_hi(a1_[j]); } \
        _Pragma("unroll") for (int w = 0; w < 4; ++w) { \
            const f32x4 g_ = *(const f32x4*)(l1g + lane * 16 + 4 * w), b_ = *(const f32x4*)(l1b + lane * 16 + 4 * w); \
            _Pragma("unroll") for (int k = 0; k < 4; ++k) x[4 * w + k] = (x[4 * w + k] - st_.x) * st_.y * g_[k] + b_[k]; } \
    } while (0)
#define P8_ISSUE_U(U, IDV, GV, SC2, tt_, k_) do { \
        const u32x2 en_ = *(const LAS u32x2*)(wl + (tt_) * 1024 + ((k_) * 16 + esub) * 8); \
        IDV = (int)en_.x; GV = __uint_as_float(en_.y); SC2 = SC[IDV]; \
        unsigned l8_ = lane8; asm volatile("" : "+v"(l8_)); \
        _Pragma("unroll") for (int e = 0; e < 16; ++e) { \
            unsigned long long rb_ = (unsigned long long)UV + ((unsigned long long)(unsigned)__builtin_amdgcn_readlane(IDV, e * 4) << 10); \
            asm volatile("" : "+s"(rb_));                              \
            U[e] = *(const __attribute__((address_space(1))) u32x2*)(rb_ + l8_); } \
    } while (0)
#define P8_ISSUE_V(V, IDV) do { \
        unsigned l8_ = lane8; asm volatile("" : "+v"(l8_)); \
        _Pragma("unroll") for (int e = 0; e < 16; ++e) { \
            unsigned long long rb_ = (unsigned long long)UV + ((unsigned long long)(unsigned)__builtin_amdgcn_readlane(IDV, e * 4) << 10); \
            asm volatile("" : "+s"(rb_)); \
            V[e] = *(const __attribute__((address_space(1))) u32x2*)(rb_ + 512 + l8_); } \
    } while (0)
#define P8_USIDE(U, GV, SC2, tt_, ACT) do { \
        const u32x4 xq_ = *(const LAS u32x4*)(wx + (tt_) * 1024 + lane8 * 2); \
        int p_[16]; \
        _Pragma("unroll") for (int e = 0; e < 16; ++e) { \
            int t_; asm("v_dot8_i32_i4 %0, %1, %2, 0" : "=v"(t_) : "v"(U[e].x), "v"(xq_.x)); \
            t_ = __builtin_amdgcn_sdot8((int)U[e].y, (int)xq_.y, t_, false); t_ <<= 4; \
            t_ = __builtin_amdgcn_sdot8((int)U[e].x, (int)xq_.z, t_, false); t_ = __builtin_amdgcn_sdot8((int)U[e].y, (int)xq_.w, t_, false); p_[e] = t_; } \
        const int t1_ = reduce16i(p_, b3, b2); \
        ACT = gelu_tanh(((float)t1_ + hoff[tt_]) * SC2.x * sx[tt_]) * GV * SC2.y; \
    } while (0)
#define P8_FP4(w_, b_) __builtin_amdgcn_cvt_scalef32_pk_f32_fp4(w_, 1.0f, b_)
#define P8_VSIDE(V, tt_, ACT) do { \
        f32x2 oc_[8]; \
        _Pragma("unroll") for (int j = 0; j < 8; ++j) oc_[j] = (f32x2){h_lo(ob[tt_][j]), h_hi(ob[tt_][j])}; \
        _Pragma("unroll") for (int e = 0; e < 16; ++e) { \
            const float ae_ = __int_as_float(__builtin_amdgcn_readlane(__float_as_int(ACT), e * 4)); const f32x2 aa_ = {ae_, ae_}; \
            oc_[0] = __builtin_elementwise_fma(P8_FP4(V[e].x, 0), aa_, oc_[0]); oc_[1] = __builtin_elementwise_fma(P8_FP4(V[e].x, 1), aa_, oc_[1]); \
            oc_[2] = __builtin_elementwise_fma(P8_FP4(V[e].x, 2), aa_, oc_[2]); oc_[3] = __builtin_elementwise_fma(P8_FP4(V[e].x, 3), aa_, oc_[3]); \
            oc_[4] = __builtin_elementwise_fma(P8_FP4(V[e].y, 0), aa_, oc_[4]); oc_[5] = __builtin_elementwise_fma(P8_FP4(V[e].y, 1), aa_, oc_[5]); \
            oc_[6] = __builtin_elementwise_fma(P8_FP4(V[e].y, 2), aa_, oc_[6]); oc_[7] = __builtin_elementwise_fma(P8_FP4(V[e].y, 3), aa_, oc_[7]); } \
        _Pragma("unroll") for (int j = 0; j < 8; ++j) ob[tt_][j] = pkh2(oc_[j].x, oc_[j].y); \
    } while (0)
#define P8_STEP(UC, VC, GC, SCC, tt_, UN, VN, IDN, GN, SCN, ttn_, kn_) do { \
        P8_ISSUE_U(UN, IDN, GN, SCN, ttn_, kn_); __builtin_amdgcn_sched_barrier(0); \
        float act_; P8_USIDE(UC, GC, SCC, tt_, act_); __builtin_amdgcn_sched_barrier(0); \
        P8_ISSUE_V(VN, IDN); __builtin_amdgcn_sched_barrier(0); \
        P8_VSIDE(VC, tt_, act_); __builtin_amdgcn_sched_barrier(0); \
    } while (0)
#if P8_X4_
#undef P8_STEP
#define P8_ISSUE_W(W, EN, tt_, k_) do { \
        unsigned l16_ = lane16; asm volatile("" : "+v"(l16_));                            \
        EN = *(const LAS u32x2*)(wl + (tt_) * 1024 + (k_) * 128 + ((l16_ >> 6) << 3));     \
        _Pragma("unroll") for (int e = 0; e < 16; ++e) { \
            unsigned long long rb_ = (unsigned long long)UV + ((unsigned long long)((unsigned)__builtin_amdgcn_readlane((int)EN.x, e * 4) & 0xffffu) << 10); \
            asm volatile("" : "+s"(rb_)); \
            W[e] = *(const __attribute__((address_space(1))) u32x4*)(rb_ + l16_); } \
    } while (0)
#define P8_DOT(W, e_, xq_) ({ int t_; asm("v_dot8_i32_i4 %0, %1, %2, 0" : "=v"(t_) : "v"(W[e_].x), "v"(xq_.x)); \
        t_ = __builtin_amdgcn_sdot8((int)W[e_].y, (int)xq_.y, t_, false); t_ <<= 4; \
        t_ = __builtin_amdgcn_sdot8((int)W[e_].x, (int)xq_.z, t_, false); __builtin_amdgcn_sdot8((int)W[e_].y, (int)xq_.w, t_, false); })
#define P8_USIDE_W(W, EN, tt_, ACT) do { \
        unsigned lx_ = lane16; asm volatile("" : "+v"(lx_)); \
        const u32x4 xq_ = *(const LAS u32x4*)(wx + (tt_) * 1024 + lx_); \
        int q8_[8]; \
        _Pragma("unroll") for (int i = 0; i < 8; ++i) {                                   \
            const int ta_ = P8_DOT(W, i, xq_), tb_ = P8_DOT(W, i + 8, xq_); \
            const auto r_ = __builtin_amdgcn_permlane32_swap((unsigned)ta_, (unsigned)tb_, false, false); q8_[i] = (int)(r_[0] + r_[1]); } \
        const int t1_ = reduce8i(q8_, b3, b2); \
        ACT = gelu_tanh(((float)t1_ + hoff[tt_]) * h_hi(EN.x) * sx[tt_]) * __uint_as_float(EN.y); \
    } while (0)
#define P8_VSIDE_W(W, tt_, ACT) do { \
        f32x2 oc_[8]; \
        _Pragma("unroll") for (int j = 0; j < 8; ++j) oc_[j] = (f32x2){h_lo(ob[tt_][j]), h_hi(ob[tt_][j])}; \
        _Pragma("unroll") for (int e = 0; e < 16; ++e) { \
            const float ae_ = __int_as_float(__builtin_amdgcn_readlane(__float_as_int(ACT), e * 4)); const f32x2 aa_ = {ae_, ae_}; \
            oc_[0] = __builtin_elementwise_fma(P8_FP4(W[e].z, 0), aa_, oc_[0]); oc_[1] = __builtin_elementwise_fma(P8_FP4(W[e].z, 1), aa_, oc_[1]); \
            oc_[2] = __builtin_elementwise_fma(P8_FP4(W[e].z, 2), aa_, oc_[2]); oc_[3] = __builtin_elementwise_fma(P8_FP4(W[e].z, 3), aa_, oc_[3]); \
            oc_[4] = __builtin_elementwise_fma(P8_FP4(W[e].w, 0), aa_, oc_[4]); oc_[5] = __builtin_elementwise_fma(P8_FP4(W[e].w, 1), aa_, oc_[5]); \
            oc_[6] = __builtin_elementwise_fma(P8_FP4(W[e].w, 2), aa_, oc_[6]); oc_[7] = __builtin_elementwise_fma(P8_FP4(W[e].w, 3), aa_, oc_[7]); } \
        _Pragma("unroll") for (int j = 0; j < 8; ++j) ob[tt_][j] = pkh2(oc_[j].x, oc_[j].y); \
    } while (0)
#define P8_STEP(WC, ENC, tt_, WN, ENN, ttn_, kn_) do { \
        P8_ISSUE_W(WN, ENN, ttn_, kn_); __builtin_amdgcn_sched_barrier(0); \
        float act_; P8_USIDE_W(WC, ENC, tt_, act_); __builtin_amdgcn_sched_barrier(0); \
        P8_VSIDE_W(WC, tt_, act_); __builtin_amdgcn_sched_barrier(0); \
    } while (0)
#endif
__device__ __forceinline__ void phase8(const Ctx& c, LAS unsigned char* lds, const XcdBarrier& xbar) {
    int tid_ = threadIdx.x; asm volatile("" : "+v"(tid_)); const int tid = tid_, lane = tid & 63, wid = __builtin_amdgcn_readfirstlane(tid >> 6);
    unsigned char* ws = c.ws;
    const bf16* ZB = (const bf16*)(ws + WS_Z); const float* ST1 = (const float*)(ws + WS_ST1); const float* l1g = c.in[15]; const float* l1b = c.in[16];
    const int* IDX = (const int*)(ws + WS_IDX); const float* GATE = (const float*)(ws + WS_GATE);
    const unsigned char* UV = ws + WS_UQ; const f32x2* SC = (const f32x2*)(ws + WS_USC);
    const float* lg = c.in[21]; const float* lb = c.in[22];
    float* OUT = c.out;
    const bool b3 = (lane & 8) != 0, b2 = (lane & 4) != 0;
    const int esub = lane >> 2; const unsigned lane8 = (unsigned)lane * 8u, lane16 = (unsigned)lane * 16u;
    LAS unsigned char* wl = lds + wid * P8_WAVE_LDS;
    LAS unsigned char* wx = wl + P8_TOK * 1024;
    LAS int* hist = (LAS int*)(wx + P8_TOK * 1024);
    const int ntl = (NTILE + gridDim.x - 1) / gridDim.x;
#ifdef UBENCH
    {
        unsigned w_ = lane8; f32x2 r_ = {0.f, 0.f}, a2_ = {1.0f, 1.0f}; int d_ = 0;
        for (int it = 0; it < 1000; ++it) {
#pragma unroll
            for (int j = 0; j < 32; ++j) {
#if UBENCH == 1
                asm volatile("v_cvt_scalef32_pk_f32_fp4 %0, %1, 1.0" : "=v"(r_) : "v"(w_));
#elif UBENCH == 2
                asm volatile("v_pk_fma_f32 %0, %1, %2, %1" : "=v"(r_) : "v"(a2_), "v"(a2_));
#elif UBENCH == 3
                asm volatile("v_dot8_i32_i4 %0, %1, %2, 0" : "=v"(d_) : "v"(w_), "v"(w_));
#elif UBENCH == 4
                asm volatile("v_fma_f32 %0, %1, %1, %1" : "=v"(d_) : "v"(w_));
#endif
            }
        }
    }
#endif
    for (int ti = 0; ti < ntl; ++ti) {
        const int tile = blockIdx.x + ti * gridDim.x; const bool live = tile < NTILE;
        for (int rnd = 0; rnd < 16 / P8_TOK; ++rnd) {
            const int tok0 = tile * CHUNK + wid * 16 + rnd * P8_TOK;
            float sx[P8_TOK], hoff[P8_TOK]; unsigned ob[P8_TOK][8];
            if (live) {
                int lane_p = threadIdx.x; asm volatile("" : "+v"(lane_p)); lane_p &= 63;
#pragma unroll
                for (int tt = 0; tt < P8_TOK; ++tt) {
                    const int lane = lane_p; const unsigned lane8 = (unsigned)lane_p * 8u;
                    const int tok = tok0 + tt;
                    {
                        float x[16];
                        P8_LOAD_X1(x, tok);
                        float m = 0.f;
#pragma unroll
                        for (int j = 0; j < 16; ++j) m = fmaxf(m, fabsf(x[j]));
#pragma unroll
                        for (int of = 32; of >= 1; of >>= 1) m = fmaxf(m, p8_shx(m, of, lane));
                        const float sc = (m > 0.f) ? m * (1.0f / 119.0f) : 1.0f, inv = 1.0f / sc;
                        sx[tt] = __int_as_float(__builtin_amdgcn_readfirstlane(__float_as_int(sc)));
                        unsigned xh0 = 0u, xh1 = 0u, xl0 = 0u, xl1 = 0u; int sm = 0;
#pragma unroll
                        for (int k = 0; k < 16; ++k) {
                            const int xi = (int)rintf(x[k] * inv), lo = ((xi + 8) & 15) - 8, hi = (xi - lo) >> 4;
                            sm += xi;
                            if (k < 8) { xh0 |= (unsigned)(hi & 15) << (4 * k); xl0 |= (unsigned)(lo & 15) << (4 * k); }
                            else { xh1 |= (unsigned)(hi & 15) << (4 * (k - 8)); xl1 |= (unsigned)(lo & 15) << (4 * (k - 8)); }
                        }
                        *(LAS u32x4*)(wx + tt * 1024 + lane8 * 2) = (u32x4){xh0, xh1, xl0, xl1};
                        hoff[tt] = __int_as_float(__builtin_amdgcn_readfirstlane(__float_as_int(0.5f * p8_sum((float)sm, lane))));
                    }
#pragma unroll
                    for (int j = 0; j < 8; ++j) ob[tt][j] = 0u;
                    {
                        LAS unsigned char* L = wl + tt * 1024;
                        const int i0 = IDX[(size_t)tok * 128 + lane], i1 = IDX[(size_t)tok * 128 + 64 + lane];
                        const float g0 = GATE[(size_t)tok * 128 + lane], g1 = GATE[(size_t)tok * 128 + 64 + lane];
                        const int k0 = i0 >> 7, k1 = i1 >> 7;
                        *(LAS u32x2*)(hist + 2 * lane) = (u32x2){0u, 0u};
                        asm volatile("" ::: "memory");
                        const int w0 = __hip_atomic_fetch_add(hist + k0, 1, __ATOMIC_RELAXED, __HIP_MEMORY_SCOPE_WORKGROUP);
                        const int w1 = __hip_atomic_fetch_add(hist + k1, 1, __ATOMIC_RELAXED, __HIP_MEMORY_SCOPE_WORKGROUP);
                        asm volatile("" ::: "memory");
                        const u32x2 cc = *(const LAS u32x2*)(hist + 2 * lane);
                        const int s = (int)(cc.x + cc.y); int incl = s;
#pragma unroll
                        for (int o = 1; o < 64; o <<= 1) { const int t = __builtin_amdgcn_ds_bpermute((lane - o) << 2, incl); incl += (lane >= o) ? t : 0; }
                        const int excl = incl - s;
                        asm volatile("" ::: "memory");
                        *(LAS u32x2*)(hist + 2 * lane) = (u32x2){(unsigned)excl, (unsigned)excl + cc.x};
                        asm volatile("" ::: "memory");
                        const int pos0 = hist[k0] + w0, pos1 = hist[k1] + w1;
                        asm volatile("" ::: "memory");
#if P8_X4_
                        const f32x2 sc0 = SC[i0], sc1 = SC[i1];
                        *(LAS u32x2*)(L + pos0 * 8) = (u32x2){(unsigned)i0 | (pkh2(0.f, sc0.x) & 0xffff0000u), __float_as_uint(g0 * sc0.y)};
                        *(LAS u32x2*)(L + pos1 * 8) = (u32x2){(unsigned)i1 | (pkh2(0.f, sc1.x) & 0xffff0000u), __float_as_uint(g1 * sc1.y)};
#else
                        *(LAS u32x2*)(L + pos0 * 8) = (u32x2){(unsigned)i0, __float_as_uint(g0)};
                        *(LAS u32x2*)(L + pos1 * 8) = (u32x2){(unsigned)i1, __float_as_uint(g1)};
#endif
                        asm volatile("" ::: "memory");
                    }
                }
#if P8_X4_
                u32x4 wa[16], wb[16]; u32x2 ena, enb;
                P8_ISSUE_W(wa, ena, 0, 0);
                for (int k = 0; k < 8; ++k) {
                    const int kn = k < 7 ? k + 1 : 7;
#pragma unroll
                    for (int tt = 0; tt < P8_TOK; tt += 2) {
                        P8_STEP(wa, ena, tt, wb, enb, tt + 1, k);
                        if (tt + 2 < P8_TOK) P8_STEP(wb, enb, tt + 1, wa, ena, tt + 2, k);
                        else P8_STEP(wb, enb, tt + 1, wa, ena, 0, kn);
                    }
                }
#else
                u32x2 ua[16], ub[16], va[16], vb[16]; int ida, idb; float ga, gb; f32x2 sa, sb;
                P8_ISSUE_U(ua, ida, ga, sa, 0, 0);
                P8_ISSUE_V(va, ida);
                for (int k = 0; k < 8; ++k) {
                    const int kn = k < 7 ? k + 1 : 7;
#pragma unroll
                    for (int tt = 0; tt < P8_TOK; tt += 2) {
                        P8_STEP(ua, va, ga, sa, tt, ub, vb, idb, gb, sb, tt + 1, k);
                        if (tt + 2 < P8_TOK) P8_STEP(ub, vb, gb, sb, tt + 1, ua, va, ida, ga, sa, tt + 2, k);
                        else P8_STEP(ub, vb, gb, sb, tt + 1, ua, va, ida, ga, sa, 0, kn);
                    }
                }
#endif
                int tok0e = tok0; asm volatile("" : "+s"(tok0e));
                int lane_e = threadIdx.x; asm volatile("" : "+v"(lane_e)); lane_e &= 63;
#pragma unroll
                for (int tt = 0; tt < P8_TOK; ++tt) {
                    const int lane = lane_e;
                    const int tok = tok0e + tt;
                    float x[16];
                    P8_LOAD_X1(x, tok);
                    float sm = 0.f;
                    float o[16];
#pragma unroll
                    for (int j = 0; j < 8; ++j) { o[2 * j] = h_lo(ob[tt][j]); o[2 * j + 1] = h_hi(ob[tt][j]); }
#pragma unroll
                    for (int j = 0; j < 16; ++j) { o[j] = ALPHA * x[j] + o[j]; sm += o[j]; }
                    const float mean = p8_sum(sm, lane) * (1.0f / 1024.0f);
                    float qv = 0.f;
#pragma unroll
                    for (int j = 0; j < 16; ++j) { o[j] -= mean; qv += o[j] * o[j]; }
                    const float rstd = rsqrtf(p8_sum(qv, lane) * (1.0f / 1024.0f) + LN_EPS);
                    const float* gp = lg + lane * 16; const float* bp = lb + lane * 16;
                    float* op = OUT + (size_t)tok * 1024 + lane * 16;
#pragma unroll
                    for (int w = 0; w < 4; ++w) {
                        const f32x4 gg = *(const f32x4*)(gp + 4 * w), hb = *(const f32x4*)(bp + 4 * w);
                        *(f32x4*)(op + 4 * w) = (f32x4){o[4 * w], o[4 * w + 1], o[4 * w + 2], o[4 * w + 3]} * rstd * gg + hb;
                    }
                }
            }
        }
    }
}

struct Params { const float* in[23]; float* out; unsigned char* ws; };

__global__ void __launch_bounds__(NTHR, 2) hybrid_fwd(Params p) {
    extern __shared__ __attribute__((aligned(16))) unsigned char lds_raw[];
    LAS unsigned char* lds = (LAS unsigned char*)lds_raw;
    cg::grid_group grid = cg::this_grid();
    Ctx c;
#pragma unroll
    for (int i = 0; i < 23; ++i) c.in[i] = p.in[i];
    c.out = p.out; c.ws = p.ws;
    unsigned char* ws = p.ws;

#ifndef G6_ALIGN
#define G6_ALIGN true
#endif
#ifndef G4_ALIGN
#define G4_ALIGN true
#endif
#ifndef G1_ALIGN
#define G1_ALIGN true
#endif
#ifndef G1_SP2
#define G1_SP2 true
#endif
#ifndef PH_MASK
#define PH_MASK 0x1ff
#endif
#ifndef REP0
#define REP0 1
#endif
#ifndef REP123
#define REP123 1
#endif
#ifndef REP1
#define REP1 1
#endif
#ifndef REP4
#define REP4 1
#endif
#ifndef REP5
#define REP5 1
#endif
#ifndef REP6
#define REP6 1
#endif
#ifndef REP7
#define REP7 1
#endif
#ifndef REP8
#define REP8 1
#endif
    if (threadIdx.x < 4) ((volatile LAS unsigned*)(lds + LDS_BARST))[threadIdx.x] = 0u;
    __syncthreads();
    const XcdBarrier xbar = xcd_barrier_post((unsigned*)(ws + WS_BAR), (volatile LAS unsigned*)(lds + LDS_BARST));
    if (p.ws == nullptr) grid.sync();
#define GSYNC() xcd_barrier(xbar)
    for (int rep = 0; rep < REP0; ++rep) { if (PH_MASK & 1) phase0(c, lds);
    GSYNC(); }
    if (PH_MASK & 1) phase0b(c);
    GSYNC();
    for (int rep123 = 0; rep123 < REP123; ++rep123) {
    for (int rep1 = 0; rep1 < REP1; ++rep1) {
    if (PH_MASK & 2) {
        pg8::Gemm g{(const bf16*)(ws + WS_XQ8), (const bf16*)(ws + WS_WQ8), T, DIN, 512, 512, 512, 0};
        pg8::StaticOrder S; S.init(T, DIN, (int)gridDim.x, (int)blockIdx.x);
        pg8::EpiProj E{(bf16*)(ws + WS_P4), (const float*)(ws + WS_BGS), (const float*)(ws + WS_SXR), (const float*)(ws + WS_SWC)};
        pg8::gemm_phase<pg8::EpiProj, pg8::StaticOrder, G1_ALIGN, G1_SP2>(lds, g, S, E);
    }
    GSYNC(); }
#ifndef REP2A
#define REP2A 1
#endif
#ifndef REP2B
#define REP2B 1
#endif
#ifndef REP3A
#define REP3A 1
#endif
    for (int r2 = 0; r2 < REP2B; ++r2) {
    if (PH_MASK & 4) {
        pg8::Gemm g{(const bf16*)p.out, (const bf16*)(ws + WS_WAX), T, 2048, 128, 1024, 128, 256};
        pg8::StaticOrder S; S.init(T, 2048, (int)gridDim.x, (int)blockIdx.x);
        phase2a(c, S);
        asm volatile("s_waitcnt vmcnt(0)" ::: "memory");
        __syncthreads();
        pg8::EpiGate E{(const bf16*)p.out, (bf16*)(ws + WS_HL), (bf16*)((unsigned char*)p.out + OUT_PC), (float*)(ws + WS_PEND), (float*)(ws + WS_HEND), (const float*)(ws + WS_BAS), (const float*)(ws + WS_BXS), (const float*)(ws + WS_SPT)};
        pg8::gemm_phase<pg8::EpiGate, pg8::StaticOrder, true, true>(lds, g, S, E);
    }
    GSYNC(); }
#ifdef REP2C
    phase2c(c, lds, 0); GSYNC();
#endif
    if (PH_MASK & 4) phase2c(c, lds);
    GSYNC(); }
    for (int rep4 = 0; rep4 < REP4; ++rep4) {
    if (PH_MASK & 16) {
        pg8::Gemm g{(const bf16*)(ws + WS_P4) + 2048, (const bf16*)(ws + WS_WOUT), T, 1024, 1024, 4096, 1024, 0};
        pg8::StaticOrder S; S.init(T, 1024, (int)gridDim.x, (int)blockIdx.x);
        pg8::EpiResid E{(const bf16*)(ws + WS_XB), (bf16*)(ws + WS_Z), 1024, ALPHA, (float*)(ws + WS_PARTZ)};
        pg8::gemm_phase<pg8::EpiResid, pg8::StaticOrder, G4_ALIGN, true>(lds, g, S, E);
    }
    GSYNC(); }
    for (int rep6 = 0; rep6 < REP6; ++rep6) {
    if (PH_MASK & 64) {
#if Q_I8
        pg8::Gemm g{(const bf16*)(ws + WS_X1Q8), (const bf16*)(ws + WS_WQQ8), T, 2048, 512, 512, 512, 0};
        pg8::StaticOrder S; S.init(T, 2048, (int)gridDim.x, (int)blockIdx.x);
        pg8::EpiBf16I8 E{(bf16*)p.out, 2048, (const float*)(ws + WS_SX1), (const float*)(ws + WS_SWQ)};
        pg8::gemm_phase<pg8::EpiBf16I8, pg8::StaticOrder, G6_ALIGN, true>(lds, g, S, E);
#else
        pg8::StaticOrder S; S.init(T, 2048, (int)gridDim.x, (int)blockIdx.x);
        LAS float* tab = (LAS float*)(lds + 131072);
        {
            const int ui = threadIdx.x >> 7; pg8::Unit uu;
            if (S.next(ui, uu)) {
#pragma unroll
                for (int rr = 0; rr < 2; ++rr) {
                    const int rl = (threadIdx.x & 127) * 2 + rr, row = uu.pm * 256 + rl;
                    const f32x4* pp = (const f32x4*)((const float*)(ws + WS_PARTZ) + (size_t)row * 32);
                    float s1 = 0.f, s2 = 0.f;
#pragma unroll
                    for (int k = 0; k < 8; ++k) { const f32x4 v = pp[k]; s1 += v.x + v.z; s2 += v.y + v.w; }
                    const float mean = s1 * (1.0f / 1024.0f), rstd = rsqrtf(fmaxf(s2 * (1.0f / 1024.0f) - mean * mean, 0.f) + LN_EPS);
                    tab[(ui * 256 + rl) * 2] = mean; tab[(ui * 256 + rl) * 2 + 1] = rstd;
                    if (uu.pn == 0) *(f32x2*)((float*)(ws + WS_ST1) + (size_t)row * 2) = (f32x2){mean, rstd};
                }
            }
        }
        __syncthreads();
        pg8::Gemm g{(const bf16*)(ws + WS_Z), (const bf16*)(ws + WS_WQ), T, 2048, 1024, 1024, 1024, 0};
        pg8::EpiQ E{(bf16*)p.out, 2048, (const float*)(ws + WS_CQ), (const float*)(ws + WS_DQ), (const LAS float*)tab, S};
        pg8::gemm_phase<pg8::EpiQ, pg8::StaticOrder, G6_ALIGN, true>(lds, g, S, E);
#endif
    }
    GSYNC(); }
    for (int rep = 0; rep < REP7; ++rep) { if (PH_MASK & 128) phase7(c, lds);
    GSYNC(); }
#ifdef REP8B
    phase8(c, lds, xbar); GSYNC();
#endif
    if (PH_MASK & 256) phase8(c, lds, xbar);
}

extern "C" void kernel_launch(void* const* d_in, const int* in_sizes, int n_in, void* d_out, int out_size,
                              void* d_ws, size_t ws_size, hipStream_t stream) {
    static int grid_blocks = 0;
    if (grid_blocks == 0) {
        if (n_in != 23 || out_size != T * D || ws_size < WS_END) {
            fprintf(stderr, "kernel_launch: unexpected problem (n_in %d, out %d, ws %zu); nothing launched\n", n_in, out_size, ws_size);
            grid_blocks = -1; return;
        }
        int dev = 0, cus = 0, per_cu = 0;
        (void)hipGetDevice(&dev);
        (void)hipDeviceGetAttribute(&cus, hipDeviceAttributeMultiprocessorCount, dev);
        (void)hipFuncSetAttribute((const void*)hybrid_fwd, hipFuncAttributeMaxDynamicSharedMemorySize, LDS_BYTES);
        (void)hipOccupancyMaxActiveBlocksPerMultiprocessor(&per_cu, (const void*)hybrid_fwd, NTHR, LDS_BYTES);
        if (per_cu < 1) { fprintf(stderr, "kernel_launch: occupancy query reports %d blocks per CU\n", per_cu); grid_blocks = -1; return; }
        grid_blocks = cus;
        (void)hipGetLastError();
    }
    if (grid_blocks < 0) return;
    Params p{};
    for (int i = 0; i < 23; ++i) p.in[i] = (const float*)d_in[i];
    p.out = (float*)d_out; p.ws = (unsigned char*)d_ws;
    if (hipMemsetAsync((unsigned char*)d_ws + WS_BAR, 0, XCD_BAR_WORDS * sizeof(unsigned), stream) != hipSuccess) { fprintf(stderr, "kernel_launch: hipMemsetAsync of the barrier words failed; nothing launched\n"); return; }
    void* args[] = {&p};
    hipError_t e = hipLaunchCooperativeKernel((const void*)hybrid_fwd, dim3(grid_blocks), dim3(NTHR), args, LDS_BYTES, stream);
    if (e != hipSuccess) fprintf(stderr, "cooperative launch failed: %s (grid %d)\n", hipGetErrorString(e), grid_blocks);
}
```

```cpp
#include <hip/hip_runtime.h>
#include <hip/hip_cooperative_groups.h>
#include <cstdio>
#include <cstdint>
namespace cg = cooperative_groups;

#define LAS __attribute__((address_space(3)))
typedef unsigned short bf16;
typedef short bf16x8 __attribute__((ext_vector_type(8)));
typedef float f32x4 __attribute__((ext_vector_type(4)));
typedef float f32x16 __attribute__((ext_vector_type(16)));
typedef float f32x2 __attribute__((ext_vector_type(2)));
typedef unsigned u32x4 __attribute__((ext_vector_type(4)));
typedef unsigned u32x2 __attribute__((ext_vector_type(2)));
typedef int i32x4 __attribute__((ext_vector_type(4)));
typedef __bf16 bf16v2 __attribute__((ext_vector_type(2)));

#ifndef P8_X4_
#define P8_X4_ 1
#endif
#ifndef Q_I8
#define Q_I8 0
#endif
constexpr int T = 32768, D = 1024, SEQ = 4096, DIN = 6144, CHUNK = 128, NTILE = T / CHUNK, NCHUNK = SEQ / CHUNK, NH = 8, HD = 128;
constexpr int NEXP = 16384;
constexpr float ALPHA = 1.18920711500272f, LN_EPS = 1e-5f;
constexpr int NTHR = 512;
constexpr int LDS_BYTES = 147456;
constexpr int LDS_BARST = 147440;

constexpr size_t MiB = 1u << 20;
constexpr size_t WS_SPT = 0;
constexpr size_t WS_BAS = 4096;
constexpr size_t WS_BXS = 8192;
constexpr size_t WS_BGS = 12288;
constexpr size_t WS_STATS = 256 * 1024;
constexpr size_t WS_BAR = 64 * 1024;
constexpr size_t WS_WIN = 1 * MiB;
constexpr size_t WS_WOUT = 13 * MiB;
constexpr size_t WS_WQ = 15 * MiB;
constexpr size_t WS_KEYS = 19 * MiB;
constexpr size_t WS_WAX = 20 * MiB;
constexpr size_t WS_WTRIL = 20 * MiB + 512 * 1024;
constexpr size_t WS_UQ = 22 * MiB;
constexpr size_t WS_VQ = 38 * MiB;
constexpr size_t WS_USC = 54 * MiB;
constexpr size_t WS_VSC = 55 * MiB;
constexpr size_t WS_WQ8 = 56 * MiB;
constexpr size_t WS_SXR = 62 * MiB;
constexpr size_t WS_SWC = 63 * MiB;
constexpr size_t WS_WQQ8 = 64 * MiB;
constexpr size_t WS_SWQ = 66 * MiB;
constexpr size_t WS_SX1 = 67 * MiB;
constexpr size_t WS_X1Q8 = 182 * MiB;
constexpr size_t WS_XQ8 = 472 * MiB;
constexpr size_t WS_XB = 86 * MiB;
constexpr size_t OUT_PC = 64 * MiB;
constexpr size_t WS_P4 = 150 * MiB;
constexpr size_t WS_HL = 406 * MiB;
constexpr size_t WS_PEND = 470 * MiB;
constexpr size_t WS_HEND = 471 * MiB;
constexpr size_t WS_Z = 406 * MiB;
constexpr size_t WS_PARTZ = 68 * MiB;
constexpr size_t WS_ST1 = 72 * MiB;
constexpr size_t WS_CQ = 73 * MiB;
constexpr size_t WS_DQ = 73 * MiB + 8192;
constexpr size_t WS_PARTCD = 74 * MiB;
constexpr size_t WS_IDX = 470 * MiB;
constexpr size_t WS_GATE = 486 * MiB;
constexpr size_t WS_END = 504 * MiB;

__device__ __forceinline__ unsigned pk2(float lo, float hi) { f32x2 v = {lo, hi}; return __builtin_bit_cast(unsigned, __builtin_convertvector(v, bf16v2)); }
__device__ __forceinline__ float bf_lo(unsigned w) { return __uint_as_float(w << 16); }
__device__ __forceinline__ float bf_hi(unsigned w) { return __uint_as_float(w & 0xffff0000u); }
constexpr float NLOG2E = -1.4426950408889634f;
__device__ __forceinline__ float sig_pre(float xs) { return __builtin_amdgcn_rcpf(1.0f + __builtin_amdgcn_exp2f(xs)); }
__device__ __forceinline__ float gelu_tanh(float x) { const float u = x * (1.0f + 0.044715f * x * x); return x * __builtin_amdgcn_rcpf(1.0f + __builtin_amdgcn_exp2f(-2.3022081989f * u)); }
__device__ __forceinline__ float wave_sum(float v) {
#pragma unroll
    for (int o = 32; o >= 1; o >>= 1) v += __shfl_xor(v, o);
    return v;
}
#define XB_TMO      128
#define XB_XCNT(j)  (256  + 64 * (j))
#define XB_XSUB(j)  (1280 + 64 * (j))
#define XB_XGEN(j)  (2304 + 64 * (j))
#define XB_TOP      3328
#define XB_TOPGEN   3392
#define XCD_BAR_WORDS 3456
#define XB_SPIN_CAP (1u << 22)

__device__ __forceinline__ unsigned xb_ld(unsigned* p)              { return __hip_atomic_load(p, __ATOMIC_RELAXED, __HIP_MEMORY_SCOPE_AGENT); }
__device__ __forceinline__ unsigned xb_add(unsigned* p, unsigned v) { return __hip_atomic_fetch_add(p, v, __ATOMIC_RELAXED, __HIP_MEMORY_SCOPE_AGENT); }
__device__ __forceinline__ unsigned xb_xcc_id() { return (unsigned)__builtin_amdgcn_s_getreg((3 << 11) | 20) & 0xFu; }
#define XB_SPIN(cond, bar) do { unsigned _sp = 0; while (cond) { __builtin_amdgcn_s_sleep(1); \
    if ((++_sp & 255u) == 0u) { if (xb_ld(&(bar)[XB_TMO])) break; if (_sp > XB_SPIN_CAP) { atomicAdd(&(bar)[XB_TMO], 1u); break; } } } } while (0)

struct XcdBarrier {
    unsigned* bar; unsigned x;
    volatile LAS unsigned* st;
};

__device__ __forceinline__ XcdBarrier xcd_barrier_post(unsigned* bar, volatile LAS unsigned* st) {
    XcdBarrier b; b.bar = bar; b.x = xb_xcc_id(); b.st = st;
    if (threadIdx.x == 0) (void)xb_add(&bar[XB_XCNT(b.x)], 1u);
    return b;
}
__device__ __forceinline__ void xcd_barrier_complete(unsigned* bar, unsigned x, unsigned& nloc, unsigned& nx) {
    const unsigned G = gridDim.x * gridDim.y * gridDim.z;
    unsigned sum, cnt, mine, sp = 0u;
    for (;;) {
        sum = 0u; cnt = 0u; mine = 0u;
#pragma unroll
        for (unsigned j = 0; j < 16; ++j) { const unsigned c = xb_ld(&bar[XB_XCNT(j)]); sum += c; cnt += (c > 0u) ? 1u : 0u; mine = (j == x) ? c : mine; }
        if (sum == G) break;
        __builtin_amdgcn_s_sleep(1);
        if ((++sp & 255u) == 0u) { if (xb_ld(&bar[XB_TMO])) break; if (sp > XB_SPIN_CAP) { atomicAdd(&bar[XB_TMO], 1u); break; } }
    }
    nloc = mine > 0u ? mine : 1u; nx = cnt > 0u ? cnt : 1u;
}

__device__ __forceinline__ void xcd_barrier(const XcdBarrier& b) {
    asm volatile("s_waitcnt vmcnt(0)" ::: "memory");
    __syncthreads();
    if (threadIdx.x == 0) {
        unsigned* bar = b.bar;
        __builtin_amdgcn_s_waitcnt(0);
        unsigned nloc = b.st[0], nx = b.st[1];
        if (nloc == 0u) { xcd_barrier_complete(bar, b.x, nloc, nx); b.st[0] = nloc; b.st[1] = nx; }
        const unsigned old = xb_add(&bar[XB_XSUB(b.x)], 1u);
        const unsigned gen = old / nloc;
        if (old + 1u == (gen + 1u) * nloc) {
            __builtin_amdgcn_fence(__ATOMIC_RELEASE, "agent");
            asm volatile("s_waitcnt vmcnt(0)" ::: "memory");
            const unsigned og = xb_add(&bar[XB_TOP], 1u);
            const unsigned tg = og / nx;
            if (og + 1u == (tg + 1u) * nx) xb_add(&bar[XB_TOPGEN], 1u);
            else XB_SPIN(xb_ld(&bar[XB_TOPGEN]) == tg, bar);
            __builtin_amdgcn_fence(__ATOMIC_ACQUIRE, "agent");
            xb_add(&bar[XB_XGEN(b.x)], 1u);
            asm volatile("s_waitcnt vmcnt(0)" ::: "memory");
        } else {
            XB_SPIN(xb_ld(&bar[XB_XGEN(b.x)]) == gen, bar);
            __builtin_amdgcn_fence(__ATOMIC_ACQUIRE, "agent");
            asm volatile("s_waitcnt vmcnt(0)" ::: "memory");
        }
    }
    __syncthreads();
}
namespace pg8 {
#define PG8_LAS __attribute__((address_space(3)))
typedef unsigned short bf16_t;
typedef short bf16x8 __attribute__((ext_vector_type(8)));
typedef float f32x4 __attribute__((ext_vector_type(4)));
typedef unsigned u32x4 __attribute__((ext_vector_type(4)));
typedef int i32x4_ __attribute__((ext_vector_type(4)));
constexpr int BM = 256, BK = 64, HALF = 128, HTB = HALF * BK * 2  , STAGE_BYTES = 8 * HTB, NXCD = 8, WGM = 8;

__host__ __device__ __forceinline__ int lds_byte(int r, int c) { const int st = (r >> 4) * 2 + (c >> 5), rr = r & 15, cc = c & 31, ob = rr * 64 + cc * 2; return st * 1024 + (ob ^ (((ob >> 9) & 1) << 5)); }
__host__ __device__ __forceinline__ void stage_rc(int b, int& R, int& C) { const int st = b / 1024, sb = b % 1024, swz = sb ^ (((sb >> 9) & 1) << 5); R = (st >> 1) * 16 + swz / 64; C = (st & 1) * 32 + (swz % 64) / 2; }
__host__ __device__ __forceinline__ int perm32(int rho) { const int n = rho >> 4, i = rho & 15; return 8 * (i >> 2) + 4 * n + (i & 3); }

struct Unit { int pm, pn; };
struct Gemm { const bf16_t* A; const bf16_t* Bt; int M, N, K, lda, ldb, a_pn_bytes; };

struct StaticOrder {
    int nM, nN, nwg, G, c;
    __host__ __device__ __forceinline__ void init(int M, int N, int G_, int c_) { nM = M / BM; nN = N / BM; nwg = nM * nN; G = G_; c = c_; }
    __host__ __device__ __forceinline__ bool next(int i, Unit& u) const {
        const long L = (long)i * G + c; if (L >= nwg) return false;
        int wgid = (int)L; { const int q = nwg / NXCD, r = nwg % NXCD, xcd = wgid % NXCD, off = wgid / NXCD; wgid = (xcd < r ? xcd * (q + 1) : r * (q + 1) + (xcd - r) * q) + off; }
        const int nig = WGM * nN, gid = wgid / nig, fm = gid * WGM, gsz = (nM - fm) < WGM ? (nM - fm) : WGM;
        u.pm = fm + ((wgid % nig) % gsz); u.pn = (wgid % nig) / gsz; return true;
    }
    __device__ __forceinline__ void a_ready(const Unit&) const {}
    __device__ __forceinline__ void done(const Unit&) const {}
};


struct EpiProj {
    static constexpr bool PERM = true, AFTER_DRAIN = false, AROWS = false, I8 = true;
    bf16_t* P4; const float* bgate;
    const float* sxr; const float* swc;
    __device__ __forceinline__ void operator()(const f32x4 (&acc)[2][2][4][2], const Unit& u, int, int, int, int) const {
        int t_ = threadIdx.x; asm volatile("" : "+v"(t_)); const int fr = t_ & 15, fq = (t_ >> 4) & 3, wc = (t_ >> 6) & 3, wr = t_ >> 8;
        const int k = u.pn / 3, ty = u.pn - 3 * k;
        const int row0 = u.pm * BM + wr * 64 + fr, cl = k * 128 + wc * 32 + 8 * fq;
        const float* swp = swc + u.pn * BM + wc * 32 + 8 * fq;
        const f32x4 w00 = *(const f32x4*)swp, w01 = *(const f32x4*)(swp + 4), w10 = *(const f32x4*)(swp + HALF), w11 = *(const f32x4*)(swp + HALF + 4);
#define EPI_I2F(v, w, s) ((f32x4){(float)__builtin_bit_cast(i32x4_, v)[0], (float)__builtin_bit_cast(i32x4_, v)[1], (float)__builtin_bit_cast(i32x4_, v)[2], (float)__builtin_bit_cast(i32x4_, v)[3]} * (w) * (s))
        if (ty == 0) {
#pragma unroll
            for (int ai = 0; ai < 2; ++ai)
#pragma unroll
                for (int m = 0; m < 4; ++m) {
                    const int row = row0 + ai * HALF + m * 16; const float sx = sxr[row];
                    bf16_t* rowp = P4 + (size_t)row * 4096 + cl;
                    const f32x4 a0 = EPI_I2F(acc[ai][0][m][0], w00, sx), a1 = EPI_I2F(acc[ai][0][m][1], w01, sx); f32x4 v0 = EPI_I2F(acc[ai][1][m][0], w10, sx), v1 = EPI_I2F(acc[ai][1][m][1], w11, sx);
#pragma unroll
                    for (int j = 0; j < 4; ++j) { v0[j] = gelu_tanh(v0[j]); v1[j] = gelu_tanh(v1[j]); }
                    u32x4 w; w.x = pk2(a0[0], a0[1]); w.y = pk2(a0[2], a0[3]); w.z = pk2(a1[0], a1[1]); w.w = pk2(a1[2], a1[3]);
                    *(u32x4*)rowp = w;
                    w.x = pk2(v0[0], v0[1]); w.y = pk2(v0[2], v0[3]); w.z = pk2(v1[0], v1[1]); w.w = pk2(v1[2], v1[3]);
                    *(u32x4*)(rowp + 3072) = w;
                }
        } else {
            const float* bp = bgate + (ty - 1) * 1024 + cl;
            const f32x4 b0 = *(const f32x4*)bp, b1 = *(const f32x4*)(bp + 4);
#pragma unroll
            for (int ai = 0; ai < 2; ++ai)
#pragma unroll
                for (int m = 0; m < 4; ++m) {
                    const int row = row0 + ai * HALF + m * 16; const float sx = sxr[row];
                    bf16_t* rowp = P4 + (size_t)row * 4096 + ty * 1024 + cl;
                    f32x4 a0 = EPI_I2F(acc[ai][0][m][0], w00, sx), a1 = EPI_I2F(acc[ai][0][m][1], w01, sx); const f32x4 g0 = EPI_I2F(acc[ai][1][m][0], w10, sx) + b0, g1 = EPI_I2F(acc[ai][1][m][1], w11, sx) + b1;
#pragma unroll
                    for (int j = 0; j < 4; ++j) { a0[j] = gelu_tanh(a0[j]) * sig_pre(g0[j]); a1[j] = gelu_tanh(a1[j]) * sig_pre(g1[j]); }
                    u32x4 w; w.x = pk2(a0[0], a0[1]); w.y = pk2(a0[2], a0[3]); w.z = pk2(a1[0], a1[1]); w.w = pk2(a1[2], a1[3]);
                    *(u32x4*)rowp = w;
                }
        }
#undef EPI_I2F
    }
};
template <int S> __device__ __forceinline__ float row_shr_f(float ident, float v) {
    return __int_as_float(__builtin_amdgcn_update_dpp(__float_as_int(ident), __float_as_int(v), 0x110 + S, 0xf, 0xf, false));
}
struct EpiGate {
    static constexpr bool PERM = true, AFTER_DRAIN = false, AROWS = true, I8 = false;
    const bf16_t* XC; bf16_t* HL; bf16_t* PC; float* PEND; float* HEND; const float* b_a; const float* b_x; const float* spt;
    __device__ __forceinline__ void operator()(const f32x4 (&acc)[2][2][4][2], const Unit& u, int, int, int, int) const {
        int t_ = threadIdx.x; asm volatile("" : "+v"(t_)); const int fr = t_ & 15, fq = (t_ >> 4) & 3, wc = (t_ >> 6) & 3, wr = t_ >> 8, lane15 = (t_ & 63) | 15;
        const int row0 = u.pm * BM + wr * 128 + fr, ch = u.pn * 128 + wc * 32 + 8 * fq, chunk = u.pm * 2 + wr;
        float Ac[8], Hc[8];
#pragma unroll
        for (int j = 0; j < 8; ++j) { Ac[j] = 1.0f; Hc[j] = 0.0f; }
#pragma unroll
        for (int ai = 0; ai < 2; ++ai)
#pragma unroll
            for (int m = 0; m < 4; ++m) {
                asm volatile("" ::: "memory");
                int zo = 0; asm volatile("" : "+v"(zo));
                const size_t off = (size_t)(row0 + ai * 64 + m * 16) * 1024 + ch;
                const u32x4 xw = *(const u32x4*)(XC + off);
                float ba[8], bx[8], sp[8];
                { const int cz = ch + zo;
                  const f32x4 t0 = *(const f32x4*)(b_a + cz), t1 = *(const f32x4*)(b_a + cz + 4), t2 = *(const f32x4*)(b_x + cz), t3 = *(const f32x4*)(b_x + cz + 4), t4 = *(const f32x4*)(spt + cz), t5 = *(const f32x4*)(spt + cz + 4);
#pragma unroll
                  for (int j = 0; j < 4; ++j) { ba[j] = t0[j]; ba[4 + j] = t1[j]; bx[j] = t2[j]; bx[4 + j] = t3[j]; sp[j] = t4[j]; sp[4 + j] = t5[j]; } }
                float a[8], b[8];
#pragma unroll
                for (int j = 0; j < 8; ++j) {
                    const float rp = acc[ai][0][m][j >> 2][j & 3], ip = acc[ai][1][m][j >> 2][j & 3];
                    const float xv = (j & 1) ? bf_hi(xw[j >> 1]) : bf_lo(xw[j >> 1]);
                    a[j] = __builtin_amdgcn_exp2f(sig_pre(rp + ba[j]) * sp[j]);
                    b[j] = __builtin_amdgcn_sqrtf(__builtin_fmaxf(1.0f - a[j] * a[j], 0.f)) * sig_pre(ip + bx[j]) * xv;
                }
#pragma unroll
                for (int j = 0; j < 8; ++j) { const float ap = row_shr_f<1>(1.0f, a[j]), bp = row_shr_f<1>(0.0f, b[j]); b[j] = a[j] * bp + b[j]; a[j] = a[j] * ap; }
#pragma unroll
                for (int j = 0; j < 8; ++j) { const float ap = row_shr_f<2>(1.0f, a[j]), bp = row_shr_f<2>(0.0f, b[j]); b[j] = a[j] * bp + b[j]; a[j] = a[j] * ap; }
#pragma unroll
                for (int j = 0; j < 8; ++j) { const float ap = row_shr_f<4>(1.0f, a[j]), bp = row_shr_f<4>(0.0f, b[j]); b[j] = a[j] * bp + b[j]; a[j] = a[j] * ap; }
#pragma unroll
                for (int j = 0; j < 8; ++j) { const float ap = row_shr_f<8>(1.0f, a[j]), bp = row_shr_f<8>(0.0f, b[j]); b[j] = a[j] * bp + b[j]; a[j] = a[j] * ap; }
                float hl[8], pc[8];
#pragma unroll
                for (int j = 0; j < 8; ++j) {
                    const float at = __shfl(a[j], lane15), bt = __shfl(b[j], lane15);
                    hl[j] = b[j] + a[j] * Hc[j]; pc[j] = a[j] * Ac[j];
                    Hc[j] = bt + at * Hc[j]; Ac[j] = at * Ac[j];
                }
                u32x4 w; w.x = pk2(hl[0], hl[1]); w.y = pk2(hl[2], hl[3]); w.z = pk2(hl[4], hl[5]); w.w = pk2(hl[6], hl[7]);
                *(u32x4*)(HL + off) = w;
                w.x = pk2(pc[0], pc[1]); w.y = pk2(pc[2], pc[3]); w.z = pk2(pc[4], pc[5]); w.w = pk2(pc[6], pc[7]);
                *(u32x4*)(PC + off) = w;
            }
        if (fr == 0) {
            float* pp = PEND + (size_t)chunk * 1024 + ch; float* hp = HEND + (size_t)chunk * 1024 + ch;
            *(f32x4*)pp = (f32x4){Ac[0], Ac[1], Ac[2], Ac[3]}; *(f32x4*)(pp + 4) = (f32x4){Ac[4], Ac[5], Ac[6], Ac[7]};
            *(f32x4*)hp = (f32x4){Hc[0], Hc[1], Hc[2], Hc[3]}; *(f32x4*)(hp + 4) = (f32x4){Hc[4], Hc[5], Hc[6], Hc[7]};
        }
    }
};
struct EpiBf16 {
    static constexpr bool PERM = true, AFTER_DRAIN = false, AROWS = false, I8 = false;
    bf16_t* O; int ldc;
    __device__ __forceinline__ void operator()(const f32x4 (&acc)[2][2][4][2], const Unit& u, int, int, int, int) const {
        int t_ = threadIdx.x; asm volatile("" : "+v"(t_)); const int fr = t_ & 15, fq = (t_ >> 4) & 3, wc = (t_ >> 6) & 3, wr = t_ >> 8;
        const int row0 = u.pm * BM + wr * 64 + fr, col0 = u.pn * BM + wc * 32 + 8 * fq;
#pragma unroll
        for (int ai = 0; ai < 2; ++ai)
#pragma unroll
            for (int m = 0; m < 4; ++m) {
                bf16_t* rowp = O + (size_t)(row0 + ai * HALF + m * 16) * ldc + col0;
#pragma unroll
                for (int bj = 0; bj < 2; ++bj) {
                    const f32x4 v0 = acc[ai][bj][m][0], v1 = acc[ai][bj][m][1];
                    u32x4 w; w.x = pk2(v0[0], v0[1]); w.y = pk2(v0[2], v0[3]); w.z = pk2(v1[0], v1[1]); w.w = pk2(v1[2], v1[3]);
                    *(u32x4*)(rowp + bj * HALF) = w;
                }
            }
    }
};
struct EpiResid {
    static constexpr bool PERM = true, AFTER_DRAIN = false, AROWS = false, I8 = false;
    const bf16_t* X; bf16_t* Z; int ldc; float alpha; float* PART;
    __device__ __forceinline__ void operator()(const f32x4 (&acc)[2][2][4][2], const Unit& u, int, int, int, int) const {
        int t_ = threadIdx.x; asm volatile("" : "+v"(t_)); const int fr = t_ & 15, fq = (t_ >> 4) & 3, wc = (t_ >> 6) & 3, wr = t_ >> 8;
        const int row0 = u.pm * BM + wr * 64 + fr, col0 = u.pn * BM + wc * 32 + 8 * fq;
#pragma unroll
        for (int ai = 0; ai < 2; ++ai)
#pragma unroll
            for (int m = 0; m < 4; ++m) {
                const int row = row0 + ai * HALF + m * 16;
                const size_t off = (size_t)row * ldc + col0;
                float s1 = 0.f, s2 = 0.f;
#pragma unroll
                for (int bj = 0; bj < 2; ++bj) {
                    const u32x4 xw = *(const u32x4*)(X + off + bj * HALF);
                    const f32x4 x0 = (f32x4){bf_lo(xw.x), bf_hi(xw.x), bf_lo(xw.y), bf_hi(xw.y)}, x1 = (f32x4){bf_lo(xw.z), bf_hi(xw.z), bf_lo(xw.w), bf_hi(xw.w)};
                    const f32x4 z0 = x0 * alpha + acc[ai][bj][m][0], z1 = x1 * alpha + acc[ai][bj][m][1];
                    u32x4 w; w.x = pk2(z0[0], z0[1]); w.y = pk2(z0[2], z0[3]); w.z = pk2(z1[0], z1[1]); w.w = pk2(z1[2], z1[3]);
                    *(u32x4*)(Z + off + bj * HALF) = w;
#pragma unroll
                    for (int j = 0; j < 4; ++j) { s1 += z0[j] + z1[j]; s2 += z0[j] * z0[j] + z1[j] * z1[j]; }
                }
                s1 += __shfl_xor(s1, 16); s2 += __shfl_xor(s2, 16); s1 += __shfl_xor(s1, 32); s2 += __shfl_xor(s2, 32);
                if (fq == 0) *(f32x2*)(PART + ((size_t)row * 16 + u.pn * 4 + wc) * 2) = (f32x2){s1, s2};
            }
    }
};
struct EpiQ {
    static constexpr bool PERM = true, AFTER_DRAIN = false, AROWS = false, I8 = false;
    bf16_t* O; int ldc; const float* cq; const float* dq; const PG8_LAS float* tab; StaticOrder S;
    __device__ __forceinline__ void operator()(const f32x4 (&acc)[2][2][4][2], const Unit& u, int, int, int, int) const {
        int t_ = threadIdx.x; asm volatile("" : "+v"(t_)); const int fr = t_ & 15, fq = (t_ >> 4) & 3, wc = (t_ >> 6) & 3, wr = t_ >> 8;
        int ord = 0;
#pragma unroll
        for (int i = 1; i < 4; ++i) { Unit v; if (S.next(i, v) && v.pm == u.pm && v.pn == u.pn) ord = i; }
        const int rl0 = wr * 64 + fr, col0 = u.pn * BM + wc * 32 + 8 * fq;
        f32x4 cv[2][2], dv[2][2];
#pragma unroll
        for (int bj = 0; bj < 2; ++bj)
#pragma unroll
            for (int n = 0; n < 2; ++n) { cv[bj][n] = *(const f32x4*)(cq + col0 + bj * HALF + 4 * n); dv[bj][n] = *(const f32x4*)(dq + col0 + bj * HALF + 4 * n); }
#pragma unroll
        for (int ai = 0; ai < 2; ++ai)
#pragma unroll
            for (int m = 0; m < 4; ++m) {
                const int rl = rl0 + ai * HALF + m * 16;
                const float mean = tab[(ord * 256 + rl) * 2], rstd = tab[(ord * 256 + rl) * 2 + 1];
                bf16_t* rowp = O + (size_t)(u.pm * BM + rl) * ldc + col0;
#pragma unroll
                for (int bj = 0; bj < 2; ++bj) {
                    const f32x4 v0 = (acc[ai][bj][m][0] - cv[bj][0] * mean) * rstd + dv[bj][0], v1 = (acc[ai][bj][m][1] - cv[bj][1] * mean) * rstd + dv[bj][1];
                    u32x4 w; w.x = pk2(v0[0], v0[1]); w.y = pk2(v0[2], v0[3]); w.z = pk2(v1[0], v1[1]); w.w = pk2(v1[2], v1[3]);
                    *(u32x4*)(rowp + bj * HALF) = w;
                }
            }
    }
};
struct EpiBf16I8 {
    static constexpr bool PERM = true, AFTER_DRAIN = false, AROWS = false, I8 = true;
    bf16_t* O; int ldc; const float* sxr; const float* swc;
    __device__ __forceinline__ void operator()(const f32x4 (&acc)[2][2][4][2], const Unit& u, int, int, int, int) const {
        int t_ = threadIdx.x; asm volatile("" : "+v"(t_)); const int fr = t_ & 15, fq = (t_ >> 4) & 3, wc = (t_ >> 6) & 3, wr = t_ >> 8;
        const int row0 = u.pm * BM + wr * 64 + fr, col0 = u.pn * BM + wc * 32 + 8 * fq;
        const f32x4 w00 = *(const f32x4*)(swc + col0), w01 = *(const f32x4*)(swc + col0 + 4), w10 = *(const f32x4*)(swc + col0 + HALF), w11 = *(const f32x4*)(swc + col0 + HALF + 4);
#define EPI_I2F(v, w, s) ((f32x4){(float)__builtin_bit_cast(i32x4_, v)[0], (float)__builtin_bit_cast(i32x4_, v)[1], (float)__builtin_bit_cast(i32x4_, v)[2], (float)__builtin_bit_cast(i32x4_, v)[3]} * (w) * (s))
#pragma unroll
        for (int ai = 0; ai < 2; ++ai)
#pragma unroll
            for (int m = 0; m < 4; ++m) {
                const int row = row0 + ai * HALF + m * 16; const float sx = sxr[row];
                bf16_t* rowp = O + (size_t)row * ldc + col0;
                { const f32x4 v0 = EPI_I2F(acc[ai][0][m][0], w00, sx), v1 = EPI_I2F(acc[ai][0][m][1], w01, sx);
                  u32x4 w; w.x = pk2(v0[0], v0[1]); w.y = pk2(v0[2], v0[3]); w.z = pk2(v1[0], v1[1]); w.w = pk2(v1[2], v1[3]); *(u32x4*)rowp = w; }
                { const f32x4 v0 = EPI_I2F(acc[ai][1][m][0], w10, sx), v1 = EPI_I2F(acc[ai][1][m][1], w11, sx);
                  u32x4 w; w.x = pk2(v0[0], v0[1]); w.y = pk2(v0[2], v0[3]); w.z = pk2(v1[0], v1[1]); w.w = pk2(v1[2], v1[3]); *(u32x4*)(rowp + HALF) = w; }
            }
#undef EPI_I2F
    }
};
template <class Epi, class Sched, bool ALIGN_EPI = false, bool SP2 = false>
__device__ __forceinline__ void gemm_phase(PG8_LAS unsigned char* lds, const Gemm g, const Sched& S, const Epi& E) {
    int tid_ = threadIdx.x; asm volatile("" : "+v"(tid_)); const int tid = tid_, wid = __builtin_amdgcn_readfirstlane(tid >> 6), lane = tid & 63, wr = wid >> 2, wc = wid & 3, fr = lane & 15, fq = lane >> 4;
    const int K = g.K, nt = K / BK;
    unsigned voffA[2], voffB[2];
#pragma unroll
    for (int i = 0; i < 2; ++i) { int R, C; stage_rc(tid * 16 + i * 8192, R, C); const int Rb = Epi::PERM ? ((R & ~31) + perm32(R & 31)) : R;
        const int Ra = Epi::AROWS ? ((R >> 6) * 128 + (R & 63)) : R;
        voffA[i] = (unsigned)(Ra * g.lda + C) * 2u; voffB[i] = (unsigned)(Rb * g.ldb + C) * 2u; }
    const size_t kstep = (size_t)(BK * 2);
    const size_t hstepA = (size_t)(Epi::AROWS ? 64 : HALF) * g.lda * 2, hstepB = (size_t)HALF * g.ldb * 2;
    const size_t tstepA = (size_t)2 * HALF * g.lda * 2, tstepB = 2 * hstepB;
    const unsigned ldsw = (unsigned)wid * 1024u;
    const int aoff = lds_byte(wr * 64 + fr, fq * 8), boff = lds_byte(wc * 32 + fr, fq * 8);
#define PG8_SA(b, h) (((b) * 2 + (h)) * HTB)
#define PG8_SB(b, h) ((4 + (b) * 2 + (h)) * HTB)
#define PG8_STAGE(bufoff, gbase, voff) do { _Pragma("unroll") for (int _i = 0; _i < 2; ++_i) \
        __builtin_amdgcn_global_load_lds((const unsigned*)((const char*)(gbase) + (voff)[_i]), (PG8_LAS unsigned*)(lds + (bufoff) + ldsw + _i * 8192), 16, 0, 0); } while (0)
#define PG8_LDA(dst, b, h) do { _Pragma("unroll") for (int m = 0; m < 4; ++m) _Pragma("unroll") for (int k = 0; k < 2; ++k) dst[m][k] = *(const PG8_LAS bf16x8*)(lds + PG8_SA(b, h) + aoff + m * 2048 + k * 1024); } while (0)
#define PG8_LDB(dst, b, h) do { _Pragma("unroll") for (int n = 0; n < 2; ++n) _Pragma("unroll") for (int k = 0; k < 2; ++k) dst[n][k] = *(const PG8_LAS bf16x8*)(lds + PG8_SB(b, h) + boff + n * 2048 + k * 1024); } while (0)
#define PG8_MMA(ai, bj, At, Bt) do { __builtin_amdgcn_s_setprio(1); _Pragma("unroll") for (int m = 0; m < 4; ++m) _Pragma("unroll") for (int n = 0; n < 2; ++n) _Pragma("unroll") for (int k = 0; k < 2; ++k) \
        { if constexpr (Epi::I8) acc[ai][bj][m][n] = __builtin_bit_cast(f32x4, __builtin_amdgcn_mfma_i32_16x16x64_i8(__builtin_bit_cast(i32x4_, Bt[n][k]), __builtin_bit_cast(i32x4_, At[m][k]), __builtin_bit_cast(i32x4_, acc[ai][bj][m][n]), 0, 0, 0)); \
          else acc[ai][bj][m][n] = __builtin_amdgcn_mfma_f32_16x16x32_bf16(Bt[n][k], At[m][k], acc[ai][bj][m][n], 0, 0, 0); } __builtin_amdgcn_s_setprio(0); } while (0)
#define PG8_WAIT_V(n) asm volatile("s_waitcnt vmcnt(" #n ")" ::: "memory")
#define PG8_WAIT_L(n) asm volatile("s_waitcnt lgkmcnt(" #n ")" ::: "memory")
#define PG8_BAR __builtin_amdgcn_s_barrier()
#define PG8_SCHED __builtin_amdgcn_sched_barrier(0)
    Unit cur, nxt; int ui = 0;
    if (!S.next(0, cur)) return;
    f32x4 acc[2][2][4][2];
#pragma unroll
    for (int a = 0; a < 2; ++a)
#pragma unroll
        for (int b = 0; b < 2; ++b)
#pragma unroll
            for (int m = 0; m < 4; ++m)
#pragma unroll
                for (int n = 0; n < 2; ++n) acc[a][b][m][n] = (f32x4){0.f, 0.f, 0.f, 0.f};
    bf16x8 At[4][2], B0[2][2], B1[2][2];
    const char* cA = (const char*)g.A + (size_t)cur.pm * tstepA + (size_t)cur.pn * g.a_pn_bytes; const char* cB = (const char*)g.Bt + (size_t)cur.pn * tstepB;
    S.a_ready(cur);
    if constexpr (SP2) {
        PG8_STAGE(PG8_SB(0, 0), cB, voffB); PG8_STAGE(PG8_SB(0, 1), cB + hstepB, voffB); PG8_STAGE(PG8_SA(0, 0), cA, voffA); PG8_STAGE(PG8_SA(0, 1), cA + hstepA, voffA);
        if (wr == 1) PG8_BAR;
        PG8_WAIT_V(2); PG8_BAR;
        PG8_STAGE(PG8_SB(1, 0), cB + kstep, voffB); PG8_STAGE(PG8_SA(1, 0), cA + kstep, voffA); PG8_STAGE(PG8_SB(1, 1), cB + hstepB + kstep, voffB);
        PG8_WAIT_V(6); PG8_BAR;
    } else {
        PG8_STAGE(PG8_SB(0, 0), cB, voffB); PG8_STAGE(PG8_SA(0, 0), cA, voffA); PG8_STAGE(PG8_SB(0, 1), cB + hstepB, voffB); PG8_STAGE(PG8_SA(0, 1), cA + hstepA, voffA);
        if (wr == 1) PG8_BAR;
        PG8_WAIT_V(4); PG8_BAR;
        PG8_STAGE(PG8_SB(1, 0), cB + kstep, voffB); PG8_STAGE(PG8_SA(1, 0), cA + kstep, voffA); PG8_STAGE(PG8_SB(1, 1), cB + hstepB + kstep, voffB);
        PG8_WAIT_V(6); PG8_BAR;
    }
    for (;;) {
        const bool has_next = S.next(ui + 1, nxt);
        const char* nA = has_next ? (const char*)g.A + (size_t)nxt.pm * tstepA + (size_t)nxt.pn * g.a_pn_bytes : cA; const char* nB = has_next ? (const char*)g.Bt + (size_t)nxt.pn * tstepB : cB;
        for (int t = 0; t < nt; t += 2) {
            const bool last = (t == nt - 2);
            const char* a1 = cA + (size_t)(t + 1) * kstep;
            const char* a2 = last ? nA : cA + (size_t)(t + 2) * kstep; const char* b2 = last ? nB : cB + (size_t)(t + 2) * kstep;
            const char* a3 = a2 + kstep; const char* b3 = b2 + kstep;
            if (last && has_next) S.a_ready(nxt);
            if constexpr (SP2) {
            PG8_LDB(B0, 0, 0); PG8_LDB(B1, 0, 1); PG8_SCHED; PG8_LDA(At, 0, 0); PG8_STAGE(PG8_SA(1, 1), a1 + hstepA, voffA);
            PG8_WAIT_V(8); PG8_WAIT_L(0); PG8_BAR; PG8_MMA(0, 0, At, B0); PG8_MMA(0, 1, At, B1); PG8_BAR; PG8_SCHED;
            PG8_LDA(At, 0, 1); PG8_STAGE(PG8_SB(0, 0), b2, voffB); PG8_STAGE(PG8_SB(0, 1), b2 + hstepB, voffB); PG8_STAGE(PG8_SA(0, 0), a2, voffA);
            PG8_WAIT_V(8); PG8_WAIT_L(0); PG8_BAR; PG8_MMA(1, 0, At, B0); PG8_MMA(1, 1, At, B1); PG8_BAR; PG8_SCHED;
            PG8_LDB(B0, 1, 0); PG8_LDB(B1, 1, 1); PG8_SCHED; PG8_LDA(At, 1, 0); PG8_STAGE(PG8_SA(0, 1), a2 + hstepA, voffA);
            PG8_WAIT_V(8); PG8_WAIT_L(0); PG8_BAR; PG8_MMA(0, 0, At, B0); PG8_MMA(0, 1, At, B1); PG8_BAR; PG8_SCHED;
            PG8_LDA(At, 1, 1); PG8_STAGE(PG8_SB(1, 0), b3, voffB); PG8_STAGE(PG8_SB(1, 1), b3 + hstepB, voffB); PG8_STAGE(PG8_SA(1, 0), a3, voffA);
            PG8_WAIT_V(8); PG8_WAIT_L(0); PG8_BAR; PG8_MMA(1, 0, At, B0); PG8_MMA(1, 1, At, B1); PG8_BAR; PG8_SCHED;
            } else {
            PG8_LDB(B0, 0, 0); PG8_SCHED; PG8_LDA(At, 0, 0); PG8_STAGE(PG8_SA(1, 1), a1 + hstepA, voffA);
            PG8_WAIT_L(8); PG8_BAR; PG8_WAIT_L(0); PG8_MMA(0, 0, At, B0); PG8_BAR; PG8_SCHED;
            PG8_LDB(B1, 0, 1); PG8_STAGE(PG8_SB(0, 0), b2, voffB);
            PG8_BAR; PG8_WAIT_L(0); PG8_MMA(0, 1, At, B1); PG8_BAR;
            PG8_LDA(At, 0, 1); PG8_STAGE(PG8_SA(0, 0), a2, voffA);
            PG8_BAR; PG8_WAIT_L(0); PG8_MMA(1, 0, At, B0); PG8_BAR; PG8_SCHED;
            PG8_STAGE(PG8_SB(0, 1), b2 + hstepB, voffB);
            PG8_WAIT_V(6); PG8_BAR; PG8_MMA(1, 1, At, B1); PG8_BAR;
            PG8_LDB(B0, 1, 0); PG8_SCHED; PG8_LDA(At, 1, 0); PG8_STAGE(PG8_SA(0, 1), a2 + hstepA, voffA);
            PG8_WAIT_L(8); PG8_BAR; PG8_WAIT_L(0); PG8_MMA(0, 0, At, B0); PG8_BAR; PG8_SCHED;
            PG8_LDB(B1, 1, 1); PG8_STAGE(PG8_SB(1, 0), b3, voffB);
            PG8_BAR; PG8_WAIT_L(0); PG8_MMA(0, 1, At, B1); PG8_BAR;
            PG8_LDA(At, 1, 1); PG8_STAGE(PG8_SA(1, 0), a3, voffA);
            PG8_BAR; PG8_WAIT_L(0); PG8_MMA(1, 0, At, B0); PG8_BAR; PG8_SCHED;
            PG8_STAGE(PG8_SB(1, 1), b3 + hstepB, voffB);
            PG8_WAIT_V(6); PG8_BAR; PG8_MMA(1, 1, At, B1); PG8_BAR;
            }
        }
        if constexpr (ALIGN_EPI) { if (wr == 0) PG8_BAR; }
        if constexpr (!Epi::AFTER_DRAIN) { E(acc, cur, wr, wc, fr, fq); S.done(cur); }
        if (!has_next) break;
#pragma unroll
        for (int a = 0; a < 2; ++a)
#pragma unroll
            for (int b = 0; b < 2; ++b)
#pragma unroll
                for (int m = 0; m < 4; ++m)
#pragma unroll
                    for (int n = 0; n < 2; ++n) acc[a][b][m][n] = (f32x4){0.f, 0.f, 0.f, 0.f};
        cur = nxt; cA = nA; cB = nB; ++ui;
        if constexpr (ALIGN_EPI) { if (wr == 1) PG8_BAR; }
    }
    PG8_WAIT_V(0);
    if constexpr (!ALIGN_EPI) { if (wr == 0) PG8_BAR; }
    PG8_BAR;
    if constexpr (Epi::AFTER_DRAIN) { E.fused(acc, cur, wr, wc, fr, fq, lds, wid, lane); S.done(cur); }
#undef PG8_SA
#undef PG8_SB
#undef PG8_STAGE
#undef PG8_LDA
#undef PG8_LDB
#undef PG8_MMA
#undef PG8_WAIT_V
#undef PG8_WAIT_L
#undef PG8_BAR
#undef PG8_SCHED
}
}

__device__ __forceinline__ void cvt_f32_bf16(const float* __restrict__ src, bf16* dst, size_t n8, size_t gtid, size_t gthreads) {
    for (size_t i = gtid; i < n8; i += gthreads) {
        const f32x4 a = ((const f32x4*)src)[2 * i], b = ((const f32x4*)src)[2 * i + 1];
        u32x4 o; o.x = pk2(a.x, a.y); o.y = pk2(a.z, a.w); o.z = pk2(b.x, b.y); o.w = pk2(b.z, b.w);
        ((u32x4*)dst)[i] = o;
    }
}
__device__ __forceinline__ void transpose_tile(const float* __restrict__ W, int ldw, bf16* WT, int ldt, int k0, int n0, int nd0, LAS float* s, int tid, float sc = 1.0f) {
    {
        const int kk = tid >> 3, c8 = (tid & 7) * 8;
        const float* p = W + (size_t)(k0 + kk) * ldw + n0 + c8;
        const f32x4 a = *(const f32x4*)p, b = *(const f32x4*)(p + 4);
        LAS float* q = s + kk * 65 + c8;
        q[0] = a.x; q[1] = a.y; q[2] = a.z; q[3] = a.w; q[4] = b.x; q[5] = b.y; q[6] = b.z; q[7] = b.w;
    }
    __syncthreads();
    {
        const int nn = tid >> 3, k8 = (tid & 7) * 8;
        const LAS float* q = s + k8 * 65 + nn;
        u32x4 o; o.x = pk2(q[0] * sc, q[65] * sc); o.y = pk2(q[2 * 65] * sc, q[3 * 65] * sc); o.z = pk2(q[4 * 65] * sc, q[5 * 65] * sc); o.w = pk2(q[6 * 65] * sc, q[7 * 65] * sc);
        *(u32x4*)(WT + (size_t)(nd0 + nn) * ldt + k0 + k8) = o;
    }
    __syncthreads();
}

template <int NR> __device__ __forceinline__ void quant_rows_i8(const float (&v)[NR][16], unsigned char* const (&dst)[NR], float* const (&scale_out)[NR], int lane) {
    float m[NR];
#pragma unroll
    for (int r = 0; r < NR; ++r) { m[r] = 0.f;
#pragma unroll
        for (int j = 0; j < 16; ++j) m[r] = fmaxf(m[r], fabsf(v[r][j])); }
#pragma unroll
    for (int o = 32; o >= 1; o >>= 1) {
#pragma unroll
        for (int r = 0; r < NR; ++r) m[r] = fmaxf(m[r], __shfl_xor(m[r], o));
    }
#pragma unroll
    for (int r = 0; r < NR; ++r) {
        const float scale = (m[r] > 0.f) ? m[r] * (1.0f / 127.0f) : 1.0f, inv = 1.0f / scale;
        u32x4 q;
#pragma unroll
        for (int w = 0; w < 4; ++w) {
            unsigned pk = 0;
#pragma unroll
            for (int k = 0; k < 4; ++k) { int qi = (int)rintf(v[r][4 * w + k] * inv); qi = qi < -127 ? -127 : (qi > 127 ? 127 : qi); pk |= (unsigned)(qi & 0xff) << (8 * k); }
            q[w] = pk;
        }
        *(u32x4*)(dst[r] + lane * 16) = q;
        if (lane == 0) *scale_out[r] = scale;
    }
}
struct Ctx {
    const float* in[23];
    float* out;
    unsigned char* ws;
};

__device__ __forceinline__ void quant_peer_tables(const Ctx& c, int gw, int NW, int lane) {
    unsigned char* ws = c.ws;
    for (int e2 = gw * 2; e2 < NEXP; e2 += NW * 2) {
        float v[4][16];
#pragma unroll
        for (int r = 0; r < 4; ++r) {
            const float* src = ((r & 2) ? c.in[20] : c.in[19]) + (size_t)(e2 + (r & 1)) * 1024 + lane * 16;
            const f32x4 a0 = *(const f32x4*)src, a1 = *(const f32x4*)(src + 4), a2 = *(const f32x4*)(src + 8), a3 = *(const f32x4*)(src + 12);
            v[r][0] = a0.x; v[r][1] = a0.y; v[r][2] = a0.z; v[r][3] = a0.w; v[r][4] = a1.x; v[r][5] = a1.y; v[r][6] = a1.z; v[r][7] = a1.w;
            v[r][8] = a2.x; v[r][9] = a2.y; v[r][10] = a2.z; v[r][11] = a2.w; v[r][12] = a3.x; v[r][13] = a3.y; v[r][14] = a3.z; v[r][15] = a3.w;
        }
        float s2[4];
#pragma unroll
        for (int r = 0; r < 4; ++r) { s2[r] = 0.f;
#pragma unroll
            for (int j = 0; j < 16; ++j) s2[r] += v[r][j] * v[r][j]; }
#pragma unroll
        for (int o = 32; o >= 1; o >>= 1) {
#pragma unroll
            for (int r = 0; r < 4; ++r) s2[r] += __shfl_xor(s2[r], o);
        }
#pragma unroll
        for (int x = 0; x < 2; ++x) {
            const float su = 0.335f * sqrtf(s2[x] * (1.0f / 1024.0f)) + 1e-30f, sv = 0.48f * sqrtf(s2[2 + x] * (1.0f / 1024.0f)) + 1e-30f;
            const float iu = 1.0f / su, iv = 1.0f / sv;
            unsigned w[4] = {0u, 0u, 0u, 0u};
#pragma unroll
            for (int k = 0; k < 16; ++k) {
                int q = (int)floorf(v[x][k] * iu); q = q < -8 ? -8 : (q > 7 ? 7 : q);
                w[k >> 3] |= (unsigned)(q & 15) << (4 * (k & 7));
                const float a = fabsf(v[2 + x][k]) * iv;
                unsigned m = (unsigned)(a > 0.25f) + (unsigned)(a > 0.75f) + (unsigned)(a > 1.25f) + (unsigned)(a > 1.75f) + (unsigned)(a > 2.5f) + (unsigned)(a > 3.5f) + (unsigned)(a > 5.0f);
                m |= (v[2 + x][k] < 0.f) ? 8u : 0u;
                w[2 + (k >> 3)] |= m << (4 * (k & 7));
            }
#if P8_X4_
            *(u32x4*)(ws + WS_UQ + (size_t)(e2 + x) * 1024 + lane * 16) = (u32x4){w[0], w[1], w[2], w[3]};
#else
            *(u32x2*)(ws + WS_UQ + (size_t)(e2 + x) * 1024 + lane * 8) = (u32x2){w[0], w[1]};
            *(u32x2*)(ws + WS_UQ + (size_t)(e2 + x) * 1024 + 512 + lane * 8) = (u32x2){w[2], w[3]};
#endif
            if (lane == 0) *(f32x2*)(ws + WS_USC + (size_t)(e2 + x) * 8) = (f32x2){su, sv};
        }
    }
}

__device__ __forceinline__ void phase0(const Ctx& c, LAS unsigned char* lds) {
    int tid_ = threadIdx.x; asm volatile("" : "+v"(tid_)); const int tid = tid_;
    const size_t gtid = (size_t)blockIdx.x * NTHR + tid, gthreads = (size_t)gridDim.x * NTHR;
    unsigned char* ws = c.ws;
    cvt_f32_bf16(c.in[18], (bf16*)(ws + WS_KEYS), (size_t)8 * 2 * 128 * 128 / 8, gtid, gthreads);
    {
        const int lane = tid & 63, gw = blockIdx.x * 8 + (tid >> 6), NW = gridDim.x * 8;
        for (int row4 = gw * 4; row4 < T; row4 += NW * 4) {
            float v[4][16]; unsigned char* dst[4]; float* sc[4];
#pragma unroll
            for (int r = 0; r < 4; ++r) {
                const float* src = c.in[0] + (size_t)(row4 + r) * 1024 + lane * 16;
                const f32x4 a0 = *(const f32x4*)src, a1 = *(const f32x4*)(src + 4), a2 = *(const f32x4*)(src + 8), a3 = *(const f32x4*)(src + 12);
                v[r][0] = a0.x; v[r][1] = a0.y; v[r][2] = a0.z; v[r][3] = a0.w; v[r][4] = a1.x; v[r][5] = a1.y; v[r][6] = a1.z; v[r][7] = a1.w;
                v[r][8] = a2.x; v[r][9] = a2.y; v[r][10] = a2.z; v[r][11] = a2.w; v[r][12] = a3.x; v[r][13] = a3.y; v[r][14] = a3.z; v[r][15] = a3.w;
                dst[r] = ws + WS_XQ8 + (size_t)(row4 + r) * 1024; sc[r] = (float*)(ws + WS_SXR) + row4 + r;
            }
            quant_rows_i8<4>(v, dst, sc, lane);
#pragma unroll
            for (int r = 0; r < 4; ++r) {
                u32x4 b0, b1;
#pragma unroll
                for (int j = 0; j < 4; ++j) { b0[j] = pk2(v[r][2 * j], v[r][2 * j + 1]); b1[j] = pk2(v[r][8 + 2 * j], v[r][8 + 2 * j + 1]); }
                bf16* xb = (bf16*)(ws + WS_XB) + (size_t)(row4 + r) * 1024 + lane * 16;
                *(u32x4*)xb = b0; *(u32x4*)(xb + 8) = b1;
            }
        }
    }
    {
        const float* wsrc = c.in[12]; bf16* wt = (bf16*)(ws + WS_WTRIL);
        for (size_t i = gtid; i < (size_t)8 * 128 * 128 / 8; i += gthreads) {
            const int e = (int)i * 8, s0 = e & 127, t = (e >> 7) & 127;
            const f32x4 a = ((const f32x4*)wsrc)[2 * i], b = ((const f32x4*)wsrc)[2 * i + 1];
            float v[8] = {a.x, a.y, a.z, a.w, b.x, b.y, b.z, b.w};
#pragma unroll
            for (int j = 0; j < 8; ++j) v[j] = (s0 + j <= t) ? v[j] : 0.f;
            u32x4 o; o.x = pk2(v[0], v[1]); o.y = pk2(v[2], v[3]); o.z = pk2(v[4], v[5]); o.w = pk2(v[6], v[7]);
            ((u32x4*)wt)[i] = o;
        }
    }
    if (gtid < 1024) { const float lam = c.in[9][gtid]; ((float*)(ws + WS_SPT))[gtid] = 8.0f * NLOG2E * log1pf(expf(-lam));
                       ((float*)(ws + WS_BAS))[gtid] = NLOG2E * c.in[6][gtid]; ((float*)(ws + WS_BXS))[gtid] = NLOG2E * c.in[8][gtid]; }
    if (gtid < 2048) ((float*)(ws + WS_BGS))[gtid] = NLOG2E * c.in[2][gtid];
    {
        LAS float* s = (LAS float*)lds;
        constexpr int N_IN = 16 * 96, N_OUT = 16 * 16, N_Q = 16 * 32, N_G = 64, N_ALL = N_IN + N_OUT + N_Q + N_G;
        for (int it = blockIdx.x; it < N_ALL; it += gridDim.x) {
            int r = it;
            if (r < N_IN) {
                const int n0 = (r % 96) * 64, sec = n0 >> 10, kg = (n0 & 1023) >> 7, j0 = n0 & 127;
                const int ty = (sec == 0 || sec == 3) ? 0 : ((sec == 1 || sec == 4) ? 1 : 2), half = sec >= 3;
                transpose_tile(c.in[1], DIN, (bf16*)(ws + WS_WIN), 1024, (r / 96) * 64, n0, (3 * kg + ty) * 256 + half * 128 + j0, s, tid, sec >= 4 ? NLOG2E : 1.0f); continue;
            }
            r -= N_IN;
            if (r < N_OUT) { transpose_tile(c.in[14], 1024, (bf16*)(ws + WS_WOUT), 1024, (r / 16) * 64, (r % 16) * 64, (r % 16) * 64, s, tid); continue; }
            r -= N_OUT;
            if (r < N_Q) {
                const int k0 = (r / 32) * 64, n0 = (r % 32) * 64;
                {
                    const int kk = tid >> 3, c8 = (tid & 7) * 8;
                    const float* p = c.in[17] + (size_t)(k0 + kk) * 2048 + n0 + c8;
                    const f32x4 a = *(const f32x4*)p, b = *(const f32x4*)(p + 4);
                    LAS float* q = s + kk * 65 + c8;
                    q[0] = a.x; q[1] = a.y; q[2] = a.z; q[3] = a.w; q[4] = b.x; q[5] = b.y; q[6] = b.z; q[7] = b.w;
                }
                __syncthreads();
                if (tid < 64) {
                    float pc = 0.f, pd = 0.f;
                    for (int kk = 0; kk < 64; ++kk) { const float w = s[kk * 65 + tid]; pc += c.in[15][k0 + kk] * w; pd += c.in[16][k0 + kk] * w; }
                    float* part = (float*)(ws + WS_PARTCD) + (size_t)(r / 32) * 4096;
                    part[n0 + tid] = pc; part[2048 + n0 + tid] = pd;
                }
                {
                    const int nn = tid >> 3, k8 = (tid & 7) * 8;
                    const LAS float* q = s + k8 * 65 + nn;
                    const float* g = c.in[15] + k0 + k8;
                    u32x4 o; o.x = pk2(q[0] * g[0], q[65] * g[1]); o.y = pk2(q[2 * 65] * g[2], q[3 * 65] * g[3]); o.z = pk2(q[4 * 65] * g[4], q[5 * 65] * g[5]); o.w = pk2(q[6 * 65] * g[6], q[7 * 65] * g[7]);
                    *(u32x4*)((bf16*)(ws + WS_WQ) + (size_t)(n0 + nn) * 1024 + k0 + k8) = o;
                }
                __syncthreads();
                continue;
            }
            r -= N_Q;
            {
                const int h = r >> 3, g = (r >> 2) & 1, kb = (r >> 1) & 1, nb = r & 1;
                const float* W = (g ? c.in[7] : c.in[5]) + (size_t)h * 128 * 128;
                transpose_tile(W, 128, (bf16*)(ws + WS_WAX) + (size_t)h * 256 * 128 + (size_t)g * 128 * 128, 128, kb * 64, nb * 64, nb * 64, s, tid, NLOG2E);
            }
        }
    }
}

__device__ __forceinline__ void phase0b(const Ctx& c) {
    int tid_ = threadIdx.x; asm volatile("" : "+v"(tid_)); const int tid = tid_, lane = tid & 63, wid = tid >> 6;
    unsigned char* ws = c.ws;
    const bf16* W = (const bf16*)(ws + WS_WIN);
    {
        const int gt = blockIdx.x * NTHR + tid;
        if (gt < 4096) {
            const float* part = (const float*)(ws + WS_PARTCD) + gt;
            float sacc = 0.f;
#pragma unroll
            for (int kb = 0; kb < 16; ++kb) sacc += part[(size_t)kb * 4096];
            ((float*)(ws + WS_CQ))[gt] = sacc;
        }
    }
    for (int row4 = (blockIdx.x * 8 + wid) * 4; row4 < DIN + (Q_I8 ? 2048 : 0); row4 += gridDim.x * 8 * 4) {
        float v[4][16]; unsigned char* dst[4]; float* sc[4];
#pragma unroll
        for (int r = 0; r < 4; ++r) {
            const int rw = row4 + r; const bool isq = rw >= DIN;
            const bf16* src = (isq ? (const bf16*)(ws + WS_WQ) + (size_t)(rw - DIN) * 1024 : W + (size_t)rw * 1024) + lane * 16;
            const u32x4 a = *(const u32x4*)src, b = *(const u32x4*)(src + 8);
#pragma unroll
            for (int j = 0; j < 4; ++j) { v[r][2 * j] = bf_lo(a[j]); v[r][2 * j + 1] = bf_hi(a[j]); v[r][8 + 2 * j] = bf_lo(b[j]); v[r][8 + 2 * j + 1] = bf_hi(b[j]); }
            dst[r] = isq ? ws + WS_WQQ8 + (size_t)(rw - DIN) * 1024 : ws + WS_WQ8 + (size_t)rw * 1024; sc[r] = isq ? (float*)(ws + WS_SWQ) + (rw - DIN) : (float*)(ws + WS_SWC) + rw;
        }
        quant_rows_i8<4>(v, dst, sc, lane);
    }
}

__device__ __forceinline__ void phase2a(const Ctx& c, const pg8::StaticOrder& S) {
    int tid_ = threadIdx.x; asm volatile("" : "+v"(tid_)); const int tid = tid_, lane = tid & 63, wid = tid >> 6;
    unsigned char* ws = c.ws;
    const bf16* P4 = (const bf16*)(ws + WS_P4); bf16* XC = (bf16*)c.out; float* STATS = (float*)(ws + WS_STATS);
    const float* conv_w = c.in[3]; const float* conv_b = c.in[4];
    for (int u0 = 0; ; u0 += 4) {
        pg8::Unit uu; bool any = false;
        { pg8::Unit tmp; any = S.next(u0, tmp); }
        if (!any) break;
        if (!S.next(u0 + (tid >> 7), uu)) continue;
        const int cg = tid & 15, run = uu.pm * 8 + ((tid & 127) >> 4), ch = uu.pn * 128 + cg * 8;
        float w[4][8], bias[8];
#pragma unroll
        for (int k = 0; k < 4; ++k) { const f32x4 a = *(const f32x4*)(conv_w + k * 1024 + ch), b = *(const f32x4*)(conv_w + k * 1024 + ch + 4);
            w[k][0] = a.x; w[k][1] = a.y; w[k][2] = a.z; w[k][3] = a.w; w[k][4] = b.x; w[k][5] = b.y; w[k][6] = b.z; w[k][7] = b.w; }
        { const f32x4 a = *(const f32x4*)(conv_b + ch), b = *(const f32x4*)(conv_b + ch + 4);
          bias[0] = a.x; bias[1] = a.y; bias[2] = a.z; bias[3] = a.w; bias[4] = b.x; bias[5] = b.y; bias[6] = b.z; bias[7] = b.w; }
        {
            const int t0 = run * 32; const bool first = (t0 & (SEQ - 1)) == 0;
            const bf16* src = P4 + (size_t)t0 * 4096 + ch;
            u32x4 x0 = (u32x4){0u, 0u, 0u, 0u}, x1 = x0, x2 = x0;
            if (!first) { x0 = *(const u32x4*)(src - 3 * 4096); x1 = *(const u32x4*)(src - 2 * 4096); x2 = *(const u32x4*)(src - 4096); }
#pragma unroll 8
            for (int t = 0; t < 32; ++t) {
                const u32x4 x3 = *(const u32x4*)(src + (size_t)t * 4096);
                float o[8];
#pragma unroll
                for (int j = 0; j < 8; ++j) {
                    const float v0 = (j & 1) ? bf_hi(x0[j >> 1]) : bf_lo(x0[j >> 1]), v1 = (j & 1) ? bf_hi(x1[j >> 1]) : bf_lo(x1[j >> 1]);
                    const float v2 = (j & 1) ? bf_hi(x2[j >> 1]) : bf_lo(x2[j >> 1]), v3 = (j & 1) ? bf_hi(x3[j >> 1]) : bf_lo(x3[j >> 1]);
                    o[j] = bias[j] + w[0][j] * v0 + w[1][j] * v1 + w[2][j] * v2 + w[3][j] * v3;
                }
                u32x4 pk; pk.x = pk2(o[0], o[1]); pk.y = pk2(o[2], o[3]); pk.z = pk2(o[4], o[5]); pk.w = pk2(o[6], o[7]);
                *(u32x4*)(XC + (size_t)(t0 + t) * 1024 + ch) = pk;
                x0 = x1; x1 = x2; x2 = x3;
            }
        }
    }
    for (int row4 = (blockIdx.x * 8 + wid) * 4; row4 < T; row4 += gridDim.x * 8 * 4) {
        u32x4 a[4], b[4];
#pragma unroll
        for (int r = 0; r < 4; ++r) { const bf16* p = P4 + (size_t)(row4 + r) * 4096 + 3072 + lane * 16; a[r] = *(const u32x4*)p; b[r] = *(const u32x4*)(p + 8); }
        float mean[4], q[4];
#pragma unroll
        for (int r = 0; r < 4; ++r) {
            float s = 0.f;
#pragma unroll
            for (int j = 0; j < 4; ++j) s += (bf_lo(a[r][j]) + bf_hi(a[r][j])) + (bf_lo(b[r][j]) + bf_hi(b[r][j]));
            mean[r] = s;
        }
#pragma unroll
        for (int o = 32; o >= 1; o >>= 1) {
#pragma unroll
            for (int r = 0; r < 4; ++r) mean[r] += __shfl_xor(mean[r], o);
        }
#pragma unroll
        for (int r = 0; r < 4; ++r) {
            mean[r] *= (1.0f / 1024.0f);
            float s = 0.f;
#pragma unroll
            for (int j = 0; j < 4; ++j) {
                const float d0 = bf_lo(a[r][j]) - mean[r], d1 = bf_hi(a[r][j]) - mean[r], d2 = bf_lo(b[r][j]) - mean[r], d3 = bf_hi(b[r][j]) - mean[r];
                s += (d0 * d0 + d1 * d1) + (d2 * d2 + d3 * d3);
            }
            q[r] = s;
        }
#pragma unroll
        for (int o = 32; o >= 1; o >>= 1) {
#pragma unroll
            for (int r = 0; r < 4; ++r) q[r] += __shfl_xor(q[r], o);
        }
        if (lane < 4) {
            const float mm = lane == 0 ? mean[0] : lane == 1 ? mean[1] : lane == 2 ? mean[2] : mean[3];
            const float qq = lane == 0 ? q[0] : lane == 1 ? q[1] : lane == 2 ? q[2] : q[3];
            *(f32x2*)(STATS + (size_t)(row4 + lane) * 2) = (f32x2){mm, rsqrtf(qq * (1.0f / 1024.0f) + LN_EPS)};
        }
    }
}

typedef short s16x4 __attribute__((ext_vector_type(4)));
struct P2cRegs { u32x4 v[4]; f32x2 st[4]; };
__device__ __forceinline__ void p2c_load_v(P2cRegs& R, const bf16* P4, const float* STATS, int tile, int h, int tid) {
    const int piece = tid & 15, rowb = tid >> 4;
#pragma unroll
    for (int j = 0; j < 4; ++j) {
        const size_t row = (size_t)(tile * CHUNK + rowb + 32 * j);
        R.v[j] = *(const u32x4*)(P4 + row * 4096 + 3072 + h * 128 + piece * 8);
        R.st[j] = *(const f32x2*)(STATS + row * 2);
    }
}
__device__ __forceinline__ void phase2c(const Ctx& c, LAS unsigned char* lds, const int outcol = 2048) {
    int tid_ = threadIdx.x; asm volatile("" : "+v"(tid_)); const int tid = tid_, lane = tid & 63, wid = __builtin_amdgcn_readfirstlane(tid >> 6), fr = lane & 15, fq = lane >> 4, wr = wid >> 1, wc = wid & 1;
    unsigned char* ws = c.ws;
    bf16* P4 = (bf16*)(ws + WS_P4); const float* STATS = (const float*)(ws + WS_STATS);
    const bf16* HL = (const bf16*)(ws + WS_HL); const bf16* PC = (const bf16*)((const unsigned char*)c.out + OUT_PC);
    const float* PEND = (const float*)(ws + WS_PEND); const float* HEND = (const float*)(ws + WS_HEND);
    LAS float* carry = (LAS float*)(lds + 65536);
    const bf16* WTRIL = (const bf16*)(ws + WS_WTRIL);
    const float* ln_g = c.in[10]; const float* ln_b = c.in[11]; const float* gm_bs = c.in[13];
    const int h = blockIdx.x & 7;
    bf16x8 wf[2][4];
#pragma unroll
    for (int m = 0; m < 2; ++m)
#pragma unroll
        for (int ks = 0; ks < 4; ++ks) wf[m][ks] = *(const bf16x8*)(WTRIL + (size_t)h * 128 * 128 + (32 * wr + 16 * m + fr) * 128 + ks * 32 + fq * 8);
    const int piece = tid & 15, rowb = tid >> 4;
    float lg[8], lb[8];
    { const f32x4 g0 = *(const f32x4*)(ln_g + h * 128 + piece * 8), g1 = *(const f32x4*)(ln_g + h * 128 + piece * 8 + 4), b0 = *(const f32x4*)(ln_b + h * 128 + piece * 8), b1 = *(const f32x4*)(ln_b + h * 128 + piece * 8 + 4);
#pragma unroll
      for (int j = 0; j < 4; ++j) { lg[j] = g0[j]; lg[4 + j] = g1[j]; lb[j] = b0[j]; lb[4 + j] = b1[j]; } }
    const int wr_off = rowb * 256 + ((piece ^ ((rowb & 3) << 2)) << 4);
    const bool wr_swap = ((rowb >> 3) & 1) != 0;
    const int q_ = fr >> 2, p_ = fr & 3;
    int rd_off[2][2];
#pragma unroll
    for (int n2 = 0; n2 < 2; ++n2)
#pragma unroll
        for (int np = 0; np < 2; ++np) rd_off[n2][np] = (fq * 8 + q_) * 256 + (((8 * wc + 4 * n2 + p_) ^ (q_ << 2)) << 4) + ((np ^ (fq & 1)) << 3);
    const int nblk_h = gridDim.x >> 3;
    const int tile0 = blockIdx.x >> 3;
    P2cRegs RA, RB;
    if (tile0 < NTILE) p2c_load_v(RA, P4, STATS, tile0, h, tid);
    if (tile0 + nblk_h < NTILE) p2c_load_v(RB, P4, STATS, tile0 + nblk_h, h, tid);
#define P2C_UNIT(R, tile, par) do { \
        const int t0 = (tile) * CHUNK; \
        LAS unsigned char* V = lds + (par) * 32768; \
        _Pragma("unroll") for (int j = 0; j < 4; ++j) { \
            const float mean = R.st[j].x, rstd = R.st[j].y; \
            u32x4 w; \
            _Pragma("unroll") for (int e = 0; e < 4; ++e) w[e] = pk2((bf_lo(R.v[j][e]) - mean) * rstd * lg[2 * e] + lb[2 * e], (bf_hi(R.v[j][e]) - mean) * rstd * lg[2 * e + 1] + lb[2 * e + 1]); \
            if (wr_swap) w = (u32x4){w.z, w.w, w.x, w.y}; \
            *(LAS u32x4*)(V + wr_off + j * 32 * 256) = w; } \
        if (tid < 128) {                                        \
            const int cidx_ = (tile) & (NCHUNK - 1), tb_ = (tile) - cidx_; float hin_ = 0.f; \
            _Pragma("unroll") for (int cc = 0; cc < NCHUNK - 1; ++cc) { \
                const bool on_ = cc < cidx_; const int tl_ = on_ ? tb_ + cc : tb_; \
                const float p_ = PEND[(size_t)tl_ * 1024 + h * 128 + tid], q_ = HEND[(size_t)tl_ * 1024 + h * 128 + tid]; \
                hin_ = on_ ? p_ * hin_ + q_ : hin_; } \
            carry[(par) * 128 + tid] = hin_; } \
        __syncthreads(); \
        if ((tile) + 2 * nblk_h < NTILE) p2c_load_v(R, P4, STATS, (tile) + 2 * nblk_h, h, tid); \
        u32x4 hlv[2][2], pcv[2][2], gvv[2][2], ugv[2][2]; \
        _Pragma("unroll") for (int m = 0; m < 2; ++m) _Pragma("unroll") for (int n2 = 0; n2 < 2; ++n2) { \
            const size_t row_ = (size_t)(t0 + 32 * wr + 16 * m + fr); const int col_ = h * 128 + 64 * wc + 32 * n2 + 8 * fq; \
            hlv[m][n2] = *(const u32x4*)(HL + row_ * 1024 + col_); pcv[m][n2] = *(const u32x4*)(PC + row_ * 1024 + col_); gvv[m][n2] = *(const u32x4*)(P4 + row_ * 4096 + 1024 + col_); ugv[m][n2] = *(const u32x4*)(P4 + row_ * 4096 + 2048 + col_); } \
        f32x4 acc[2][4]; \
        _Pragma("unroll") for (int m = 0; m < 2; ++m) _Pragma("unroll") for (int n = 0; n < 4; ++n) acc[m][n] = (f32x4){0.f, 0.f, 0.f, 0.f}; \
        _Pragma("unroll") for (int ks = 0; ks < 4; ++ks) { \
            if (ks <= wr) { \
                bf16x8 b[4]; \
                _Pragma("unroll") for (int n = 0; n < 4; ++n) { \
                    const s16x4 lo = __builtin_amdgcn_ds_read_tr16_b64_v4i16((LAS s16x4*)(V + rd_off[n >> 1][n & 1] + ks * 32 * 256)); \
                    const s16x4 hi = __builtin_amdgcn_ds_read_tr16_b64_v4i16((LAS s16x4*)(V + rd_off[n >> 1][n & 1] + ks * 32 * 256 + 4 * 256)); \
                    b[n] = __builtin_shufflevector(lo, hi, 0, 1, 2, 3, 4, 5, 6, 7); } \
                _Pragma("unroll") for (int m = 0; m < 2; ++m) _Pragma("unroll") for (int n = 0; n < 4; ++n) acc[m][n] = __builtin_amdgcn_mfma_f32_16x16x32_bf16(b[n], wf[m][ks], acc[m][n], 0, 0, 0); } } \
        _Pragma("unroll") for (int m = 0; m < 2; ++m) { \
            const int tl = 32 * wr + 16 * m + fr; \
            const float bsv = gm_bs[h * 128 + tl]; \
            _Pragma("unroll") for (int n2 = 0; n2 < 2; ++n2) { \
                const f32x4 m0 = acc[m][2 * n2] + bsv, m1 = acc[m][2 * n2 + 1] + bsv; \
                const u32x4 ug = ugv[m][n2], hl_ = hlv[m][n2], pc_ = pcv[m][n2], g_ = gvv[m][n2]; \
                const LAS float* cp_ = carry + (par) * 128 + 64 * wc + 32 * n2 + 8 * fq; \
                const f32x4 h0_ = *(const LAS f32x4*)cp_, h1_ = *(const LAS f32x4*)(cp_ + 4); \
                u32x4 o;                                             \
                o.x = pk2(bf_lo(g_.x) * (bf_lo(hl_.x) + bf_lo(pc_.x) * h0_[0]) + bf_lo(ug.x) * m0[0], bf_hi(g_.x) * (bf_hi(hl_.x) + bf_hi(pc_.x) * h0_[1]) + bf_hi(ug.x) * m0[1]); \
                o.y = pk2(bf_lo(g_.y) * (bf_lo(hl_.y) + bf_lo(pc_.y) * h0_[2]) + bf_lo(ug.y) * m0[2], bf_hi(g_.y) * (bf_hi(hl_.y) + bf_hi(pc_.y) * h0_[3]) + bf_hi(ug.y) * m0[3]); \
                o.z = pk2(bf_lo(g_.z) * (bf_lo(hl_.z) + bf_lo(pc_.z) * h1_[0]) + bf_lo(ug.z) * m1[0], bf_hi(g_.z) * (bf_hi(hl_.z) + bf_hi(pc_.z) * h1_[1]) + bf_hi(ug.z) * m1[1]); \
                o.w = pk2(bf_lo(g_.w) * (bf_lo(hl_.w) + bf_lo(pc_.w) * h1_[2]) + bf_lo(ug.w) * m1[2], bf_hi(g_.w) * (bf_hi(hl_.w) + bf_hi(pc_.w) * h1_[3]) + bf_hi(ug.w) * m1[3]); \
                *(u32x4*)(P4 + (size_t)(t0 + tl) * 4096 + outcol + h * 128 + 64 * wc + 32 * n2 + 8 * fq) = o; } } \
    } while (0)
    for (int tile = tile0; tile < NTILE; tile += 2 * nblk_h) {
        P2C_UNIT(RA, tile, 0);
        if (tile + nblk_h < NTILE) P2C_UNIT(RB, tile + nblk_h, 1);
    }
#undef P2C_UNIT
}


__device__ __forceinline__ int f2key(float f) { const int b = __float_as_int(f); return b ^ ((b >> 31) & 0x7fffffff); }
__device__ __forceinline__ float key2f(int k) { return __int_as_float(k ^ ((k >> 31) & 0x7fffffff)); }
#define CE_DESC(a, b) do { const int _mx = max((a), (b)), _mn = min((a), (b)); (a) = _mx; (b) = _mn; } while (0)

template <int OFF, int N> __device__ __forceinline__ void sort16_desc(int (&v)[N]) {
#pragma unroll
    for (int k = 2; k <= 16; k <<= 1) {
#pragma unroll
        for (int j = k >> 1; j > 0; j >>= 1) {
#pragma unroll
            for (int i = 0; i < 16; ++i) {
                const int l = i ^ j;
                if (l > i) { if ((i & k) == 0) CE_DESC(v[OFF + i], v[OFF + l]); else CE_DESC(v[OFF + l], v[OFF + i]); }
            }
        }
    }
}
template <int OA, int OB, int N> __device__ __forceinline__ void merge16_desc(int (&v)[N]) {
#pragma unroll
    for (int i = 0; i < 16; ++i) v[OA + i] = max(v[OA + i], v[OB + 15 - i]);
#pragma unroll
    for (int j = 8; j > 0; j >>= 1) {
#pragma unroll
        for (int i = 0; i < 16; ++i) { const int l = i ^ j; if (l > i) CE_DESC(v[OA + i], v[OA + l]); }
    }
}
__device__ __forceinline__ void top16_of_64(int (&v)[64]) {
    sort16_desc<0>(v); sort16_desc<16>(v); sort16_desc<32>(v); sort16_desc<48>(v);
    merge16_desc<0, 16>(v); merge16_desc<32, 48>(v); merge16_desc<0, 32>(v);
}
__device__ __forceinline__ void merge_partner(int (&L)[16]) {
    int P[16];
#pragma unroll
    for (int i = 0; i < 16; ++i) P[i] = __shfl_xor(L[i], 32);
#pragma unroll
    for (int i = 0; i < 16; ++i) L[i] = max(L[i], P[15 - i]);
#pragma unroll
    for (int j = 8; j > 0; j >>= 1) {
#pragma unroll
        for (int i = 0; i < 16; ++i) { const int l = i ^ j; if (l > i) CE_DESC(L[i], L[l]); }
    }
}
__device__ __forceinline__ unsigned lookup_byte(const unsigned (&t)[4], int i) {
    const int w = i >> 2;
    const unsigned dw = (w == 0) ? t[0] : (w == 1) ? t[1] : (w == 2) ? t[2] : t[3];
    return (dw >> ((i & 3) * 8)) & 0xffu;
}

typedef _Float16 h16x2 __attribute__((ext_vector_type(2)));
__device__ __forceinline__ unsigned pkh2(float lo, float hi) { return __builtin_bit_cast(unsigned, __builtin_amdgcn_cvt_pkrtz(lo, hi)); }
__device__ __forceinline__ float h_lo(unsigned w) { return (float)__builtin_bit_cast(h16x2, w)[0]; }
__device__ __forceinline__ float h_hi(unsigned w) { return (float)__builtin_bit_cast(h16x2, w)[1]; }
constexpr int P7_KP = 272;
__device__ __forceinline__ void phase7(const Ctx& c, LAS unsigned char* lds) {
    int tid_ = threadIdx.x; asm volatile("" : "+v"(tid_)); const int tid = tid_, lane = tid & 63, wid = __builtin_amdgcn_readfirstlane(tid >> 6), r = lane & 31, hh = lane >> 5;
    unsigned char* ws = c.ws;
    const bf16* Q = (const bf16*)c.out; const bf16* KB = (const bf16*)(ws + WS_KEYS);
    int* IDX = (int*)(ws + WS_IDX); float* GATE = (float*)(ws + WS_GATE);
    const int head = blockIdx.x & 7, nblk_h = gridDim.x >> 3;
    {
        const bf16* ksrc = KB + (size_t)head * 256 * 128;
        for (int i = tid; i < 256 * 16; i += NTHR) { const int row = i >> 4, sg = i & 15; *(LAS u32x4*)(lds + row * P7_KP + sg * 16) = *(const u32x4*)(ksrc + row * 128 + sg * 8); }
    }
    __syncthreads();
    const LAS unsigned char* kl = lds + r * P7_KP + hh * 16;
    if (wid & 1) quant_peer_tables(c, blockIdx.x * 8 + wid, gridDim.x * 8, lane);
    for (int grp = (blockIdx.x >> 3) * 8 + wid; grp < T / 32; grp += nblk_h * 8) {
        const int tok = grp * 32 + r;
        int kz = 0; asm volatile("" : "+v"(kz));
        const LAS unsigned char* klz = kl + kz;
        bf16x8 qf[2][8];
        {
            const bf16* qp = Q + (size_t)tok * 2048 + head * 256 + hh * 8;
#pragma unroll
            for (int p = 0; p < 2; ++p)
#pragma unroll
                for (int ks = 0; ks < 8; ++ks) qf[p][ks] = *(const bf16x8*)(qp + p * 128 + ks * 16);
        }
        int S[2][16];
#pragma unroll
        for (int p = 0; p < 2; ++p) {
            f32x16 acc[4];
#pragma unroll
            for (int mb = 0; mb < 4; ++mb)
#pragma unroll
                for (int e = 0; e < 16; ++e) acc[mb][e] = 0.f;
#pragma unroll
            for (int ks = 0; ks < 8; ++ks) {
#pragma unroll
                for (int mb = 0; mb < 4; ++mb) {
                    const bf16x8 a = *(const LAS bf16x8*)(klz + (p * 128 + mb * 32) * P7_KP + ks * 32);
                    acc[mb] = __builtin_amdgcn_mfma_f32_32x32x16_bf16(a, qf[p][ks], acc[mb], 0, 0, 0);
                }
            }
            int v[64];
#pragma unroll
            for (int mb = 0; mb < 4; ++mb)
#pragma unroll
                for (int e = 0; e < 16; ++e) {
                    const int n = mb * 32 + (e & 3) + 8 * (e >> 2);
                    v[mb * 16 + e] = (f2key(acc[mb][e]) & ~0x7f) | n;
                }
            top16_of_64(v);
            int L[16];
#pragma unroll
            for (int i = 0; i < 16; ++i) L[i] = v[i] | (hh << 2);
            merge_partner(L);
#pragma unroll
            for (int i = 0; i < 16; ++i) S[p][i] = L[i];
        }
        float f1[16], f2[16];
#pragma unroll
        for (int i = 0; i < 16; ++i) { f1[i] = key2f(S[0][i]); f2[i] = key2f(S[1][i]); }
        int cv[64];
        {
            int n = 0;
#pragma unroll
            for (int i = 0; i < 16; ++i)
#pragma unroll
                for (int j = 0; j < 16; ++j)
                    if ((i + 1) * (j + 1) <= 16) { cv[n] = (f2key(f1[i] + f2[j]) & ~0xff) | (i * 16 + j); ++n; }
#pragma unroll
            for (int q = 50; q < 64; ++q) cv[q] = (int)0x80000000;
        }
        top16_of_64(cv);
        unsigned t1[4], t2[4];
#pragma unroll
        for (int w = 0; w < 4; ++w) {
            t1[w] = (unsigned)(S[0][4 * w] & 0x7f) | ((unsigned)(S[0][4 * w + 1] & 0x7f) << 8) | ((unsigned)(S[0][4 * w + 2] & 0x7f) << 16) | ((unsigned)(S[0][4 * w + 3] & 0x7f) << 24);
            t2[w] = (unsigned)(S[1][4 * w] & 0x7f) | ((unsigned)(S[1][4 * w + 1] & 0x7f) << 8) | ((unsigned)(S[1][4 * w + 2] & 0x7f) << 16) | ((unsigned)(S[1][4 * w + 3] & 0x7f) << 24);
        }
        int eid[16]; float ev[16];
        const float vmax = key2f(cv[0]);
        float esum = 0.f;
#pragma unroll
        for (int k = 0; k < 16; ++k) {
            const int pos = cv[k] & 0xff;
            eid[k] = (int)(lookup_byte(t1, pos >> 4) * 128u + lookup_byte(t2, pos & 15));
            ev[k] = __expf(key2f(cv[k]) - vmax);
            esum += ev[k];
        }
        const float inv = 1.0f / esum;
        if (hh == 0) {
            i32x4* ip = (i32x4*)(IDX + (size_t)tok * 128 + head * 16); f32x4* gp = (f32x4*)(GATE + (size_t)tok * 128 + head * 16);
#pragma unroll
            for (int w = 0; w < 4; ++w) {
                ip[w] = (i32x4){eid[4 * w], eid[4 * w + 1], eid[4 * w + 2], eid[4 * w + 3]};
                gp[w] = (f32x4){ev[4 * w] * inv, ev[4 * w + 1] * inv, ev[4 * w + 2] * inv, ev[4 * w + 3] * inv};
            }
        }
    }
    if (!(wid & 1)) quant_peer_tables(c, blockIdx.x * 8 + wid, gridDim.x * 8, lane);
}

#ifndef P8_TOK_
#define P8_TOK_ 8
#endif
#ifndef P8_EARLY_
#define P8_EARLY_ 1
#endif
#ifndef P8_SC1_
#define P8_SC1_ 0
#endif
#ifndef P8_F16ACC_
#define P8_F16ACC_ 1
#endif
#ifndef P8_PAIR_
#define P8_PAIR_ 1
#endif
#ifndef P8_KEYMASK_
#define P8_KEYMASK_ 127
#endif
#ifndef P8_X4_
#define P8_X4_ 1
#endif
constexpr int P8_TOK = P8_TOK_, P8_WAVE_LDS = P8_TOK * 2048 + 512;
template <int CTRL> __device__ __forceinline__ int dppi(int v) { return __builtin_amdgcn_update_dpp(0, v, CTRL, 0xf, 0xf, false); }
__device__ __forceinline__ int reduce16i(const int (&p)[16], bool b3, bool b2) {
    int q8[8], r4[4], s2[2];
#pragma unroll
    for (int i = 0; i < 8; ++i) { const auto r = __builtin_amdgcn_permlane32_swap((unsigned)p[i], (unsigned)p[8 + i], false, false); q8[i] = (int)(r[0] + r[1]); }
#pragma unroll
    for (int i = 0; i < 4; ++i) { const auto r = __builtin_amdgcn_permlane16_swap((unsigned)q8[i], (unsigned)q8[4 + i], false, false); r4[i] = (int)(r[0] + r[1]); }
#pragma unroll
    for (int i = 0; i < 2; ++i) { const int ta = r4[i] + dppi<0x128>(r4[i]), tb = r4[2 + i] + dppi<0x128>(r4[2 + i]); s2[i] = b3 ? tb : ta; }
    const int ta = s2[0] + dppi<0x141>(s2[0]), tb = s2[1] + dppi<0x141>(s2[1]);
    int t = b2 ? tb : ta;
    t += dppi<0x4e>(t);
    t += dppi<0xb1>(t);
    return t;
}
__device__ __forceinline__ int reduce8i(const int (&q8)[8], bool b3, bool b2) {
    int r4[4], s2[2];
#pragma unroll
    for (int i = 0; i < 4; ++i) { const auto r = __builtin_amdgcn_permlane16_swap((unsigned)q8[i], (unsigned)q8[4 + i], false, false); r4[i] = (int)(r[0] + r[1]); }
#pragma unroll
    for (int i = 0; i < 2; ++i) { const int ta = r4[i] + dppi<0x128>(r4[i]), tb = r4[2 + i] + dppi<0x128>(r4[2 + i]); s2[i] = b3 ? tb : ta; }
    const int ta = s2[0] + dppi<0x141>(s2[0]), tb = s2[1] + dppi<0x141>(s2[1]);
    int t = b2 ? tb : ta;
    t += dppi<0x4e>(t);
    t += dppi<0xb1>(t);
    return t;
}
__device__ __forceinline__ float p8_shx(float v, int of, int lane) { return __int_as_float(__builtin_amdgcn_ds_bpermute((lane ^ of) << 2, __float_as_int(v))); }
__device__ __forceinline__ float p8_sum(float v, int lane) {
#pragma unroll
    for (int of = 32; of >= 1; of >>= 1) v += p8_shx(v, of, lane);
    return v;
}
#define P8_LOAD_X1(x, tok) do { \
        const bf16* zr_ = ZB + (size_t)(tok) * 1024 + lane * 16; \
        const u32x4 a0_ = *(const u32x4*)zr_, a1_ = *(const u32x4*)(zr_ + 8); \
        const f32x2 st_ = *(const f32x2*)(ST1 + (size_t)(tok) * 2); \
        _Pragma("unroll") for (int j = 0; j < 4; ++j) { x[2 * j] = bf_lo(a0_[j]); x[2 * j + 1] = bf_hi(a0_[j]); x[8 + 2 * j] = bf_lo(a1_[j]); x[8 + 2 * j + 1] = bf_hi(a1_[j]); } \
        _Pragma("unroll") for (int w = 0; w < 4; ++w) { \
            const f32x4 g_ = *(const f32x4*)(l1g + lane * 16 + 4 * w), b_ = *(const f32x4*)(l1b + lane * 16 + 4 * w); \
            _Pragma("unroll") for (int k = 0; k < 4; ++k) x[4 * w + k] = (x[4 * w + k] - st_.x) * st_.y * g_[k] + b_[k]; } \
    } while (0)
#define P8_ISSUE_U(U, IDV, GV, SC2, tt_, k_) do { \
        const u32x2 en_ = *(const LAS u32x2*)(wl + (tt_) * 1024 + ((k_) * 16 + esub) * 8); \
        IDV = (int)en_.x; GV = __uint_as_float(en_.y); SC2 = SC[IDV]; \
        unsigned l8_ = lane8; asm volatile("" : "+v"(l8_)); \
        _Pragma("unroll") for (int e = 0; e < 16; ++e) { \
            unsigned long long rb_ = (unsigned long long)UV + ((unsigned long long)(unsigned)__builtin_amdgcn_readlane(IDV, e * 4) << 10); \
            asm volatile("" : "+s"(rb_));                              \
            U[e] = *(const __attribute__((address_space(1))) u32x2*)(rb_ + l8_); } \
    } while (0)
#define P8_ISSUE_V(V, IDV) do { \
        unsigned l8_ = lane8; asm volatile("" : "+v"(l8_)); \
        _Pragma("unroll") for (int e = 0; e < 16; ++e) { \
            unsigned long long rb_ = (unsigned long long)UV + ((unsigned long long)(unsigned)__builtin_amdgcn_readlane(IDV, e * 4) << 10); \
            asm volatile("" : "+s"(rb_)); \
            V[e] = *(const __attribute__((address_space(1))) u32x2*)(rb_ + 512 + l8_); } \
    } while (0)
#define P8_USIDE(U, GV, SC2, tt_, ACT) do { \
        const u32x4 xq_ = *(const LAS u32x4*)(wx + (tt_) * 1024 + lane8 * 2); \
        int p_[16]; \
        _Pragma("unroll") for (int e = 0; e < 16; ++e) { \
            int t_; asm("v_dot8_i32_i4 %0, %1, %2, 0" : "=v"(t_) : "v"(U[e].x), "v"(xq_.x)); \
            t_ = __builtin_amdgcn_sdot8((int)U[e].y, (int)xq_.y, t_, false); t_ <<= 4; \
            t_ = __builtin_amdgcn_sdot8((int)U[e].x, (int)xq_.z, t_, false); t_ = __builtin_amdgcn_sdot8((int)U[e].y, (int)xq_.w, t_, false); p_[e] = t_; } \
        const int t1_ = reduce16i(p_, b3, b2); \
        ACT = gelu_tanh(((float)t1_ + hoff[tt_]) * SC2.x * sx[tt_]) * GV * SC2.y; \
    } while (0)
#define P8_FP4(w_, b_) __builtin_amdgcn_cvt_scalef32_pk_f32_fp4(w_, 1.0f, b_)
#define P8_VSIDE(V, tt_, ACT) do { \
        f32x2 oc_[8]; \
        _Pragma("unroll") for (int j = 0; j < 8; ++j) oc_[j] = (f32x2){h_lo(ob[tt_][j]), h_hi(ob[tt_][j])}; \
        _Pragma("unroll") for (int e = 0; e < 16; ++e) { \
            const float ae_ = __int_as_float(__builtin_amdgcn_readlane(__float_as_int(ACT), e * 4)); const f32x2 aa_ = {ae_, ae_}; \
            oc_[0] = __builtin_elementwise_fma(P8_FP4(V[e].x, 0), aa_, oc_[0]); oc_[1] = __builtin_elementwise_fma(P8_FP4(V[e].x, 1), aa_, oc_[1]); \
            oc_[2] = __builtin_elementwise_fma(P8_FP4(V[e].x, 2), aa_, oc_[2]); oc_[3] = __builtin_elementwise_fma(P8_FP4(V[e].x, 3), aa_, oc_[3]); \
            oc_[4] = __builtin_elementwise_fma(P8_FP4(V[e].y, 0), aa_, oc_[4]); oc_[5] = __builtin_elementwise_fma(P8_FP4(V[e].y, 1), aa_, oc_[5]); \
            oc_[6] = __builtin_elementwise_fma(P8_FP4(V[e].y, 2), aa_, oc_[6]); oc_[7] = __builtin_elementwise_fma(P8_FP4(V[e].y, 3), aa_, oc_[7]); } \
        _Pragma("unroll") for (int j = 0; j < 8; ++j) ob[tt_][j] = pkh2(oc_[j].x, oc_[j].y); \
    } while (0)
#define P8_STEP(UC, VC, GC, SCC, tt_, UN, VN, IDN, GN, SCN, ttn_, kn_) do { \
        P8_ISSUE_U(UN, IDN, GN, SCN, ttn_, kn_); __builtin_amdgcn_sched_barrier(0); \
        float act_; P8_USIDE(UC, GC, SCC, tt_, act_); __builtin_amdgcn_sched_barrier(0); \
        P8_ISSUE_V(VN, IDN); __builtin_amdgcn_sched_barrier(0); \
        P8_VSIDE(VC, tt_, act_); __builtin_amdgcn_sched_barrier(0); \
    } while (0)
#if P8_X4_
#undef P8_STEP
#define P8_ISSUE_W(W, EN, tt_, k_) do { \
        unsigned l16_ = lane16; asm volatile("" : "+v"(l16_));                            \
        EN = *(const LAS u32x2*)(wl + (tt_) * 1024 + (k_) * 128 + ((l16_ >> 6) << 3));     \
        _Pragma("unroll") for (int e = 0; e < 16; ++e) { \
            unsigned long long rb_ = (unsigned long long)UV + ((unsigned long long)((unsigned)__builtin_amdgcn_readlane((int)EN.x, e * 4) & 0xffffu) << 10); \
            asm volatile("" : "+s"(rb_)); \
            W[e] = *(const __attribute__((address_space(1))) u32x4*)(rb_ + l16_); } \
    } while (0)
#define P8_DOT(W, e_, xq_) ({ int t_; asm("v_dot8_i32_i4 %0, %1, %2, 0" : "=v"(t_) : "v"(W[e_].x), "v"(xq_.x)); \
        t_ = __builtin_amdgcn_sdot8((int)W[e_].y, (int)xq_.y, t_, false); t_ <<= 4; \
        t_ = __builtin_amdgcn_sdot8((int)W[e_].x, (int)xq_.z, t_, false); __builtin_amdgcn_sdot8((int)W[e_].y, (int)xq_.w, t_, false); })
#define P8_USIDE_W(W, EN, tt_, ACT) do { \
        unsigned lx_ = lane16; asm volatile("" : "+v"(lx_)); \
        const u32x4 xq_ = *(const LAS u32x4*)(wx + (tt_) * 1024 + lx_); \
        int q8_[8]; \
        _Pragma("unroll") for (int i = 0; i < 8; ++i) {                                   \
            const int ta_ = P8_DOT(W, i, xq_), tb_ = P8_DOT(W, i + 8, xq_); \
            const auto r_ = __builtin_amdgcn_permlane32_swap((unsigned)ta_, (unsigned)tb_, false, false); q8_[i] = (int)(r_[0] + r_[1]); } \
        const int t1_ = reduce8i(q8_, b3, b2); \
        ACT = gelu_tanh(((float)t1_ + hoff[tt_]) * h_hi(EN.x) * sx[tt_]) * __uint_as_float(EN.y); \
    } while (0)
#define P8_VSIDE_W(W, tt_, ACT) do { \
        f32x2 oc_[8]; \
        _Pragma("unroll") for (int j = 0; j < 8; ++j) oc_[j] = (f32x2){h_lo(ob[tt_][j]), h_hi(ob[tt_][j])}; \
        _Pragma("unroll") for (int e = 0; e < 16; ++e) { \
            const float ae_ = __int_as_float(__builtin_amdgcn_readlane(__float_as_int(ACT), e * 4)); const f32x2 aa_ = {ae_, ae_}; \
            oc_[0] = __builtin_elementwise_fma(P8_FP4(W[e].z, 0), aa_, oc_[0]); oc_[1] = __builtin_elementwise_fma(P8_FP4(W[e].z, 1), aa_, oc_[1]); \
            oc_[2] = __builtin_elementwise_fma(P8_FP4(W[e].z, 2), aa_, oc_[2]); oc_[3] = __builtin_elementwise_fma(P8_FP4(W[e].z, 3), aa_, oc_[3]); \
            oc_[4] = __builtin_elementwise_fma(P8_FP4(W[e].w, 0), aa_, oc_[4]); oc_[5] = __builtin_elementwise_fma(P8_FP4(W[e].w, 1), aa_, oc_[5]); \
            oc_[6] = __builtin_elementwise_fma(P8_FP4(W[e].w, 2), aa_, oc_[6]); oc_[7] = __builtin_elementwise_fma(P8_FP4(W[e].w, 3), aa_, oc_[7]); } \
        _Pragma("unroll") for (int j = 0; j < 8; ++j) ob[tt_][j] = pkh2(oc_[j].x, oc_[j].y); \
    } while (0)
#ifdef P8_DUP_
#define P8_DUPU(WC, ENC, tt_, ACT) do { float a2_; P8_USIDE_W(WC, ENC, tt_, a2_); ACT = 0.5f * (ACT + a2_); __builtin_amdgcn_sched_barrier(0); } while (0)
#else
#define P8_DUPU(WC, ENC, tt_, ACT) do { } while (0)
#endif
#define P8_STEP(WC, ENC, tt_, WN, ENN, ttn_, kn_) do { \
        P8_ISSUE_W(WN, ENN, ttn_, kn_); __builtin_amdgcn_sched_barrier(0); \
        float act_; P8_USIDE_W(WC, ENC, tt_, act_); __builtin_amdgcn_sched_barrier(0); \
        P8_DUPU(WC, ENC, tt_, act_); \
        P8_VSIDE_W(WC, tt_, act_); __builtin_amdgcn_sched_barrier(0); \
    } while (0)
#if P8_PAIR_
#define P8_ISSUE_P(W, EN, pp_, j_) do { \
        unsigned l16_ = lane16; asm volatile("" : "+v"(l16_)); \
        EN = *(const LAS u32x2*)(wl + (pp_) * 2048 + (j_) * 64 + ((l16_ >> 9) << 10) + (((l16_ >> 6) & 7u) << 3)); \
        _Pragma("unroll") for (int e = 0; e < 16; ++e) { \
            unsigned long long rb_ = (unsigned long long)UV + ((unsigned long long)((unsigned)__builtin_amdgcn_readlane((int)EN.x, e * 4) & 0xffffu) << 10); \
            asm volatile("" : "+s"(rb_)); \
            W[e] = *(const __attribute__((address_space(1))) u32x4*)(rb_ + l16_); } \
    } while (0)
#define P8_USIDE_P(W, EN, pp_, ACT) do { \
        unsigned lx_ = lane16; asm volatile("" : "+v"(lx_)); \
        const u32x4 xa_ = *(const LAS u32x4*)(wx + (2 * (pp_)) * 1024 + lx_), xb_ = *(const LAS u32x4*)(wx + (2 * (pp_) + 1) * 1024 + lx_); \
        int q8_[8]; \
        _Pragma("unroll") for (int i = 0; i < 8; ++i) { \
            const int ta_ = P8_DOT(W, i, xa_), tb_ = P8_DOT(W, i + 8, xb_); \
            const auto r_ = __builtin_amdgcn_permlane32_swap((unsigned)ta_, (unsigned)tb_, false, false); q8_[i] = (int)(r_[0] + r_[1]); } \
        const int t1_ = reduce8i(q8_, b3, b2); \
        const bool hi_ = lx_ >= 512u; \
        ACT = gelu_tanh(((float)t1_ + (hi_ ? hoff[2 * (pp_) + 1] : hoff[2 * (pp_)])) * h_hi(EN.x) * (hi_ ? sx[2 * (pp_) + 1] : sx[2 * (pp_)])) * __uint_as_float(EN.y); \
    } while (0)
#if P8_F16ACC_
#define P8_FP4H(w_, b_) __builtin_bit_cast(h16x2, __builtin_amdgcn_cvt_scalef32_pk_f16_fp4(w_, 1.0f, b_))
#define P8_VHALF(W, e0_, tt_, ACT) do {                                     \
        const int a16_ = (int)pkh2(ACT, ACT); \
        h16x2 oc_[8]; \
        _Pragma("unroll") for (int j = 0; j < 8; ++j) oc_[j] = __builtin_bit_cast(h16x2, ob[tt_][j]); \
        _Pragma("unroll") for (int e = e0_; e < e0_ + 8; ++e) { \
            const h16x2 aa_ = __builtin_bit_cast(h16x2, __builtin_amdgcn_readlane(a16_, e * 4)); \
            oc_[0] = __builtin_elementwise_fma(P8_FP4H(W[e].z, 0), aa_, oc_[0]); oc_[1] = __builtin_elementwise_fma(P8_FP4H(W[e].z, 1), aa_, oc_[1]); \
            oc_[2] = __builtin_elementwise_fma(P8_FP4H(W[e].z, 2), aa_, oc_[2]); oc_[3] = __builtin_elementwise_fma(P8_FP4H(W[e].z, 3), aa_, oc_[3]); \
            oc_[4] = __builtin_elementwise_fma(P8_FP4H(W[e].w, 0), aa_, oc_[4]); oc_[5] = __builtin_elementwise_fma(P8_FP4H(W[e].w, 1), aa_, oc_[5]); \
            oc_[6] = __builtin_elementwise_fma(P8_FP4H(W[e].w, 2), aa_, oc_[6]); oc_[7] = __builtin_elementwise_fma(P8_FP4H(W[e].w, 3), aa_, oc_[7]); } \
        _Pragma("unroll") for (int j = 0; j < 8; ++j) ob[tt_][j] = __builtin_bit_cast(unsigned, oc_[j]); \
    } while (0)
#else
#define P8_VHALF(W, e0_, tt_, ACT) do { \
        f32x2 oc_[8]; \
        _Pragma("unroll") for (int j = 0; j < 8; ++j) oc_[j] = (f32x2){h_lo(ob[tt_][j]), h_hi(ob[tt_][j])}; \
        _Pragma("unroll") for (int e = e0_; e < e0_ + 8; ++e) { \
            const float ae_ = __int_as_float(__builtin_amdgcn_readlane(__float_as_int(ACT), e * 4)); const f32x2 aa_ = {ae_, ae_}; \
            oc_[0] = __builtin_elementwise_fma(P8_FP4(W[e].z, 0), aa_, oc_[0]); oc_[1] = __builtin_elementwise_fma(P8_FP4(W[e].z, 1), aa_, oc_[1]); \
            oc_[2] = __builtin_elementwise_fma(P8_FP4(W[e].z, 2), aa_, oc_[2]); oc_[3] = __builtin_elementwise_fma(P8_FP4(W[e].z, 3), aa_, oc_[3]); \
            oc_[4] = __builtin_elementwise_fma(P8_FP4(W[e].w, 0), aa_, oc_[4]); oc_[5] = __builtin_elementwise_fma(P8_FP4(W[e].w, 1), aa_, oc_[5]); \
            oc_[6] = __builtin_elementwise_fma(P8_FP4(W[e].w, 2), aa_, oc_[6]); oc_[7] = __builtin_elementwise_fma(P8_FP4(W[e].w, 3), aa_, oc_[7]); } \
        _Pragma("unroll") for (int j = 0; j < 8; ++j) ob[tt_][j] = pkh2(oc_[j].x, oc_[j].y); \
    } while (0)
#endif
#define P8_STEP_P(WC, ENC, pp_, WN, ENN, ppn_, jn_) do { \
        P8_ISSUE_P(WN, ENN, ppn_, jn_); __builtin_amdgcn_sched_barrier(0); \
        float act_; P8_USIDE_P(WC, ENC, pp_, act_); __builtin_amdgcn_sched_barrier(0); \
        P8_VHALF(WC, 0, 2 * (pp_), act_); P8_VHALF(WC, 8, 2 * (pp_) + 1, act_); __builtin_amdgcn_sched_barrier(0); \
    } while (0)
#endif
#endif
template <int FAKE> __device__ __forceinline__ void phase8(const Ctx& c, LAS unsigned char* lds, const XcdBarrier& xbar) {
    int tid_ = threadIdx.x; asm volatile("" : "+v"(tid_)); const int tid = tid_, lane = tid & 63, wid = __builtin_amdgcn_readfirstlane(tid >> 6);
    unsigned char* ws = c.ws;
    const bf16* ZB = (const bf16*)(ws + WS_Z); const float* ST1 = (const float*)(ws + WS_ST1); const float* l1g = c.in[15]; const float* l1b = c.in[16];
    const int* IDX = (const int*)(ws + WS_IDX); const float* GATE = (const float*)(ws + WS_GATE);
    const unsigned char* UV = ws + WS_UQ; const f32x2* SC = (const f32x2*)(ws + WS_USC);
    const float* lg = c.in[21]; const float* lb = c.in[22];
    float* OUT = FAKE ? (float*)(ws + WS_P4) : c.out;
    const bool b3 = (lane & 8) != 0, b2 = (lane & 4) != 0;
    const int esub = lane >> 2; const unsigned lane8 = (unsigned)lane * 8u, lane16 = (unsigned)lane * 16u;
    LAS unsigned char* wl = lds + wid * P8_WAVE_LDS;
    LAS unsigned char* wx = wl + P8_TOK * 1024;
    LAS int* hist = (LAS int*)(wx + P8_TOK * 1024);
    const int ntl = (NTILE + gridDim.x - 1) / gridDim.x;
#ifdef UBENCH
    {
        unsigned w_ = lane8; f32x2 r_ = {0.f, 0.f}, a2_ = {1.0f, 1.0f}; int d_ = 0;
        for (int it = 0; it < 1000; ++it) {
#pragma unroll
            for (int j = 0; j < 32; ++j) {
#if UBENCH == 1
                asm volatile("v_cvt_scalef32_pk_f32_fp4 %0, %1, 1.0" : "=v"(r_) : "v"(w_));
#elif UBENCH == 2
                asm volatile("v_pk_fma_f32 %0, %1, %2, %1" : "=v"(r_) : "v"(a2_), "v"(a2_));
#elif UBENCH == 3
                asm volatile("v_dot8_i32_i4 %0, %1, %2, 0" : "=v"(d_) : "v"(w_), "v"(w_));
#elif UBENCH == 5
                if ((j & 7) == 0) asm volatile("v_readlane_b32 s16, %0, 4\n\ts_mov_b32 s17, s16" :: "v"(w_) : "s16", "s17");
                if (j & 1) asm volatile("v_pk_fma_f32 %0, %1, s[16:17], %1 op_sel_hi:[1,0,1]" : "=v"(r_) : "v"(a2_) : "s16", "s17");
                else asm volatile("v_cvt_scalef32_pk_f32_fp4 %0, %1, 1.0" : "=v"(r_) : "v"(w_));
#elif UBENCH == 6
                if (j & 1) asm volatile("v_pk_fma_f32 %0, %1, %2, %1" : "=v"(r_) : "v"(a2_), "v"(a2_));
                else asm volatile("v_cvt_scalef32_pk_f32_fp4 %0, %1, 1.0" : "=v"(r_) : "v"(w_));
#elif UBENCH == 4
                asm volatile("v_fma_f32 %0, %1, %1, %1" : "=v"(d_) : "v"(w_));
#endif
            }
        }
    }
#endif
    for (int ti = 0; ti < ntl; ++ti) {
        const int tile = blockIdx.x + ti * gridDim.x; const bool live = tile < NTILE;
        for (int rnd = 0; rnd < 16 / P8_TOK; ++rnd) {
            const int tok0 = tile * CHUNK + wid * 16 + rnd * P8_TOK;
            float sx[P8_TOK], hoff[P8_TOK]; unsigned ob[P8_TOK][8];
            if (live) {
                int lane_p = threadIdx.x; asm volatile("" : "+v"(lane_p)); lane_p &= 63;
#pragma unroll
                for (int tt = 0; tt < P8_TOK; ++tt) {
                    const int lane = lane_p; const unsigned lane8 = (unsigned)lane_p * 8u;
                    const int tok = tok0 + tt;
                    {
                        float x[16];
                        P8_LOAD_X1(x, tok);
                        float m = 0.f;
#pragma unroll
                        for (int j = 0; j < 16; ++j) m = fmaxf(m, fabsf(x[j]));
#pragma unroll
                        for (int of = 32; of >= 1; of >>= 1) m = fmaxf(m, p8_shx(m, of, lane));
                        const float sc = (m > 0.f) ? m * (1.0f / 119.0f) : 1.0f, inv = 1.0f / sc;
                        sx[tt] = __int_as_float(__builtin_amdgcn_readfirstlane(__float_as_int(sc)));
                        unsigned xh0 = 0u, xh1 = 0u, xl0 = 0u, xl1 = 0u; int sm = 0;
#pragma unroll
                        for (int k = 0; k < 16; ++k) {
                            const int xi = (int)rintf(x[k] * inv), lo = ((xi + 8) & 15) - 8, hi = (xi - lo) >> 4;
                            sm += xi;
                            if (k < 8) { xh0 |= (unsigned)(hi & 15) << (4 * k); xl0 |= (unsigned)(lo & 15) << (4 * k); }
                            else { xh1 |= (unsigned)(hi & 15) << (4 * (k - 8)); xl1 |= (unsigned)(lo & 15) << (4 * (k - 8)); }
                        }
                        *(LAS u32x4*)(wx + tt * 1024 + lane8 * 2) = (u32x4){xh0, xh1, xl0, xl1};
                        hoff[tt] = __int_as_float(__builtin_amdgcn_readfirstlane(__float_as_int(0.5f * p8_sum((float)sm, lane))));
                    }
#pragma unroll
                    for (int j = 0; j < 8; ++j) ob[tt][j] = 0u;
                    {
                        LAS unsigned char* L = wl + tt * 1024;
                        int i0 = IDX[(size_t)tok * 128 + lane], i1 = IDX[(size_t)tok * 128 + 64 + lane];
                        if (FAKE) { i0 &= FAKE - 1; i1 &= FAKE - 1; }
                        const float g0 = GATE[(size_t)tok * 128 + lane], g1 = GATE[(size_t)tok * 128 + 64 + lane];
                        const int k0 = (i0 >> 7) & P8_KEYMASK_, k1 = (i1 >> 7) & P8_KEYMASK_;
                        *(LAS u32x2*)(hist + 2 * lane) = (u32x2){0u, 0u};
                        asm volatile("" ::: "memory");
                        const int w0 = __hip_atomic_fetch_add(hist + k0, 1, __ATOMIC_RELAXED, __HIP_MEMORY_SCOPE_WORKGROUP);
                        const int w1 = __hip_atomic_fetch_add(hist + k1, 1, __ATOMIC_RELAXED, __HIP_MEMORY_SCOPE_WORKGROUP);
                        asm volatile("" ::: "memory");
                        const u32x2 cc = *(const LAS u32x2*)(hist + 2 * lane);
                        const int s = (int)(cc.x + cc.y); int incl = s;
#pragma unroll
                        for (int o = 1; o < 64; o <<= 1) { const int t = __builtin_amdgcn_ds_bpermute((lane - o) << 2, incl); incl += (lane >= o) ? t : 0; }
                        const int excl = incl - s;
                        asm volatile("" ::: "memory");
                        *(LAS u32x2*)(hist + 2 * lane) = (u32x2){(unsigned)excl, (unsigned)excl + cc.x};
                        asm volatile("" ::: "memory");
                        const int pos0 = hist[k0] + w0, pos1 = hist[k1] + w1;
                        asm volatile("" ::: "memory");
#if P8_X4_
                        const f32x2 sc0 = SC[i0], sc1 = SC[i1];
                        *(LAS u32x2*)(L + pos0 * 8) = (u32x2){(unsigned)i0 | (pkh2(0.f, sc0.x) & 0xffff0000u), __float_as_uint(g0 * sc0.y)};
                        *(LAS u32x2*)(L + pos1 * 8) = (u32x2){(unsigned)i1 | (pkh2(0.f, sc1.x) & 0xffff0000u), __float_as_uint(g1 * sc1.y)};
#else
                        *(LAS u32x2*)(L + pos0 * 8) = (u32x2){(unsigned)i0, __float_as_uint(g0)};
                        *(LAS u32x2*)(L + pos1 * 8) = (u32x2){(unsigned)i1, __float_as_uint(g1)};
#endif
                        asm volatile("" ::: "memory");
                    }
                }
#if P8_X4_
                u32x4 wa[16], wb[16]; u32x2 ena, enb;
#if P8_PAIR_
                P8_ISSUE_P(wa, ena, 0, 0);
                for (int j = 0; j < 16; ++j) {
                    const int jn = j < 15 ? j + 1 : 15;
#pragma unroll
                    for (int pp = 0; pp < P8_TOK / 2; pp += 2) {
                        P8_STEP_P(wa, ena, pp, wb, enb, pp + 1, j);
                        if (pp + 2 < P8_TOK / 2) P8_STEP_P(wb, enb, pp + 1, wa, ena, pp + 2, j);
                        else P8_STEP_P(wb, enb, pp + 1, wa, ena, 0, jn);
                    }
                }
#else
                P8_ISSUE_W(wa, ena, 0, 0);
                for (int k = 0; k < 8; ++k) {
                    const int kn = k < 7 ? k + 1 : 7;
#pragma unroll
                    for (int tt = 0; tt < P8_TOK; tt += 2) {
                        P8_STEP(wa, ena, tt, wb, enb, tt + 1, k);
                        if (tt + 2 < P8_TOK) P8_STEP(wb, enb, tt + 1, wa, ena, tt + 2, k);
                        else P8_STEP(wb, enb, tt + 1, wa, ena, 0, kn);
                    }
                }
#endif
#else
                u32x2 ua[16], ub[16], va[16], vb[16]; int ida, idb; float ga, gb; f32x2 sa, sb;
                P8_ISSUE_U(ua, ida, ga, sa, 0, 0);
                P8_ISSUE_V(va, ida);
                for (int k = 0; k < 8; ++k) {
                    const int kn = k < 7 ? k + 1 : 7;
#pragma unroll
                    for (int tt = 0; tt < P8_TOK; tt += 2) {
                        P8_STEP(ua, va, ga, sa, tt, ub, vb, idb, gb, sb, tt + 1, k);
                        if (tt + 2 < P8_TOK) P8_STEP(ub, vb, gb, sb, tt + 1, ua, va, ida, ga, sa, tt + 2, k);
                        else P8_STEP(ub, vb, gb, sb, tt + 1, ua, va, ida, ga, sa, 0, kn);
                    }
                }
#endif
                int tok0e = tok0; asm volatile("" : "+s"(tok0e));
                int lane_e = threadIdx.x; asm volatile("" : "+v"(lane_e)); lane_e &= 63;
#pragma unroll
                for (int tt = 0; tt < P8_TOK; ++tt) {
                    const int lane = lane_e;
                    const int tok = tok0e + tt;
                    float x[16];
                    P8_LOAD_X1(x, tok);
                    float sm = 0.f;
                    float o[16];
#pragma unroll
                    for (int j = 0; j < 8; ++j) { o[2 * j] = h_lo(ob[tt][j]); o[2 * j + 1] = h_hi(ob[tt][j]); }
#pragma unroll
                    for (int j = 0; j < 16; ++j) { o[j] = ALPHA * x[j] + o[j]; sm += o[j]; }
                    const float mean = p8_sum(sm, lane) * (1.0f / 1024.0f);
                    float qv = 0.f;
#pragma unroll
                    for (int j = 0; j < 16; ++j) { o[j] -= mean; qv += o[j] * o[j]; }
                    const float rstd = rsqrtf(p8_sum(qv, lane) * (1.0f / 1024.0f) + LN_EPS);
                    const float* gp = lg + lane * 16; const float* bp = lb + lane * 16;
                    float* op = OUT + (size_t)tok * 1024 + lane * 16;
#pragma unroll
                    for (int w = 0; w < 4; ++w) {
                        const f32x4 gg = *(const f32x4*)(gp + 4 * w), hb = *(const f32x4*)(bp + 4 * w);
                        const f32x4 res = (f32x4){o[4 * w], o[4 * w + 1], o[4 * w + 2], o[4 * w + 3]} * rstd * gg + hb;
#if P8_SC1_
                        asm volatile("global_store_dwordx4 %0, %1, off sc1\n\ts_nop 1" :: "v"(op + 4 * w), "v"(res) : "memory");
#else
                        *(f32x4*)(op + 4 * w) = res;
#endif
                    }
                }
            }
        }
    }
}

struct Params { const float* in[23]; float* out; unsigned char* ws; };

__global__ void __launch_bounds__(NTHR, 2) hybrid_fwd(Params p) {
    extern __shared__ __attribute__((aligned(16))) unsigned char lds_raw[];
    LAS unsigned char* lds = (LAS unsigned char*)lds_raw;
    cg::grid_group grid = cg::this_grid();
    Ctx c;
#pragma unroll
    for (int i = 0; i < 23; ++i) c.in[i] = p.in[i];
    c.out = p.out; c.ws = p.ws;
    unsigned char* ws = p.ws;

#ifndef G6_ALIGN
#define G6_ALIGN true
#endif
#ifndef G4_ALIGN
#define G4_ALIGN true
#endif
#ifndef G1_ALIGN
#define G1_ALIGN true
#endif
#ifndef G1_SP2
#define G1_SP2 true
#endif
#ifndef PH_MASK
#define PH_MASK 0x1ff
#endif
#ifndef REP0
#define REP0 1
#endif
#ifndef REP123
#define REP123 1
#endif
#ifndef REP1
#define REP1 1
#endif
#ifndef REP4
#define REP4 1
#endif
#ifndef REP5
#define REP5 1
#endif
#ifndef REP6
#define REP6 1
#endif
#ifndef REP7
#define REP7 1
#endif
#ifndef REP8
#define REP8 1
#endif
    if (threadIdx.x < 4) ((volatile LAS unsigned*)(lds + LDS_BARST))[threadIdx.x] = 0u;
    __syncthreads();
    const XcdBarrier xbar = xcd_barrier_post((unsigned*)(ws + WS_BAR), (volatile LAS unsigned*)(lds + LDS_BARST));
    if (p.ws == nullptr) grid.sync();
#define GSYNC() xcd_barrier(xbar)
    for (int rep = 0; rep < REP0; ++rep) { if (PH_MASK & 1) phase0(c, lds);
    GSYNC(); }
    if (PH_MASK & 1) phase0b(c);
    GSYNC();
    for (int rep123 = 0; rep123 < REP123; ++rep123) {
    for (int rep1 = 0; rep1 < REP1; ++rep1) {
    if (PH_MASK & 2) {
        pg8::Gemm g{(const bf16*)(ws + WS_XQ8), (const bf16*)(ws + WS_WQ8), T, DIN, 512, 512, 512, 0};
        pg8::StaticOrder S; S.init(T, DIN, (int)gridDim.x, (int)blockIdx.x);
        pg8::EpiProj E{(bf16*)(ws + WS_P4), (const float*)(ws + WS_BGS), (const float*)(ws + WS_SXR), (const float*)(ws + WS_SWC)};
        pg8::gemm_phase<pg8::EpiProj, pg8::StaticOrder, G1_ALIGN, G1_SP2>(lds, g, S, E);
    }
    GSYNC(); }
#ifndef REP2A
#define REP2A 1
#endif
#ifndef REP2B
#define REP2B 1
#endif
#ifndef REP3A
#define REP3A 1
#endif
    for (int r2 = 0; r2 < REP2B; ++r2) {
    if (PH_MASK & 4) {
        pg8::Gemm g{(const bf16*)p.out, (const bf16*)(ws + WS_WAX), T, 2048, 128, 1024, 128, 256};
        pg8::StaticOrder S; S.init(T, 2048, (int)gridDim.x, (int)blockIdx.x);
        phase2a(c, S);
        asm volatile("s_waitcnt vmcnt(0)" ::: "memory");
        __syncthreads();
        pg8::EpiGate E{(const bf16*)p.out, (bf16*)(ws + WS_HL), (bf16*)((unsigned char*)p.out + OUT_PC), (float*)(ws + WS_PEND), (float*)(ws + WS_HEND), (const float*)(ws + WS_BAS), (const float*)(ws + WS_BXS), (const float*)(ws + WS_SPT)};
        pg8::gemm_phase<pg8::EpiGate, pg8::StaticOrder, true, true>(lds, g, S, E);
    }
    GSYNC(); }
#ifdef REP2C
    phase2c(c, lds, 0); GSYNC();
#endif
    if (PH_MASK & 4) phase2c(c, lds);
    GSYNC(); }
    for (int rep4 = 0; rep4 < REP4; ++rep4) {
    if (PH_MASK & 16) {
        pg8::Gemm g{(const bf16*)(ws + WS_P4) + 2048, (const bf16*)(ws + WS_WOUT), T, 1024, 1024, 4096, 1024, 0};
        pg8::StaticOrder S; S.init(T, 1024, (int)gridDim.x, (int)blockIdx.x);
        pg8::EpiResid E{(const bf16*)(ws + WS_XB), (bf16*)(ws + WS_Z), 1024, ALPHA, (float*)(ws + WS_PARTZ)};
        pg8::gemm_phase<pg8::EpiResid, pg8::StaticOrder, G4_ALIGN, true>(lds, g, S, E);
    }
    GSYNC(); }
    for (int rep6 = 0; rep6 < REP6; ++rep6) {
    if (PH_MASK & 64) {
#if Q_I8
        pg8::Gemm g{(const bf16*)(ws + WS_X1Q8), (const bf16*)(ws + WS_WQQ8), T, 2048, 512, 512, 512, 0};
        pg8::StaticOrder S; S.init(T, 2048, (int)gridDim.x, (int)blockIdx.x);
        pg8::EpiBf16I8 E{(bf16*)p.out, 2048, (const float*)(ws + WS_SX1), (const float*)(ws + WS_SWQ)};
        pg8::gemm_phase<pg8::EpiBf16I8, pg8::StaticOrder, G6_ALIGN, true>(lds, g, S, E);
#else
        pg8::StaticOrder S; S.init(T, 2048, (int)gridDim.x, (int)blockIdx.x);
        LAS float* tab = (LAS float*)(lds + 131072);
        {
            const int ui = threadIdx.x >> 7; pg8::Unit uu;
            if (S.next(ui, uu)) {
#pragma unroll
                for (int rr = 0; rr < 2; ++rr) {
                    const int rl = (threadIdx.x & 127) * 2 + rr, row = uu.pm * 256 + rl;
                    const f32x4* pp = (const f32x4*)((const float*)(ws + WS_PARTZ) + (size_t)row * 32);
                    float s1 = 0.f, s2 = 0.f;
#pragma unroll
                    for (int k = 0; k < 8; ++k) { const f32x4 v = pp[k]; s1 += v.x + v.z; s2 += v.y + v.w; }
                    const float mean = s1 * (1.0f / 1024.0f), rstd = rsqrtf(fmaxf(s2 * (1.0f / 1024.0f) - mean * mean, 0.f) + LN_EPS);
                    tab[(ui * 256 + rl) * 2] = mean; tab[(ui * 256 + rl) * 2 + 1] = rstd;
                    if (uu.pn == 0) *(f32x2*)((float*)(ws + WS_ST1) + (size_t)row * 2) = (f32x2){mean, rstd};
                }
            }
        }
        __syncthreads();
        pg8::Gemm g{(const bf16*)(ws + WS_Z), (const bf16*)(ws + WS_WQ), T, 2048, 1024, 1024, 1024, 0};
        pg8::EpiQ E{(bf16*)p.out, 2048, (const float*)(ws + WS_CQ), (const float*)(ws + WS_DQ), (const LAS float*)tab, S};
        pg8::gemm_phase<pg8::EpiQ, pg8::StaticOrder, G6_ALIGN, true>(lds, g, S, E);
#endif
    }
    GSYNC(); }
    for (int rep = 0; rep < REP7; ++rep) { if (PH_MASK & 128) phase7(c, lds);
    GSYNC(); }
#ifdef REP8B
    phase8<REP8B>(c, lds, xbar); GSYNC();
#endif
    if (PH_MASK & 256) phase8<0>(c, lds, xbar);
}

extern "C" void kernel_launch(void* const* d_in, const int* in_sizes, int n_in, void* d_out, int out_size,
                              void* d_ws, size_t ws_size, hipStream_t stream) {
    static int grid_blocks = 0;
    if (grid_blocks == 0) {
        if (n_in != 23 || out_size != T * D || ws_size < WS_END) {
            fprintf(stderr, "kernel_launch: unexpected problem (n_in %d, out %d, ws %zu); nothing launched\n", n_in, out_size, ws_size);
            grid_blocks = -1; return;
        }
        int dev = 0, cus = 0, per_cu = 0;
        (void)hipGetDevice(&dev);
        (void)hipDeviceGetAttribute(&cus, hipDeviceAttributeMultiprocessorCount, dev);
        (void)hipFuncSetAttribute((const void*)hybrid_fwd, hipFuncAttributeMaxDynamicSharedMemorySize, LDS_BYTES);
        (void)hipOccupancyMaxActiveBlocksPerMultiprocessor(&per_cu, (const void*)hybrid_fwd, NTHR, LDS_BYTES);
        if (per_cu < 1) { fprintf(stderr, "kernel_launch: occupancy query reports %d blocks per CU\n", per_cu); grid_blocks = -1; return; }
        grid_blocks = cus;
        (void)hipGetLastError();
    }
    if (grid_blocks < 0) return;
    Params p{};
    for (int i = 0; i < 23; ++i) p.in[i] = (const float*)d_in[i];
    p.out = (float*)d_out; p.ws = (unsigned char*)d_ws;
    if (hipMemsetAsync((unsigned char*)d_ws + WS_BAR, 0, XCD_BAR_WORDS * sizeof(unsigned), stream) != hipSuccess) { fprintf(stderr, "kernel_launch: hipMemsetAsync of the barrier words failed; nothing launched\n"); return; }
    void* args[] = {&p};
    hipError_t e = hipLaunchCooperativeKernel((const void*)hybrid_fwd, dim3(grid_blocks), dim3(NTHR), args, LDS_BYTES, stream);
    if (e != hipSuccess) fprintf(stderr, "cooperative launch failed: %s (grid %d)\n", hipGetErrorString(e), grid_blocks);
}
```
